# Optimizing an MI355X kernel written in HIP

```python
import math
import jax, jax.numpy as jnp
from jax import lax
import numpy as np

D_MODEL = 1024
BATCH = 8
SEQ = 2048
DEPTH = 1
DEC_BATCH = 128
DEC_SEQ = 4
PAST_LEN = 16384
PAGE_SIZE = 128

PLE_DIM = 256
D_A = D_MODEL
D_B = D_MODEL
SSD_HEAD_DIM = 64
SSD_HEADS = D_A // SSD_HEAD_DIM
SSD_STATE = 128
SSD_GROUPS = 2
SSD_HPG = SSD_HEADS // SSD_GROUPS
SSD_CHUNK = 128
CONV_K = 4
CONV_DIM = D_A + 2 * SSD_GROUPS * SSD_STATE
S5_CH = 16
S5_GROUPS = D_B // S5_CH
S5_STATE = 64
D_IN = D_A + CONV_DIM + SSD_HEADS + D_B + D_B
EPS = 1e-6
DT_MIN = 1e-3
DT_MAX = 1e-1

kernel_name = 'hymba_ssd_s5_decode_step'


def rmsnorm(x, g):
    xf = x.astype(jnp.float32)
    y = xf * lax.rsqrt(jnp.mean(xf * xf, axis=-1, keepdims=True) + EPS)
    return (y * g.astype(jnp.float32)).astype(x.dtype)


def cmul(ar, ai, br, bi):
    return ar * br - ai * bi, ar * bi + ai * br


def causal_conv(xbc, buf, w, b):
    full = jnp.concatenate([buf.astype(xbc.dtype), xbc], axis=1)
    y = lax.conv_general_dilated(full, w[:, None, :].astype(full.dtype), window_strides=(1,),
                                 padding='VALID', dimension_numbers=('NWC', 'WIO', 'NWC'),
                                 feature_group_count=full.shape[-1])
    return jax.nn.silu(y + b.astype(y.dtype)), full[:, -(CONV_K - 1):, :]


def ssd_scan(x, dt, A, Bm, Cm, h0):
    b, T = x.shape[:2]
    L = math.gcd(T, SSD_CHUNK)
    nc = T // L
    x = x.reshape((b, nc, L) + x.shape[2:])
    dt = dt.reshape((b, nc, L) + dt.shape[2:])
    Bm = Bm.reshape((b, nc, L) + Bm.shape[2:])
    Cm = Cm.reshape((b, nc, L) + Cm.shape[2:])
    Acs = jnp.cumsum(dt * A, axis=2)
    Acs_t = jnp.transpose(Acs, (0, 1, 3, 4, 2))
    seg = Acs_t[..., :, None] - Acs_t[..., None, :]
    causal = jnp.tril(jnp.ones((L, L), dtype=bool))
    decay = jnp.exp(jnp.where(causal, seg, -jnp.inf))
    dt_t = jnp.transpose(dt, (0, 1, 3, 4, 2))
    CB = jnp.einsum('bclgn,bcsgn->bcgls', Cm, Bm)
    M = CB[:, :, :, None] * decay * dt_t[..., None, :]
    y_diag = jnp.einsum('bcgels,bcsgep->bclgep', M, x)
    w_end = jnp.exp(Acs[:, :, -1:] - Acs) * dt
    states = jnp.einsum('bclgn,bclge,bclgep->bcgepn', Bm, w_end, x)
    chunk_decay = jnp.exp(Acs[:, :, -1])

    def step(h, inp):
        s, d = inp
        return d[..., None, None] * h + s, h

    h_final, h_starts = lax.scan(step, h0, (jnp.moveaxis(states, 1, 0), jnp.moveaxis(chunk_decay, 1, 0)))
    h_starts = jnp.moveaxis(h_starts, 0, 1)
    y_off = jnp.einsum('bclgn,bcgepn,bclge->bclgep', Cm, h_starts, jnp.exp(Acs))
    y = (y_diag + y_off).reshape((b, T) + x.shape[3:])
    return y, h_final


def ssd_branch(z, xbc, dt_raw, conv_buf, h0, conv_w, conv_b, dt_bias, a_log, ssd_d, ssd_norm_g):
    f32 = jnp.float32
    b, T, _ = xbc.shape
    xbc, new_buf = causal_conv(xbc, conv_buf, conv_w, conv_b)
    xbc = xbc.astype(f32)
    xs, Bm, Cm = jnp.split(xbc, [D_A, D_A + SSD_GROUPS * SSD_STATE], axis=-1)
    xs = xs.reshape(b, T, SSD_GROUPS, SSD_HPG, SSD_HEAD_DIM)
    Bm = Bm.reshape(b, T, SSD_GROUPS, SSD_STATE)
    Cm = Cm.reshape(b, T, SSD_GROUPS, SSD_STATE)
    dt = jax.nn.softplus(dt_raw.astype(f32) + dt_bias.astype(f32)).reshape(b, T, SSD_GROUPS, SSD_HPG)
    A = -jnp.exp(a_log.astype(f32)).reshape(SSD_GROUPS, SSD_HPG)
    h0 = h0.astype(f32).reshape(b, SSD_GROUPS, SSD_HPG, SSD_HEAD_DIM, SSD_STATE)
    y, hT = ssd_scan(xs, dt, A, Bm, Cm, h0)
    y = y + ssd_d.astype(f32).reshape(SSD_GROUPS, SSD_HPG)[..., None] * xs
    gw = SSD_HPG * SSD_HEAD_DIM
    y = y.reshape(b, T, SSD_GROUPS, gw) * jax.nn.silu(z.astype(f32)).reshape(b, T, SSD_GROUPS, gw)
    y = y * lax.rsqrt(jnp.mean(y * y, axis=-1, keepdims=True) + EPS) * ssd_norm_g.astype(f32).reshape(SSD_GROUPS, gw)
    return y.reshape(b, T, D_A), new_buf, hT.reshape(b, SSD_HEADS, SSD_HEAD_DIM, SSD_STATE)


def s5_branch(u, z, h0_re, h0_im, lam_re, lam_im, log_dt, b_re, b_im, c_re, c_im, s5_d, glu_w, glu_b):
    f32 = jnp.float32
    b, T, _ = u.shape
    uf = u.astype(f32).reshape(b, T, S5_GROUPS, S5_CH)
    lr = lam_re.astype(f32)
    li = lam_im.astype(f32)
    delta = jnp.exp(log_dt.astype(f32))[:, None]
    mag = jnp.exp(lr * delta)
    ab_re = mag * jnp.cos(li * delta)
    ab_im = mag * jnp.sin(li * delta)
    q_re = ab_re - 1.0
    den = lr * lr + li * li
    f_re = (q_re * lr + ab_im * li) / den
    f_im = (ab_im * lr - q_re * li) / den
    bb_re, bb_im = cmul(f_re[..., None], f_im[..., None], b_re.astype(f32), b_im.astype(f32))
    bu_re = jnp.einsum('btgh,gph->btgp', uf, bb_re)
    bu_im = jnp.einsum('btgh,gph->btgp', uf, bb_im)
    a_re = jnp.broadcast_to(ab_re, bu_re.shape)
    a_im = jnp.broadcast_to(ab_im, bu_im.shape)

    def combine(l, r):
        a1r, a1i, b1r, b1i = l
        a2r, a2i, b2r, b2i = r
        ar, ai = cmul(a2r, a2i, a1r, a1i)
        br, bi = cmul(a2r, a2i, b1r, b1i)
        return ar, ai, br + b2r, bi + b2i

    acr, aci, xr, xi = lax.associative_scan(combine, (a_re, a_im, bu_re, bu_im), axis=1)
    pr, pi = cmul(acr, aci, h0_re.astype(f32)[:, None], h0_im.astype(f32)[:, None])
    xr = xr + pr
    xi = xi + pi
    y = (jnp.einsum('btgp,ghp->btgh', xr, c_re.astype(f32))
         - jnp.einsum('btgp,ghp->btgh', xi, c_im.astype(f32))
         + s5_d.astype(f32) * uf).reshape(b, T, D_B)
    g = jax.nn.gelu(y)
    y = g * jax.nn.sigmoid(g @ glu_w.astype(f32) + glu_b.astype(f32))
    y = y * jax.nn.silu(z.astype(f32))
    return y, xr[:, -1], xi[:, -1]


def trunk_layer(h, p, conv_buf, ssd_h, s5_re, s5_im,
                w_in, g_in, conv_w, conv_b, dt_bias, a_log, ssd_d, ssd_norm_g,
                s5_lambda_re, s5_lambda_im, s5_log_dt, s5_b_re, s5_b_im, s5_c_re, s5_c_im, s5_d,
                glu_w, glu_b, w_out, g_ple, w_ple_gate, w_ple_proj):
    n = rmsnorm(h, g_in)
    proj = n @ w_in
    i1 = D_A
    i2 = i1 + CONV_DIM
    i3 = i2 + SSD_HEADS
    i4 = i3 + D_B
    z_a, xbc, dt_raw, z_b, u_b = jnp.split(proj, [i1, i2, i3, i4], axis=-1)
    ya, conv_new, ssd_new = ssd_branch(z_a, xbc, dt_raw, conv_buf, ssd_h, conv_w, conv_b,
                                       dt_bias, a_log, ssd_d, ssd_norm_g)
    yb, s5r_new, s5i_new = s5_branch(u_b, z_b, s5_re, s5_im, s5_lambda_re, s5_lambda_im, s5_log_dt,
                                     s5_b_re, s5_b_im, s5_c_re, s5_c_im, s5_d, glu_w, glu_b)
    mix = jnp.concatenate([ya, yb], axis=-1).astype(h.dtype) @ w_out
    h = h + mix
    gate = jax.nn.sigmoid(rmsnorm(h, g_ple) @ w_ple_gate)
    h = h + (p @ w_ple_proj) * gate
    return h, conv_new, ssd_new, s5r_new, s5i_new


def setup_inputs(seed: int = 0) -> dict:
    key = jax.random.key(seed)
    ks = jax.random.split(key, 40)
    f32 = jnp.float32
    nrm = lambda k, s, sc: jax.random.normal(k, s, f32) * sc
    dt0 = jnp.exp(jax.random.uniform(ks[10], (DEPTH, SSD_HEADS), f32, math.log(DT_MIN), math.log(DT_MAX)))
    lam_im0 = jnp.pi * jnp.arange(S5_STATE, dtype=f32)
    return {
        'x_prompt': nrm(ks[0], (BATCH, SEQ, D_MODEL), 1.0),
        'x_sample': nrm(ks[1], (DEC_BATCH, DEC_SEQ, D_MODEL), 1.0),
        'p_prompt': nrm(ks[2], (DEPTH, BATCH, SEQ, PLE_DIM), 1.0),
        'p_sample': nrm(ks[3], (DEPTH, DEC_BATCH, DEC_SEQ, PLE_DIM), 1.0),
        'state_ssd': nrm(ks[4], (DEPTH, DEC_BATCH, SSD_HEADS, SSD_HEAD_DIM, SSD_STATE), 0.1),
        'state_conv': nrm(ks[5], (DEPTH, DEC_BATCH, CONV_K - 1, CONV_DIM), 1.0),
        'state_s5_re': nrm(ks[6], (DEPTH, DEC_BATCH, S5_GROUPS, S5_STATE), 0.1),
        'state_s5_im': nrm(ks[7], (DEPTH, DEC_BATCH, S5_GROUPS, S5_STATE), 0.1),
        'w_in': nrm(ks[8], (DEPTH, D_MODEL, D_IN), D_MODEL ** -0.5),
        'g_in': 1.0 + nrm(ks[9], (DEPTH, D_MODEL), 0.01),
        'conv_w': nrm(ks[11], (DEPTH, CONV_K, CONV_DIM), 0.5 * CONV_K ** -0.5),
        'conv_b': nrm(ks[12], (DEPTH, CONV_DIM), 0.01),
        'dt_bias': dt0 + jnp.log(-jnp.expm1(-dt0)),
        'a_log': jnp.log(jax.random.uniform(ks[13], (DEPTH, SSD_HEADS), f32, 1.0, 16.0)),
        'ssd_d': 1.0 + nrm(ks[14], (DEPTH, SSD_HEADS), 0.01),
        'ssd_norm_g': 1.0 + nrm(ks[15], (DEPTH, D_A), 0.01),
        's5_lambda_re': -0.5 + nrm(ks[16], (DEPTH, S5_GROUPS, S5_STATE), 0.01),
        's5_lambda_im': lam_im0 + nrm(ks[17], (DEPTH, S5_GROUPS, S5_STATE), 0.01),
        's5_log_dt': jax.random.uniform(ks[18], (DEPTH, S5_GROUPS), f32, math.log(DT_MIN), math.log(DT_MAX)),
        's5_b_re': nrm(ks[19], (DEPTH, S5_GROUPS, S5_STATE, S5_CH), (2 * S5_CH) ** -0.5),
        's5_b_im': nrm(ks[20], (DEPTH, S5_GROUPS, S5_STATE, S5_CH), (2 * S5_CH) ** -0.5),
        's5_c_re': nrm(ks[21], (DEPTH, S5_GROUPS, S5_CH, S5_STATE), S5_STATE ** -0.5),
        's5_c_im': nrm(ks[22], (DEPTH, S5_GROUPS, S5_CH, S5_STATE), S5_STATE ** -0.5),
        's5_d': nrm(ks[23], (DEPTH, S5_GROUPS, S5_CH), 1.0),
        'glu_w': nrm(ks[24], (DEPTH, D_B, D_B), D_B ** -0.5),
        'glu_b': nrm(ks[25], (DEPTH, D_B), 0.01),
        'w_out': nrm(ks[26], (DEPTH, D_A + D_B, D_MODEL), (D_A + D_B) ** -0.5),
        'g_ple': 1.0 + nrm(ks[27], (DEPTH, D_MODEL), 0.01),
        'w_ple_gate': nrm(ks[28], (DEPTH, D_MODEL, D_MODEL), D_MODEL ** -0.5),
        'w_ple_proj': nrm(ks[29], (DEPTH, PLE_DIM, D_MODEL), PLE_DIM ** -0.5),
        'g_final': 1.0 + nrm(ks[30], (D_MODEL,), 0.01),
    }


def reference(x_prompt, x_sample, p_prompt, p_sample, state_ssd, state_conv, state_s5_re, state_s5_im,
              w_in, g_in, conv_w, conv_b, dt_bias, a_log, ssd_d, ssd_norm_g,
              s5_lambda_re, s5_lambda_im, s5_log_dt, s5_b_re, s5_b_im, s5_c_re, s5_c_im, s5_d,
              glu_w, glu_b, w_out, g_ple, w_ple_gate, w_ple_proj, g_final):
    f32 = jnp.float32
    bp = x_prompt.shape[0]
    hp = x_prompt
    hs = x_sample
    ssd_p, conv_p, re_p, im_p = [], [], [], []
    ssd_s, conv_s, re_s, im_s = [], [], [], []
    for i in range(DEPTH):
        lw = (w_in[i], g_in[i], conv_w[i], conv_b[i], dt_bias[i], a_log[i], ssd_d[i], ssd_norm_g[i],
              s5_lambda_re[i], s5_lambda_im[i], s5_log_dt[i], s5_b_re[i], s5_b_im[i], s5_c_re[i],
              s5_c_im[i], s5_d[i], glu_w[i], glu_b[i], w_out[i], g_ple[i], w_ple_gate[i], w_ple_proj[i])
        hp, c_new, s_new, r_new, m_new = trunk_layer(
            hp, p_prompt[i],
            jnp.zeros((bp, CONV_K - 1, CONV_DIM), x_prompt.dtype),
            jnp.zeros((bp, SSD_HEADS, SSD_HEAD_DIM, SSD_STATE), f32),
            jnp.zeros((bp, S5_GROUPS, S5_STATE), f32),
            jnp.zeros((bp, S5_GROUPS, S5_STATE), f32),
            *lw)
        ssd_p.append(s_new)
        conv_p.append(c_new)
        re_p.append(r_new)
        im_p.append(m_new)
        hs, c_new, s_new, r_new, m_new = trunk_layer(
            hs, p_sample[i], state_conv[i], state_ssd[i], state_s5_re[i], state_s5_im[i], *lw)
        ssd_s.append(s_new)
        conv_s.append(c_new)
        re_s.append(r_new)
        im_s.append(m_new)
    y_prompt = rmsnorm(hp, g_final)
    y_sample = rmsnorm(hs, g_final)
    return (y_prompt, y_sample,
            jnp.stack(ssd_p), jnp.stack(conv_p), jnp.stack(re_p), jnp.stack(im_p),
            jnp.stack(ssd_s), jnp.stack(conv_s), jnp.stack(re_s), jnp.stack(im_s))
```

```cpp
#include <hip/hip_runtime.h>
#include <hip/hip_cooperative_groups.h>
#include <cstdio>
namespace cg = cooperative_groups;

typedef unsigned short bf16_t;
typedef short bf16x8 __attribute__((ext_vector_type(8)));
typedef float f32x4 __attribute__((ext_vector_type(4)));
typedef unsigned u32x2 __attribute__((ext_vector_type(2)));
typedef unsigned u32x4 __attribute__((ext_vector_type(4)));
#define DEV __device__ __forceinline__

constexpr int NPROMPT = 16384, NSAMPLE = 512, NTOK = 16896;
constexpr int PLD = 4608;
constexpr int C_ZA = 0, C_ZB = 1024, C_XBC = 2048, C_UB = 3584;
constexpr float EPS = 1e-6f;
constexpr long O_YP = 0, O_YS = 16777216, O_SSDP = 17301504, O_CONVP = 18350080, O_S5RP = 18386944, O_S5IP = 18419712,
               O_SSDS = 18452480, O_CONVS = 35229696, O_S5RS = 35819520, O_S5IS = 36343808, O_END = 36868096;
constexpr size_t W_WTIN = 0;
constexpr size_t W_WTOUT = W_WTIN + 4608ull * 1024 * 2;
constexpr size_t W_WTGLU = W_WTOUT + 1024ull * 2048 * 2;
constexpr size_t W_WTGATE = W_WTGLU + 1024ull * 1024 * 2;
constexpr size_t W_WTPP = W_WTGATE + 1024ull * 1024 * 2;
constexpr size_t W_NB = W_WTPP + 1024ull * 256 * 2;
constexpr size_t W_PB = W_NB + 16896ull * 1024 * 2;
constexpr size_t W_DTR = W_PB + 16896ull * 256 * 2;
constexpr size_t W_ACS = W_DTR + 16896ull * 16 * 4;
constexpr size_t W_CDEC = W_ACS + 16384ull * 16 * 4;
constexpr size_t W_RSS1 = W_CDEC + 8192;
constexpr size_t W_RSS2 = W_RSS1 + 16896ull * 4;
constexpr size_t W_PROJ = W_RSS2 + 16896ull * 4;
constexpr size_t W_PP = W_PROJ + 16896ull * 4608 * 2;
constexpr size_t W_END = W_PP + 16896ull * 1024 * 2;

constexpr int LDS_BYTES = 131072;

struct Params {
    const float* in[31];
    float* out;
    char* ws;
};
enum { I_XP = 0, I_XS, I_PP, I_PS, I_SSD, I_CONV, I_S5R, I_S5I, I_WIN, I_GIN, I_CONVW, I_CONVB, I_DTB, I_ALOG, I_SSDD, I_SSDG,
       I_LRE, I_LIM, I_LDT, I_BRE, I_BIM, I_CRE, I_CIM, I_S5D, I_GLUW, I_GLUB, I_WOUT, I_GPLE, I_WGATE, I_WPP, I_GFIN };

extern __shared__ __attribute__((aligned(16))) char smem[];

DEV unsigned pk2(float lo, float hi) { unsigned r; asm("v_cvt_pk_bf16_f32 %0, %1, %2" : "=v"(r) : "v"(lo), "v"(hi)); return r; }
DEV float bflo(unsigned u) { return __uint_as_float(u << 16); }
DEV float bfhi(unsigned u) { return __uint_as_float(u & 0xffff0000u); }
DEV float wave_sum(float v) {
#pragma unroll
    for (int o = 1; o < 64; o <<= 1) v += __shfl_xor(v, o);
    return v;
}
DEV float siluf(float v) { return v / (1.f + __expf(-v)); }
DEV float sigmf(float v) { return 1.f / (1.f + __expf(-v)); }
DEV float geluf(float y) { float z = 0.7978845608f * (y + 0.044715f * y * y * y); return y / (1.f + __expf(-2.f * z)); }
DEV f32x4 mfma16(bf16x8 a, bf16x8 b, f32x4 c) { return __builtin_amdgcn_mfma_f32_16x16x32_bf16(a, b, c, 0, 0, 0); }
DEV void lds_fence() { asm volatile("s_waitcnt lgkmcnt(0)" ::: "memory"); }

constexpr int BM = 256, BK = 64, HALF = 128, HT = HALF * BK;
DEV int lds_byte(int r, int c) {
    int st = (r >> 4) * 2 + (c >> 5), rr = r & 15, cc = c & 31, ob = rr * 64 + cc * 2;
    return st * 1024 + (ob ^ (((ob >> 9) & 1) << 5));
}
DEV void stage_rc(int b, int& R, int& C) {
    int st = b / 1024, sb = b % 1024, swz = sb ^ (((sb >> 9) & 1) << 5);
    R = (st >> 1) * 16 + swz / 64; C = (st & 1) * 32 + (swz % 64) / 2;
}

#define LAS __attribute__((address_space(3)))
template <class Epi>
DEV void gemm_tile(const bf16_t* __restrict__ A, int lda, const bf16_t* __restrict__ Bt, int ldb, int K, int brow, int bcol, const Epi& epi) {
    LAS unsigned char* lds = (LAS unsigned char*)smem;
    constexpr int HTB = HT * 2;
    const int tid = threadIdx.x, wid = __builtin_amdgcn_readfirstlane(tid >> 6), lane = tid & 63, wr = wid >> 2, wc = wid & 3, fr = lane & 15, fq = lane >> 4;
    unsigned voffA[2], voffB[2];
#pragma unroll
    for (int i = 0; i < 2; ++i) { int R, C; stage_rc(tid * 16 + i * 8192, R, C); voffA[i] = (unsigned)(R * lda + C) * 2u; voffB[i] = (unsigned)(R * ldb + C) * 2u; }
    const size_t kstep = (size_t)(BK * 2), hstepA = (size_t)HALF * lda * 2, hstepB = (size_t)HALF * ldb * 2;
    const unsigned ldsw = (unsigned)wid * 1024u;
    const int aoff = lds_byte(wr * 64 + fr, fq * 8), boff = lds_byte(wc * 32 + fr, fq * 8);
#define SA(b, h) (((b) * 2 + (h)) * HTB)
#define SB(b, h) ((4 + (b) * 2 + (h)) * HTB)
#define STAGE(bufoff, gbase, voff) do { _Pragma("unroll") for (int _i = 0; _i < 2; ++_i) \
        __builtin_amdgcn_global_load_lds((const unsigned*)((const char*)(gbase) + (voff)[_i]), (LAS unsigned*)(lds + (bufoff) + ldsw + _i * 8192), 16, 0, 0); } while (0)
#define LDA(dst, b, h) do { _Pragma("unroll") for (int m = 0; m < 4; ++m) _Pragma("unroll") for (int k = 0; k < 2; ++k) dst[m][k] = *(const LAS bf16x8*)(lds + SA(b, h) + aoff + m * 2048 + k * 1024); } while (0)
#define LDB(dst, b, h) do { _Pragma("unroll") for (int n = 0; n < 2; ++n) _Pragma("unroll") for (int k = 0; k < 2; ++k) dst[n][k] = *(const LAS bf16x8*)(lds + SB(b, h) + boff + n * 2048 + k * 1024); } while (0)
#define MMA(ai, bj, At, Bt_) do { __builtin_amdgcn_s_setprio(1); _Pragma("unroll") for (int m = 0; m < 4; ++m) _Pragma("unroll") for (int n = 0; n < 2; ++n) _Pragma("unroll") for (int k = 0; k < 2; ++k) \
        acc[ai][bj][m][n] = __builtin_amdgcn_mfma_f32_16x16x32_bf16(Bt_[n][k], At[m][k], acc[ai][bj][m][n], 0, 0, 0); __builtin_amdgcn_s_setprio(0); } while (0)
#define WAIT_V(n) asm volatile("s_waitcnt vmcnt(" #n ")" ::: "memory")
#define WAIT_L(n) asm volatile("s_waitcnt lgkmcnt(" #n ")" ::: "memory")
#define BAR __builtin_amdgcn_s_barrier()
#define SCHED __builtin_amdgcn_sched_barrier(0)
    f32x4 acc[2][2][4][2];
#pragma unroll
    for (int a = 0; a < 2; ++a)
#pragma unroll
        for (int b = 0; b < 2; ++b)
#pragma unroll
            for (int m = 0; m < 4; ++m)
#pragma unroll
                for (int n = 0; n < 2; ++n) acc[a][b][m][n] = (f32x4){0.f, 0.f, 0.f, 0.f};
    bf16x8 At[4][2], B0[2][2], B1[2][2];
    const int nt = K / BK;
    const char* cA = (const char*)A + (size_t)brow * lda * 2; const char* cB = (const char*)Bt + (size_t)bcol * ldb * 2;
    STAGE(SB(0, 0), cB, voffB); STAGE(SA(0, 0), cA, voffA); STAGE(SB(0, 1), cB + hstepB, voffB); STAGE(SA(0, 1), cA + hstepA, voffA);
    if (wr == 1) BAR;
    WAIT_V(4); BAR;
    STAGE(SB(1, 0), cB + kstep, voffB); STAGE(SA(1, 0), cA + kstep, voffA); STAGE(SB(1, 1), cB + hstepB + kstep, voffB);
    WAIT_V(6); BAR;
    for (int t = 0; t < nt - 2; t += 2) {
        const char* a1 = cA + (size_t)(t + 1) * kstep;
        const char* a2 = cA + (size_t)(t + 2) * kstep; const char* b2 = cB + (size_t)(t + 2) * kstep;
        const char* a3 = a2 + kstep; const char* b3 = b2 + kstep;
        LDB(B0, 0, 0); SCHED; LDA(At, 0, 0); STAGE(SA(1, 1), a1 + hstepA, voffA);
        WAIT_L(8); BAR; WAIT_L(0); MMA(0, 0, At, B0); BAR; SCHED;
        LDB(B1, 0, 1); STAGE(SB(0, 0), b2, voffB);
        BAR; WAIT_L(0); MMA(0, 1, At, B1); BAR;
        LDA(At, 0, 1); STAGE(SA(0, 0), a2, voffA);
        BAR; WAIT_L(0); MMA(1, 0, At, B0); BAR; SCHED;
        STAGE(SB(0, 1), b2 + hstepB, voffB);
        WAIT_V(6); BAR; MMA(1, 1, At, B1); BAR;
        LDB(B0, 1, 0); SCHED; LDA(At, 1, 0); STAGE(SA(0, 1), a2 + hstepA, voffA);
        WAIT_L(8); BAR; WAIT_L(0); MMA(0, 0, At, B0); BAR; SCHED;
        LDB(B1, 1, 1); STAGE(SB(1, 0), b3, voffB);
        BAR; WAIT_L(0); MMA(0, 1, At, B1); BAR;
        LDA(At, 1, 1); STAGE(SA(1, 0), a3, voffA);
        BAR; WAIT_L(0); MMA(1, 0, At, B0); BAR; SCHED;
        STAGE(SB(1, 1), b3 + hstepB, voffB);
        WAIT_V(6); BAR; MMA(1, 1, At, B1); BAR;
    }
    { const char* a1 = cA + (size_t)(nt - 1) * kstep;
      LDB(B0, 0, 0); LDA(At, 0, 0); STAGE(SA(1, 1), a1 + hstepA, voffA);
      BAR; WAIT_L(0); MMA(0, 0, At, B0); BAR;
      LDB(B1, 0, 1); BAR; WAIT_L(0); MMA(0, 1, At, B1); BAR;
      LDA(At, 0, 1); WAIT_V(4); BAR; WAIT_L(0); MMA(1, 0, At, B0); MMA(1, 1, At, B1); BAR; }
    { LDB(B0, 1, 0); LDA(At, 1, 0); WAIT_V(2); BAR; WAIT_L(0); MMA(0, 0, At, B0); BAR;
      LDB(B1, 1, 1); WAIT_V(0); BAR; WAIT_L(0); MMA(0, 1, At, B1); BAR;
      LDA(At, 1, 1); BAR; WAIT_L(0); MMA(1, 0, At, B0); MMA(1, 1, At, B1); BAR; }
    if (wr == 0) BAR;
    epi(acc, brow, bcol, wr, wc, fr, fq);
    __syncthreads();
#undef SA
#undef SB
#undef STAGE
#undef LDA
#undef LDB
#undef MMA
}

DEV void tile_of(int L, int nM, int nN, int& pm, int& pn) {
    const int nwg = nM * nN; int wgid = L;
    { const int q = nwg / 8, r = nwg % 8, xcd = wgid % 8, off = wgid / 8; wgid = (xcd < r ? xcd * (q + 1) : r * (q + 1) + (xcd - r) * q) + off; }
    const int nig = 8 * nN, gid = wgid / nig, fm = gid * 8, gsz = (nM - fm) < 8 ? (nM - fm) : 8;
    pm = fm + ((wgid % nig) % gsz); pn = (wgid % nig) / gsz;
}

struct EpiBf16 {
    bf16_t* dst; int ld;
    DEV void operator()(const f32x4 (&acc)[2][2][4][2], int brow, int bcol, int wr, int wc, int fr, int fq) const {
#pragma unroll
        for (int ai = 0; ai < 2; ++ai)
#pragma unroll
            for (int m = 0; m < 4; ++m) {
                const int row = brow + ai * 128 + wr * 64 + m * 16 + fr;
                bf16_t* rp = dst + (long)row * ld + bcol + wc * 32 + fq * 4;
#pragma unroll
                for (int bj = 0; bj < 2; ++bj)
#pragma unroll
                    for (int n = 0; n < 2; ++n) {
                        const f32x4 v = acc[ai][bj][m][n];
                        u32x2 o; o.x = pk2(v[0], v[1]); o.y = pk2(v[2], v[3]);
                        *(u32x2*)(rp + bj * 128 + n * 16) = o;
                    }
            }
    }
};
struct EpiGlu {
    bf16_t* proj; const float* glu_b;
    DEV void operator()(const f32x4 (&acc)[2][2][4][2], int brow, int bcol, int wr, int wc, int fr, int fq) const {
#pragma unroll
        for (int ai = 0; ai < 2; ++ai)
#pragma unroll
            for (int m = 0; m < 4; ++m) {
                const int row = brow + ai * 128 + wr * 64 + m * 16 + fr;
#pragma unroll
                for (int bj = 0; bj < 2; ++bj)
#pragma unroll
                    for (int n = 0; n < 2; ++n) {
                        const int col = bcol + bj * 128 + wc * 32 + n * 16 + fq * 4;
                        const f32x4 v = acc[ai][bj][m][n];
                        const f32x4 bb = *(const f32x4*)(glu_b + col);
                        const u32x2 gg = *(const u32x2*)(proj + (long)row * PLD + C_UB + col);
                        u32x2* zp = (u32x2*)(proj + (long)row * PLD + C_ZB + col);
                        const u32x2 zz = *zp;
                        float g0 = bflo(gg.x), g1 = bfhi(gg.x), g2 = bflo(gg.y), g3 = bfhi(gg.y);
                        float z0 = bflo(zz.x), z1 = bfhi(zz.x), z2 = bflo(zz.y), z3 = bfhi(zz.y);
                        float y0 = g0 * sigmf(v[0] + bb[0]) * siluf(z0), y1 = g1 * sigmf(v[1] + bb[1]) * siluf(z1);
                        float y2 = g2 * sigmf(v[2] + bb[2]) * siluf(z2), y3 = g3 * sigmf(v[3] + bb[3]) * siluf(z3);
                        u32x2 o; o.x = pk2(y0, y1); o.y = pk2(y2, y3);
                        *zp = o;
                    }
            }
    }
};
struct EpiOut {
    const float* xp; const float* xs; float* out; bf16_t* h1b; float* rss;
    DEV void operator()(const f32x4 (&acc)[2][2][4][2], int brow, int bcol, int wr, int wc, int fr, int fq) const {
#pragma unroll
        for (int ai = 0; ai < 2; ++ai)
#pragma unroll
            for (int m = 0; m < 4; ++m) {
                const int row = brow + ai * 128 + wr * 64 + m * 16 + fr;
                const float* xrow = row < NPROMPT ? xp + (long)row * 1024 : xs + (long)(row - NPROMPT) * 1024;
                float ss = 0.f;
#pragma unroll
                for (int bj = 0; bj < 2; ++bj)
#pragma unroll
                    for (int n = 0; n < 2; ++n) {
                        const int col = bcol + bj * 128 + wc * 32 + n * 16 + fq * 4;
                        f32x4 v = acc[ai][bj][m][n] + *(const f32x4*)(xrow + col);
                        *(f32x4*)(out + (long)row * 1024 + col) = v;
                        u32x2 o; o.x = pk2(v[0], v[1]); o.y = pk2(v[2], v[3]);
                        *(u32x2*)(h1b + (long)row * 1024 + col) = o;
                        ss += v[0] * v[0] + v[1] * v[1] + v[2] * v[2] + v[3] * v[3];
                    }
                ss += __shfl_xor(ss, 16); ss += __shfl_xor(ss, 32);
                if (fq == 0) atomicAdd(rss + row, ss);
            }
    }
};
struct EpiPle {
    float* out; const bf16_t* pp; const float* rss1; float* rss2;
    DEV void operator()(const f32x4 (&acc)[2][2][4][2], int brow, int bcol, int wr, int wc, int fr, int fq) const {
#pragma unroll
        for (int ai = 0; ai < 2; ++ai)
#pragma unroll
            for (int m = 0; m < 4; ++m) {
                const int row = brow + ai * 128 + wr * 64 + m * 16 + fr;
                const float rstd = rsqrtf(rss1[row] * (1.f / 1024.f) + EPS);
                float ss = 0.f;
#pragma unroll
                for (int bj = 0; bj < 2; ++bj)
#pragma unroll
                    for (int n = 0; n < 2; ++n) {
                        const int col = bcol + bj * 128 + wc * 32 + n * 16 + fq * 4;
                        const f32x4 a = acc[ai][bj][m][n];
                        float* hp = out + (long)row * 1024 + col;
                        f32x4 h = *(const f32x4*)hp;
                        const u32x2 pv = *(const u32x2*)(pp + (long)row * 1024 + col);
                        h[0] += bflo(pv.x) * sigmf(a[0] * rstd); h[1] += bfhi(pv.x) * sigmf(a[1] * rstd);
                        h[2] += bflo(pv.y) * sigmf(a[2] * rstd); h[3] += bfhi(pv.y) * sigmf(a[3] * rstd);
                        *(f32x4*)hp = h;
                        ss += h[0] * h[0] + h[1] * h[1] + h[2] * h[2] + h[3] * h[3];
                    }
                ss += __shfl_xor(ss, 16); ss += __shfl_xor(ss, 32);
                if (fq == 0) atomicAdd(rss2 + row, ss);
            }
    }
};

DEV void transpose_tile(const float* __restrict__ src, int ldsrc, int k0, int c0, bf16_t* __restrict__ dst, int lddst, int n0,
                        const float* __restrict__ kscale, float* tile) {
    const int tid = threadIdx.x;
    const int c = tid & 63, r0 = tid >> 6;
#pragma unroll
    for (int i = 0; i < 8; ++i) {
        const int r = r0 + i * 8; float v = src[(long)(k0 + r) * ldsrc + c0 + c];
        if (kscale) v *= kscale[k0 + r];
        tile[r * 65 + c] = v;
    }
    __syncthreads();
    const int n = tid >> 3, kc = tid & 7;
    u32x4 o;
    o.x = pk2(tile[(kc * 8 + 0) * 65 + n], tile[(kc * 8 + 1) * 65 + n]);
    o.y = pk2(tile[(kc * 8 + 2) * 65 + n], tile[(kc * 8 + 3) * 65 + n]);
    o.z = pk2(tile[(kc * 8 + 4) * 65 + n], tile[(kc * 8 + 5) * 65 + n]);
    o.w = pk2(tile[(kc * 8 + 6) * 65 + n], tile[(kc * 8 + 7) * 65 + n]);
    *(u32x4*)(dst + (long)(n0 + n) * lddst + k0 + kc * 8) = o;
    __syncthreads();
}

DEV void phase0(const Params& P) {
    const int tid = threadIdx.x, lane = tid & 63, wave = tid >> 6, G = gridDim.x, bid = blockIdx.x;
    char* ws = P.ws;
    float* tile = (float*)smem;
    constexpr int T_IN = 72 * 16, T_OUT = 16 * 32, T_GLU = 16 * 16, T_GATE = 16 * 16, T_PP = 16 * 4;
    constexpr int T_ALL = T_IN + T_OUT + T_GLU + T_GATE + T_PP;
    for (int it = bid; it < T_ALL; it += G) {
        int r = it;
        if (r < T_IN) {
            const int nb = r >> 4, kb = r & 15, n0 = nb * 64;
            int c0;
            if (n0 < 1024) c0 = n0; else if (n0 < 2048) c0 = 2576 + (n0 - 1024); else if (n0 < 3584) c0 = 1024 + (n0 - 2048); else c0 = 3600 + (n0 - 3584);
            transpose_tile(P.in[I_WIN], 4624, kb * 64, c0, (bf16_t*)(ws + W_WTIN), 1024, n0, nullptr, tile); continue;
        }
        r -= T_IN;
        if (r < T_OUT) { const int nb = r >> 5, kb = r & 31; transpose_tile(P.in[I_WOUT], 1024, kb * 64, nb * 64, (bf16_t*)(ws + W_WTOUT), 2048, nb * 64, nullptr, tile); continue; }
        r -= T_OUT;
        if (r < T_GLU) { const int nb = r >> 4, kb = r & 15; transpose_tile(P.in[I_GLUW], 1024, kb * 64, nb * 64, (bf16_t*)(ws + W_WTGLU), 1024, nb * 64, nullptr, tile); continue; }
        r -= T_GLU;
        if (r < T_GATE) { const int nb = r >> 4, kb = r & 15; transpose_tile(P.in[I_WGATE], 1024, kb * 64, nb * 64, (bf16_t*)(ws + W_WTGATE), 1024, nb * 64, P.in[I_GPLE], tile); continue; }
        r -= T_GATE;
        { const int nb = r >> 2, kb = r & 3; transpose_tile(P.in[I_WPP], 1024, kb * 64, nb * 64, (bf16_t*)(ws + W_WTPP), 256, nb * 64, nullptr, tile); }
    }
    float* wdt = (float*)smem;
    for (int idx = tid; idx < 16 * 1024; idx += 512) { const int k = idx >> 4, e = idx & 15; wdt[e * 1024 + k] = P.in[I_WIN][(long)k * 4624 + 2560 + e]; }
    __syncthreads();
    bf16_t* nb_ = (bf16_t*)(ws + W_NB);
    float* dtr = (float*)(ws + W_DTR);
    for (int row = bid * 8 + wave; row < NTOK; row += G * 8) {
        const float* xr = row < NPROMPT ? P.in[I_XP] + (long)row * 1024 : P.in[I_XS] + (long)(row - NPROMPT) * 1024;
        f32x4 v[4]; float s = 0.f;
#pragma unroll
        for (int j = 0; j < 4; ++j) { v[j] = *(const f32x4*)(xr + j * 256 + lane * 4); s += v[j][0] * v[j][0] + v[j][1] * v[j][1] + v[j][2] * v[j][2] + v[j][3] * v[j][3]; }
        s = wave_sum(s);
        const float rstd = rsqrtf(s * (1.f / 1024.f) + EPS);
#pragma unroll
        for (int j = 0; j < 4; ++j) {
            const f32x4 g = *(const f32x4*)(P.in[I_GIN] + j * 256 + lane * 4);
            v[j] = v[j] * rstd * g;
            u32x2 o; o.x = pk2(v[j][0], v[j][1]); o.y = pk2(v[j][2], v[j][3]);
            *(u32x2*)(nb_ + (long)row * 1024 + j * 256 + lane * 4) = o;
        }
        float outv = 0.f;
#pragma unroll
        for (int e = 0; e < 16; ++e) {
            float a = 0.f;
#pragma unroll
            for (int j = 0; j < 4; ++j) { const f32x4 w = *(const f32x4*)(wdt + e * 1024 + j * 256 + lane * 4); a += v[j][0] * w[0] + v[j][1] * w[1] + v[j][2] * w[2] + v[j][3] * w[3]; }
            a = wave_sum(a);
            if (lane == e) outv = a;
        }
        if (lane < 16) dtr[(long)row * 16 + lane] = outv;
    }
    bf16_t* pb = (bf16_t*)(ws + W_PB);
    for (int idx = bid * 512 + tid; idx < NTOK * 64; idx += G * 512) {
        const int row = idx >> 6, c4 = (idx & 63) * 4;
        const float* src = row < NPROMPT ? P.in[I_PP] + (long)row * 256 : P.in[I_PS] + (long)(row - NPROMPT) * 256;
        const f32x4 v = *(const f32x4*)(src + c4);
        u32x2 o; o.x = pk2(v[0], v[1]); o.y = pk2(v[2], v[3]);
        *(u32x2*)(pb + (long)row * 256 + c4) = o;
    }
    float* rss = (float*)(ws + W_RSS1);
    for (int idx = bid * 512 + tid; idx < 2 * NTOK; idx += G * 512) rss[idx] = 0.f;
    __syncthreads();
}

DEV void conv4x8(const bf16_t* __restrict__ pcol, long row0, int t0, const float* __restrict__ hist, const float* __restrict__ cw, const float* __restrict__ cb, float (&o)[4][8]) {
    float raw[7][8];
#pragma unroll
    for (int i = 0; i < 7; ++i) {
        const int t = t0 - 3 + i;
        if (t >= 0) {
            const u32x4 u = *(const u32x4*)(pcol + (row0 - 3 + i) * PLD);
            raw[i][0] = bflo(u.x); raw[i][1] = bfhi(u.x); raw[i][2] = bflo(u.y); raw[i][3] = bfhi(u.y);
            raw[i][4] = bflo(u.z); raw[i][5] = bfhi(u.z); raw[i][6] = bflo(u.w); raw[i][7] = bfhi(u.w);
        } else if (hist) {
            const f32x4 a = *(const f32x4*)(hist + (long)(t + 3) * 1536), b = *(const f32x4*)(hist + (long)(t + 3) * 1536 + 4);
            raw[i][0] = a[0]; raw[i][1] = a[1]; raw[i][2] = a[2]; raw[i][3] = a[3]; raw[i][4] = b[0]; raw[i][5] = b[1]; raw[i][6] = b[2]; raw[i][7] = b[3];
        } else {
#pragma unroll
            for (int c = 0; c < 8; ++c) raw[i][c] = 0.f;
        }
    }
    float w[4][8], bias[8];
#pragma unroll
    for (int k = 0; k < 4; ++k) {
        const f32x4 a = *(const f32x4*)(cw + k * 1536), b = *(const f32x4*)(cw + k * 1536 + 4);
        w[k][0] = a[0]; w[k][1] = a[1]; w[k][2] = a[2]; w[k][3] = a[3]; w[k][4] = b[0]; w[k][5] = b[1]; w[k][6] = b[2]; w[k][7] = b[3];
    }
    { const f32x4 a = *(const f32x4*)(cb), b = *(const f32x4*)(cb + 4);
      bias[0] = a[0]; bias[1] = a[1]; bias[2] = a[2]; bias[3] = a[3]; bias[4] = b[0]; bias[5] = b[1]; bias[6] = b[2]; bias[7] = b[3]; }
#pragma unroll
    for (int j = 0; j < 4; ++j)
#pragma unroll
        for (int c = 0; c < 8; ++c) {
            float a = bias[c];
#pragma unroll
            for (int k = 0; k < 4; ++k) a += w[k][c] * raw[j + k][c];
            o[j][c] = siluf(a);
        }
}

constexpr int PIT = 136;
constexpr int R1_OFF = 0, R2_OFF = 128 * PIT * 2, R3_OFF = 2 * 128 * PIT * 2, R4_OFF = 3 * 128 * PIT * 2;

DEV void ssd_s1_item(const Params& P, int item) {
    const int tid = threadIdx.x, lane = tid & 63, w = tid >> 6, fr = lane & 15, fq = lane >> 4;
    const int b = item >> 5, c = (item >> 1) & 15, g = item & 1;
    char* ws = P.ws;
    const bf16_t* proj = (const bf16_t*)(ws + W_PROJ);
    const long rowc = (long)b * 2048 + c * 128;
    bf16_t* R1 = (bf16_t*)(smem + R1_OFF); bf16_t* R2 = (bf16_t*)(smem + R2_OFF); bf16_t* R3 = (bf16_t*)(smem + R3_OFF);
    float* acs = (float*)(smem + R4_OFF);
    float* dtv = acs + 1024;
    {
        const int h = g * 8 + w;
        const float bias = P.in[I_DTB][h], A = -__expf(P.in[I_ALOG][h]);
        const float* dtr = (const float*)(ws + W_DTR);
        float x0 = dtr[(rowc + 2 * lane) * 16 + h] + bias, x1 = dtr[(rowc + 2 * lane + 1) * 16 + h] + bias;
        float d0 = x0 > 20.f ? x0 : log1pf(__expf(x0)), d1 = x1 > 20.f ? x1 : log1pf(__expf(x1));
        float a0 = d0 * A, a1 = a0 + d1 * A;
        float run = a1;
#pragma unroll
        for (int o = 1; o < 64; o <<= 1) { float t = __shfl_up(run, o); if (lane >= o) run += t; }
        const float excl = run - a1;
        a0 += excl; a1 += excl;
        acs[w * 128 + 2 * lane] = a0; acs[w * 128 + 2 * lane + 1] = a1;
        dtv[w * 128 + 2 * lane] = d0; dtv[w * 128 + 2 * lane + 1] = d1;
        float* acsg = (float*)(ws + W_ACS) + (((long)b * 16 + c) * 16 + h) * 128;
        acsg[2 * lane] = a0; acsg[2 * lane + 1] = a1;
        if (lane == 63) ((float*)(ws + W_CDEC))[(b * 16 + c) * 16 + h] = __expf(a1);
    }
    {
        const int nblk = tid & 15, lq = tid >> 4, l0 = lq * 4;
#pragma unroll
        for (int j = 0; j < 2; ++j) {
            const int ch0 = 1024 + j * 256 + g * 128 + nblk * 8;
            float o[4][8];
            conv4x8(proj + C_XBC + ch0, rowc + l0, c * 128 + l0, nullptr, P.in[I_CONVW] + ch0, P.in[I_CONVB] + ch0, o);
            bf16_t* dst = j == 0 ? R2 : R1;
#pragma unroll
            for (int r = 0; r < 4; ++r) {
                u32x4 q; q.x = pk2(o[r][0], o[r][1]); q.y = pk2(o[r][2], o[r][3]); q.z = pk2(o[r][4], o[r][5]); q.w = pk2(o[r][6], o[r][7]);
                *(u32x4*)(dst + (l0 + r) * PIT + nblk * 8) = q;
            }
            if (j == 0) {
#pragma unroll
                for (int i = 0; i < 8; ++i) {
                    u32x2 q; q.x = pk2(o[0][i], o[1][i]); q.y = pk2(o[2][i], o[3][i]);
                    *(u32x2*)(R3 + (nblk * 8 + i) * PIT + l0) = q;
                }
            }
        }
    }
    __syncthreads();
    const int wr = w >> 1, wc = w & 1;
    f32x4 cbm[2][4];
#pragma unroll
    for (int m = 0; m < 2; ++m)
#pragma unroll
        for (int n = 0; n < 4; ++n) cbm[m][n] = (f32x4){0.f, 0.f, 0.f, 0.f};
#pragma unroll
    for (int ks = 0; ks < 4; ++ks) {
        bf16x8 af[2], bfm[4];
#pragma unroll
        for (int m = 0; m < 2; ++m) af[m] = *(const bf16x8*)(R1 + (wr * 32 + m * 16 + fr) * PIT + ks * 32 + fq * 8);
#pragma unroll
        for (int n = 0; n < 4; ++n) bfm[n] = *(const bf16x8*)(R2 + (wc * 64 + n * 16 + fr) * PIT + ks * 32 + fq * 8);
#pragma unroll
        for (int m = 0; m < 2; ++m)
#pragma unroll
            for (int n = 0; n < 4; ++n) cbm[m][n] = mfma16(bfm[n], af[m], cbm[m][n]);
    }
    __syncthreads();
    bf16_t* XT = R2; bf16_t* XW = R2 + 64 * PIT;
    bf16_t* ydg = (bf16_t*)(ws + W_NB);
    float* states = P.out;
    const int wp = w >> 2, wn = w & 3;
    for (int e = 0; e < 8; ++e) {
        const int h = g * 8 + e;
        if (tid < 256) {
            const int pblk = tid & 7, lq = tid >> 3, l0 = lq * 4, ch0 = h * 64 + pblk * 8;
            float o[4][8];
            conv4x8(proj + C_XBC + ch0, rowc + l0, c * 128 + l0, nullptr, P.in[I_CONVW] + ch0, P.in[I_CONVB] + ch0, o);
            const float alast = acs[e * 128 + 127];
            float we[4];
#pragma unroll
            for (int r = 0; r < 4; ++r) we[r] = __expf(alast - acs[e * 128 + l0 + r]) * dtv[e * 128 + l0 + r];
#pragma unroll
            for (int i = 0; i < 8; ++i) {
                u32x2 q; q.x = pk2(o[0][i], o[1][i]); q.y = pk2(o[2][i], o[3][i]);
                *(u32x2*)(XT + (pblk * 8 + i) * PIT + l0) = q;
                u32x2 q2; q2.x = pk2(o[0][i] * we[0], o[1][i] * we[1]); q2.y = pk2(o[2][i] * we[2], o[3][i] * we[3]);
                *(u32x2*)(XW + (pblk * 8 + i) * PIT + l0) = q2;
            }
        }
#pragma unroll
        for (int m = 0; m < 2; ++m) {
            const int l = wr * 32 + m * 16 + fr; const float al = acs[e * 128 + l];
#pragma unroll
            for (int n = 0; n < 4; ++n) {
                const int s0 = wc * 64 + n * 16 + fq * 4;
                const f32x4 as = *(const f32x4*)(acs + e * 128 + s0), ds = *(const f32x4*)(dtv + e * 128 + s0);
                float v[4];
#pragma unroll
                for (int r = 0; r < 4; ++r) { const float t = cbm[m][n][r] * __expf(al - as[r]) * ds[r]; v[r] = (s0 + r <= l) ? t : 0.f; }
                u32x2 q; q.x = pk2(v[0], v[1]); q.y = pk2(v[2], v[3]);
                *(u32x2*)(R1 + l * PIT + s0) = q;
            }
        }
        __syncthreads();
        {
            f32x4 yd[2][2];
#pragma unroll
            for (int m = 0; m < 2; ++m)
#pragma unroll
                for (int n = 0; n < 2; ++n) yd[m][n] = (f32x4){0.f, 0.f, 0.f, 0.f};
            for (int ks = 0; ks <= wr; ++ks) {
                bf16x8 af[2], bfm[2];
#pragma unroll
                for (int m = 0; m < 2; ++m) af[m] = *(const bf16x8*)(R1 + (wr * 32 + m * 16 + fr) * PIT + ks * 32 + fq * 8);
#pragma unroll
                for (int n = 0; n < 2; ++n) bfm[n] = *(const bf16x8*)(XT + (wc * 32 + n * 16 + fr) * PIT + ks * 32 + fq * 8);
#pragma unroll
                for (int m = 0; m < 2; ++m)
#pragma unroll
                    for (int n = 0; n < 2; ++n) yd[m][n] = mfma16(bfm[n], af[m], yd[m][n]);
            }
#pragma unroll
            for (int m = 0; m < 2; ++m)
#pragma unroll
                for (int n = 0; n < 2; ++n) {
                    const int l = wr * 32 + m * 16 + fr, p0 = wc * 32 + n * 16 + fq * 4;
                    u32x2 q; q.x = pk2(yd[m][n][0], yd[m][n][1]); q.y = pk2(yd[m][n][2], yd[m][n][3]);
                    *(u32x2*)(ydg + (rowc + l) * 1024 + h * 64 + p0) = q;
                }
        }
        {
            f32x4 st[2][2];
#pragma unroll
            for (int m = 0; m < 2; ++m)
#pragma unroll
                for (int n = 0; n < 2; ++n) st[m][n] = (f32x4){0.f, 0.f, 0.f, 0.f};
#pragma unroll
            for (int ks = 0; ks < 4; ++ks) {
                bf16x8 af[2], bfm[2];
#pragma unroll
                for (int m = 0; m < 2; ++m) af[m] = *(const bf16x8*)(XW + (wp * 32 + m * 16 + fr) * PIT + ks * 32 + fq * 8);
#pragma unroll
                for (int n = 0; n < 2; ++n) bfm[n] = *(const bf16x8*)(R3 + (wn * 32 + n * 16 + fr) * PIT + ks * 32 + fq * 8);
#pragma unroll
                for (int m = 0; m < 2; ++m)
#pragma unroll
                    for (int n = 0; n < 2; ++n) st[m][n] = mfma16(bfm[n], af[m], st[m][n]);
            }
            float* sp = states + (((long)b * 16 + c) * 16 + h) * 8192;
#pragma unroll
            for (int m = 0; m < 2; ++m)
#pragma unroll
                for (int n = 0; n < 2; ++n) {
                    const int p = wp * 32 + m * 16 + fr, n0 = wn * 32 + n * 16 + fq * 4;
                    *(f32x4*)(sp + p * 128 + n0) = st[m][n];
                }
        }
        __syncthreads();
    }
}

DEV void ssd_s2(const Params& P) {
    float* states = P.out;
    const float* cdec = (const float*)(P.ws + W_CDEC);
    for (int idx = blockIdx.x * 512 + threadIdx.x; idx < 262144; idx += gridDim.x * 512) {
        const int bh = idx >> 11, q = idx & 2047, b = bh >> 4, h = bh & 15;
        f32x4 H = (f32x4){0.f, 0.f, 0.f, 0.f};
#pragma unroll
        for (int c = 0; c < 16; ++c) {
            f32x4* ptr = (f32x4*)(states + (((long)b * 16 + c) * 16 + h) * 8192) + q;
            const f32x4 s = *ptr; *ptr = H;
            const float d = cdec[(b * 16 + c) * 16 + h];
            H = H * d + s;
        }
        *((f32x4*)(P.out + O_SSDP + (long)bh * 8192) + q) = H;
    }
}

DEV void ssd_s3_item(const Params& P, int item) {
    const int tid = threadIdx.x, lane = tid & 63, w = tid >> 6, fr = lane & 15, fq = lane >> 4;
    const int b = item >> 5, c = (item >> 1) & 15, g = item & 1;
    char* ws = P.ws;
    bf16_t* proj = (bf16_t*)(ws + W_PROJ);
    const long rowc = (long)b * 2048 + c * 128;
    bf16_t* R1 = (bf16_t*)(smem + R1_OFF); bf16_t* HB = (bf16_t*)(smem + R2_OFF);
    float* ssq = (float*)(smem + R4_OFF);
    const bf16_t* ydg = (const bf16_t*)(ws + W_NB);
    const float* states = P.out;
    const float* acsg = (const float*)(ws + W_ACS);
    {
        const int nblk = tid & 15, lq = tid >> 4, l0 = lq * 4;
        const int ch0 = 1280 + g * 128 + nblk * 8;
        float o[4][8];
        conv4x8(proj + C_XBC + ch0, rowc + l0, c * 128 + l0, nullptr, P.in[I_CONVW] + ch0, P.in[I_CONVB] + ch0, o);
#pragma unroll
        for (int r = 0; r < 4; ++r) {
            u32x4 q; q.x = pk2(o[r][0], o[r][1]); q.y = pk2(o[r][2], o[r][3]); q.z = pk2(o[r][4], o[r][5]); q.w = pk2(o[r][6], o[r][7]);
            *(u32x4*)(R1 + (l0 + r) * PIT + nblk * 8) = q;
        }
        if (tid < 128) ssq[tid] = 0.f;
    }
    const int wr = w >> 1, wc = w & 1;
    for (int e = 0; e < 8; ++e) {
        const int h = g * 8 + e;
        __syncthreads();
        {
            const int p = tid >> 3, n0 = (tid & 7) * 16;
            const float* sp = states + (((long)b * 16 + c) * 16 + h) * 8192 + p * 128 + n0;
            const f32x4 a0 = *(const f32x4*)(sp), a1 = *(const f32x4*)(sp + 4), a2 = *(const f32x4*)(sp + 8), a3 = *(const f32x4*)(sp + 12);
            u32x4 q0, q1;
            q0.x = pk2(a0[0], a0[1]); q0.y = pk2(a0[2], a0[3]); q0.z = pk2(a1[0], a1[1]); q0.w = pk2(a1[2], a1[3]);
            q1.x = pk2(a2[0], a2[1]); q1.y = pk2(a2[2], a2[3]); q1.z = pk2(a3[0], a3[1]); q1.w = pk2(a3[2], a3[3]);
            *(u32x4*)(HB + p * PIT + n0) = q0; *(u32x4*)(HB + p * PIT + n0 + 8) = q1;
        }
        __syncthreads();
        f32x4 yo[2][2];
#pragma unroll
        for (int m = 0; m < 2; ++m)
#pragma unroll
            for (int n = 0; n < 2; ++n) yo[m][n] = (f32x4){0.f, 0.f, 0.f, 0.f};
#pragma unroll
        for (int ks = 0; ks < 4; ++ks) {
            bf16x8 af[2], bfm[2];
#pragma unroll
            for (int m = 0; m < 2; ++m) af[m] = *(const bf16x8*)(R1 + (wr * 32 + m * 16 + fr) * PIT + ks * 32 + fq * 8);
#pragma unroll
            for (int n = 0; n < 2; ++n) bfm[n] = *(const bf16x8*)(HB + (wc * 32 + n * 16 + fr) * PIT + ks * 32 + fq * 8);
#pragma unroll
            for (int m = 0; m < 2; ++m)
#pragma unroll
                for (int n = 0; n < 2; ++n) yo[m][n] = mfma16(bfm[n], af[m], yo[m][n]);
        }
        const float dsk = P.in[I_SSDD][h];
#pragma unroll
        for (int m = 0; m < 2; ++m) {
            const int l = wr * 32 + m * 16 + fr; const long row = rowc + l; const int t = c * 128 + l;
            const float ea = __expf(acsg[(((long)b * 16 + c) * 16 + h) * 128 + l]);
            float ss = 0.f;
#pragma unroll
            for (int n = 0; n < 2; ++n) {
                const int p0 = wc * 32 + n * 16 + fq * 4, ch0 = h * 64 + p0;
                const f32x4 bias = *(const f32x4*)(P.in[I_CONVB] + ch0);
                float xa[4] = {bias[0], bias[1], bias[2], bias[3]};
#pragma unroll
                for (int k = 0; k < 4; ++k) {
                    if (t - 3 + k >= 0) {
                        const u32x2 u = *(const u32x2*)(proj + (row - 3 + k) * PLD + C_XBC + ch0);
                        const f32x4 wk = *(const f32x4*)(P.in[I_CONVW] + k * 1536 + ch0);
                        xa[0] += wk[0] * bflo(u.x); xa[1] += wk[1] * bfhi(u.x); xa[2] += wk[2] * bflo(u.y); xa[3] += wk[3] * bfhi(u.y);
                    }
                }
                const u32x2 yq = *(const u32x2*)(ydg + row * 1024 + h * 64 + p0);
                u32x2* zp = (u32x2*)(proj + row * PLD + C_ZA + h * 64 + p0);
                const u32x2 zz = *zp;
                float yv[4] = {bflo(yq.x), bfhi(yq.x), bflo(yq.y), bfhi(yq.y)};
                float zv[4] = {bflo(zz.x), bfhi(zz.x), bflo(zz.y), bfhi(zz.y)};
                float v[4];
#pragma unroll
                for (int r = 0; r < 4; ++r) { const float y = yv[r] + ea * yo[m][n][r] + dsk * siluf(xa[r]); v[r] = y * siluf(zv[r]); ss += v[r] * v[r]; }
                u32x2 o; o.x = pk2(v[0], v[1]); o.y = pk2(v[2], v[3]);
                *zp = o;
            }
            ss += __shfl_xor(ss, 16); ss += __shfl_xor(ss, 32);
            if (fq == 0) atomicAdd(ssq + l, ss);
        }
    }
    __syncthreads();
    for (int e = 0; e < 8; ++e) {
        const int h = g * 8 + e;
#pragma unroll
        for (int m = 0; m < 2; ++m) {
            const int l = wr * 32 + m * 16 + fr; const long row = rowc + l;
            const float rstd = rsqrtf(ssq[l] * (1.f / 512.f) + EPS);
#pragma unroll
            for (int n = 0; n < 2; ++n) {
                const int p0 = wc * 32 + n * 16 + fq * 4;
                u32x2* zp = (u32x2*)(proj + row * PLD + C_ZA + h * 64 + p0);
                const u32x2 zz = *zp;
                const f32x4 gg = *(const f32x4*)(P.in[I_SSDG] + h * 64 + p0);
                u32x2 o; o.x = pk2(bflo(zz.x) * rstd * gg[0], bfhi(zz.x) * rstd * gg[1]); o.y = pk2(bflo(zz.y) * rstd * gg[2], bfhi(zz.y) * rstd * gg[3]);
                *zp = o;
            }
        }
    }
    __syncthreads();
}

DEV void ssd_sample_item(const Params& P, int item) {
    const int tid = threadIdx.x;
    const int b = item >> 1, g = item & 1;
    char* ws = P.ws;
    bf16_t* proj = (bf16_t*)(ws + W_PROJ);
    const long row0 = NPROMPT + (long)b * 4;
    float* xs = (float*)smem;
    float* Bs = xs + 2048;
    float* Cs = Bs + 512;
    float* dts = Cs + 512;
    float* das = dts + 32;
    float* vs = das + 32;
    float* red = vs + 2048;
    for (int u = tid; u < 768; u += 512) {
        int ch; float* dst; int dcol;
        if (u < 512) { ch = g * 512 + u; dst = xs; dcol = u; }
        else if (u < 640) { ch = 1024 + g * 128 + (u - 512); dst = Bs; dcol = u - 512; }
        else { ch = 1280 + g * 128 + (u - 640); dst = Cs; dcol = u - 640; }
        const int pitch = u < 512 ? 512 : 128;
        float full[7];
#pragma unroll
        for (int i = 0; i < 3; ++i) full[i] = P.in[I_CONV][((long)b * 3 + i) * 1536 + ch];
#pragma unroll
        for (int i = 0; i < 4; ++i) full[3 + i] = __uint_as_float(((unsigned)proj[(row0 + i) * PLD + C_XBC + ch]) << 16);
        const float w0 = P.in[I_CONVW][ch], w1 = P.in[I_CONVW][1536 + ch], w2 = P.in[I_CONVW][3072 + ch], w3 = P.in[I_CONVW][4608 + ch], bias = P.in[I_CONVB][ch];
#pragma unroll
        for (int t = 0; t < 4; ++t) dst[t * pitch + dcol] = siluf(bias + w0 * full[t] + w1 * full[t + 1] + w2 * full[t + 2] + w3 * full[t + 3]);
    }
    if (tid < 32) {
        const int t = tid >> 3, e = tid & 7, h = g * 8 + e;
        const float x = ((const float*)(ws + W_DTR))[(row0 + t) * 16 + h] + P.in[I_DTB][h];
        const float d = x > 20.f ? x : log1pf(__expf(x));
        dts[tid] = d; das[tid] = __expf(-d * __expf(P.in[I_ALOG][h]));
    }
    __syncthreads();
    const int p = tid >> 3, nb = tid & 7, n0 = nb * 16;
    for (int e = 0; e < 8; ++e) {
        const int h = g * 8 + e;
        const float* sp = P.in[I_SSD] + (((long)b * 16 + h) * 64 + p) * 128 + n0;
        float* op = P.out + O_SSDS + (((long)b * 16 + h) * 64 + p) * 128 + n0;
        f32x4 hv[4];
#pragma unroll
        for (int i = 0; i < 4; ++i) hv[i] = *(const f32x4*)(sp + i * 4);
        const float dsk = P.in[I_SSDD][h];
#pragma unroll
        for (int t = 0; t < 4; ++t) {
            const float dec = das[t * 8 + e], xv = xs[t * 512 + e * 64 + p], coef = dts[t * 8 + e] * xv;
            float part = 0.f;
#pragma unroll
            for (int i = 0; i < 4; ++i) {
                const f32x4 bv = *(const f32x4*)(Bs + t * 128 + n0 + i * 4), cv = *(const f32x4*)(Cs + t * 128 + n0 + i * 4);
                hv[i] = hv[i] * dec + bv * coef;
                part += hv[i][0] * cv[0] + hv[i][1] * cv[1] + hv[i][2] * cv[2] + hv[i][3] * cv[3];
            }
            part += __shfl_xor(part, 1); part += __shfl_xor(part, 2); part += __shfl_xor(part, 4);
            if (nb == 0) {
                const float z = __uint_as_float(((unsigned)proj[(row0 + t) * PLD + C_ZA + h * 64 + p]) << 16);
                vs[t * 512 + e * 64 + p] = (part + dsk * xv) * siluf(z);
            }
        }
#pragma unroll
        for (int i = 0; i < 4; ++i) *(f32x4*)(op + i * 4) = hv[i];
    }
    __syncthreads();
    {
        const int t = tid >> 7, cidx = tid & 127;
        float v[4]; float ss = 0.f;
#pragma unroll
        for (int i = 0; i < 4; ++i) { v[i] = vs[t * 512 + cidx * 4 + i]; ss += v[i] * v[i]; }
        ss = wave_sum(ss);
        if ((tid & 63) == 0) red[tid >> 6] = ss;
        __syncthreads();
        const float tot = red[t * 2] + red[t * 2 + 1];
        const float rstd = rsqrtf(tot * (1.f / 512.f) + EPS);
        const f32x4 gg = *(const f32x4*)(P.in[I_SSDG] + g * 512 + cidx * 4);
        u32x2 o; o.x = pk2(v[0] * rstd * gg[0], v[1] * rstd * gg[1]); o.y = pk2(v[2] * rstd * gg[2], v[3] * rstd * gg[3]);
        *(u32x2*)(proj + (row0 + t) * PLD + C_ZA + g * 512 + cidx * 4) = o;
    }
    __syncthreads();
}

constexpr int S5P = 20;
template <bool SAMPLE>
DEV void s5_item(const Params& P, int g, long rowbase, int bidx) {
    const int tid = threadIdx.x, lane = tid & 63, w = tid >> 6, fr = lane & 15, fq = lane >> 4;
    constexpr int TPW = SAMPLE ? 32 : 256;
    bf16_t* proj = (bf16_t*)(P.ws + W_PROJ);
    float* buf = (float*)smem + w * (128 * S5P);
    float* carry = (float*)smem + 8 * 128 * S5P;
    float* fs = carry + 1024 + w * 128;
    float ar, ai;
    {
        const float lr = P.in[I_LRE][g * 64 + lane], li = P.in[I_LIM][g * 64 + lane], delta = expf(P.in[I_LDT][g]);
        const float mag = expf(lr * delta), ang = li * delta;
        ar = mag * cosf(ang); ai = mag * sinf(ang);
        const float qre = ar - 1.f, den = lr * lr + li * li;
        fs[lane] = (qre * lr + ai * li) / den; fs[64 + lane] = (ai * lr - qre * li) / den;
    }
    lds_fence();
    bf16x8 bbf[8];
#pragma unroll
    for (int j = 0; j < 8; ++j) {
        bf16x8 z = {0, 0, 0, 0, 0, 0, 0, 0};
        if (fq < 2) {
            const int p = (j & 3) * 16 + fr;
            const float f_r = fs[p], f_i = fs[64 + p];
            const float* br = P.in[I_BRE] + ((long)(g * 64 + p)) * 16 + fq * 8;
            const float* bi = P.in[I_BIM] + ((long)(g * 64 + p)) * 16 + fq * 8;
            const f32x4 r0 = *(const f32x4*)br, r1 = *(const f32x4*)(br + 4), i0 = *(const f32x4*)bi, i1 = *(const f32x4*)(bi + 4);
            f32x4 o0, o1;
            if (j < 4) { o0 = r0 * f_r - i0 * f_i; o1 = r1 * f_r - i1 * f_i; }
            else { o0 = i0 * f_r + r0 * f_i; o1 = i1 * f_r + r1 * f_i; }
            u32x4 q; q.x = pk2(o0[0], o0[1]); q.y = pk2(o0[2], o0[3]); q.z = pk2(o1[0], o1[1]); q.w = pk2(o1[2], o1[3]);
            z = __builtin_bit_cast(bf16x8, q);
        }
        bbf[j] = z;
    }
    bf16x8 ccf[4];
#pragma unroll
    for (int ks = 0; ks < 4; ++ks) {
        const float* src = (ks < 2 ? P.in[I_CRE] : P.in[I_CIM]) + ((long)(g * 16 + fr)) * 64 + (ks & 1) * 32 + fq * 8;
        f32x4 c0 = *(const f32x4*)src, c1 = *(const f32x4*)(src + 4);
        if (ks >= 2) { c0 = -c0; c1 = -c1; }
        u32x4 q; q.x = pk2(c0[0], c0[1]); q.y = pk2(c0[2], c0[3]); q.z = pk2(c1[0], c1[1]); q.w = pk2(c1[2], c1[3]);
        ccf[ks] = __builtin_bit_cast(bf16x8, q);
    }
    const f32x4 dsk = *(const f32x4*)(P.in[I_S5D] + g * 16 + fq * 4);
    const long roww = rowbase + (long)w * TPW;
    float xr = 0.f, xi = 0.f;
    constexpr int NPASS = SAMPLE ? 1 : 2;
#pragma unroll 1
    for (int pass = 0; pass < NPASS; ++pass) {
        const bool last = (pass == NPASS - 1);
        if (!SAMPLE && pass == 1) {
            carry[w * 128 + lane] = xr; carry[w * 128 + 64 + lane] = xi;
            __syncthreads();
            float pr = ar, pi = ai;
#pragma unroll
            for (int q = 0; q < 8; ++q) { const float nr = pr * pr - pi * pi, ni = 2.f * pr * pi; pr = nr; pi = ni; }
            float sr = 0.f, si = 0.f;
            for (int ww = 0; ww < w; ++ww) {
                const float cr = carry[ww * 128 + lane], ci = carry[ww * 128 + 64 + lane];
                const float nr = pr * sr - pi * si + cr, ni = pr * si + pi * sr + ci; sr = nr; si = ni;
            }
            xr = sr; xi = si;
        }
        if (!SAMPLE && pass == 0 && w == 7) continue;
#pragma unroll 1
        for (int sb = 0; sb < TPW / 16; ++sb) {
            const long r = roww + sb * 16;
            bf16x8 uf = {0, 0, 0, 0, 0, 0, 0, 0};
            if (fq < 2) uf = *(const bf16x8*)(proj + (r + fr) * PLD + C_UB + g * 16 + fq * 8);
            const f32x4 zero = {0.f, 0.f, 0.f, 0.f};
#pragma unroll
            for (int j = 0; j < 8; ++j) {
                const f32x4 d = mfma16(uf, bbf[j], zero);
                *(f32x4*)(buf + (j * 16 + fr) * S5P + fq * 4) = d;
            }
            lds_fence();
#pragma unroll
            for (int q = 0; q < 4; ++q) {
                f32x4 br = *(const f32x4*)(buf + lane * S5P + q * 4), bi = *(const f32x4*)(buf + (64 + lane) * S5P + q * 4);
                if (SAMPLE) {
                    const long seq = (r - NPROMPT) / 4 + q;
                    xr = P.in[I_S5R][(seq * 64 + g) * 64 + lane]; xi = P.in[I_S5I][(seq * 64 + g) * 64 + lane];
                }
#pragma unroll
                for (int i = 0; i < 4; ++i) {
                    const float nr = ar * xr - ai * xi + br[i], ni = ar * xi + ai * xr + bi[i];
                    xr = nr; xi = ni; br[i] = nr; bi[i] = ni;
                }
                if (last) { *(f32x4*)(buf + lane * S5P + q * 4) = br; *(f32x4*)(buf + (64 + lane) * S5P + q * 4) = bi; }
                if (SAMPLE) {
                    const long seq = (r - NPROMPT) / 4 + q;
                    P.out[O_S5RS + (seq * 64 + g) * 64 + lane] = xr; P.out[O_S5IS + (seq * 64 + g) * 64 + lane] = xi;
                }
            }
            if (last) {
                lds_fence();
                f32x4 y = {0.f, 0.f, 0.f, 0.f};
#pragma unroll
                for (int ks = 0; ks < 4; ++ks) {
                    float xv[8];
#pragma unroll
                    for (int i = 0; i < 8; ++i) xv[i] = buf[(ks * 32 + fq * 8 + i) * S5P + fr];
                    u32x4 q; q.x = pk2(xv[0], xv[1]); q.y = pk2(xv[2], xv[3]); q.z = pk2(xv[4], xv[5]); q.w = pk2(xv[6], xv[7]);
                    y = mfma16(ccf[ks], __builtin_bit_cast(bf16x8, q), y);
                }
                u32x2* up = (u32x2*)(proj + (r + fr) * PLD + C_UB + g * 16 + fq * 4);
                const u32x2 uu = *up;
                const float y0 = geluf(y[0] + dsk[0] * bflo(uu.x)), y1 = geluf(y[1] + dsk[1] * bfhi(uu.x));
                const float y2 = geluf(y[2] + dsk[2] * bflo(uu.y)), y3 = geluf(y[3] + dsk[3] * bfhi(uu.y));
                u32x2 o; o.x = pk2(y0, y1); o.y = pk2(y2, y3);
                *up = o;
            }
            lds_fence();
        }
    }
    if (!SAMPLE && w == 7) {
        P.out[O_S5RP + ((long)bidx * 64 + g) * 64 + lane] = xr; P.out[O_S5IP + ((long)bidx * 64 + g) * 64 + lane] = xi;
    }
    __syncthreads();
}

__global__ void __launch_bounds__(512) hymba_fwd(Params P) {
    cg::grid_group grid = cg::this_grid();
    const int G = gridDim.x, bid = blockIdx.x;
    char* ws = P.ws;
    bf16_t* proj = (bf16_t*)(ws + W_PROJ);
#ifndef NO_P0
    phase0(P);
#endif
    grid.sync();
#ifndef NO_P1
    for (int L = bid; L < 1188; L += G) {
        int pm, pn; tile_of(L, 66, 18, pm, pn);
        gemm_tile((const bf16_t*)(ws + W_NB), 1024, (const bf16_t*)(ws + W_WTIN), 1024, 1024, pm * 256, pn * 256, EpiBf16{proj, PLD});
    }
    for (int L = (bid + G - 1188 % G) % G; L < 264; L += G) {
        int pm, pn; tile_of(L, 66, 4, pm, pn);
        gemm_tile((const bf16_t*)(ws + W_PB), 256, (const bf16_t*)(ws + W_WTPP), 256, 256, pm * 256, pn * 256, EpiBf16{(bf16_t*)(ws + W_PP), 1024});
    }
#endif
    grid.sync();
    for (int idx = bid * 512 + threadIdx.x; idx < (8 + 128) * 3 * 1536; idx += G * 512) {
        const int ch = idx % 1536, sj = idx / 1536, j = sj % 3, sq = sj / 3;
        const long row = sq < 8 ? (long)sq * 2048 + 2045 + j : NPROMPT + (long)(sq - 8) * 4 + 1 + j;
        const float v = __uint_as_float(((unsigned)proj[row * PLD + C_XBC + ch]) << 16);
        if (sq < 8) P.out[O_CONVP + ((long)sq * 3 + j) * 1536 + ch] = v; else P.out[O_CONVS + ((long)(sq - 8) * 3 + j) * 1536 + ch] = v;
    }
#ifndef NO_S1
    for (int it = bid; it < 256; it += G) ssd_s1_item(P, it);
#endif
#ifndef NO_SS
    for (int it = bid; it < 256; it += G) ssd_sample_item(P, it);
#endif
#ifndef NO_S5P
    for (int it = bid; it < 512; it += G) s5_item<false>(P, it & 63, (long)(it >> 6) * 2048, it >> 6);
#endif
#ifndef NO_S5S
    for (int it = bid; it < 128; it += G) s5_item<true>(P, it & 63, NPROMPT + (long)(it >> 6) * 256, 0);
#endif
    grid.sync();
#ifndef NO_P3
    for (int L = bid; L < 264; L += G) {
        int pm, pn; tile_of(L, 66, 4, pm, pn);
        gemm_tile(proj + C_UB, PLD, (const bf16_t*)(ws + W_WTGLU), 1024, 1024, pm * 256, pn * 256, EpiGlu{proj, P.in[I_GLUB]});
    }
#endif
#ifndef NO_S2
    ssd_s2(P);
#endif
    grid.sync();
#ifndef NO_S3
    for (int it = bid; it < 256; it += G) ssd_s3_item(P, it);
#endif
    grid.sync();
#ifndef NO_P5
    for (int L = bid; L < 264; L += G) {
        int pm, pn; tile_of(L, 66, 4, pm, pn);
        gemm_tile(proj, PLD, (const bf16_t*)(ws + W_WTOUT), 2048, 2048, pm * 256, pn * 256,
                  EpiOut{P.in[I_XP], P.in[I_XS], P.out, (bf16_t*)(ws + W_NB), (float*)(ws + W_RSS1)});
    }
#endif
    grid.sync();
#ifndef NO_P6
    for (int L = bid; L < 264; L += G) {
        int pm, pn; tile_of(L, 66, 4, pm, pn);
        gemm_tile((const bf16_t*)(ws + W_NB), 1024, (const bf16_t*)(ws + W_WTGATE), 1024, 1024, pm * 256, pn * 256,
                  EpiPle{P.out, (const bf16_t*)(ws + W_PP), (const float*)(ws + W_RSS1), (float*)(ws + W_RSS2)});
    }
#endif
    grid.sync();
    {
        const float* rss2 = (const float*)(ws + W_RSS2);
        for (int idx = bid * 512 + threadIdx.x; idx < NTOK * 256; idx += G * 512) {
            const int row = idx >> 8, c4 = (idx & 255) * 4;
            const float rstd = rsqrtf(rss2[row] * (1.f / 1024.f) + EPS);
            f32x4* p = (f32x4*)(P.out + (long)row * 1024 + c4);
            const f32x4 gf = *(const f32x4*)(P.in[I_GFIN] + c4);
            *p = *p * rstd * gf;
        }
    }
}

extern "C" void kernel_launch(void* const* d_in, const int* in_sizes, int n_in, void* d_out, int out_size, void* d_ws, size_t ws_size, hipStream_t stream) {
    static int grid_blocks = 0;
    if (grid_blocks == 0) {
        if (n_in != 31 || out_size != (int)O_END || ws_size < W_END) {
            fprintf(stderr, "kernel_launch: unexpected shapes n_in %d out %d ws %zu (need %zu)\n", n_in, out_size, ws_size, (size_t)W_END);
            grid_blocks = -1; return;
        }
        int dev = 0, cus = 0, per_cu = 0;
        hipGetDevice(&dev);
        hipDeviceGetAttribute(&cus, hipDeviceAttributeMultiprocessorCount, dev);
        hipFuncSetAttribute((const void*)hymba_fwd, hipFuncAttributeMaxDynamicSharedMemorySize, LDS_BYTES);
        hipOccupancyMaxActiveBlocksPerMultiprocessor(&per_cu, (const void*)hymba_fwd, 512, LDS_BYTES);
        if (per_cu < 1) { fprintf(stderr, "kernel_launch: occupancy query says %d blocks/CU\n", per_cu); per_cu = 1; }
        grid_blocks = cus;
        (void)hipGetLastError();
    }
    if (grid_blocks < 0) return;
    Params p{};
    for (int i = 0; i < 31; ++i) p.in[i] = (const float*)d_in[i];
    p.out = (float*)d_out; p.ws = (char*)d_ws;
    void* args[] = {&p};
    hipError_t e = hipLaunchCooperativeKernel((const void*)hymba_fwd, dim3(grid_blocks), dim3(512), args, LDS_BYTES, stream);
    if (e != hipSuccess) fprintf(stderr, "cooperative launch failed: %s (grid %d)\n", hipGetErrorString(e), grid_blocks);
}
```

```cpp
#include <hip/hip_runtime.h>
#include <hip/hip_cooperative_groups.h>
#include <cstdio>
namespace cg = cooperative_groups;

typedef unsigned short bf16_t;
typedef short bf16x8 __attribute__((ext_vector_type(8)));
typedef float f32x4 __attribute__((ext_vector_type(4)));
typedef unsigned u32x2 __attribute__((ext_vector_type(2)));
typedef unsigned u32x4 __attribute__((ext_vector_type(4)));
#define DEV __device__ __forceinline__

constexpr int NPROMPT = 16384, NSAMPLE = 512, NTOK = 16896;
constexpr int PLD = 4608;
constexpr int C_ZA = 0, C_ZB = 1024, C_XBC = 2048, C_UB = 3584;
constexpr float EPS = 1e-6f;
constexpr long O_YP = 0, O_YS = 16777216, O_SSDP = 17301504, O_CONVP = 18350080, O_S5RP = 18386944, O_S5IP = 18419712,
               O_SSDS = 18452480, O_CONVS = 35229696, O_S5RS = 35819520, O_S5IS = 36343808, O_END = 36868096;
constexpr size_t W_WTIN = 0;
constexpr size_t W_WTOUT = W_WTIN + 4608ull * 1024 * 2;
constexpr size_t W_WTGLU = W_WTOUT + 1024ull * 2048 * 2;
constexpr size_t W_WTGATE = W_WTGLU + 1024ull * 1024 * 2;
constexpr size_t W_WTPP = W_WTGATE + 1024ull * 1024 * 2;
constexpr size_t W_NB = W_WTPP + 1024ull * 256 * 2;
constexpr size_t W_PB = W_NB + 16896ull * 1024 * 2;
constexpr size_t W_DTR = W_PB + 16896ull * 256 * 2;
constexpr size_t W_ACS = W_DTR + 16896ull * 16 * 4;
constexpr size_t W_CDEC = W_ACS + 16384ull * 16 * 4;
constexpr size_t W_RSS1 = W_CDEC + 8192;
constexpr size_t W_RSS2 = W_RSS1 + 16896ull * 4;
constexpr size_t W_PROJ = W_RSS2 + 16896ull * 4;
constexpr size_t W_PP = W_PROJ + 16896ull * 4608 * 2;
constexpr size_t W_BAR = W_PP + 16896ull * 1024 * 2;
constexpr size_t W_END = W_BAR + 16384;

constexpr int LDS_BYTES = 131072 + 64;

struct Params {
    const float* in[31];
    float* out;
    char* ws;
};
enum { I_XP = 0, I_XS, I_PP, I_PS, I_SSD, I_CONV, I_S5R, I_S5I, I_WIN, I_GIN, I_CONVW, I_CONVB, I_DTB, I_ALOG, I_SSDD, I_SSDG,
       I_LRE, I_LIM, I_LDT, I_BRE, I_BIM, I_CRE, I_CIM, I_S5D, I_GLUW, I_GLUB, I_WOUT, I_GPLE, I_WGATE, I_WPP, I_GFIN };

extern __shared__ __attribute__((aligned(16))) char smem[];

DEV unsigned pk2(float lo, float hi) { unsigned r; asm("v_cvt_pk_bf16_f32 %0, %1, %2" : "=v"(r) : "v"(lo), "v"(hi)); return r; }
DEV float bflo(unsigned u) { return __uint_as_float(u << 16); }
DEV float bfhi(unsigned u) { return __uint_as_float(u & 0xffff0000u); }
DEV float wave_sum(float v) {
#pragma unroll
    for (int o = 1; o < 64; o <<= 1) v += __shfl_xor(v, o);
    return v;
}
DEV float siluf(float v) { return v / (1.f + __expf(-v)); }
DEV float sigmf(float v) { return 1.f / (1.f + __expf(-v)); }
DEV float geluf(float y) { float z = 0.7978845608f * (y + 0.044715f * y * y * y); return y / (1.f + __expf(-2.f * z)); }
DEV f32x4 mfma16(bf16x8 a, bf16x8 b, f32x4 c) { return __builtin_amdgcn_mfma_f32_16x16x32_bf16(a, b, c, 0, 0, 0); }
DEV int tid_fresh() { int t = threadIdx.x; asm volatile("" : "+v"(t)); return t; }
DEV void lds_fence() { asm volatile("s_waitcnt lgkmcnt(0)" ::: "memory"); }


#define XB_TMO      128
#define XB_XCNT(j)  (256  + 64 * (j))
#define XB_XSUB(j)  (1280 + 64 * (j))
#define XB_XGEN(j)  (2304 + 64 * (j))
#define XB_TOP      3328
#define XB_TOPGEN   3392
#define XCD_BAR_WORDS 3456
#define XB_SPIN_CAP (1u << 22)
#define LAS __attribute__((address_space(3)))
DEV unsigned xb_ld(unsigned* p) { return __hip_atomic_load(p, __ATOMIC_RELAXED, __HIP_MEMORY_SCOPE_AGENT); }
DEV unsigned xb_add(unsigned* p, unsigned v) { return __hip_atomic_fetch_add(p, v, __ATOMIC_RELAXED, __HIP_MEMORY_SCOPE_AGENT); }
DEV unsigned xb_xcc_id() { return (unsigned)__builtin_amdgcn_s_getreg((3 << 11) | 20) & 0xFu; }
#define XB_SPIN(cond, bar) do { unsigned _sp = 0; while (cond) { __builtin_amdgcn_s_sleep(1); \
    if ((++_sp & 255u) == 0u) { if (xb_ld(&(bar)[XB_TMO])) break; if (_sp > XB_SPIN_CAP) { atomicAdd(&(bar)[XB_TMO], 1u); break; } } } } while (0)
struct XcdBarrier { unsigned* bar; unsigned x; volatile LAS unsigned* st; };
DEV XcdBarrier xcd_barrier_post(unsigned* bar, volatile LAS unsigned* st) {
    XcdBarrier b; b.bar = bar; b.x = xb_xcc_id(); b.st = st;
    if (threadIdx.x == 0) (void)xb_add(&bar[XB_XCNT(b.x)], 1u);
    return b;
}
DEV void xcd_barrier_complete(unsigned* bar, unsigned x, unsigned& nloc, unsigned& nx) {
    const unsigned G = gridDim.x * gridDim.y * gridDim.z;
    unsigned sum, cnt, mine, sp = 0u;
    for (;;) {
        sum = 0u; cnt = 0u; mine = 0u;
#pragma unroll
        for (unsigned j = 0; j < 16; ++j) { const unsigned c = xb_ld(&bar[XB_XCNT(j)]); sum += c; cnt += (c > 0u) ? 1u : 0u; mine = (j == x) ? c : mine; }
        if (sum == G) break;
        __builtin_amdgcn_s_sleep(1);
        if ((++sp & 255u) == 0u) { if (xb_ld(&bar[XB_TMO])) break; if (sp > XB_SPIN_CAP) { atomicAdd(&bar[XB_TMO], 1u); break; } }
    }
    nloc = mine > 0u ? mine : 1u; nx = cnt > 0u ? cnt : 1u;
}
DEV void xcd_barrier(const XcdBarrier& b) {
    asm volatile("s_waitcnt vmcnt(0)" ::: "memory");
    __syncthreads();
    if (threadIdx.x == 0) {
        unsigned* bar = b.bar;
        __builtin_amdgcn_s_waitcnt(0);
        unsigned nloc = b.st[0], nx = b.st[1];
        if (nloc == 0u) { xcd_barrier_complete(bar, b.x, nloc, nx); b.st[0] = nloc; b.st[1] = nx; }
        const unsigned old = xb_add(&bar[XB_XSUB(b.x)], 1u);
        const unsigned gen = old / nloc;
        if (old + 1u == (gen + 1u) * nloc) {
            __builtin_amdgcn_fence(__ATOMIC_RELEASE, "agent");
            asm volatile("s_waitcnt vmcnt(0)" ::: "memory");
            const unsigned og = xb_add(&bar[XB_TOP], 1u);
            const unsigned tg = og / nx;
            if (og + 1u == (tg + 1u) * nx) xb_add(&bar[XB_TOPGEN], 1u);
            else XB_SPIN(xb_ld(&bar[XB_TOPGEN]) == tg, bar);
            __builtin_amdgcn_fence(__ATOMIC_ACQUIRE, "agent");
            xb_add(&bar[XB_XGEN(b.x)], 1u);
            asm volatile("s_waitcnt vmcnt(0)" ::: "memory");
        } else {
            XB_SPIN(xb_ld(&bar[XB_XGEN(b.x)]) == gen, bar);
            __builtin_amdgcn_fence(__ATOMIC_ACQUIRE, "agent");
            asm volatile("s_waitcnt vmcnt(0)" ::: "memory");
        }
    }
    __syncthreads();
}

constexpr int BM = 256, BK = 64, HALF = 128, HT = HALF * BK;
DEV int lds_byte(int r, int c) {
    int st = (r >> 4) * 2 + (c >> 5), rr = r & 15, cc = c & 31, ob = rr * 64 + cc * 2;
    return st * 1024 + (ob ^ (((ob >> 9) & 1) << 5));
}
DEV void stage_rc(int b, int& R, int& C) {
    int st = b / 1024, sb = b % 1024, swz = sb ^ (((sb >> 9) & 1) << 5);
    R = (st >> 1) * 16 + swz / 64; C = (st & 1) * 32 + (swz % 64) / 2;
}

template <class Epi>
DEV void gemm_tile(const bf16_t* __restrict__ A, int lda, const bf16_t* __restrict__ Bt, int ldb, int K, int brow, int bcol, const Epi& epi) {
    LAS unsigned char* lds = (LAS unsigned char*)smem;
    constexpr int HTB = HT * 2;
    const int tid = tid_fresh(), wid = __builtin_amdgcn_readfirstlane(tid >> 6), lane = tid & 63, wr = wid >> 2, wc = wid & 3, fr = lane & 15, fq = lane >> 4;
    unsigned voffA[2], voffB[2];
#pragma unroll
    for (int i = 0; i < 2; ++i) { int R, C; stage_rc(tid * 16 + i * 8192, R, C); voffA[i] = (unsigned)(R * lda + C) * 2u; voffB[i] = (unsigned)(R * ldb + C) * 2u; }
    const size_t kstep = (size_t)(BK * 2), hstepA = (size_t)HALF * lda * 2, hstepB = (size_t)HALF * ldb * 2;
    const unsigned ldsw = (unsigned)wid * 1024u;
    const int aoff = lds_byte(wr * 64 + fr, fq * 8), boff = lds_byte(wc * 32 + fr, fq * 8);
#define SA(b, h) (((b) * 2 + (h)) * HTB)
#define SB(b, h) ((4 + (b) * 2 + (h)) * HTB)
#define STAGE(bufoff, gbase, voff) do { _Pragma("unroll") for (int _i = 0; _i < 2; ++_i) \
        __builtin_amdgcn_global_load_lds((const unsigned*)((const char*)(gbase) + (voff)[_i]), (LAS unsigned*)(lds + (bufoff) + ldsw + _i * 8192), 16, 0, 0); } while (0)
#define LDA(dst, b, h) do { _Pragma("unroll") for (int m = 0; m < 4; ++m) _Pragma("unroll") for (int k = 0; k < 2; ++k) dst[m][k] = *(const LAS bf16x8*)(lds + SA(b, h) + aoff + m * 2048 + k * 1024); } while (0)
#define LDB(dst, b, h) do { _Pragma("unroll") for (int n = 0; n < 2; ++n) _Pragma("unroll") for (int k = 0; k < 2; ++k) dst[n][k] = *(const LAS bf16x8*)(lds + SB(b, h) + boff + n * 2048 + k * 1024); } while (0)
#define MMA(ai, bj, At, Bt_) do { __builtin_amdgcn_s_setprio(1); _Pragma("unroll") for (int m = 0; m < 4; ++m) _Pragma("unroll") for (int n = 0; n < 2; ++n) _Pragma("unroll") for (int k = 0; k < 2; ++k) \
        acc[ai][bj][m][n] = __builtin_amdgcn_mfma_f32_16x16x32_bf16(Bt_[n][k], At[m][k], acc[ai][bj][m][n], 0, 0, 0); __builtin_amdgcn_s_setprio(0); } while (0)
#define WAIT_V(n) asm volatile("s_waitcnt vmcnt(" #n ")" ::: "memory")
#define WAIT_L(n) asm volatile("s_waitcnt lgkmcnt(" #n ")" ::: "memory")
#define BAR __builtin_amdgcn_s_barrier()
#define SCHED __builtin_amdgcn_sched_barrier(0)
    f32x4 acc[2][2][4][2];
#pragma unroll
    for (int a = 0; a < 2; ++a)
#pragma unroll
        for (int b = 0; b < 2; ++b)
#pragma unroll
            for (int m = 0; m < 4; ++m)
#pragma unroll
                for (int n = 0; n < 2; ++n) acc[a][b][m][n] = (f32x4){0.f, 0.f, 0.f, 0.f};
    bf16x8 At[4][2], B0[2][2], B1[2][2];
    const int nt = K / BK;
    const char* cA = (const char*)A + (size_t)brow * lda * 2; const char* cB = (const char*)Bt + (size_t)bcol * ldb * 2;
    STAGE(SB(0, 0), cB, voffB); STAGE(SA(0, 0), cA, voffA); STAGE(SB(0, 1), cB + hstepB, voffB); STAGE(SA(0, 1), cA + hstepA, voffA);
    if (wr == 1) BAR;
    WAIT_V(4); BAR;
    STAGE(SB(1, 0), cB + kstep, voffB); STAGE(SA(1, 0), cA + kstep, voffA); STAGE(SB(1, 1), cB + hstepB + kstep, voffB);
    WAIT_V(6); BAR;
    for (int t = 0; t < nt - 2; t += 2) {
        const char* a1 = cA + (size_t)(t + 1) * kstep;
        const char* a2 = cA + (size_t)(t + 2) * kstep; const char* b2 = cB + (size_t)(t + 2) * kstep;
        const char* a3 = a2 + kstep; const char* b3 = b2 + kstep;
        LDB(B0, 0, 0); SCHED; LDA(At, 0, 0); STAGE(SA(1, 1), a1 + hstepA, voffA);
        WAIT_L(8); BAR; WAIT_L(0); MMA(0, 0, At, B0); BAR; SCHED;
        LDB(B1, 0, 1); STAGE(SB(0, 0), b2, voffB);
        BAR; WAIT_L(0); MMA(0, 1, At, B1); BAR;
        LDA(At, 0, 1); STAGE(SA(0, 0), a2, voffA);
        BAR; WAIT_L(0); MMA(1, 0, At, B0); BAR; SCHED;
        STAGE(SB(0, 1), b2 + hstepB, voffB);
        WAIT_V(6); BAR; MMA(1, 1, At, B1); BAR;
        LDB(B0, 1, 0); SCHED; LDA(At, 1, 0); STAGE(SA(0, 1), a2 + hstepA, voffA);
        WAIT_L(8); BAR; WAIT_L(0); MMA(0, 0, At, B0); BAR; SCHED;
        LDB(B1, 1, 1); STAGE(SB(1, 0), b3, voffB);
        BAR; WAIT_L(0); MMA(0, 1, At, B1); BAR;
        LDA(At, 1, 1); STAGE(SA(1, 0), a3, voffA);
        BAR; WAIT_L(0); MMA(1, 0, At, B0); BAR; SCHED;
        STAGE(SB(1, 1), b3 + hstepB, voffB);
        WAIT_V(6); BAR; MMA(1, 1, At, B1); BAR;
    }
    { const char* a1 = cA + (size_t)(nt - 1) * kstep;
      LDB(B0, 0, 0); LDA(At, 0, 0); STAGE(SA(1, 1), a1 + hstepA, voffA);
      BAR; WAIT_L(0); MMA(0, 0, At, B0); BAR;
      LDB(B1, 0, 1); BAR; WAIT_L(0); MMA(0, 1, At, B1); BAR;
      LDA(At, 0, 1); WAIT_V(4); BAR; WAIT_L(0); MMA(1, 0, At, B0); MMA(1, 1, At, B1); BAR; }
    { LDB(B0, 1, 0); LDA(At, 1, 0); WAIT_V(2); BAR; WAIT_L(0); MMA(0, 0, At, B0); BAR;
      LDB(B1, 1, 1); WAIT_V(0); BAR; WAIT_L(0); MMA(0, 1, At, B1); BAR;
      LDA(At, 1, 1); BAR; WAIT_L(0); MMA(1, 0, At, B0); MMA(1, 1, At, B1); BAR; }
    if (wr == 0) BAR;
    epi_big(epi, acc, brow, bcol, wr, wc, fr, fq);
    __syncthreads();
#undef SA
#undef SB
#undef STAGE
#undef LDA
#undef LDB
#undef MMA
}

DEV void tile_of(int L, int nM, int nN, int& pm, int& pn) {
    const int nwg = nM * nN; int wgid = L;
    { const int q = nwg / 8, r = nwg % 8, xcd = wgid % 8, off = wgid / 8; wgid = (xcd < r ? xcd * (q + 1) : r * (q + 1) + (xcd - r) * q) + off; }
    const int nig = 8 * nN, gid = wgid / nig, fm = gid * 8, gsz = (nM - fm) < 8 ? (nM - fm) : 8;
    pm = fm + ((wgid % nig) % gsz); pn = (wgid % nig) / gsz;
}

struct EpiBf16 {
    bf16_t* dst; int ld; const float* rstd;
    struct Ld { float rs; };
    DEV void load(int row, int col, Ld& d) const { d.rs = rstd ? rstd[row] : 1.f; }
    DEV void apply(int row, int col, const f32x4& v, const Ld& d, float& ss) const {
        u32x2 o; o.x = pk2(v[0] * d.rs, v[1] * d.rs); o.y = pk2(v[2] * d.rs, v[3] * d.rs);
        *(u32x2*)(dst + (long)row * ld + col) = o;
    }
    DEV void rowdone(int row, float ss, int fq) const {}
};
struct EpiGlu {
    bf16_t* proj; const float* glu_b;
    struct Ld { u32x2 g, z; f32x4 b; };
    DEV void load(int row, int col, Ld& d) const {
        d.g = *(const u32x2*)(proj + (long)row * PLD + C_UB + col); d.z = *(const u32x2*)(proj + (long)row * PLD + C_ZB + col); d.b = *(const f32x4*)(glu_b + col);
    }
    DEV void apply(int row, int col, const f32x4& v, const Ld& d, float& ss) const {
        const float y0 = bflo(d.g.x) * sigmf(v[0] + d.b[0]) * siluf(bflo(d.z.x)), y1 = bfhi(d.g.x) * sigmf(v[1] + d.b[1]) * siluf(bfhi(d.z.x));
        const float y2 = bflo(d.g.y) * sigmf(v[2] + d.b[2]) * siluf(bflo(d.z.y)), y3 = bfhi(d.g.y) * sigmf(v[3] + d.b[3]) * siluf(bfhi(d.z.y));
        u32x2 o; o.x = pk2(y0, y1); o.y = pk2(y2, y3);
        *(u32x2*)(proj + (long)row * PLD + C_ZB + col) = o;
    }
    DEV void rowdone(int row, float ss, int fq) const {}
};
struct EpiOut {
    const float* xp; const float* xs; float* out; bf16_t* h1b; float* rss;
    struct Ld { f32x4 x; };
    DEV void load(int row, int col, Ld& d) const {
        const float* xrow = row < NPROMPT ? xp + (long)row * 1024 : xs + (long)(row - NPROMPT) * 1024;
        d.x = *(const f32x4*)(xrow + col);
    }
    DEV void apply(int row, int col, const f32x4& a, const Ld& d, float& ss) const {
        const f32x4 v = a + d.x;
        *(f32x4*)(out + (long)row * 1024 + col) = v;
        u32x2 o; o.x = pk2(v[0], v[1]); o.y = pk2(v[2], v[3]);
        *(u32x2*)(h1b + (long)row * 1024 + col) = o;
        ss += v[0] * v[0] + v[1] * v[1] + v[2] * v[2] + v[3] * v[3];
    }
    DEV void rowdone(int row, float ss, int fq) const {
        ss += __shfl_xor(ss, 16); ss += __shfl_xor(ss, 32);
        if (fq == 0) atomicAdd(rss + row, ss);
    }
};
struct EpiPle {
    float* out; const bf16_t* pp; const float* rss1; float* rss2;
    struct Ld { f32x4 h; u32x2 pv; float rs; };
    DEV void load(int row, int col, Ld& d) const {
        d.h = *(const f32x4*)(out + (long)row * 1024 + col); d.pv = *(const u32x2*)(pp + (long)row * 1024 + col); d.rs = rss1[row];
    }
    DEV void apply(int row, int col, const f32x4& a, const Ld& d, float& ss) const {
        const float rstd = rsqrtf(d.rs * (1.f / 1024.f) + EPS);
        f32x4 h = d.h;
        h[0] += bflo(d.pv.x) * sigmf(a[0] * rstd); h[1] += bfhi(d.pv.x) * sigmf(a[1] * rstd);
        h[2] += bflo(d.pv.y) * sigmf(a[2] * rstd); h[3] += bfhi(d.pv.y) * sigmf(a[3] * rstd);
        *(f32x4*)(out + (long)row * 1024 + col) = h;
        ss += h[0] * h[0] + h[1] * h[1] + h[2] * h[2] + h[3] * h[3];
    }
    DEV void rowdone(int row, float ss, int fq) const {
        ss += __shfl_xor(ss, 16); ss += __shfl_xor(ss, 32);
        if (fq == 0) atomicAdd(rss2 + row, ss);
    }
};
template <class Epi>
DEV void epi_big(const Epi& E, const f32x4 (&acc)[2][2][4][2], int brow, int bcol, int wr, int wc, int fr, int fq) {
#pragma unroll
    for (int ai = 0; ai < 2; ++ai)
#pragma unroll
        for (int mp = 0; mp < 2; ++mp) {
            typename Epi::Ld d[2][4];
#pragma unroll
            for (int mm = 0; mm < 2; ++mm)
#pragma unroll
                for (int j = 0; j < 4; ++j)
                    E.load(brow + ai * 128 + wr * 64 + (mp * 2 + mm) * 16 + fr, bcol + (j >> 1) * 128 + wc * 32 + (j & 1) * 16 + fq * 4, d[mm][j]);
#pragma unroll
            for (int mm = 0; mm < 2; ++mm) {
                const int row = brow + ai * 128 + wr * 64 + (mp * 2 + mm) * 16 + fr; float ss = 0.f;
#pragma unroll
                for (int j = 0; j < 4; ++j)
                    E.apply(row, bcol + (j >> 1) * 128 + wc * 32 + (j & 1) * 16 + fq * 4, acc[ai][j >> 1][mp * 2 + mm][j & 1], d[mm][j], ss);
                E.rowdone(row, ss, fq);
            }
        }
}
template <class Epi>
DEV void gemm_small(const bf16_t* __restrict__ A, int lda, const bf16_t* __restrict__ Bt, int ldb, int K, int row0, int col0, const Epi& E) {
    const int tid = tid_fresh(), w = tid >> 6, lane = tid & 63, fr = lane & 15, fq = lane >> 4, wr = w >> 1, wc = w & 1;
    const bf16_t* ap = A + (long)(row0 + wr * 16 + fr) * lda + fq * 8;
    const bf16_t* bp = Bt + (long)(col0 + wc * 64 + fr) * ldb + fq * 8;
    f32x4 acc[4];
#pragma unroll
    for (int n = 0; n < 4; ++n) acc[n] = (f32x4){0.f, 0.f, 0.f, 0.f};
#pragma unroll 4
    for (int k = 0; k < K; k += 32) {
        const bf16x8 a = *(const bf16x8*)(ap + k);
        bf16x8 b[4];
#pragma unroll
        for (int n = 0; n < 4; ++n) b[n] = *(const bf16x8*)(bp + (long)n * 16 * ldb + k);
#pragma unroll
        for (int n = 0; n < 4; ++n) acc[n] = mfma16(b[n], a, acc[n]);
    }
    const int row = row0 + wr * 16 + fr;
    typename Epi::Ld d[4];
#pragma unroll
    for (int n = 0; n < 4; ++n) E.load(row, col0 + wc * 64 + n * 16 + fq * 4, d[n]);
    float ss = 0.f;
#pragma unroll
    for (int n = 0; n < 4; ++n) E.apply(row, col0 + wc * 64 + n * 16 + fq * 4, acc[n], d[n], ss);
    E.rowdone(row, ss, fq);
}

DEV void transpose_tile(const float* __restrict__ src, int ldsrc, int k0, int c0, bf16_t* __restrict__ dst, int lddst, int n0,
                        const float* __restrict__ kscale, float* tile) {
    const int tid = tid_fresh();
    const int c = tid & 63, r0 = tid >> 6;
#pragma unroll
    for (int i = 0; i < 8; ++i) {
        const int r = r0 + i * 8; float v = src[(long)(k0 + r) * ldsrc + c0 + c];
        if (kscale) v *= kscale[k0 + r];
        tile[r * 65 + c] = v;
    }
    __syncthreads();
    const int n = tid >> 3, kc = tid & 7;
    u32x4 o;
    o.x = pk2(tile[(kc * 8 + 0) * 65 + n], tile[(kc * 8 + 1) * 65 + n]);
    o.y = pk2(tile[(kc * 8 + 2) * 65 + n], tile[(kc * 8 + 3) * 65 + n]);
    o.z = pk2(tile[(kc * 8 + 4) * 65 + n], tile[(kc * 8 + 5) * 65 + n]);
    o.w = pk2(tile[(kc * 8 + 6) * 65 + n], tile[(kc * 8 + 7) * 65 + n]);
    *(u32x4*)(dst + (long)(n0 + n) * lddst + k0 + kc * 8) = o;
    __syncthreads();
}

DEV void phase0(const Params& P) {
    const int tid = tid_fresh(), lane = tid & 63, wave = tid >> 6, G = gridDim.x, bid = blockIdx.x;
    char* ws = P.ws;
    float* tile = (float*)smem;
    constexpr int T_IN = 72 * 16, T_OUT = 16 * 32, T_GLU = 16 * 16, T_GATE = 16 * 16, T_PP = 16 * 4;
    constexpr int T_ALL = T_IN + T_OUT + T_GLU + T_GATE + T_PP;
    for (int it = bid; it < T_ALL; it += G) {
        int r = it;
        if (r < T_IN) {
            const int nb = r >> 4, kb = r & 15, n0 = nb * 64;
            int c0;
            if (n0 < 1024) c0 = n0; else if (n0 < 2048) c0 = 2576 + (n0 - 1024); else if (n0 < 3584) c0 = 1024 + (n0 - 2048); else c0 = 3600 + (n0 - 3584);
            transpose_tile(P.in[I_WIN], 4624, kb * 64, c0, (bf16_t*)(ws + W_WTIN), 1024, n0, nullptr, tile); continue;
        }
        r -= T_IN;
        if (r < T_OUT) { const int nb = r >> 5, kb = r & 31; transpose_tile(P.in[I_WOUT], 1024, kb * 64, nb * 64, (bf16_t*)(ws + W_WTOUT), 2048, nb * 64, nullptr, tile); continue; }
        r -= T_OUT;
        if (r < T_GLU) { const int nb = r >> 4, kb = r & 15; transpose_tile(P.in[I_GLUW], 1024, kb * 64, nb * 64, (bf16_t*)(ws + W_WTGLU), 1024, nb * 64, nullptr, tile); continue; }
        r -= T_GLU;
        if (r < T_GATE) { const int nb = r >> 4, kb = r & 15; transpose_tile(P.in[I_WGATE], 1024, kb * 64, nb * 64, (bf16_t*)(ws + W_WTGATE), 1024, nb * 64, P.in[I_GPLE], tile); continue; }
        r -= T_GATE;
        { const int nb = r >> 2, kb = r & 3; transpose_tile(P.in[I_WPP], 1024, kb * 64, nb * 64, (bf16_t*)(ws + W_WTPP), 256, nb * 64, nullptr, tile); }
    }
    float* wdt = (float*)smem;
    for (int idx = tid; idx < 16 * 1024; idx += 512) { const int k = idx >> 4, e = idx & 15; wdt[e * 1024 + k] = P.in[I_WIN][(long)k * 4624 + 2560 + e]; }
    __syncthreads();
    bf16_t* nb_ = (bf16_t*)(ws + W_NB);
    float* dtr = (float*)(ws + W_DTR);
    for (int row = bid * 8 + wave; row < NTOK; row += G * 8) {
        const float* xr = row < NPROMPT ? P.in[I_XP] + (long)row * 1024 : P.in[I_XS] + (long)(row - NPROMPT) * 1024;
        f32x4 v[4]; float s = 0.f;
#pragma unroll
        for (int j = 0; j < 4; ++j) { v[j] = *(const f32x4*)(xr + j * 256 + lane * 4); s += v[j][0] * v[j][0] + v[j][1] * v[j][1] + v[j][2] * v[j][2] + v[j][3] * v[j][3]; }
        s = wave_sum(s);
        const float rstd = rsqrtf(s * (1.f / 1024.f) + EPS);
#pragma unroll
        for (int j = 0; j < 4; ++j) {
            const f32x4 g = *(const f32x4*)(P.in[I_GIN] + j * 256 + lane * 4);
            v[j] = v[j] * rstd * g;
            u32x2 o; o.x = pk2(v[j][0], v[j][1]); o.y = pk2(v[j][2], v[j][3]);
            *(u32x2*)(nb_ + (long)row * 1024 + j * 256 + lane * 4) = o;
        }
        float outv = 0.f;
#pragma unroll
        for (int e = 0; e < 16; ++e) {
            float a = 0.f;
#pragma unroll
            for (int j = 0; j < 4; ++j) { const f32x4 w = *(const f32x4*)(wdt + e * 1024 + j * 256 + lane * 4); a += v[j][0] * w[0] + v[j][1] * w[1] + v[j][2] * w[2] + v[j][3] * w[3]; }
            a = wave_sum(a);
            if (lane == e) outv = a;
        }
        if (lane < 16) dtr[(long)row * 16 + lane] = outv;
    }
    bf16_t* pb = (bf16_t*)(ws + W_PB);
    for (int idx = bid * 512 + tid; idx < NTOK * 64; idx += G * 512) {
        const int row = idx >> 6, c4 = (idx & 63) * 4;
        const float* src = row < NPROMPT ? P.in[I_PP] + (long)row * 256 : P.in[I_PS] + (long)(row - NPROMPT) * 256;
        const f32x4 v = *(const f32x4*)(src + c4);
        u32x2 o; o.x = pk2(v[0], v[1]); o.y = pk2(v[2], v[3]);
        *(u32x2*)(pb + (long)row * 256 + c4) = o;
    }
    float* rss = (float*)(ws + W_RSS1);
    for (int idx = bid * 512 + tid; idx < 2 * NTOK; idx += G * 512) rss[idx] = 0.f;
    __syncthreads();
}

DEV void conv4x8(const bf16_t* __restrict__ pcol, long row0, int t0, const float* __restrict__ hist, const float* __restrict__ cw, const float* __restrict__ cb, float (&o)[4][8]) {
    float raw[7][8];
#pragma unroll
    for (int i = 0; i < 7; ++i) {
        const int t = t0 - 3 + i;
        if (t >= 0) {
            const u32x4 u = *(const u32x4*)(pcol + (row0 - 3 + i) * PLD);
            raw[i][0] = bflo(u.x); raw[i][1] = bfhi(u.x); raw[i][2] = bflo(u.y); raw[i][3] = bfhi(u.y);
            raw[i][4] = bflo(u.z); raw[i][5] = bfhi(u.z); raw[i][6] = bflo(u.w); raw[i][7] = bfhi(u.w);
        } else if (hist) {
            const f32x4 a = *(const f32x4*)(hist + (long)(t + 3) * 1536), b = *(const f32x4*)(hist + (long)(t + 3) * 1536 + 4);
            raw[i][0] = a[0]; raw[i][1] = a[1]; raw[i][2] = a[2]; raw[i][3] = a[3]; raw[i][4] = b[0]; raw[i][5] = b[1]; raw[i][6] = b[2]; raw[i][7] = b[3];
        } else {
#pragma unroll
            for (int c = 0; c < 8; ++c) raw[i][c] = 0.f;
        }
    }
    float w[4][8], bias[8];
#pragma unroll
    for (int k = 0; k < 4; ++k) {
        const f32x4 a = *(const f32x4*)(cw + k * 1536), b = *(const f32x4*)(cw + k * 1536 + 4);
        w[k][0] = a[0]; w[k][1] = a[1]; w[k][2] = a[2]; w[k][3] = a[3]; w[k][4] = b[0]; w[k][5] = b[1]; w[k][6] = b[2]; w[k][7] = b[3];
    }
    { const f32x4 a = *(const f32x4*)(cb), b = *(const f32x4*)(cb + 4);
      bias[0] = a[0]; bias[1] = a[1]; bias[2] = a[2]; bias[3] = a[3]; bias[4] = b[0]; bias[5] = b[1]; bias[6] = b[2]; bias[7] = b[3]; }
#pragma unroll
    for (int j = 0; j < 4; ++j)
#pragma unroll
        for (int c = 0; c < 8; ++c) {
            float a = bias[c];
#pragma unroll
            for (int k = 0; k < 4; ++k) a += w[k][c] * raw[j + k][c];
            o[j][c] = siluf(a);
        }
}

constexpr int PIT = 136;
constexpr int R1_OFF = 0, R2_OFF = 128 * PIT * 2, R3_OFF = 2 * 128 * PIT * 2, R4_OFF = 3 * 128 * PIT * 2;

DEV void ssd_s1_item(const Params& P, int item) {
    const int tid = tid_fresh(), lane = tid & 63, w = tid >> 6, fr = lane & 15, fq = lane >> 4;
    const int b = item >> 5, c = (item >> 1) & 15, g = item & 1;
    char* ws = P.ws;
    const bf16_t* proj = (const bf16_t*)(ws + W_PROJ);
    const long rowc = (long)b * 2048 + c * 128;
    bf16_t* R1 = (bf16_t*)(smem + R1_OFF); bf16_t* R2 = (bf16_t*)(smem + R2_OFF); bf16_t* R3 = (bf16_t*)(smem + R3_OFF);
    float* acs = (float*)(smem + R4_OFF);
    float* dtv = acs + 1024;
    {
        const int h = g * 8 + w;
        const float bias = P.in[I_DTB][h], A = -__expf(P.in[I_ALOG][h]);
        const float* dtr = (const float*)(ws + W_DTR);
        float x0 = dtr[(rowc + 2 * lane) * 16 + h] + bias, x1 = dtr[(rowc + 2 * lane + 1) * 16 + h] + bias;
        float d0 = x0 > 20.f ? x0 : log1pf(__expf(x0)), d1 = x1 > 20.f ? x1 : log1pf(__expf(x1));
        float a0 = d0 * A, a1 = a0 + d1 * A;
        float run = a1;
#pragma unroll
        for (int o = 1; o < 64; o <<= 1) { float t = __shfl_up(run, o); if (lane >= o) run += t; }
        const float excl = run - a1;
        a0 += excl; a1 += excl;
        acs[w * 128 + 2 * lane] = a0; acs[w * 128 + 2 * lane + 1] = a1;
        dtv[w * 128 + 2 * lane] = d0; dtv[w * 128 + 2 * lane + 1] = d1;
        float* acsg = (float*)(ws + W_ACS) + (((long)b * 16 + c) * 16 + h) * 128;
        acsg[2 * lane] = a0; acsg[2 * lane + 1] = a1;
        if (lane == 63) ((float*)(ws + W_CDEC))[(b * 16 + c) * 16 + h] = __expf(a1);
    }
    {
        const int nblk = tid & 15, lq = tid >> 4, l0 = lq * 4;
#pragma unroll
        for (int j = 0; j < 2; ++j) {
            const int ch0 = 1024 + j * 256 + g * 128 + nblk * 8;
            float o[4][8];
            conv4x8(proj + C_XBC + ch0, rowc + l0, c * 128 + l0, nullptr, P.in[I_CONVW] + ch0, P.in[I_CONVB] + ch0, o);
            bf16_t* dst = j == 0 ? R2 : R1;
#pragma unroll
            for (int r = 0; r < 4; ++r) {
                u32x4 q; q.x = pk2(o[r][0], o[r][1]); q.y = pk2(o[r][2], o[r][3]); q.z = pk2(o[r][4], o[r][5]); q.w = pk2(o[r][6], o[r][7]);
                *(u32x4*)(dst + (l0 + r) * PIT + nblk * 8) = q;
            }
            if (j == 0) {
#pragma unroll
                for (int i = 0; i < 8; ++i) {
                    u32x2 q; q.x = pk2(o[0][i], o[1][i]); q.y = pk2(o[2][i], o[3][i]);
                    *(u32x2*)(R3 + (nblk * 8 + i) * PIT + l0) = q;
                }
            }
        }
    }
    __syncthreads();
    const int wr = w >> 1, wc = w & 1;
    f32x4 cbm[2][4];
#pragma unroll
    for (int m = 0; m < 2; ++m)
#pragma unroll
        for (int n = 0; n < 4; ++n) cbm[m][n] = (f32x4){0.f, 0.f, 0.f, 0.f};
#pragma unroll
    for (int ks = 0; ks < 4; ++ks) {
        bf16x8 af[2], bfm[4];
#pragma unroll
        for (int m = 0; m < 2; ++m) af[m] = *(const bf16x8*)(R1 + (wr * 32 + m * 16 + fr) * PIT + ks * 32 + fq * 8);
#pragma unroll
        for (int n = 0; n < 4; ++n) bfm[n] = *(const bf16x8*)(R2 + (wc * 64 + n * 16 + fr) * PIT + ks * 32 + fq * 8);
#pragma unroll
        for (int m = 0; m < 2; ++m)
#pragma unroll
            for (int n = 0; n < 4; ++n) cbm[m][n] = mfma16(bfm[n], af[m], cbm[m][n]);
    }
    __syncthreads();
    bf16_t* XT = R2; bf16_t* XW = R2 + 64 * PIT;
    bf16_t* ydg = (bf16_t*)(ws + W_NB);
    float* states = P.out;
    const int wp = w >> 2, wn = w & 3;
    for (int e = 0; e < 8; ++e) {
        const int h = g * 8 + e;
        if (tid < 256) {
            const int pblk = tid & 7, lq = tid >> 3, l0 = lq * 4, ch0 = h * 64 + pblk * 8;
            float o[4][8];
            conv4x8(proj + C_XBC + ch0, rowc + l0, c * 128 + l0, nullptr, P.in[I_CONVW] + ch0, P.in[I_CONVB] + ch0, o);
            const float alast = acs[e * 128 + 127];
            float we[4];
#pragma unroll
            for (int r = 0; r < 4; ++r) we[r] = __expf(alast - acs[e * 128 + l0 + r]) * dtv[e * 128 + l0 + r];
#pragma unroll
            for (int i = 0; i < 8; ++i) {
                u32x2 q; q.x = pk2(o[0][i], o[1][i]); q.y = pk2(o[2][i], o[3][i]);
                *(u32x2*)(XT + (pblk * 8 + i) * PIT + l0) = q;
                u32x2 q2; q2.x = pk2(o[0][i] * we[0], o[1][i] * we[1]); q2.y = pk2(o[2][i] * we[2], o[3][i] * we[3]);
                *(u32x2*)(XW + (pblk * 8 + i) * PIT + l0) = q2;
            }
        }
#pragma unroll
        for (int m = 0; m < 2; ++m) {
            const int l = wr * 32 + m * 16 + fr; const float al = acs[e * 128 + l];
#pragma unroll
            for (int n = 0; n < 4; ++n) {
                const int s0 = wc * 64 + n * 16 + fq * 4;
                const f32x4 as = *(const f32x4*)(acs + e * 128 + s0), ds = *(const f32x4*)(dtv + e * 128 + s0);
                float v[4];
#pragma unroll
                for (int r = 0; r < 4; ++r) { const float t = cbm[m][n][r] * __expf(al - as[r]) * ds[r]; v[r] = (s0 + r <= l) ? t : 0.f; }
                u32x2 q; q.x = pk2(v[0], v[1]); q.y = pk2(v[2], v[3]);
                *(u32x2*)(R1 + l * PIT + s0) = q;
            }
        }
        __syncthreads();
        {
            f32x4 yd[2][2];
#pragma unroll
            for (int m = 0; m < 2; ++m)
#pragma unroll
                for (int n = 0; n < 2; ++n) yd[m][n] = (f32x4){0.f, 0.f, 0.f, 0.f};
            for (int ks = 0; ks <= wr; ++ks) {
                bf16x8 af[2], bfm[2];
#pragma unroll
                for (int m = 0; m < 2; ++m) af[m] = *(const bf16x8*)(R1 + (wr * 32 + m * 16 + fr) * PIT + ks * 32 + fq * 8);
#pragma unroll
                for (int n = 0; n < 2; ++n) bfm[n] = *(const bf16x8*)(XT + (wc * 32 + n * 16 + fr) * PIT + ks * 32 + fq * 8);
#pragma unroll
                for (int m = 0; m < 2; ++m)
#pragma unroll
                    for (int n = 0; n < 2; ++n) yd[m][n] = mfma16(bfm[n], af[m], yd[m][n]);
            }
#pragma unroll
            for (int m = 0; m < 2; ++m)
#pragma unroll
                for (int n = 0; n < 2; ++n) {
                    const int l = wr * 32 + m * 16 + fr, p0 = wc * 32 + n * 16 + fq * 4;
                    u32x2 q; q.x = pk2(yd[m][n][0], yd[m][n][1]); q.y = pk2(yd[m][n][2], yd[m][n][3]);
                    *(u32x2*)(ydg + (rowc + l) * 1024 + h * 64 + p0) = q;
                }
        }
        {
            f32x4 st[2][2];
#pragma unroll
            for (int m = 0; m < 2; ++m)
#pragma unroll
                for (int n = 0; n < 2; ++n) st[m][n] = (f32x4){0.f, 0.f, 0.f, 0.f};
#pragma unroll
            for (int ks = 0; ks < 4; ++ks) {
                bf16x8 af[2], bfm[2];
#pragma unroll
                for (int m = 0; m < 2; ++m) af[m] = *(const bf16x8*)(XW + (wp * 32 + m * 16 + fr) * PIT + ks * 32 + fq * 8);
#pragma unroll
                for (int n = 0; n < 2; ++n) bfm[n] = *(const bf16x8*)(R3 + (wn * 32 + n * 16 + fr) * PIT + ks * 32 + fq * 8);
#pragma unroll
                for (int m = 0; m < 2; ++m)
#pragma unroll
                    for (int n = 0; n < 2; ++n) st[m][n] = mfma16(bfm[n], af[m], st[m][n]);
            }
            float* sp = states + (((long)b * 16 + c) * 16 + h) * 8192;
#pragma unroll
            for (int m = 0; m < 2; ++m)
#pragma unroll
                for (int n = 0; n < 2; ++n) {
                    const int p = wp * 32 + m * 16 + fr, n0 = wn * 32 + n * 16 + fq * 4;
                    *(f32x4*)(sp + p * 128 + n0) = st[m][n];
                }
        }
        __syncthreads();
    }
}

DEV void ssd_s2(const Params& P) {
    float* states = P.out;
    const float* cdec = (const float*)(P.ws + W_CDEC);
    for (int idx = blockIdx.x * 512 + threadIdx.x; idx < 262144; idx += gridDim.x * 512) {
        const int bh = idx >> 11, q = idx & 2047, b = bh >> 4, h = bh & 15;
        f32x4 H = (f32x4){0.f, 0.f, 0.f, 0.f};
#pragma unroll
        for (int c = 0; c < 16; ++c) {
            f32x4* ptr = (f32x4*)(states + (((long)b * 16 + c) * 16 + h) * 8192) + q;
            const f32x4 s = *ptr; *ptr = H;
            const float d = cdec[(b * 16 + c) * 16 + h];
            H = H * d + s;
        }
        *((f32x4*)(P.out + O_SSDP + (long)bh * 8192) + q) = H;
    }
}

DEV void ssd_s3_item(const Params& P, int item) {
    const int tid = tid_fresh(), lane = tid & 63, w = tid >> 6, fr = lane & 15, fq = lane >> 4;
    const int b = item >> 5, c = (item >> 1) & 15, g = item & 1;
    char* ws = P.ws;
    bf16_t* proj = (bf16_t*)(ws + W_PROJ);
    const long rowc = (long)b * 2048 + c * 128;
    bf16_t* R1 = (bf16_t*)(smem + R1_OFF); bf16_t* HB = (bf16_t*)(smem + R2_OFF);
    float* ssq = (float*)(smem + R4_OFF);
    const bf16_t* ydg = (const bf16_t*)(ws + W_NB);
    const float* states = P.out;
    const float* acsg = (const float*)(ws + W_ACS);
    {
        const int nblk = tid & 15, lq = tid >> 4, l0 = lq * 4;
        const int ch0 = 1280 + g * 128 + nblk * 8;
        float o[4][8];
        conv4x8(proj + C_XBC + ch0, rowc + l0, c * 128 + l0, nullptr, P.in[I_CONVW] + ch0, P.in[I_CONVB] + ch0, o);
#pragma unroll
        for (int r = 0; r < 4; ++r) {
            u32x4 q; q.x = pk2(o[r][0], o[r][1]); q.y = pk2(o[r][2], o[r][3]); q.z = pk2(o[r][4], o[r][5]); q.w = pk2(o[r][6], o[r][7]);
            *(u32x4*)(R1 + (l0 + r) * PIT + nblk * 8) = q;
        }
        if (tid < 128) ssq[tid] = 0.f;
    }
    const int wr = w >> 1, wc = w & 1;
    for (int e = 0; e < 8; ++e) {
        const int h = g * 8 + e;
        __syncthreads();
        {
            const int p = tid >> 3, n0 = (tid & 7) * 16;
            const float* sp = states + (((long)b * 16 + c) * 16 + h) * 8192 + p * 128 + n0;
            const f32x4 a0 = *(const f32x4*)(sp), a1 = *(const f32x4*)(sp + 4), a2 = *(const f32x4*)(sp + 8), a3 = *(const f32x4*)(sp + 12);
            u32x4 q0, q1;
            q0.x = pk2(a0[0], a0[1]); q0.y = pk2(a0[2], a0[3]); q0.z = pk2(a1[0], a1[1]); q0.w = pk2(a1[2], a1[3]);
            q1.x = pk2(a2[0], a2[1]); q1.y = pk2(a2[2], a2[3]); q1.z = pk2(a3[0], a3[1]); q1.w = pk2(a3[2], a3[3]);
            *(u32x4*)(HB + p * PIT + n0) = q0; *(u32x4*)(HB + p * PIT + n0 + 8) = q1;
        }
        __syncthreads();
        f32x4 yo[2][2];
#pragma unroll
        for (int m = 0; m < 2; ++m)
#pragma unroll
            for (int n = 0; n < 2; ++n) yo[m][n] = (f32x4){0.f, 0.f, 0.f, 0.f};
#pragma unroll
        for (int ks = 0; ks < 4; ++ks) {
            bf16x8 af[2], bfm[2];
#pragma unroll
            for (int m = 0; m < 2; ++m) af[m] = *(const bf16x8*)(R1 + (wr * 32 + m * 16 + fr) * PIT + ks * 32 + fq * 8);
#pragma unroll
            for (int n = 0; n < 2; ++n) bfm[n] = *(const bf16x8*)(HB + (wc * 32 + n * 16 + fr) * PIT + ks * 32 + fq * 8);
#pragma unroll
            for (int m = 0; m < 2; ++m)
#pragma unroll
                for (int n = 0; n < 2; ++n) yo[m][n] = mfma16(bfm[n], af[m], yo[m][n]);
        }
        const float dsk = P.in[I_SSDD][h];
#pragma unroll
        for (int m = 0; m < 2; ++m) {
            const int l = wr * 32 + m * 16 + fr; const long row = rowc + l; const int t = c * 128 + l;
            const float ea = __expf(acsg[(((long)b * 16 + c) * 16 + h) * 128 + l]);
            float ss = 0.f;
#pragma unroll
            for (int n = 0; n < 2; ++n) {
                const int p0 = wc * 32 + n * 16 + fq * 4, ch0 = h * 64 + p0;
                const f32x4 bias = *(const f32x4*)(P.in[I_CONVB] + ch0);
                float xa[4] = {bias[0], bias[1], bias[2], bias[3]};
#pragma unroll
                for (int k = 0; k < 4; ++k) {
                    if (t - 3 + k >= 0) {
                        const u32x2 u = *(const u32x2*)(proj + (row - 3 + k) * PLD + C_XBC + ch0);
                        const f32x4 wk = *(const f32x4*)(P.in[I_CONVW] + k * 1536 + ch0);
                        xa[0] += wk[0] * bflo(u.x); xa[1] += wk[1] * bfhi(u.x); xa[2] += wk[2] * bflo(u.y); xa[3] += wk[3] * bfhi(u.y);
                    }
                }
                const u32x2 yq = *(const u32x2*)(ydg + row * 1024 + h * 64 + p0);
                u32x2* zp = (u32x2*)(proj + row * PLD + C_ZA + h * 64 + p0);
                const u32x2 zz = *zp;
                float yv[4] = {bflo(yq.x), bfhi(yq.x), bflo(yq.y), bfhi(yq.y)};
                float zv[4] = {bflo(zz.x), bfhi(zz.x), bflo(zz.y), bfhi(zz.y)};
                float v[4];
#pragma unroll
                for (int r = 0; r < 4; ++r) { const float y = yv[r] + ea * yo[m][n][r] + dsk * siluf(xa[r]); v[r] = y * siluf(zv[r]); ss += v[r] * v[r]; }
                u32x2 o; o.x = pk2(v[0], v[1]); o.y = pk2(v[2], v[3]);
                *zp = o;
            }
            ss += __shfl_xor(ss, 16); ss += __shfl_xor(ss, 32);
            if (fq == 0) atomicAdd(ssq + l, ss);
        }
    }
    __syncthreads();
    for (int e = 0; e < 8; ++e) {
        const int h = g * 8 + e;
#pragma unroll
        for (int m = 0; m < 2; ++m) {
            const int l = wr * 32 + m * 16 + fr; const long row = rowc + l;
            const float rstd = rsqrtf(ssq[l] * (1.f / 512.f) + EPS);
#pragma unroll
            for (int n = 0; n < 2; ++n) {
                const int p0 = wc * 32 + n * 16 + fq * 4;
                u32x2* zp = (u32x2*)(proj + row * PLD + C_ZA + h * 64 + p0);
                const u32x2 zz = *zp;
                const f32x4 gg = *(const f32x4*)(P.in[I_SSDG] + h * 64 + p0);
                u32x2 o; o.x = pk2(bflo(zz.x) * rstd * gg[0], bfhi(zz.x) * rstd * gg[1]); o.y = pk2(bflo(zz.y) * rstd * gg[2], bfhi(zz.y) * rstd * gg[3]);
                *zp = o;
            }
        }
    }
    __syncthreads();
}

DEV void ssd_sample_item(const Params& P, int item) {
    const int tid = tid_fresh();
    const int b = item >> 1, g = item & 1;
    char* ws = P.ws;
    bf16_t* proj = (bf16_t*)(ws + W_PROJ);
    const long row0 = NPROMPT + (long)b * 4;
    float* xs = (float*)smem;
    float* Bs = xs + 2048;
    float* Cs = Bs + 512;
    float* dts = Cs + 512;
    float* das = dts + 32;
    float* vs = das + 32;
    float* red = vs + 2048;
    for (int u = tid; u < 768; u += 512) {
        int ch; float* dst; int dcol;
        if (u < 512) { ch = g * 512 + u; dst = xs; dcol = u; }
        else if (u < 640) { ch = 1024 + g * 128 + (u - 512); dst = Bs; dcol = u - 512; }
        else { ch = 1280 + g * 128 + (u - 640); dst = Cs; dcol = u - 640; }
        const int pitch = u < 512 ? 512 : 128;
        float full[7];
#pragma unroll
        for (int i = 0; i < 3; ++i) full[i] = P.in[I_CONV][((long)b * 3 + i) * 1536 + ch];
#pragma unroll
        for (int i = 0; i < 4; ++i) full[3 + i] = __uint_as_float(((unsigned)proj[(row0 + i) * PLD + C_XBC + ch]) << 16);
        const float w0 = P.in[I_CONVW][ch], w1 = P.in[I_CONVW][1536 + ch], w2 = P.in[I_CONVW][3072 + ch], w3 = P.in[I_CONVW][4608 + ch], bias = P.in[I_CONVB][ch];
#pragma unroll
        for (int t = 0; t < 4; ++t) dst[t * pitch + dcol] = siluf(bias + w0 * full[t] + w1 * full[t + 1] + w2 * full[t + 2] + w3 * full[t + 3]);
    }
    if (tid < 32) {
        const int t = tid >> 3, e = tid & 7, h = g * 8 + e;
        const float x = ((const float*)(ws + W_DTR))[(row0 + t) * 16 + h] + P.in[I_DTB][h];
        const float d = x > 20.f ? x : log1pf(__expf(x));
        dts[tid] = d; das[tid] = __expf(-d * __expf(P.in[I_ALOG][h]));
    }
    __syncthreads();
    const int p = tid >> 3, nb = tid & 7, n0 = nb * 16;
    for (int e = 0; e < 8; ++e) {
        const int h = g * 8 + e;
        const float* sp = P.in[I_SSD] + (((long)b * 16 + h) * 64 + p) * 128 + n0;
        float* op = P.out + O_SSDS + (((long)b * 16 + h) * 64 + p) * 128 + n0;
        f32x4 hv[4];
#pragma unroll
        for (int i = 0; i < 4; ++i) hv[i] = *(const f32x4*)(sp + i * 4);
        const float dsk = P.in[I_SSDD][h];
#pragma unroll
        for (int t = 0; t < 4; ++t) {
            const float dec = das[t * 8 + e], xv = xs[t * 512 + e * 64 + p], coef = dts[t * 8 + e] * xv;
            float part = 0.f;
#pragma unroll
            for (int i = 0; i < 4; ++i) {
                const f32x4 bv = *(const f32x4*)(Bs + t * 128 + n0 + i * 4), cv = *(const f32x4*)(Cs + t * 128 + n0 + i * 4);
                hv[i] = hv[i] * dec + bv * coef;
                part += hv[i][0] * cv[0] + hv[i][1] * cv[1] + hv[i][2] * cv[2] + hv[i][3] * cv[3];
            }
            part += __shfl_xor(part, 1); part += __shfl_xor(part, 2); part += __shfl_xor(part, 4);
            if (nb == 0) {
                const float z = __uint_as_float(((unsigned)proj[(row0 + t) * PLD + C_ZA + h * 64 + p]) << 16);
                vs[t * 512 + e * 64 + p] = (part + dsk * xv) * siluf(z);
            }
        }
#pragma unroll
        for (int i = 0; i < 4; ++i) *(f32x4*)(op + i * 4) = hv[i];
    }
    __syncthreads();
    {
        const int t = tid >> 7, cidx = tid & 127;
        float v[4]; float ss = 0.f;
#pragma unroll
        for (int i = 0; i < 4; ++i) { v[i] = vs[t * 512 + cidx * 4 + i]; ss += v[i] * v[i]; }
        ss = wave_sum(ss);
        if ((tid & 63) == 0) red[tid >> 6] = ss;
        __syncthreads();
        const float tot = red[t * 2] + red[t * 2 + 1];
        const float rstd = rsqrtf(tot * (1.f / 512.f) + EPS);
        const f32x4 gg = *(const f32x4*)(P.in[I_SSDG] + g * 512 + cidx * 4);
        u32x2 o; o.x = pk2(v[0] * rstd * gg[0], v[1] * rstd * gg[1]); o.y = pk2(v[2] * rstd * gg[2], v[3] * rstd * gg[3]);
        *(u32x2*)(proj + (row0 + t) * PLD + C_ZA + g * 512 + cidx * 4) = o;
    }
    __syncthreads();
}

constexpr int S5P = 20;
template <bool SAMPLE>
DEV void s5_item(const Params& P, int g, long rowbase, int bidx) {
    const int tid = tid_fresh(), lane = tid & 63, w = tid >> 6, fr = lane & 15, fq = lane >> 4;
    constexpr int TPW = SAMPLE ? 32 : 256;
    bf16_t* proj = (bf16_t*)(P.ws + W_PROJ);
    float* buf = (float*)smem + w * (128 * S5P);
    float* carry = (float*)smem + 8 * 128 * S5P;
    float* fs = carry + 1024 + w * 128;
    float ar, ai;
    {
        const float lr = P.in[I_LRE][g * 64 + lane], li = P.in[I_LIM][g * 64 + lane], delta = expf(P.in[I_LDT][g]);
        const float mag = expf(lr * delta), ang = li * delta;
        ar = mag * cosf(ang); ai = mag * sinf(ang);
        const float qre = ar - 1.f, den = lr * lr + li * li;
        fs[lane] = (qre * lr + ai * li) / den; fs[64 + lane] = (ai * lr - qre * li) / den;
    }
    lds_fence();
    bf16x8 bbf[8];
#pragma unroll
    for (int j = 0; j < 8; ++j) {
        bf16x8 z = {0, 0, 0, 0, 0, 0, 0, 0};
        if (fq < 2) {
            const int p = (j & 3) * 16 + fr;
            const float f_r = fs[p], f_i = fs[64 + p];
            const float* br = P.in[I_BRE] + ((long)(g * 64 + p)) * 16 + fq * 8;
            const float* bi = P.in[I_BIM] + ((long)(g * 64 + p)) * 16 + fq * 8;
            const f32x4 r0 = *(const f32x4*)br, r1 = *(const f32x4*)(br + 4), i0 = *(const f32x4*)bi, i1 = *(const f32x4*)(bi + 4);
            f32x4 o0, o1;
            if (j < 4) { o0 = r0 * f_r - i0 * f_i; o1 = r1 * f_r - i1 * f_i; }
            else { o0 = i0 * f_r + r0 * f_i; o1 = i1 * f_r + r1 * f_i; }
            u32x4 q; q.x = pk2(o0[0], o0[1]); q.y = pk2(o0[2], o0[3]); q.z = pk2(o1[0], o1[1]); q.w = pk2(o1[2], o1[3]);
            z = __builtin_bit_cast(bf16x8, q);
        }
        bbf[j] = z;
    }
    bf16x8 ccf[4];
#pragma unroll
    for (int ks = 0; ks < 4; ++ks) {
        const float* src = (ks < 2 ? P.in[I_CRE] : P.in[I_CIM]) + ((long)(g * 16 + fr)) * 64 + (ks & 1) * 32 + fq * 8;
        f32x4 c0 = *(const f32x4*)src, c1 = *(const f32x4*)(src + 4);
        if (ks >= 2) { c0 = -c0; c1 = -c1; }
        u32x4 q; q.x = pk2(c0[0], c0[1]); q.y = pk2(c0[2], c0[3]); q.z = pk2(c1[0], c1[1]); q.w = pk2(c1[2], c1[3]);
        ccf[ks] = __builtin_bit_cast(bf16x8, q);
    }
    const f32x4 dsk = *(const f32x4*)(P.in[I_S5D] + g * 16 + fq * 4);
    const long roww = rowbase + (long)w * TPW;
    float xr = 0.f, xi = 0.f;
    constexpr int NPASS = SAMPLE ? 1 : 2;
#pragma unroll 1
    for (int pass = 0; pass < NPASS; ++pass) {
        const bool last = (pass == NPASS - 1);
        if (!SAMPLE && pass == 1) {
            carry[w * 128 + lane] = xr; carry[w * 128 + 64 + lane] = xi;
            __syncthreads();
            float pr = ar, pi = ai;
#pragma unroll
            for (int q = 0; q < 8; ++q) { const float nr = pr * pr - pi * pi, ni = 2.f * pr * pi; pr = nr; pi = ni; }
            float sr = 0.f, si = 0.f;
            for (int ww = 0; ww < w; ++ww) {
                const float cr = carry[ww * 128 + lane], ci = carry[ww * 128 + 64 + lane];
                const float nr = pr * sr - pi * si + cr, ni = pr * si + pi * sr + ci; sr = nr; si = ni;
            }
            xr = sr; xi = si;
        }
        if (!SAMPLE && pass == 0 && w == 7) continue;
#pragma unroll 1
        for (int sb = 0; sb < TPW / 16; ++sb) {
            const long r = roww + sb * 16;
            bf16x8 uf = {0, 0, 0, 0, 0, 0, 0, 0};
            if (fq < 2) uf = *(const bf16x8*)(proj + (r + fr) * PLD + C_UB + g * 16 + fq * 8);
            const f32x4 zero = {0.f, 0.f, 0.f, 0.f};
#pragma unroll
            for (int j = 0; j < 8; ++j) {
                const f32x4 d = mfma16(uf, bbf[j], zero);
                *(f32x4*)(buf + (j * 16 + fr) * S5P + fq * 4) = d;
            }
            lds_fence();
#pragma unroll
            for (int q = 0; q < 4; ++q) {
                f32x4 br = *(const f32x4*)(buf + lane * S5P + q * 4), bi = *(const f32x4*)(buf + (64 + lane) * S5P + q * 4);
                if (SAMPLE) {
                    const long seq = (r - NPROMPT) / 4 + q;
                    xr = P.in[I_S5R][(seq * 64 + g) * 64 + lane]; xi = P.in[I_S5I][(seq * 64 + g) * 64 + lane];
                }
#pragma unroll
                for (int i = 0; i < 4; ++i) {
                    const float nr = ar * xr - ai * xi + br[i], ni = ar * xi + ai * xr + bi[i];
                    xr = nr; xi = ni; br[i] = nr; bi[i] = ni;
                }
                if (last) { *(f32x4*)(buf + lane * S5P + q * 4) = br; *(f32x4*)(buf + (64 + lane) * S5P + q * 4) = bi; }
                if (SAMPLE) {
                    const long seq = (r - NPROMPT) / 4 + q;
                    P.out[O_S5RS + (seq * 64 + g) * 64 + lane] = xr; P.out[O_S5IS + (seq * 64 + g) * 64 + lane] = xi;
                }
            }
            if (last) {
                lds_fence();
                f32x4 y = {0.f, 0.f, 0.f, 0.f};
#pragma unroll
                for (int ks = 0; ks < 4; ++ks) {
                    float xv[8];
#pragma unroll
                    for (int i = 0; i < 8; ++i) xv[i] = buf[(ks * 32 + fq * 8 + i) * S5P + fr];
                    u32x4 q; q.x = pk2(xv[0], xv[1]); q.y = pk2(xv[2], xv[3]); q.z = pk2(xv[4], xv[5]); q.w = pk2(xv[6], xv[7]);
                    y = mfma16(ccf[ks], __builtin_bit_cast(bf16x8, q), y);
                }
                u32x2* up = (u32x2*)(proj + (r + fr) * PLD + C_UB + g * 16 + fq * 4);
                const u32x2 uu = *up;
                const float y0 = geluf(y[0] + dsk[0] * bflo(uu.x)), y1 = geluf(y[1] + dsk[1] * bfhi(uu.x));
                const float y2 = geluf(y[2] + dsk[2] * bflo(uu.y)), y3 = geluf(y[3] + dsk[3] * bfhi(uu.y));
                u32x2 o; o.x = pk2(y0, y1); o.y = pk2(y2, y3);
                *up = o;
            }
            lds_fence();
        }
    }
    if (!SAMPLE && w == 7) {
        P.out[O_S5RP + ((long)bidx * 64 + g) * 64 + lane] = xr; P.out[O_S5IP + ((long)bidx * 64 + g) * 64 + lane] = xi;
    }
    __syncthreads();
}

__global__ void __launch_bounds__(512) hymba_fwd(Params P) {
    cg::grid_group grid = cg::this_grid();
#ifdef PROBE_K
    unsigned long long tb_[9]; int nb_ = 0;
#define TB() do { tb_[nb_++] = wall_clock64(); } while (0)
    TB();
#else
#define TB() do {} while (0)
#endif
    const int G = gridDim.x, bid = blockIdx.x;
    char* ws = P.ws;
    bf16_t* proj = (bf16_t*)(ws + W_PROJ);
    unsigned* barw = (unsigned*)(ws + W_BAR);
    if (bid == 0) for (int i = threadIdx.x; i < XCD_BAR_WORDS; i += 512) barw[i] = 0u;
    volatile LAS unsigned* stw = (volatile LAS unsigned*)(smem + 131072);
    if (threadIdx.x < 4) stw[threadIdx.x] = 0u;
#ifndef NO_P0
    phase0(P);
#endif
    grid.sync(); TB();
    const XcdBarrier xb = xcd_barrier_post(barw, stw);
#ifndef NO_P1
    for (int L = bid; L < 1188; L += G) {
        int pm, pn; tile_of(L, 66, 18, pm, pn);
        gemm_tile((const bf16_t*)(ws + W_NB), 1024, (const bf16_t*)(ws + W_WTIN), 1024, 1024, pm * 256, pn * 256, EpiBf16{proj, PLD, nullptr});
    }
    for (int L = (bid + G - 1188 % G) % G; L < 264; L += G) {
        int pm, pn; tile_of(L, 66, 4, pm, pn);
        gemm_tile((const bf16_t*)(ws + W_PB), 256, (const bf16_t*)(ws + W_WTPP), 256, 256, pm * 256, pn * 256, EpiBf16{(bf16_t*)(ws + W_PP), 1024, nullptr});
    }
#endif
    xcd_barrier(xb); TB();
    for (int idx = bid * 512 + threadIdx.x; idx < (8 + 128) * 3 * 1536; idx += G * 512) {
        const int ch = idx % 1536, sj = idx / 1536, j = sj % 3, sq = sj / 3;
        const long row = sq < 8 ? (long)sq * 2048 + 2045 + j : NPROMPT + (long)(sq - 8) * 4 + 1 + j;
        const float v = __uint_as_float(((unsigned)proj[row * PLD + C_XBC + ch]) << 16);
        if (sq < 8) P.out[O_CONVP + ((long)sq * 3 + j) * 1536 + ch] = v; else P.out[O_CONVS + ((long)(sq - 8) * 3 + j) * 1536 + ch] = v;
    }
#ifndef NO_S1
    for (int it = bid; it < 256; it += G) ssd_s1_item(P, it);
#endif
#ifndef NO_SS
    for (int it = bid; it < 256; it += G) ssd_sample_item(P, it);
#endif
#ifndef NO_S5P
    for (int it = bid; it < 512; it += G) s5_item<false>(P, it & 63, (long)(it >> 6) * 2048, it >> 6);
#endif
#ifndef NO_S5S
    for (int it = bid; it < 128; it += G) s5_item<true>(P, it & 63, NPROMPT + (long)(it >> 6) * 256, 0);
#endif
    xcd_barrier(xb); TB();
#ifndef NO_P3
    {
        const EpiGlu eg{proj, P.in[I_GLUB]};
        for (int L = bid; L < 256; L += G) {
            int pm, pn; tile_of(L, 64, 4, pm, pn);
            gemm_tile(proj + C_UB, PLD, (const bf16_t*)(ws + W_WTGLU), 1024, 1024, pm * 256, pn * 256, eg);
        }
        for (int L = G - 1 - bid; L < 64; L += G)
            gemm_small(proj + C_UB, PLD, (const bf16_t*)(ws + W_WTGLU), 1024, 1024, NPROMPT + (L >> 3) * 64, (L & 7) * 128, eg);
    }
#endif
#ifndef NO_S2
    ssd_s2(P);
#endif
    xcd_barrier(xb); TB();
#ifndef NO_S3
    for (int it = bid; it < 256; it += G) ssd_s3_item(P, it);
#endif
    xcd_barrier(xb); TB();
#ifndef NO_P5
    {
        const EpiOut eo{P.in[I_XP], P.in[I_XS], P.out, (bf16_t*)(ws + W_NB), (float*)(ws + W_RSS1)};
        for (int L = bid; L < 256; L += G) {
            int pm, pn; tile_of(L, 64, 4, pm, pn);
            gemm_tile(proj, PLD, (const bf16_t*)(ws + W_WTOUT), 2048, 2048, pm * 256, pn * 256, eo);
        }
        for (int L = G - 1 - bid; L < 64; L += G)
            gemm_small(proj, PLD, (const bf16_t*)(ws + W_WTOUT), 2048, 2048, NPROMPT + (L >> 3) * 64, (L & 7) * 128, eo);
    }
#endif
    xcd_barrier(xb); TB();
#ifndef NO_P6
    {
        const EpiPle ep{P.out, (const bf16_t*)(ws + W_PP), (const float*)(ws + W_RSS1), (float*)(ws + W_RSS2)};
        for (int L = bid; L < 256; L += G) {
            int pm, pn; tile_of(L, 64, 4, pm, pn);
            gemm_tile((const bf16_t*)(ws + W_NB), 1024, (const bf16_t*)(ws + W_WTGATE), 1024, 1024, pm * 256, pn * 256, ep);
        }
        for (int L = G - 1 - bid; L < 64; L += G)
            gemm_small((const bf16_t*)(ws + W_NB), 1024, (const bf16_t*)(ws + W_WTGATE), 1024, 1024, NPROMPT + (L >> 3) * 64, (L & 7) * 128, ep);
    }
#endif
    xcd_barrier(xb); TB();
    {
        const float* rss2 = (const float*)(ws + W_RSS2);
        for (int idx = bid * 512 + threadIdx.x; idx < NTOK * 256; idx += G * 512) {
            const int row = idx >> 8, c4 = (idx & 255) * 4;
            const float rstd = rsqrtf(rss2[row] * (1.f / 1024.f) + EPS);
            f32x4* p = (f32x4*)(P.out + (long)row * 1024 + c4);
            const f32x4 gf = *(const f32x4*)(P.in[I_GFIN] + c4);
            *p = *p * rstd * gf;
        }
    }
#ifdef PROBE_K
    { TB(); const unsigned long long d = tb_[PROBE_K + 1] - tb_[PROBE_K], t0 = wall_clock64(); while (wall_clock64() - t0 < d) __builtin_amdgcn_s_sleep(8); }
#endif
}

extern "C" void kernel_launch(void* const* d_in, const int* in_sizes, int n_in, void* d_out, int out_size, void* d_ws, size_t ws_size, hipStream_t stream) {
    static int grid_blocks = 0;
    if (grid_blocks == 0) {
        if (n_in != 31 || out_size != (int)O_END || ws_size < W_END) {
            fprintf(stderr, "kernel_launch: unexpected shapes n_in %d out %d ws %zu (need %zu)\n", n_in, out_size, ws_size, (size_t)W_END);
            grid_blocks = -1; return;
        }
        int dev = 0, cus = 0, per_cu = 0;
        hipGetDevice(&dev);
        hipDeviceGetAttribute(&cus, hipDeviceAttributeMultiprocessorCount, dev);
        hipFuncSetAttribute((const void*)hymba_fwd, hipFuncAttributeMaxDynamicSharedMemorySize, LDS_BYTES);
        hipOccupancyMaxActiveBlocksPerMultiprocessor(&per_cu, (const void*)hymba_fwd, 512, LDS_BYTES);
        if (per_cu < 1) { fprintf(stderr, "kernel_launch: occupancy query says %d blocks/CU\n", per_cu); per_cu = 1; }
        grid_blocks = cus;
        (void)hipGetLastError();
    }
    if (grid_blocks < 0) return;
    Params p{};
    for (int i = 0; i < 31; ++i) p.in[i] = (const float*)d_in[i];
    p.out = (float*)d_out; p.ws = (char*)d_ws;
    void* args[] = {&p};
    hipError_t e = hipLaunchCooperativeKernel((const void*)hymba_fwd, dim3(grid_blocks), dim3(512), args, LDS_BYTES, stream);
    if (e != hipSuccess) fprintf(stderr, "cooperative launch failed: %s (grid %d)\n", hipGetErrorString(e), grid_blocks);
}
```

```cpp
#include <hip/hip_runtime.h>
#include <hip/hip_cooperative_groups.h>
#include <cstdio>
namespace cg = cooperative_groups;

typedef unsigned short bf16_t;
typedef short bf16x8 __attribute__((ext_vector_type(8)));
typedef float f32x4 __attribute__((ext_vector_type(4)));
typedef unsigned u32x2 __attribute__((ext_vector_type(2)));
typedef unsigned u32x4 __attribute__((ext_vector_type(4)));
#define DEV __device__ __forceinline__

constexpr int NPROMPT = 16384, NSAMPLE = 512, NTOK = 16896;
constexpr int PLD = 4608;
constexpr int C_ZA = 0, C_ZB = 1024, C_XBC = 2048, C_UB = 3584;
constexpr float EPS = 1e-6f;
constexpr long O_YP = 0, O_YS = 16777216, O_SSDP = 17301504, O_CONVP = 18350080, O_S5RP = 18386944, O_S5IP = 18419712,
               O_SSDS = 18452480, O_CONVS = 35229696, O_S5RS = 35819520, O_S5IS = 36343808, O_END = 36868096;
constexpr size_t W_WTIN = 0;
constexpr size_t W_WTOUT = W_WTIN + 4608ull * 1024 * 2;
constexpr size_t W_WTGLU = W_WTOUT + 1024ull * 2048 * 2;
constexpr size_t W_WTGATE = W_WTGLU + 1024ull * 1024 * 2;
constexpr size_t W_WTPP = W_WTGATE + 1024ull * 1024 * 2;
constexpr size_t W_NB = W_WTPP + 1024ull * 256 * 2;
constexpr size_t W_PB = W_NB + 16896ull * 1024 * 2;
constexpr size_t W_DTR = W_PB + 16896ull * 256 * 2;
constexpr size_t W_ACS = W_DTR + 16896ull * 16 * 4;
constexpr size_t W_CDEC = W_ACS + 16384ull * 16 * 4;
constexpr size_t W_RSS1 = W_CDEC + 8192;
constexpr size_t W_RSS2 = W_RSS1 + 16896ull * 4;
constexpr size_t W_PROJ = W_RSS2 + 16896ull * 4;
constexpr size_t W_PP = W_PROJ + 16896ull * 4608 * 2;
constexpr size_t W_RSTD = W_PP + 16896ull * 1024 * 2;
constexpr size_t W_BAR = W_RSTD + 16896ull * 4;
constexpr size_t W_END = W_BAR + 16384;

constexpr int LDS_BYTES = 131072 + 64;

struct Params {
    const float* in[31];
    float* out;
    char* ws;
};
enum { I_XP = 0, I_XS, I_PP, I_PS, I_SSD, I_CONV, I_S5R, I_S5I, I_WIN, I_GIN, I_CONVW, I_CONVB, I_DTB, I_ALOG, I_SSDD, I_SSDG,
       I_LRE, I_LIM, I_LDT, I_BRE, I_BIM, I_CRE, I_CIM, I_S5D, I_GLUW, I_GLUB, I_WOUT, I_GPLE, I_WGATE, I_WPP, I_GFIN };

extern __shared__ __attribute__((aligned(16))) char smem[];

DEV unsigned pk2(float lo, float hi) { unsigned r; asm("v_cvt_pk_bf16_f32 %0, %1, %2" : "=v"(r) : "v"(lo), "v"(hi)); return r; }
DEV float bflo(unsigned u) { return __uint_as_float(u << 16); }
DEV float bfhi(unsigned u) { return __uint_as_float(u & 0xffff0000u); }
DEV float wave_sum(float v) {
#pragma unroll
    for (int o = 1; o < 64; o <<= 1) v += __shfl_xor(v, o);
    return v;
}
DEV float siluf(float v) { return v / (1.f + __expf(-v)); }
DEV float sigmf(float v) { return 1.f / (1.f + __expf(-v)); }
DEV float geluf(float y) { float z = 0.7978845608f * (y + 0.044715f * y * y * y); return y / (1.f + __expf(-2.f * z)); }
DEV f32x4 mfma16(bf16x8 a, bf16x8 b, f32x4 c) { return __builtin_amdgcn_mfma_f32_16x16x32_bf16(a, b, c, 0, 0, 0); }
DEV int tid_fresh() { int t = threadIdx.x; asm volatile("" : "+v"(t)); return t; }
DEV void lds_fence() { asm volatile("s_waitcnt lgkmcnt(0)" ::: "memory"); }


#define XB_TMO      128
#define XB_XCNT(j)  (256  + 64 * (j))
#define XB_XSUB(j)  (1280 + 64 * (j))
#define XB_XGEN(j)  (2304 + 64 * (j))
#define XB_TOP      3328
#define XB_TOPGEN   3392
#define XCD_BAR_WORDS 3456
#define XB_SPIN_CAP (1u << 22)
#define LAS __attribute__((address_space(3)))
DEV unsigned xb_ld(unsigned* p) { return __hip_atomic_load(p, __ATOMIC_RELAXED, __HIP_MEMORY_SCOPE_AGENT); }
DEV unsigned xb_add(unsigned* p, unsigned v) { return __hip_atomic_fetch_add(p, v, __ATOMIC_RELAXED, __HIP_MEMORY_SCOPE_AGENT); }
DEV unsigned xb_xcc_id() { return (unsigned)__builtin_amdgcn_s_getreg((3 << 11) | 20) & 0xFu; }
#define XB_SPIN(cond, bar) do { unsigned _sp = 0; while (cond) { __builtin_amdgcn_s_sleep(1); \
    if ((++_sp & 255u) == 0u) { if (xb_ld(&(bar)[XB_TMO])) break; if (_sp > XB_SPIN_CAP) { atomicAdd(&(bar)[XB_TMO], 1u); break; } } } } while (0)
struct XcdBarrier { unsigned* bar; unsigned x; volatile LAS unsigned* st; };
DEV XcdBarrier xcd_barrier_post(unsigned* bar, volatile LAS unsigned* st) {
    XcdBarrier b; b.bar = bar; b.x = xb_xcc_id(); b.st = st;
    if (threadIdx.x == 0) (void)xb_add(&bar[XB_XCNT(b.x)], 1u);
    return b;
}
DEV void xcd_barrier_complete(unsigned* bar, unsigned x, unsigned& nloc, unsigned& nx) {
    const unsigned G = gridDim.x * gridDim.y * gridDim.z;
    unsigned sum, cnt, mine, sp = 0u;
    for (;;) {
        sum = 0u; cnt = 0u; mine = 0u;
#pragma unroll
        for (unsigned j = 0; j < 16; ++j) { const unsigned c = xb_ld(&bar[XB_XCNT(j)]); sum += c; cnt += (c > 0u) ? 1u : 0u; mine = (j == x) ? c : mine; }
        if (sum == G) break;
        __builtin_amdgcn_s_sleep(1);
        if ((++sp & 255u) == 0u) { if (xb_ld(&bar[XB_TMO])) break; if (sp > XB_SPIN_CAP) { atomicAdd(&bar[XB_TMO], 1u); break; } }
    }
    nloc = mine > 0u ? mine : 1u; nx = cnt > 0u ? cnt : 1u;
}
DEV void xcd_barrier(const XcdBarrier& b) {
    asm volatile("s_waitcnt vmcnt(0)" ::: "memory");
    __syncthreads();
    if (threadIdx.x == 0) {
        unsigned* bar = b.bar;
        __builtin_amdgcn_s_waitcnt(0);
        unsigned nloc = b.st[0], nx = b.st[1];
        if (nloc == 0u) { xcd_barrier_complete(bar, b.x, nloc, nx); b.st[0] = nloc; b.st[1] = nx; }
        const unsigned old = xb_add(&bar[XB_XSUB(b.x)], 1u);
        const unsigned gen = old / nloc;
        if (old + 1u == (gen + 1u) * nloc) {
            __builtin_amdgcn_fence(__ATOMIC_RELEASE, "agent");
            asm volatile("s_waitcnt vmcnt(0)" ::: "memory");
            const unsigned og = xb_add(&bar[XB_TOP], 1u);
            const unsigned tg = og / nx;
            if (og + 1u == (tg + 1u) * nx) xb_add(&bar[XB_TOPGEN], 1u);
            else XB_SPIN(xb_ld(&bar[XB_TOPGEN]) == tg, bar);
            __builtin_amdgcn_fence(__ATOMIC_ACQUIRE, "agent");
            xb_add(&bar[XB_XGEN(b.x)], 1u);
            asm volatile("s_waitcnt vmcnt(0)" ::: "memory");
        } else {
            XB_SPIN(xb_ld(&bar[XB_XGEN(b.x)]) == gen, bar);
            __builtin_amdgcn_fence(__ATOMIC_ACQUIRE, "agent");
            asm volatile("s_waitcnt vmcnt(0)" ::: "memory");
        }
    }
    __syncthreads();
}

constexpr int BM = 256, BK = 64, HALF = 128, HT = HALF * BK;
DEV int lds_byte(int r, int c) {
    int st = (r >> 4) * 2 + (c >> 5), rr = r & 15, cc = c & 31, ob = rr * 64 + cc * 2;
    return st * 1024 + (ob ^ (((ob >> 9) & 1) << 5));
}
DEV void stage_rc(int b, int& R, int& C) {
    int st = b / 1024, sb = b % 1024, swz = sb ^ (((sb >> 9) & 1) << 5);
    R = (st >> 1) * 16 + swz / 64; C = (st & 1) * 32 + (swz % 64) / 2;
}

template <class Epi>
DEV void gemm_tile(const bf16_t* __restrict__ A, int lda, const bf16_t* __restrict__ Bt, int ldb, int K, int brow, int bcol, const Epi& epi) {
    LAS unsigned char* lds = (LAS unsigned char*)smem;
    constexpr int HTB = HT * 2;
    const int tid = tid_fresh(), wid = __builtin_amdgcn_readfirstlane(tid >> 6), lane = tid & 63, wr = wid >> 2, wc = wid & 3, fr = lane & 15, fq = lane >> 4;
    unsigned voffA[2], voffB[2];
#pragma unroll
    for (int i = 0; i < 2; ++i) { int R, C; stage_rc(tid * 16 + i * 8192, R, C); voffA[i] = (unsigned)(R * lda + C) * 2u; voffB[i] = (unsigned)(R * ldb + C) * 2u; }
    const size_t kstep = (size_t)(BK * 2), hstepA = (size_t)HALF * lda * 2, hstepB = (size_t)HALF * ldb * 2;
    const unsigned ldsw = (unsigned)wid * 1024u;
    const int aoff = lds_byte(wr * 64 + fr, fq * 8), boff = lds_byte(wc * 32 + fr, fq * 8);
#define SA(b, h) (((b) * 2 + (h)) * HTB)
#define SB(b, h) ((4 + (b) * 2 + (h)) * HTB)
#define STAGE(bufoff, gbase, voff) do { _Pragma("unroll") for (int _i = 0; _i < 2; ++_i) \
        __builtin_amdgcn_global_load_lds((const unsigned*)((const char*)(gbase) + (voff)[_i]), (LAS unsigned*)(lds + (bufoff) + ldsw + _i * 8192), 16, 0, 0); } while (0)
#define LDA(dst, b, h) do { _Pragma("unroll") for (int m = 0; m < 4; ++m) _Pragma("unroll") for (int k = 0; k < 2; ++k) dst[m][k] = *(const LAS bf16x8*)(lds + SA(b, h) + aoff + m * 2048 + k * 1024); } while (0)
#define LDB(dst, b, h) do { _Pragma("unroll") for (int n = 0; n < 2; ++n) _Pragma("unroll") for (int k = 0; k < 2; ++k) dst[n][k] = *(const LAS bf16x8*)(lds + SB(b, h) + boff + n * 2048 + k * 1024); } while (0)
#define MMA(ai, bj, At, Bt_) do { __builtin_amdgcn_s_setprio(1); _Pragma("unroll") for (int m = 0; m < 4; ++m) _Pragma("unroll") for (int n = 0; n < 2; ++n) _Pragma("unroll") for (int k = 0; k < 2; ++k) \
        acc[ai][bj][m][n] = __builtin_amdgcn_mfma_f32_16x16x32_bf16(Bt_[n][k], At[m][k], acc[ai][bj][m][n], 0, 0, 0); __builtin_amdgcn_s_setprio(0); } while (0)
#define WAIT_V(n) asm volatile("s_waitcnt vmcnt(" #n ")" ::: "memory")
#define WAIT_L(n) asm volatile("s_waitcnt lgkmcnt(" #n ")" ::: "memory")
#define BAR __builtin_amdgcn_s_barrier()
#define SCHED __builtin_amdgcn_sched_barrier(0)
    f32x4 acc[2][2][4][2];
#pragma unroll
    for (int a = 0; a < 2; ++a)
#pragma unroll
        for (int b = 0; b < 2; ++b)
#pragma unroll
            for (int m = 0; m < 4; ++m)
#pragma unroll
                for (int n = 0; n < 2; ++n) acc[a][b][m][n] = (f32x4){0.f, 0.f, 0.f, 0.f};
    bf16x8 At[4][2], B0[2][2], B1[2][2];
    const int nt = K / BK;
    const char* cA = (const char*)A + (size_t)brow * lda * 2; const char* cB = (const char*)Bt + (size_t)bcol * ldb * 2;
    STAGE(SB(0, 0), cB, voffB); STAGE(SA(0, 0), cA, voffA); STAGE(SB(0, 1), cB + hstepB, voffB); STAGE(SA(0, 1), cA + hstepA, voffA);
    if (wr == 1) BAR;
    WAIT_V(4); BAR;
    STAGE(SB(1, 0), cB + kstep, voffB); STAGE(SA(1, 0), cA + kstep, voffA); STAGE(SB(1, 1), cB + hstepB + kstep, voffB);
    WAIT_V(6); BAR;
    for (int t = 0; t < nt - 2; t += 2) {
        const char* a1 = cA + (size_t)(t + 1) * kstep;
        const char* a2 = cA + (size_t)(t + 2) * kstep; const char* b2 = cB + (size_t)(t + 2) * kstep;
        const char* a3 = a2 + kstep; const char* b3 = b2 + kstep;
        LDB(B0, 0, 0); SCHED; LDA(At, 0, 0); STAGE(SA(1, 1), a1 + hstepA, voffA);
        WAIT_L(8); BAR; WAIT_L(0); MMA(0, 0, At, B0); BAR; SCHED;
        LDB(B1, 0, 1); STAGE(SB(0, 0), b2, voffB);
        BAR; WAIT_L(0); MMA(0, 1, At, B1); BAR;
        LDA(At, 0, 1); STAGE(SA(0, 0), a2, voffA);
        BAR; WAIT_L(0); MMA(1, 0, At, B0); BAR; SCHED;
        STAGE(SB(0, 1), b2 + hstepB, voffB);
        WAIT_V(6); BAR; MMA(1, 1, At, B1); BAR;
        LDB(B0, 1, 0); SCHED; LDA(At, 1, 0); STAGE(SA(0, 1), a2 + hstepA, voffA);
        WAIT_L(8); BAR; WAIT_L(0); MMA(0, 0, At, B0); BAR; SCHED;
        LDB(B1, 1, 1); STAGE(SB(1, 0), b3, voffB);
        BAR; WAIT_L(0); MMA(0, 1, At, B1); BAR;
        LDA(At, 1, 1); STAGE(SA(1, 0), a3, voffA);
        BAR; WAIT_L(0); MMA(1, 0, At, B0); BAR; SCHED;
        STAGE(SB(1, 1), b3 + hstepB, voffB);
        WAIT_V(6); BAR; MMA(1, 1, At, B1); BAR;
    }
    { const char* a1 = cA + (size_t)(nt - 1) * kstep;
      LDB(B0, 0, 0); LDA(At, 0, 0); STAGE(SA(1, 1), a1 + hstepA, voffA);
      BAR; WAIT_L(0); MMA(0, 0, At, B0); BAR;
      LDB(B1, 0, 1); BAR; WAIT_L(0); MMA(0, 1, At, B1); BAR;
      LDA(At, 0, 1); WAIT_V(4); BAR; WAIT_L(0); MMA(1, 0, At, B0); MMA(1, 1, At, B1); BAR; }
    { LDB(B0, 1, 0); LDA(At, 1, 0); WAIT_V(2); BAR; WAIT_L(0); MMA(0, 0, At, B0); BAR;
      LDB(B1, 1, 1); WAIT_V(0); BAR; WAIT_L(0); MMA(0, 1, At, B1); BAR;
      LDA(At, 1, 1); BAR; WAIT_L(0); MMA(1, 0, At, B0); MMA(1, 1, At, B1); BAR; }
    if (wr == 0) BAR;
    epi_big(epi, acc, brow, bcol, wr, wc, fr, fq);
    __syncthreads();
#undef SA
#undef SB
#undef STAGE
#undef LDA
#undef LDB
#undef MMA
}

DEV void tile_of(int L, int nM, int nN, int& pm, int& pn) {
    const int nwg = nM * nN; int wgid = L;
    { const int q = nwg / 8, r = nwg % 8, xcd = wgid % 8, off = wgid / 8; wgid = (xcd < r ? xcd * (q + 1) : r * (q + 1) + (xcd - r) * q) + off; }
    const int nig = 8 * nN, gid = wgid / nig, fm = gid * 8, gsz = (nM - fm) < 8 ? (nM - fm) : 8;
    pm = fm + ((wgid % nig) % gsz); pn = (wgid % nig) / gsz;
}

struct EpiBf16 {
    bf16_t* dst; int ld; const float* rstd;
    struct Ld { float rs; };
    DEV void load(int row, int col, Ld& d) const { d.rs = rstd ? rstd[row] : 1.f; }
    DEV void apply(int row, int col, const f32x4& v, const Ld& d, float& ss) const {
        u32x2 o; o.x = pk2(v[0] * d.rs, v[1] * d.rs); o.y = pk2(v[2] * d.rs, v[3] * d.rs);
        *(u32x2*)(dst + (long)row * ld + col) = o;
    }
    DEV void rowdone(int row, float ss, int fq) const {}
};
struct EpiGlu {
    bf16_t* proj; const float* glu_b;
    struct Ld { u32x2 g, z; f32x4 b; };
    DEV void load(int row, int col, Ld& d) const {
        d.g = *(const u32x2*)(proj + (long)row * PLD + C_UB + col); d.z = *(const u32x2*)(proj + (long)row * PLD + C_ZB + col); d.b = *(const f32x4*)(glu_b + col);
    }
    DEV void apply(int row, int col, const f32x4& v, const Ld& d, float& ss) const {
        const float y0 = bflo(d.g.x) * sigmf(v[0] + d.b[0]) * siluf(bflo(d.z.x)), y1 = bfhi(d.g.x) * sigmf(v[1] + d.b[1]) * siluf(bfhi(d.z.x));
        const float y2 = bflo(d.g.y) * sigmf(v[2] + d.b[2]) * siluf(bflo(d.z.y)), y3 = bfhi(d.g.y) * sigmf(v[3] + d.b[3]) * siluf(bfhi(d.z.y));
        u32x2 o; o.x = pk2(y0, y1); o.y = pk2(y2, y3);
        *(u32x2*)(proj + (long)row * PLD + C_ZB + col) = o;
    }
    DEV void rowdone(int row, float ss, int fq) const {}
};
struct EpiOut {
    const float* xp; const float* xs; float* out; bf16_t* h1b; float* rss;
    struct Ld { f32x4 x; };
    DEV void load(int row, int col, Ld& d) const {
        const float* xrow = row < NPROMPT ? xp + (long)row * 1024 : xs + (long)(row - NPROMPT) * 1024;
        d.x = *(const f32x4*)(xrow + col);
    }
    DEV void apply(int row, int col, const f32x4& a, const Ld& d, float& ss) const {
        const f32x4 v = a + d.x;
        *(f32x4*)(out + (long)row * 1024 + col) = v;
        u32x2 o; o.x = pk2(v[0], v[1]); o.y = pk2(v[2], v[3]);
        *(u32x2*)(h1b + (long)row * 1024 + col) = o;
        ss += v[0] * v[0] + v[1] * v[1] + v[2] * v[2] + v[3] * v[3];
    }
    DEV void rowdone(int row, float ss, int fq) const {
        ss += __shfl_xor(ss, 16); ss += __shfl_xor(ss, 32);
        if (fq == 0) atomicAdd(rss + row, ss);
    }
};
struct EpiPle {
    float* out; const bf16_t* pp; const float* rss1; float* rss2;
    struct Ld { f32x4 h; u32x2 pv; float rs; };
    DEV void load(int row, int col, Ld& d) const {
        d.h = *(const f32x4*)(out + (long)row * 1024 + col); d.pv = *(const u32x2*)(pp + (long)row * 1024 + col); d.rs = rss1[row];
    }
    DEV void apply(int row, int col, const f32x4& a, const Ld& d, float& ss) const {
        const float rstd = rsqrtf(d.rs * (1.f / 1024.f) + EPS);
        f32x4 h = d.h;
        h[0] += bflo(d.pv.x) * sigmf(a[0] * rstd); h[1] += bfhi(d.pv.x) * sigmf(a[1] * rstd);
        h[2] += bflo(d.pv.y) * sigmf(a[2] * rstd); h[3] += bfhi(d.pv.y) * sigmf(a[3] * rstd);
        *(f32x4*)(out + (long)row * 1024 + col) = h;
        ss += h[0] * h[0] + h[1] * h[1] + h[2] * h[2] + h[3] * h[3];
    }
    DEV void rowdone(int row, float ss, int fq) const {
        ss += __shfl_xor(ss, 16); ss += __shfl_xor(ss, 32);
        if (fq == 0) atomicAdd(rss2 + row, ss);
    }
};
template <class Epi>
DEV void epi_big(const Epi& E, const f32x4 (&acc)[2][2][4][2], int brow, int bcol, int wr, int wc, int fr, int fq) {
#pragma unroll
    for (int ai = 0; ai < 2; ++ai)
#pragma unroll
        for (int mp = 0; mp < 2; ++mp) {
            typename Epi::Ld d[2][4];
#pragma unroll
            for (int mm = 0; mm < 2; ++mm)
#pragma unroll
                for (int j = 0; j < 4; ++j)
                    E.load(brow + ai * 128 + wr * 64 + (mp * 2 + mm) * 16 + fr, bcol + (j >> 1) * 128 + wc * 32 + (j & 1) * 16 + fq * 4, d[mm][j]);
#pragma unroll
            for (int mm = 0; mm < 2; ++mm) {
                const int row = brow + ai * 128 + wr * 64 + (mp * 2 + mm) * 16 + fr; float ss = 0.f;
#pragma unroll
                for (int j = 0; j < 4; ++j)
                    E.apply(row, bcol + (j >> 1) * 128 + wc * 32 + (j & 1) * 16 + fq * 4, acc[ai][j >> 1][mp * 2 + mm][j & 1], d[mm][j], ss);
                E.rowdone(row, ss, fq);
            }
        }
}
template <class Epi>
DEV void gemm_small(const bf16_t* __restrict__ A, int lda, const bf16_t* __restrict__ Bt, int ldb, int K, int row0, int col0, const Epi& E) {
    const int tid = tid_fresh(), w = tid >> 6, lane = tid & 63, fr = lane & 15, fq = lane >> 4, wr = w >> 1, wc = w & 1;
    const bf16_t* ap = A + (long)(row0 + wr * 16 + fr) * lda + fq * 8;
    const bf16_t* bp = Bt + (long)(col0 + wc * 64 + fr) * ldb + fq * 8;
    f32x4 acc[4];
#pragma unroll
    for (int n = 0; n < 4; ++n) acc[n] = (f32x4){0.f, 0.f, 0.f, 0.f};
#pragma unroll 4
    for (int k = 0; k < K; k += 32) {
        const bf16x8 a = *(const bf16x8*)(ap + k);
        bf16x8 b[4];
#pragma unroll
        for (int n = 0; n < 4; ++n) b[n] = *(const bf16x8*)(bp + (long)n * 16 * ldb + k);
#pragma unroll
        for (int n = 0; n < 4; ++n) acc[n] = mfma16(b[n], a, acc[n]);
    }
    const int row = row0 + wr * 16 + fr;
    typename Epi::Ld d[4];
#pragma unroll
    for (int n = 0; n < 4; ++n) E.load(row, col0 + wc * 64 + n * 16 + fq * 4, d[n]);
    float ss = 0.f;
#pragma unroll
    for (int n = 0; n < 4; ++n) E.apply(row, col0 + wc * 64 + n * 16 + fq * 4, acc[n], d[n], ss);
    E.rowdone(row, ss, fq);
}

DEV void transpose_tile(const float* __restrict__ src, int ldsrc, int k0, int c0, bf16_t* __restrict__ dst, int lddst, int n0,
                        const float* __restrict__ kscale, float* tile) {
    const int tid = tid_fresh();
    const int c = tid & 63, r0 = tid >> 6;
#pragma unroll
    for (int i = 0; i < 8; ++i) {
        const int r = r0 + i * 8; float v = src[(long)(k0 + r) * ldsrc + c0 + c];
        if (kscale) v *= kscale[k0 + r];
        tile[r * 65 + c] = v;
    }
    __syncthreads();
    const int n = tid >> 3, kc = tid & 7;
    u32x4 o;
    o.x = pk2(tile[(kc * 8 + 0) * 65 + n], tile[(kc * 8 + 1) * 65 + n]);
    o.y = pk2(tile[(kc * 8 + 2) * 65 + n], tile[(kc * 8 + 3) * 65 + n]);
    o.z = pk2(tile[(kc * 8 + 4) * 65 + n], tile[(kc * 8 + 5) * 65 + n]);
    o.w = pk2(tile[(kc * 8 + 6) * 65 + n], tile[(kc * 8 + 7) * 65 + n]);
    *(u32x4*)(dst + (long)(n0 + n) * lddst + k0 + kc * 8) = o;
    __syncthreads();
}

DEV void phase0(const Params& P) {
    const int tid = tid_fresh(), lane = tid & 63, wave = tid >> 6, G = gridDim.x, bid = blockIdx.x;
    char* ws = P.ws;
    float* tile = (float*)smem;
    constexpr int T_IN = 72 * 16, T_OUT = 16 * 32, T_GLU = 16 * 16, T_GATE = 16 * 16, T_PP = 16 * 4;
    constexpr int T_ALL = T_IN + T_OUT + T_GLU + T_GATE + T_PP;
    for (int it = bid; it < T_ALL; it += G) {
        int r = it;
        if (r < T_IN) {
            const int nb = r >> 4, kb = r & 15, n0 = nb * 64;
            int c0;
            if (n0 < 1024) c0 = n0; else if (n0 < 2048) c0 = 2576 + (n0 - 1024); else if (n0 < 3584) c0 = 1024 + (n0 - 2048); else c0 = 3600 + (n0 - 3584);
            transpose_tile(P.in[I_WIN], 4624, kb * 64, c0, (bf16_t*)(ws + W_WTIN), 1024, n0, P.in[I_GIN], tile); continue;
        }
        r -= T_IN;
        if (r < T_OUT) { const int nb = r >> 5, kb = r & 31; transpose_tile(P.in[I_WOUT], 1024, kb * 64, nb * 64, (bf16_t*)(ws + W_WTOUT), 2048, nb * 64, nullptr, tile); continue; }
        r -= T_OUT;
        if (r < T_GLU) { const int nb = r >> 4, kb = r & 15; transpose_tile(P.in[I_GLUW], 1024, kb * 64, nb * 64, (bf16_t*)(ws + W_WTGLU), 1024, nb * 64, nullptr, tile); continue; }
        r -= T_GLU;
        if (r < T_GATE) { const int nb = r >> 4, kb = r & 15; transpose_tile(P.in[I_WGATE], 1024, kb * 64, nb * 64, (bf16_t*)(ws + W_WTGATE), 1024, nb * 64, P.in[I_GPLE], tile); continue; }
        r -= T_GATE;
        { const int nb = r >> 2, kb = r & 3; transpose_tile(P.in[I_WPP], 1024, kb * 64, nb * 64, (bf16_t*)(ws + W_WTPP), 256, nb * 64, nullptr, tile); }
    }
    bf16_t* wdt = (bf16_t*)smem;
    float* psum = (float*)(smem + 16 * 1032 * 2);
    float* pdt = psum + 128;
    for (int idx = tid; idx < 16 * 1024; idx += 512) {
        const int k = idx >> 4, e = idx & 15;
        wdt[e * 1032 + k] = (bf16_t)(pk2(P.in[I_WIN][(long)k * 4624 + 2560 + e] * P.in[I_GIN][k], 0.f) & 0xffffu);
    }
    __syncthreads();
    {
        const int fr = lane & 15, fq = lane >> 4;
        bf16x8 wf[4];
#pragma unroll
        for (int j = 0; j < 4; ++j) wf[j] = *(const bf16x8*)(wdt + fr * 1032 + (wave * 4 + j) * 32 + fq * 8);
        bf16_t* xb = (bf16_t*)(ws + W_NB);
        float* dtr = (float*)(ws + W_DTR);
        float* rstdp = (float*)(ws + W_RSTD);
        for (int task = bid; task < NTOK / 16; task += G) {
            const int row = task * 16 + fr;
            const float* xr = (row < NPROMPT ? P.in[I_XP] + (long)row * 1024 : P.in[I_XS] + (long)(row - NPROMPT) * 1024) + wave * 128 + fq * 8;
            f32x4 xa[4], xc[4];
#pragma unroll
            for (int j = 0; j < 4; ++j) { xa[j] = *(const f32x4*)(xr + j * 32); xc[j] = *(const f32x4*)(xr + j * 32 + 4); }
            f32x4 acc = {0.f, 0.f, 0.f, 0.f}; float ss = 0.f;
#pragma unroll
            for (int j = 0; j < 4; ++j) {
                ss += xa[j][0] * xa[j][0] + xa[j][1] * xa[j][1] + xa[j][2] * xa[j][2] + xa[j][3] * xa[j][3] + xc[j][0] * xc[j][0] + xc[j][1] * xc[j][1] + xc[j][2] * xc[j][2] + xc[j][3] * xc[j][3];
                u32x4 q; q.x = pk2(xa[j][0], xa[j][1]); q.y = pk2(xa[j][2], xa[j][3]); q.z = pk2(xc[j][0], xc[j][1]); q.w = pk2(xc[j][2], xc[j][3]);
                *(u32x4*)(xb + (long)row * 1024 + wave * 128 + j * 32 + fq * 8) = q;
                acc = mfma16(wf[j], __builtin_bit_cast(bf16x8, q), acc);
            }
            ss += __shfl_xor(ss, 16); ss += __shfl_xor(ss, 32);
            if (fq == 0) psum[wave * 16 + fr] = ss;
            *(f32x4*)(pdt + wave * 256 + fr * 16 + fq * 4) = acc;
            __syncthreads();
            if (tid < 256) {
                const int t = tid >> 4, e = tid & 15;
                float tot = 0.f, d = 0.f;
#pragma unroll
                for (int w8 = 0; w8 < 8; ++w8) { tot += psum[w8 * 16 + t]; d += pdt[w8 * 256 + t * 16 + e]; }
                const float rstd = rsqrtf(tot * (1.f / 1024.f) + EPS);
                dtr[(long)(task * 16 + t) * 16 + e] = d * rstd;
                if (e == 0) rstdp[task * 16 + t] = rstd;
            }
            __syncthreads();
        }
    }
    bf16_t* pb = (bf16_t*)(ws + W_PB);
    for (int idx = bid * 512 + tid; idx < NTOK * 64; idx += G * 512) {
        const int row = idx >> 6, c4 = (idx & 63) * 4;
        const float* src = row < NPROMPT ? P.in[I_PP] + (long)row * 256 : P.in[I_PS] + (long)(row - NPROMPT) * 256;
        const f32x4 v = *(const f32x4*)(src + c4);
        u32x2 o; o.x = pk2(v[0], v[1]); o.y = pk2(v[2], v[3]);
        *(u32x2*)(pb + (long)row * 256 + c4) = o;
    }
    float* rss = (float*)(ws + W_RSS1);
    for (int idx = bid * 512 + tid; idx < 2 * NTOK; idx += G * 512) rss[idx] = 0.f;
    __syncthreads();
}

DEV void conv4x8(const bf16_t* __restrict__ pcol, long row0, int t0, const float* __restrict__ hist, const float* __restrict__ cw, const float* __restrict__ cb, float (&o)[4][8]) {
    float raw[7][8];
#pragma unroll
    for (int i = 0; i < 7; ++i) {
        const int t = t0 - 3 + i;
        if (t >= 0) {
            const u32x4 u = *(const u32x4*)(pcol + (row0 - 3 + i) * PLD);
            raw[i][0] = bflo(u.x); raw[i][1] = bfhi(u.x); raw[i][2] = bflo(u.y); raw[i][3] = bfhi(u.y);
            raw[i][4] = bflo(u.z); raw[i][5] = bfhi(u.z); raw[i][6] = bflo(u.w); raw[i][7] = bfhi(u.w);
        } else if (hist) {
            const f32x4 a = *(const f32x4*)(hist + (long)(t + 3) * 1536), b = *(const f32x4*)(hist + (long)(t + 3) * 1536 + 4);
            raw[i][0] = a[0]; raw[i][1] = a[1]; raw[i][2] = a[2]; raw[i][3] = a[3]; raw[i][4] = b[0]; raw[i][5] = b[1]; raw[i][6] = b[2]; raw[i][7] = b[3];
        } else {
#pragma unroll
            for (int c = 0; c < 8; ++c) raw[i][c] = 0.f;
        }
    }
    float w[4][8], bias[8];
#pragma unroll
    for (int k = 0; k < 4; ++k) {
        const f32x4 a = *(const f32x4*)(cw + k * 1536), b = *(const f32x4*)(cw + k * 1536 + 4);
        w[k][0] = a[0]; w[k][1] = a[1]; w[k][2] = a[2]; w[k][3] = a[3]; w[k][4] = b[0]; w[k][5] = b[1]; w[k][6] = b[2]; w[k][7] = b[3];
    }
    { const f32x4 a = *(const f32x4*)(cb), b = *(const f32x4*)(cb + 4);
      bias[0] = a[0]; bias[1] = a[1]; bias[2] = a[2]; bias[3] = a[3]; bias[4] = b[0]; bias[5] = b[1]; bias[6] = b[2]; bias[7] = b[3]; }
#pragma unroll
    for (int j = 0; j < 4; ++j)
#pragma unroll
        for (int c = 0; c < 8; ++c) {
            float a = bias[c];
#pragma unroll
            for (int k = 0; k < 4; ++k) a += w[k][c] * raw[j + k][c];
            o[j][c] = siluf(a);
        }
}

constexpr int PIT = 136;
constexpr int R1_OFF = 0, R2_OFF = 128 * PIT * 2, R3_OFF = 2 * 128 * PIT * 2, R4_OFF = 3 * 128 * PIT * 2;

DEV void ssd_s1_item(const Params& P, int item) {
    const int tid = tid_fresh(), lane = tid & 63, w = tid >> 6, fr = lane & 15, fq = lane >> 4;
    const int b = item >> 5, c = (item >> 1) & 15, g = item & 1;
    char* ws = P.ws;
    const bf16_t* proj = (const bf16_t*)(ws + W_PROJ);
    const long rowc = (long)b * 2048 + c * 128;
    bf16_t* R1 = (bf16_t*)(smem + R1_OFF); bf16_t* R2 = (bf16_t*)(smem + R2_OFF); bf16_t* R3 = (bf16_t*)(smem + R3_OFF);
    float* acs = (float*)(smem + R4_OFF);
    float* dtv = acs + 1024;
    {
        const int h = g * 8 + w;
        const float bias = P.in[I_DTB][h], A = -__expf(P.in[I_ALOG][h]);
        const float* dtr = (const float*)(ws + W_DTR);
        float x0 = dtr[(rowc + 2 * lane) * 16 + h] + bias, x1 = dtr[(rowc + 2 * lane + 1) * 16 + h] + bias;
        float d0 = x0 > 20.f ? x0 : log1pf(__expf(x0)), d1 = x1 > 20.f ? x1 : log1pf(__expf(x1));
        float a0 = d0 * A, a1 = a0 + d1 * A;
        float run = a1;
#pragma unroll
        for (int o = 1; o < 64; o <<= 1) { float t = __shfl_up(run, o); if (lane >= o) run += t; }
        const float excl = run - a1;
        a0 += excl; a1 += excl;
        acs[w * 128 + 2 * lane] = a0; acs[w * 128 + 2 * lane + 1] = a1;
        dtv[w * 128 + 2 * lane] = d0; dtv[w * 128 + 2 * lane + 1] = d1;
        float* acsg = (float*)(ws + W_ACS) + (((long)b * 16 + c) * 16 + h) * 128;
        acsg[2 * lane] = a0; acsg[2 * lane + 1] = a1;
        if (lane == 63) ((float*)(ws + W_CDEC))[(b * 16 + c) * 16 + h] = __expf(a1);
    }
    {
        const int nblk = tid & 15, lq = tid >> 4, l0 = lq * 4;
#pragma unroll
        for (int j = 0; j < 2; ++j) {
            const int ch0 = 1024 + j * 256 + g * 128 + nblk * 8;
            float o[4][8];
            conv4x8(proj + C_XBC + ch0, rowc + l0, c * 128 + l0, nullptr, P.in[I_CONVW] + ch0, P.in[I_CONVB] + ch0, o);
            bf16_t* dst = j == 0 ? R2 : R1;
#pragma unroll
            for (int r = 0; r < 4; ++r) {
                u32x4 q; q.x = pk2(o[r][0], o[r][1]); q.y = pk2(o[r][2], o[r][3]); q.z = pk2(o[r][4], o[r][5]); q.w = pk2(o[r][6], o[r][7]);
                *(u32x4*)(dst + (l0 + r) * PIT + nblk * 8) = q;
            }
            if (j == 0) {
#pragma unroll
                for (int i = 0; i < 8; ++i) {
                    u32x2 q; q.x = pk2(o[0][i], o[1][i]); q.y = pk2(o[2][i], o[3][i]);
                    *(u32x2*)(R3 + (nblk * 8 + i) * PIT + l0) = q;
                }
            }
        }
    }
    __syncthreads();
    const int wr = w >> 1, wc = w & 1;
    f32x4 cbm[2][4];
#pragma unroll
    for (int m = 0; m < 2; ++m)
#pragma unroll
        for (int n = 0; n < 4; ++n) cbm[m][n] = (f32x4){0.f, 0.f, 0.f, 0.f};
#pragma unroll
    for (int ks = 0; ks < 4; ++ks) {
        bf16x8 af[2], bfm[4];
#pragma unroll
        for (int m = 0; m < 2; ++m) af[m] = *(const bf16x8*)(R1 + (wr * 32 + m * 16 + fr) * PIT + ks * 32 + fq * 8);
#pragma unroll
        for (int n = 0; n < 4; ++n) bfm[n] = *(const bf16x8*)(R2 + (wc * 64 + n * 16 + fr) * PIT + ks * 32 + fq * 8);
#pragma unroll
        for (int m = 0; m < 2; ++m)
#pragma unroll
            for (int n = 0; n < 4; ++n) cbm[m][n] = mfma16(bfm[n], af[m], cbm[m][n]);
    }
    __syncthreads();
    bf16_t* XT = R2; bf16_t* XW = R2 + 64 * PIT;
    bf16_t* ydg = (bf16_t*)(ws + W_NB);
    float* states = P.out;
    const int wp = w >> 2, wn = w & 3;
    for (int e = 0; e < 8; ++e) {
        const int h = g * 8 + e;
        const float dskip = P.in[I_SSDD][h];
        if (tid < 256) {
            const int pblk = tid & 7, lq = tid >> 3, l0 = lq * 4, ch0 = h * 64 + pblk * 8;
            float o[4][8];
            conv4x8(proj + C_XBC + ch0, rowc + l0, c * 128 + l0, nullptr, P.in[I_CONVW] + ch0, P.in[I_CONVB] + ch0, o);
            const float alast = acs[e * 128 + 127];
            float we[4];
#pragma unroll
            for (int r = 0; r < 4; ++r) we[r] = __expf(alast - acs[e * 128 + l0 + r]) * dtv[e * 128 + l0 + r];
#pragma unroll
            for (int i = 0; i < 8; ++i) {
                u32x2 q; q.x = pk2(o[0][i], o[1][i]); q.y = pk2(o[2][i], o[3][i]);
                *(u32x2*)(XT + (pblk * 8 + i) * PIT + l0) = q;
                u32x2 q2; q2.x = pk2(o[0][i] * we[0], o[1][i] * we[1]); q2.y = pk2(o[2][i] * we[2], o[3][i] * we[3]);
                *(u32x2*)(XW + (pblk * 8 + i) * PIT + l0) = q2;
            }
        }
#pragma unroll
        for (int m = 0; m < 2; ++m) {
            const int l = wr * 32 + m * 16 + fr; const float al = acs[e * 128 + l];
#pragma unroll
            for (int n = 0; n < 4; ++n) {
                const int s0 = wc * 64 + n * 16 + fq * 4;
                const f32x4 as = *(const f32x4*)(acs + e * 128 + s0), ds = *(const f32x4*)(dtv + e * 128 + s0);
                float v[4];
#pragma unroll
                for (int r = 0; r < 4; ++r) { const float t = cbm[m][n][r] * __expf(al - as[r]) * ds[r]; v[r] = (s0 + r <= l) ? t : 0.f; }
                u32x2 q; q.x = pk2(v[0], v[1]); q.y = pk2(v[2], v[3]);
                *(u32x2*)(R1 + l * PIT + s0) = q;
            }
        }
        __syncthreads();
        {
            f32x4 yd[2][2];
#pragma unroll
            for (int m = 0; m < 2; ++m)
#pragma unroll
                for (int n = 0; n < 2; ++n) yd[m][n] = (f32x4){0.f, 0.f, 0.f, 0.f};
            for (int ks = 0; ks <= wr; ++ks) {
                bf16x8 af[2], bfm[2];
#pragma unroll
                for (int m = 0; m < 2; ++m) af[m] = *(const bf16x8*)(R1 + (wr * 32 + m * 16 + fr) * PIT + ks * 32 + fq * 8);
#pragma unroll
                for (int n = 0; n < 2; ++n) bfm[n] = *(const bf16x8*)(XT + (wc * 32 + n * 16 + fr) * PIT + ks * 32 + fq * 8);
#pragma unroll
                for (int m = 0; m < 2; ++m)
#pragma unroll
                    for (int n = 0; n < 2; ++n) yd[m][n] = mfma16(bfm[n], af[m], yd[m][n]);
            }
#pragma unroll
            for (int m = 0; m < 2; ++m)
#pragma unroll
                for (int n = 0; n < 2; ++n) {
                    const int l = wr * 32 + m * 16 + fr, p0 = wc * 32 + n * 16 + fq * 4;
                    const float x0 = __uint_as_float(((unsigned)XT[(p0 + 0) * PIT + l]) << 16), x1 = __uint_as_float(((unsigned)XT[(p0 + 1) * PIT + l]) << 16);
                    const float x2 = __uint_as_float(((unsigned)XT[(p0 + 2) * PIT + l]) << 16), x3 = __uint_as_float(((unsigned)XT[(p0 + 3) * PIT + l]) << 16);
                    u32x2 q; q.x = pk2(yd[m][n][0] + dskip * x0, yd[m][n][1] + dskip * x1); q.y = pk2(yd[m][n][2] + dskip * x2, yd[m][n][3] + dskip * x3);
                    *(u32x2*)(ydg + (rowc + l) * 1024 + h * 64 + p0) = q;
                }
        }
        {
            f32x4 st[2][2];
#pragma unroll
            for (int m = 0; m < 2; ++m)
#pragma unroll
                for (int n = 0; n < 2; ++n) st[m][n] = (f32x4){0.f, 0.f, 0.f, 0.f};
#pragma unroll
            for (int ks = 0; ks < 4; ++ks) {
                bf16x8 af[2], bfm[2];
#pragma unroll
                for (int m = 0; m < 2; ++m) af[m] = *(const bf16x8*)(XW + (wp * 32 + m * 16 + fr) * PIT + ks * 32 + fq * 8);
#pragma unroll
                for (int n = 0; n < 2; ++n) bfm[n] = *(const bf16x8*)(R3 + (wn * 32 + n * 16 + fr) * PIT + ks * 32 + fq * 8);
#pragma unroll
                for (int m = 0; m < 2; ++m)
#pragma unroll
                    for (int n = 0; n < 2; ++n) st[m][n] = mfma16(bfm[n], af[m], st[m][n]);
            }
            float* sp = states + (((long)b * 16 + c) * 16 + h) * 8192;
#pragma unroll
            for (int m = 0; m < 2; ++m)
#pragma unroll
                for (int n = 0; n < 2; ++n) {
                    const int p = wp * 32 + m * 16 + fr, n0 = wn * 32 + n * 16 + fq * 4;
                    *(f32x4*)(sp + p * 128 + n0) = st[m][n];
                }
        }
        __syncthreads();
    }
}

DEV void ssd_s2(const Params& P) {
    float* states = P.out;
    const float* cdec = (const float*)(P.ws + W_CDEC);
    for (int idx = blockIdx.x * 512 + threadIdx.x; idx < 262144; idx += gridDim.x * 512) {
        const int bh = idx >> 11, q = idx & 2047, b = bh >> 4, h = bh & 15;
        f32x4 H = (f32x4){0.f, 0.f, 0.f, 0.f};
#pragma unroll
        for (int c = 0; c < 16; ++c) {
            f32x4* ptr = (f32x4*)(states + (((long)b * 16 + c) * 16 + h) * 8192) + q;
            const f32x4 s = *ptr; *ptr = H;
            const float d = cdec[(b * 16 + c) * 16 + h];
            H = H * d + s;
        }
        *((f32x4*)(P.out + O_SSDP + (long)bh * 8192) + q) = H;
    }
}

DEV void ssd_s3_item(const Params& P, int item) {
    const int tid = tid_fresh(), lane = tid & 63, w = tid >> 6, fr = lane & 15, fq = lane >> 4;
    const int b = item >> 5, c = (item >> 1) & 15, g = item & 1;
    char* ws = P.ws;
    bf16_t* proj = (bf16_t*)(ws + W_PROJ);
    const long rowc = (long)b * 2048 + c * 128;
    bf16_t* R1 = (bf16_t*)(smem + R1_OFF); bf16_t* HB = (bf16_t*)(smem + R2_OFF);
    float* ssq = (float*)(smem + R4_OFF);
    const bf16_t* ydg = (const bf16_t*)(ws + W_NB);
    const float* states = P.out;
    const float* acsg = (const float*)(ws + W_ACS);
    {
        const int nblk = tid & 15, lq = tid >> 4, l0 = lq * 4;
        const int ch0 = 1280 + g * 128 + nblk * 8;
        float o[4][8];
        conv4x8(proj + C_XBC + ch0, rowc + l0, c * 128 + l0, nullptr, P.in[I_CONVW] + ch0, P.in[I_CONVB] + ch0, o);
#pragma unroll
        for (int r = 0; r < 4; ++r) {
            u32x4 q; q.x = pk2(o[r][0], o[r][1]); q.y = pk2(o[r][2], o[r][3]); q.z = pk2(o[r][4], o[r][5]); q.w = pk2(o[r][6], o[r][7]);
            *(u32x4*)(R1 + (l0 + r) * PIT + nblk * 8) = q;
        }
        if (tid < 128) ssq[tid] = 0.f;
    }
    const int wr = w >> 1, wc = w & 1;
    for (int e = 0; e < 8; ++e) {
        const int h = g * 8 + e;
        __syncthreads();
        {
            const int p = tid >> 3, n0 = (tid & 7) * 16;
            const float* sp = states + (((long)b * 16 + c) * 16 + h) * 8192 + p * 128 + n0;
            const f32x4 a0 = *(const f32x4*)(sp), a1 = *(const f32x4*)(sp + 4), a2 = *(const f32x4*)(sp + 8), a3 = *(const f32x4*)(sp + 12);
            u32x4 q0, q1;
            q0.x = pk2(a0[0], a0[1]); q0.y = pk2(a0[2], a0[3]); q0.z = pk2(a1[0], a1[1]); q0.w = pk2(a1[2], a1[3]);
            q1.x = pk2(a2[0], a2[1]); q1.y = pk2(a2[2], a2[3]); q1.z = pk2(a3[0], a3[1]); q1.w = pk2(a3[2], a3[3]);
            *(u32x4*)(HB + p * PIT + n0) = q0; *(u32x4*)(HB + p * PIT + n0 + 8) = q1;
        }
        __syncthreads();
        f32x4 yo[2][2];
#pragma unroll
        for (int m = 0; m < 2; ++m)
#pragma unroll
            for (int n = 0; n < 2; ++n) yo[m][n] = (f32x4){0.f, 0.f, 0.f, 0.f};
#pragma unroll
        for (int ks = 0; ks < 4; ++ks) {
            bf16x8 af[2], bfm[2];
#pragma unroll
            for (int m = 0; m < 2; ++m) af[m] = *(const bf16x8*)(R1 + (wr * 32 + m * 16 + fr) * PIT + ks * 32 + fq * 8);
#pragma unroll
            for (int n = 0; n < 2; ++n) bfm[n] = *(const bf16x8*)(HB + (wc * 32 + n * 16 + fr) * PIT + ks * 32 + fq * 8);
#pragma unroll
            for (int m = 0; m < 2; ++m)
#pragma unroll
                for (int n = 0; n < 2; ++n) yo[m][n] = mfma16(bfm[n], af[m], yo[m][n]);
        }
        const float dsk = P.in[I_SSDD][h];
#pragma unroll
        for (int m = 0; m < 2; ++m) {
            const int l = wr * 32 + m * 16 + fr; const long row = rowc + l; const int t = c * 128 + l;
            const float ea = __expf(acsg[(((long)b * 16 + c) * 16 + h) * 128 + l]);
            float ss = 0.f;
#pragma unroll
            for (int n = 0; n < 2; ++n) {
                const int p0 = wc * 32 + n * 16 + fq * 4, ch0 = h * 64 + p0;
                const f32x4 bias = *(const f32x4*)(P.in[I_CONVB] + ch0);
                float xa[4] = {bias[0], bias[1], bias[2], bias[3]};
#pragma unroll
                for (int k = 0; k < 4; ++k) {
                    if (t - 3 + k >= 0) {
                        const u32x2 u = *(const u32x2*)(proj + (row - 3 + k) * PLD + C_XBC + ch0);
                        const f32x4 wk = *(const f32x4*)(P.in[I_CONVW] + k * 1536 + ch0);
                        xa[0] += wk[0] * bflo(u.x); xa[1] += wk[1] * bfhi(u.x); xa[2] += wk[2] * bflo(u.y); xa[3] += wk[3] * bfhi(u.y);
                    }
                }
                const u32x2 yq = *(const u32x2*)(ydg + row * 1024 + h * 64 + p0);
                u32x2* zp = (u32x2*)(proj + row * PLD + C_ZA + h * 64 + p0);
                const u32x2 zz = *zp;
                float yv[4] = {bflo(yq.x), bfhi(yq.x), bflo(yq.y), bfhi(yq.y)};
                float zv[4] = {bflo(zz.x), bfhi(zz.x), bflo(zz.y), bfhi(zz.y)};
                float v[4];
#pragma unroll
                for (int r = 0; r < 4; ++r) { const float y = yv[r] + ea * yo[m][n][r]; v[r] = y * siluf(zv[r]); ss += v[r] * v[r]; }
                u32x2 o; o.x = pk2(v[0], v[1]); o.y = pk2(v[2], v[3]);
                *zp = o;
            }
            ss += __shfl_xor(ss, 16); ss += __shfl_xor(ss, 32);
            if (fq == 0) atomicAdd(ssq + l, ss);
        }
    }
    __syncthreads();
    for (int e = 0; e < 8; ++e) {
        const int h = g * 8 + e;
#pragma unroll
        for (int m = 0; m < 2; ++m) {
            const int l = wr * 32 + m * 16 + fr; const long row = rowc + l;
            const float rstd = rsqrtf(ssq[l] * (1.f / 512.f) + EPS);
#pragma unroll
            for (int n = 0; n < 2; ++n) {
                const int p0 = wc * 32 + n * 16 + fq * 4;
                u32x2* zp = (u32x2*)(proj + row * PLD + C_ZA + h * 64 + p0);
                const u32x2 zz = *zp;
                const f32x4 gg = *(const f32x4*)(P.in[I_SSDG] + h * 64 + p0);
                u32x2 o; o.x = pk2(bflo(zz.x) * rstd * gg[0], bfhi(zz.x) * rstd * gg[1]); o.y = pk2(bflo(zz.y) * rstd * gg[2], bfhi(zz.y) * rstd * gg[3]);
                *zp = o;
            }
        }
    }
    __syncthreads();
}

DEV void ssd_sample_item(const Params& P, int item) {
    const int tid = tid_fresh();
    const int b = item >> 1, g = item & 1;
    char* ws = P.ws;
    bf16_t* proj = (bf16_t*)(ws + W_PROJ);
    const long row0 = NPROMPT + (long)b * 4;
    float* xs = (float*)smem;
    float* Bs = xs + 2048;
    float* Cs = Bs + 512;
    float* dts = Cs + 512;
    float* das = dts + 32;
    float* vs = das + 32;
    float* red = vs + 2048;
    for (int u = tid; u < 768; u += 512) {
        int ch; float* dst; int dcol;
        if (u < 512) { ch = g * 512 + u; dst = xs; dcol = u; }
        else if (u < 640) { ch = 1024 + g * 128 + (u - 512); dst = Bs; dcol = u - 512; }
        else { ch = 1280 + g * 128 + (u - 640); dst = Cs; dcol = u - 640; }
        const int pitch = u < 512 ? 512 : 128;
        float full[7];
#pragma unroll
        for (int i = 0; i < 3; ++i) full[i] = P.in[I_CONV][((long)b * 3 + i) * 1536 + ch];
#pragma unroll
        for (int i = 0; i < 4; ++i) full[3 + i] = __uint_as_float(((unsigned)proj[(row0 + i) * PLD + C_XBC + ch]) << 16);
        const float w0 = P.in[I_CONVW][ch], w1 = P.in[I_CONVW][1536 + ch], w2 = P.in[I_CONVW][3072 + ch], w3 = P.in[I_CONVW][4608 + ch], bias = P.in[I_CONVB][ch];
#pragma unroll
        for (int t = 0; t < 4; ++t) dst[t * pitch + dcol] = siluf(bias + w0 * full[t] + w1 * full[t + 1] + w2 * full[t + 2] + w3 * full[t + 3]);
    }
    if (tid < 32) {
        const int t = tid >> 3, e = tid & 7, h = g * 8 + e;
        const float x = ((const float*)(ws + W_DTR))[(row0 + t) * 16 + h] + P.in[I_DTB][h];
        const float d = x > 20.f ? x : log1pf(__expf(x));
        dts[tid] = d; das[tid] = __expf(-d * __expf(P.in[I_ALOG][h]));
    }
    __syncthreads();
    const int p = tid >> 3, nb = tid & 7, n0 = nb * 16;
    f32x4 hn[4];
    {
        const float* sp0 = P.in[I_SSD] + (((long)b * 16 + g * 8) * 64 + p) * 128 + n0;
#pragma unroll
        for (int i = 0; i < 4; ++i) hn[i] = *(const f32x4*)(sp0 + i * 4);
    }
    for (int e = 0; e < 8; ++e) {
        const int h = g * 8 + e;
        float* op = P.out + O_SSDS + (((long)b * 16 + h) * 64 + p) * 128 + n0;
        f32x4 hv[4];
#pragma unroll
        for (int i = 0; i < 4; ++i) hv[i] = hn[i];
        if (e < 7) {
            const float* sp = P.in[I_SSD] + (((long)b * 16 + h + 1) * 64 + p) * 128 + n0;
#pragma unroll
            for (int i = 0; i < 4; ++i) hn[i] = *(const f32x4*)(sp + i * 4);
        }
        const float dsk = P.in[I_SSDD][h];
#pragma unroll
        for (int t = 0; t < 4; ++t) {
            const float dec = das[t * 8 + e], xv = xs[t * 512 + e * 64 + p], coef = dts[t * 8 + e] * xv;
            float part = 0.f;
#pragma unroll
            for (int i = 0; i < 4; ++i) {
                const f32x4 bv = *(const f32x4*)(Bs + t * 128 + n0 + i * 4), cv = *(const f32x4*)(Cs + t * 128 + n0 + i * 4);
                hv[i] = hv[i] * dec + bv * coef;
                part += hv[i][0] * cv[0] + hv[i][1] * cv[1] + hv[i][2] * cv[2] + hv[i][3] * cv[3];
            }
            part += __shfl_xor(part, 1); part += __shfl_xor(part, 2); part += __shfl_xor(part, 4);
            if (nb == 0) {
                const float z = __uint_as_float(((unsigned)proj[(row0 + t) * PLD + C_ZA + h * 64 + p]) << 16);
                vs[t * 512 + e * 64 + p] = (part + dsk * xv) * siluf(z);
            }
        }
#pragma unroll
        for (int i = 0; i < 4; ++i) *(f32x4*)(op + i * 4) = hv[i];
    }
    __syncthreads();
    {
        const int t = tid >> 7, cidx = tid & 127;
        float v[4]; float ss = 0.f;
#pragma unroll
        for (int i = 0; i < 4; ++i) { v[i] = vs[t * 512 + cidx * 4 + i]; ss += v[i] * v[i]; }
        ss = wave_sum(ss);
        if ((tid & 63) == 0) red[tid >> 6] = ss;
        __syncthreads();
        const float tot = red[t * 2] + red[t * 2 + 1];
        const float rstd = rsqrtf(tot * (1.f / 512.f) + EPS);
        const f32x4 gg = *(const f32x4*)(P.in[I_SSDG] + g * 512 + cidx * 4);
        u32x2 o; o.x = pk2(v[0] * rstd * gg[0], v[1] * rstd * gg[1]); o.y = pk2(v[2] * rstd * gg[2], v[3] * rstd * gg[3]);
        *(u32x2*)(proj + (row0 + t) * PLD + C_ZA + g * 512 + cidx * 4) = o;
    }
    __syncthreads();
}

constexpr int S5P = 20;
template <bool SAMPLE>
DEV void s5_item(const Params& P, int g, long rowbase, int bidx) {
    const int tid = tid_fresh(), lane = tid & 63, w = tid >> 6, fr = lane & 15, fq = lane >> 4;
    constexpr int TPW = SAMPLE ? 32 : 256;
    bf16_t* proj = (bf16_t*)(P.ws + W_PROJ);
    float* buf = (float*)smem + w * (128 * S5P);
    float* carry = (float*)smem + 8 * 128 * S5P;
    float* fs = carry + 1024 + w * 128;
    float ar, ai;
    {
        const float lr = P.in[I_LRE][g * 64 + lane], li = P.in[I_LIM][g * 64 + lane], delta = expf(P.in[I_LDT][g]);
        const float mag = expf(lr * delta), ang = li * delta;
        ar = mag * cosf(ang); ai = mag * sinf(ang);
        const float qre = ar - 1.f, den = lr * lr + li * li;
        fs[lane] = (qre * lr + ai * li) / den; fs[64 + lane] = (ai * lr - qre * li) / den;
    }
    lds_fence();
    bf16x8 bbf[8];
#pragma unroll
    for (int j = 0; j < 8; ++j) {
        bf16x8 z = {0, 0, 0, 0, 0, 0, 0, 0};
        if (fq < 2) {
            const int p = (j & 3) * 16 + fr;
            const float f_r = fs[p], f_i = fs[64 + p];
            const float* br = P.in[I_BRE] + ((long)(g * 64 + p)) * 16 + fq * 8;
            const float* bi = P.in[I_BIM] + ((long)(g * 64 + p)) * 16 + fq * 8;
            const f32x4 r0 = *(const f32x4*)br, r1 = *(const f32x4*)(br + 4), i0 = *(const f32x4*)bi, i1 = *(const f32x4*)(bi + 4);
            f32x4 o0, o1;
            if (j < 4) { o0 = r0 * f_r - i0 * f_i; o1 = r1 * f_r - i1 * f_i; }
            else { o0 = i0 * f_r + r0 * f_i; o1 = i1 * f_r + r1 * f_i; }
            u32x4 q; q.x = pk2(o0[0], o0[1]); q.y = pk2(o0[2], o0[3]); q.z = pk2(o1[0], o1[1]); q.w = pk2(o1[2], o1[3]);
            z = __builtin_bit_cast(bf16x8, q);
        }
        bbf[j] = z;
    }
    bf16x8 ccf[4];
#pragma unroll
    for (int ks = 0; ks < 4; ++ks) {
        const float* src = (ks < 2 ? P.in[I_CRE] : P.in[I_CIM]) + ((long)(g * 16 + fr)) * 64 + (ks & 1) * 32 + fq * 8;
        f32x4 c0 = *(const f32x4*)src, c1 = *(const f32x4*)(src + 4);
        if (ks >= 2) { c0 = -c0; c1 = -c1; }
        u32x4 q; q.x = pk2(c0[0], c0[1]); q.y = pk2(c0[2], c0[3]); q.z = pk2(c1[0], c1[1]); q.w = pk2(c1[2], c1[3]);
        ccf[ks] = __builtin_bit_cast(bf16x8, q);
    }
    const f32x4 dsk = *(const f32x4*)(P.in[I_S5D] + g * 16 + fq * 4);
    const long roww = rowbase + (long)w * TPW;
    float xr = 0.f, xi = 0.f;
    constexpr int NPASS = SAMPLE ? 1 : 2;
#pragma unroll 1
    for (int pass = 0; pass < NPASS; ++pass) {
        const bool last = (pass == NPASS - 1);
        if (!SAMPLE && pass == 1) {
            carry[w * 128 + lane] = xr; carry[w * 128 + 64 + lane] = xi;
            __syncthreads();
            float pr = ar, pi = ai;
#pragma unroll
            for (int q = 0; q < 8; ++q) { const float nr = pr * pr - pi * pi, ni = 2.f * pr * pi; pr = nr; pi = ni; }
            float sr = 0.f, si = 0.f;
            for (int ww = 0; ww < w; ++ww) {
                const float cr = carry[ww * 128 + lane], ci = carry[ww * 128 + 64 + lane];
                const float nr = pr * sr - pi * si + cr, ni = pr * si + pi * sr + ci; sr = nr; si = ni;
            }
            xr = sr; xi = si;
        }
        if (!SAMPLE && pass == 0 && w == 7) continue;
        bf16x8 ufn = {0, 0, 0, 0, 0, 0, 0, 0};
        if (fq < 2) ufn = *(const bf16x8*)(proj + (roww + fr) * PLD + C_UB + g * 16 + fq * 8);
#pragma unroll 1
        for (int sb = 0; sb < TPW / 16; ++sb) {
            const long r = roww + sb * 16;
            const bf16x8 uf = ufn;
            if (fq < 2 && sb + 1 < TPW / 16) ufn = *(const bf16x8*)(proj + (r + 16 + fr) * PLD + C_UB + g * 16 + fq * 8);
            u32x2* up = (u32x2*)(proj + (r + fr) * PLD + C_UB + g * 16 + fq * 4);
            u32x2 uu = {0u, 0u};
            if (last) uu = *up;
            const f32x4 zero = {0.f, 0.f, 0.f, 0.f};
#pragma unroll
            for (int j = 0; j < 8; ++j) {
                const f32x4 d = mfma16(uf, bbf[j], zero);
                *(f32x4*)(buf + (j * 16 + fr) * S5P + fq * 4) = d;
            }
            lds_fence();
#pragma unroll
            for (int q = 0; q < 4; ++q) {
                f32x4 br = *(const f32x4*)(buf + lane * S5P + q * 4), bi = *(const f32x4*)(buf + (64 + lane) * S5P + q * 4);
                if (SAMPLE) {
                    const long seq = (r - NPROMPT) / 4 + q;
                    xr = P.in[I_S5R][(seq * 64 + g) * 64 + lane]; xi = P.in[I_S5I][(seq * 64 + g) * 64 + lane];
                }
#pragma unroll
                for (int i = 0; i < 4; ++i) {
                    const float nr = ar * xr - ai * xi + br[i], ni = ar * xi + ai * xr + bi[i];
                    xr = nr; xi = ni; br[i] = nr; bi[i] = ni;
                }
                if (last) { *(f32x4*)(buf + lane * S5P + q * 4) = br; *(f32x4*)(buf + (64 + lane) * S5P + q * 4) = bi; }
                if (SAMPLE) {
                    const long seq = (r - NPROMPT) / 4 + q;
                    P.out[O_S5RS + (seq * 64 + g) * 64 + lane] = xr; P.out[O_S5IS + (seq * 64 + g) * 64 + lane] = xi;
                }
            }
            if (last) {
                lds_fence();
                f32x4 y = {0.f, 0.f, 0.f, 0.f};
#pragma unroll
                for (int ks = 0; ks < 4; ++ks) {
                    float xv[8];
#pragma unroll
                    for (int i = 0; i < 8; ++i) xv[i] = buf[(ks * 32 + fq * 8 + i) * S5P + fr];
                    u32x4 q; q.x = pk2(xv[0], xv[1]); q.y = pk2(xv[2], xv[3]); q.z = pk2(xv[4], xv[5]); q.w = pk2(xv[6], xv[7]);
                    y = mfma16(ccf[ks], __builtin_bit_cast(bf16x8, q), y);
                }
                const float y0 = geluf(y[0] + dsk[0] * bflo(uu.x)), y1 = geluf(y[1] + dsk[1] * bfhi(uu.x));
                const float y2 = geluf(y[2] + dsk[2] * bflo(uu.y)), y3 = geluf(y[3] + dsk[3] * bfhi(uu.y));
                u32x2 o; o.x = pk2(y0, y1); o.y = pk2(y2, y3);
                *up = o;
            }
            lds_fence();
        }
    }
    if (!SAMPLE && w == 7) {
        P.out[O_S5RP + ((long)bidx * 64 + g) * 64 + lane] = xr; P.out[O_S5IP + ((long)bidx * 64 + g) * 64 + lane] = xi;
    }
    __syncthreads();
}

__global__ void __launch_bounds__(512) hymba_fwd(Params P) {
    cg::grid_group grid = cg::this_grid();
#ifdef PROBE_K
    unsigned long long tb_[9]; int nb_ = 0;
#define TB() do { tb_[nb_++] = wall_clock64(); } while (0)
    TB();
#else
#define TB() do {} while (0)
#endif
    const int G = gridDim.x, bid = blockIdx.x;
    char* ws = P.ws;
    bf16_t* proj = (bf16_t*)(ws + W_PROJ);
    unsigned* barw = (unsigned*)(ws + W_BAR);
    if (bid == 0) for (int i = threadIdx.x; i < XCD_BAR_WORDS; i += 512) barw[i] = 0u;
    volatile LAS unsigned* stw = (volatile LAS unsigned*)(smem + 131072);
    if (threadIdx.x < 4) stw[threadIdx.x] = 0u;
#ifndef NO_P0
    phase0(P);
#endif
    grid.sync(); TB();
    const XcdBarrier xb = xcd_barrier_post(barw, stw);
#ifndef NO_P1
    for (int L = bid; L < 1188; L += G) {
        int pm, pn; tile_of(L, 66, 18, pm, pn);
        gemm_tile((const bf16_t*)(ws + W_NB), 1024, (const bf16_t*)(ws + W_WTIN), 1024, 1024, pm * 256, pn * 256, EpiBf16{proj, PLD, (const float*)(ws + W_RSTD)});
    }
    for (int L = (bid + G - 1188 % G) % G; L < 264; L += G) {
        int pm, pn; tile_of(L, 66, 4, pm, pn);
        gemm_tile((const bf16_t*)(ws + W_PB), 256, (const bf16_t*)(ws + W_WTPP), 256, 256, pm * 256, pn * 256, EpiBf16{(bf16_t*)(ws + W_PP), 1024, nullptr});
    }
#endif
    xcd_barrier(xb); TB();
    for (int idx = bid * 512 + threadIdx.x; idx < (8 + 128) * 3 * 1536; idx += G * 512) {
        const int ch = idx % 1536, sj = idx / 1536, j = sj % 3, sq = sj / 3;
        const long row = sq < 8 ? (long)sq * 2048 + 2045 + j : NPROMPT + (long)(sq - 8) * 4 + 1 + j;
        const float v = __uint_as_float(((unsigned)proj[row * PLD + C_XBC + ch]) << 16);
        if (sq < 8) P.out[O_CONVP + ((long)sq * 3 + j) * 1536 + ch] = v; else P.out[O_CONVS + ((long)(sq - 8) * 3 + j) * 1536 + ch] = v;
    }
#ifndef NO_S1
    for (int it = bid; it < 256; it += G) ssd_s1_item(P, it);
#endif
#ifndef NO_SS
    for (int it = bid; it < 256; it += G) ssd_sample_item(P, it);
#endif
#ifndef NO_S5P
    for (int it = bid; it < 512; it += G) s5_item<false>(P, it & 63, (long)(it >> 6) * 2048, it >> 6);
#endif
#ifndef NO_S5S
    for (int it = bid; it < 128; it += G) s5_item<true>(P, it & 63, NPROMPT + (long)(it >> 6) * 256, 0);
#endif
    xcd_barrier(xb); TB();
#ifndef NO_P3
    {
        const EpiGlu eg{proj, P.in[I_GLUB]};
        for (int L = bid; L < 256; L += G) {
            int pm, pn; tile_of(L, 64, 4, pm, pn);
            gemm_tile(proj + C_UB, PLD, (const bf16_t*)(ws + W_WTGLU), 1024, 1024, pm * 256, pn * 256, eg);
        }
        for (int L = G - 1 - bid; L < 64; L += G)
            gemm_small(proj + C_UB, PLD, (const bf16_t*)(ws + W_WTGLU), 1024, 1024, NPROMPT + (L >> 3) * 64, (L & 7) * 128, eg);
    }
#endif
#ifndef NO_S2
    ssd_s2(P);
#endif
    xcd_barrier(xb); TB();
#ifndef NO_S3
    for (int it = bid; it < 256; it += G) ssd_s3_item(P, it);
#endif
    xcd_barrier(xb); TB();
#ifndef NO_P5
    {
        const EpiOut eo{P.in[I_XP], P.in[I_XS], P.out, (bf16_t*)(ws + W_NB), (float*)(ws + W_RSS1)};
        for (int L = bid; L < 256; L += G) {
            int pm, pn; tile_of(L, 64, 4, pm, pn);
            gemm_tile(proj, PLD, (const bf16_t*)(ws + W_WTOUT), 2048, 2048, pm * 256, pn * 256, eo);
        }
        for (int L = G - 1 - bid; L < 64; L += G)
            gemm_small(proj, PLD, (const bf16_t*)(ws + W_WTOUT), 2048, 2048, NPROMPT + (L >> 3) * 64, (L & 7) * 128, eo);
    }
#endif
    xcd_barrier(xb); TB();
#ifndef NO_P6
    {
        const EpiPle ep{P.out, (const bf16_t*)(ws + W_PP), (const float*)(ws + W_RSS1), (float*)(ws + W_RSS2)};
        for (int L = bid; L < 256; L += G) {
            int pm, pn; tile_of(L, 64, 4, pm, pn);
            gemm_tile((const bf16_t*)(ws + W_NB), 1024, (const bf16_t*)(ws + W_WTGATE), 1024, 1024, pm * 256, pn * 256, ep);
        }
        for (int L = G - 1 - bid; L < 64; L += G)
            gemm_small((const bf16_t*)(ws + W_NB), 1024, (const bf16_t*)(ws + W_WTGATE), 1024, 1024, NPROMPT + (L >> 3) * 64, (L & 7) * 128, ep);
    }
#endif
    xcd_barrier(xb); TB();
    {
        const float* rss2 = (const float*)(ws + W_RSS2);
        for (int idx = bid * 512 + threadIdx.x; idx < NTOK * 256; idx += G * 512) {
            const int row = idx >> 8, c4 = (idx & 255) * 4;
            const float rstd = rsqrtf(rss2[row] * (1.f / 1024.f) + EPS);
            f32x4* p = (f32x4*)(P.out + (long)row * 1024 + c4);
            const f32x4 gf = *(const f32x4*)(P.in[I_GFIN] + c4);
            *p = *p * rstd * gf;
        }
    }
#ifdef PROBE_K
    { TB(); const unsigned long long d = tb_[PROBE_K + 1] - tb_[PROBE_K], t0 = wall_clock64(); while (wall_clock64() - t0 < d) __builtin_amdgcn_s_sleep(8); }
#endif
}

extern "C" void kernel_launch(void* const* d_in, const int* in_sizes, int n_in, void* d_out, int out_size, void* d_ws, size_t ws_size, hipStream_t stream) {
    static int grid_blocks = 0;
    if (grid_blocks == 0) {
        if (n_in != 31 || out_size != (int)O_END || ws_size < W_END) {
            fprintf(stderr, "kernel_launch: unexpected shapes n_in %d out %d ws %zu (need %zu)\n", n_in, out_size, ws_size, (size_t)W_END);
            grid_blocks = -1; return;
        }
        int dev = 0, cus = 0, per_cu = 0;
        hipGetDevice(&dev);
        hipDeviceGetAttribute(&cus, hipDeviceAttributeMultiprocessorCount, dev);
        hipFuncSetAttribute((const void*)hymba_fwd, hipFuncAttributeMaxDynamicSharedMemorySize, LDS_BYTES);
        hipOccupancyMaxActiveBlocksPerMultiprocessor(&per_cu, (const void*)hymba_fwd, 512, LDS_BYTES);
        if (per_cu < 1) { fprintf(stderr, "kernel_launch: occupancy query says %d blocks/CU\n", per_cu); per_cu = 1; }
        grid_blocks = cus;
        (void)hipGetLastError();
    }
    if (grid_blocks < 0) return;
    Params p{};
    for (int i = 0; i < 31; ++i) p.in[i] = (const float*)d_in[i];
    p.out = (float*)d_out; p.ws = (char*)d_ws;
    void* args[] = {&p};
    hipError_t e = hipLaunchCooperativeKernel((const void*)hymba_fwd, dim3(grid_blocks), dim3(512), args, LDS_BYTES, stream);
    if (e != hipSuccess) fprintf(stderr, "cooperative launch failed: %s (grid %d)\n", hipGetErrorString(e), grid_blocks);
}
```

```cpp
#include <hip/hip_runtime.h>
#include <hip/hip_cooperative_groups.h>
#include <cstdio>
namespace cg = cooperative_groups;

typedef unsigned short bf16_t;
typedef short bf16x8 __attribute__((ext_vector_type(8)));
typedef float f32x4 __attribute__((ext_vector_type(4)));
typedef unsigned u32x2 __attribute__((ext_vector_type(2)));
typedef unsigned u32x4 __attribute__((ext_vector_type(4)));
#define DEV __device__ __forceinline__

constexpr int NPROMPT = 16384, NSAMPLE = 512, NTOK = 16896;
constexpr int PLD = 4608;
constexpr int C_ZA = 0, C_ZB = 1024, C_XBC = 2048, C_UB = 3584;
constexpr float EPS = 1e-6f;
constexpr long O_YP = 0, O_YS = 16777216, O_SSDP = 17301504, O_CONVP = 18350080, O_S5RP = 18386944, O_S5IP = 18419712,
               O_SSDS = 18452480, O_CONVS = 35229696, O_S5RS = 35819520, O_S5IS = 36343808, O_END = 36868096;
constexpr size_t W_WTIN = 0;
constexpr size_t W_WTOUT = W_WTIN + 4608ull * 1024 * 2;
constexpr size_t W_WTGLU = W_WTOUT + 1024ull * 2048 * 2;
constexpr size_t W_WTGATE = W_WTGLU + 1024ull * 1024 * 2;
constexpr size_t W_WTPP = W_WTGATE + 1024ull * 1024 * 2;
constexpr size_t W_NB = W_WTPP + 1024ull * 256 * 2;
constexpr size_t W_PB = W_NB + 16896ull * 1024 * 2;
constexpr size_t W_DTR = W_PB + 16896ull * 256 * 2;
constexpr size_t W_ACS = W_DTR + 16896ull * 16 * 4;
constexpr size_t W_CDEC = W_ACS + 16384ull * 16 * 4;
constexpr size_t W_RSS1 = W_CDEC + 8192;
constexpr size_t W_RSS2 = W_RSS1 + 16896ull * 4;
constexpr size_t W_PROJ = W_RSS2 + 16896ull * 4;
constexpr size_t W_PP = W_PROJ + 16896ull * 4608 * 2;
constexpr size_t W_RSTD = W_PP + 16896ull * 1024 * 2;
constexpr size_t W_BAR = W_RSTD + 16896ull * 4;
constexpr size_t W_END = W_BAR + 16384;

constexpr int LDS_BYTES = 131072 + 64;

struct Params {
    const float* in[31];
    float* out;
    char* ws;
};
enum { I_XP = 0, I_XS, I_PP, I_PS, I_SSD, I_CONV, I_S5R, I_S5I, I_WIN, I_GIN, I_CONVW, I_CONVB, I_DTB, I_ALOG, I_SSDD, I_SSDG,
       I_LRE, I_LIM, I_LDT, I_BRE, I_BIM, I_CRE, I_CIM, I_S5D, I_GLUW, I_GLUB, I_WOUT, I_GPLE, I_WGATE, I_WPP, I_GFIN };

extern __shared__ __attribute__((aligned(16))) char smem[];

DEV unsigned pk2(float lo, float hi) { unsigned r; asm("v_cvt_pk_bf16_f32 %0, %1, %2" : "=v"(r) : "v"(lo), "v"(hi)); return r; }
DEV float bflo(unsigned u) { return __uint_as_float(u << 16); }
DEV float bfhi(unsigned u) { return __uint_as_float(u & 0xffff0000u); }
DEV float wave_sum(float v) {
#pragma unroll
    for (int o = 1; o < 64; o <<= 1) v += __shfl_xor(v, o);
    return v;
}
DEV float siluf(float v) { return v / (1.f + __expf(-v)); }
DEV float sigmf(float v) { return 1.f / (1.f + __expf(-v)); }
DEV float geluf(float y) { float z = 0.7978845608f * (y + 0.044715f * y * y * y); return y / (1.f + __expf(-2.f * z)); }
DEV f32x4 mfma16(bf16x8 a, bf16x8 b, f32x4 c) { return __builtin_amdgcn_mfma_f32_16x16x32_bf16(a, b, c, 0, 0, 0); }
DEV int tid_fresh() { int t = threadIdx.x; asm volatile("" : "+v"(t)); return t; }
DEV void lds_fence() { asm volatile("s_waitcnt lgkmcnt(0)" ::: "memory"); }


#define XB_TMO      128
#define XB_XCNT(j)  (256  + 64 * (j))
#define XB_XSUB(j)  (1280 + 64 * (j))
#define XB_XGEN(j)  (2304 + 64 * (j))
#define XB_TOP      3328
#define XB_TOPGEN   3392
#define XCD_BAR_WORDS 3456
#define XB_SPIN_CAP (1u << 22)
#define LAS __attribute__((address_space(3)))
DEV unsigned xb_ld(unsigned* p) { return __hip_atomic_load(p, __ATOMIC_RELAXED, __HIP_MEMORY_SCOPE_AGENT); }
DEV unsigned xb_add(unsigned* p, unsigned v) { return __hip_atomic_fetch_add(p, v, __ATOMIC_RELAXED, __HIP_MEMORY_SCOPE_AGENT); }
DEV unsigned xb_xcc_id() { return (unsigned)__builtin_amdgcn_s_getreg((3 << 11) | 20) & 0xFu; }
#define XB_SPIN(cond, bar) do { unsigned _sp = 0; while (cond) { __builtin_amdgcn_s_sleep(1); \
    if ((++_sp & 255u) == 0u) { if (xb_ld(&(bar)[XB_TMO])) break; if (_sp > XB_SPIN_CAP) { atomicAdd(&(bar)[XB_TMO], 1u); break; } } } } while (0)
struct XcdBarrier { unsigned* bar; unsigned x; volatile LAS unsigned* st; };
DEV XcdBarrier xcd_barrier_post(unsigned* bar, volatile LAS unsigned* st) {
    XcdBarrier b; b.bar = bar; b.x = xb_xcc_id(); b.st = st;
    if (threadIdx.x == 0) (void)xb_add(&bar[XB_XCNT(b.x)], 1u);
    return b;
}
DEV void xcd_barrier_complete(unsigned* bar, unsigned x, unsigned& nloc, unsigned& nx) {
    const unsigned G = gridDim.x * gridDim.y * gridDim.z;
    unsigned sum, cnt, mine, sp = 0u;
    for (;;) {
        sum = 0u; cnt = 0u; mine = 0u;
#pragma unroll
        for (unsigned j = 0; j < 16; ++j) { const unsigned c = xb_ld(&bar[XB_XCNT(j)]); sum += c; cnt += (c > 0u) ? 1u : 0u; mine = (j == x) ? c : mine; }
        if (sum == G) break;
        __builtin_amdgcn_s_sleep(1);
        if ((++sp & 255u) == 0u) { if (xb_ld(&bar[XB_TMO])) break; if (sp > XB_SPIN_CAP) { atomicAdd(&bar[XB_TMO], 1u); break; } }
    }
    nloc = mine > 0u ? mine : 1u; nx = cnt > 0u ? cnt : 1u;
}
DEV void xcd_barrier(const XcdBarrier& b) {
    asm volatile("s_waitcnt vmcnt(0)" ::: "memory");
    __syncthreads();
    if (threadIdx.x == 0) {
        unsigned* bar = b.bar;
        __builtin_amdgcn_s_waitcnt(0);
        unsigned nloc = b.st[0], nx = b.st[1];
        if (nloc == 0u) { xcd_barrier_complete(bar, b.x, nloc, nx); b.st[0] = nloc; b.st[1] = nx; }
        const unsigned old = xb_add(&bar[XB_XSUB(b.x)], 1u);
        const unsigned gen = old / nloc;
        if (old + 1u == (gen + 1u) * nloc) {
            __builtin_amdgcn_fence(__ATOMIC_RELEASE, "agent");
            asm volatile("s_waitcnt vmcnt(0)" ::: "memory");
            const unsigned og = xb_add(&bar[XB_TOP], 1u);
            const unsigned tg = og / nx;
            if (og + 1u == (tg + 1u) * nx) xb_add(&bar[XB_TOPGEN], 1u);
            else XB_SPIN(xb_ld(&bar[XB_TOPGEN]) == tg, bar);
            __builtin_amdgcn_fence(__ATOMIC_ACQUIRE, "agent");
            xb_add(&bar[XB_XGEN(b.x)], 1u);
            asm volatile("s_waitcnt vmcnt(0)" ::: "memory");
        } else {
            XB_SPIN(xb_ld(&bar[XB_XGEN(b.x)]) == gen, bar);
            __builtin_amdgcn_fence(__ATOMIC_ACQUIRE, "agent");
            asm volatile("s_waitcnt vmcnt(0)" ::: "memory");
        }
    }
    __syncthreads();
}

constexpr int BM = 256, BK = 64, HALF = 128, HT = HALF * BK;
DEV int lds_byte(int r, int c) {
    int st = (r >> 4) * 2 + (c >> 5), rr = r & 15, cc = c & 31, ob = rr * 64 + cc * 2;
    return st * 1024 + (ob ^ (((ob >> 9) & 1) << 5));
}
DEV void stage_rc(int b, int& R, int& C) {
    int st = b / 1024, sb = b % 1024, swz = sb ^ (((sb >> 9) & 1) << 5);
    R = (st >> 1) * 16 + swz / 64; C = (st & 1) * 32 + (swz % 64) / 2;
}

template <class Epi>
DEV void gemm_tile(const bf16_t* __restrict__ A, int lda, const bf16_t* __restrict__ Bt, int ldb, int K, int brow, int bcol, const Epi& epi) {
    LAS unsigned char* lds = (LAS unsigned char*)smem;
    constexpr int HTB = HT * 2;
    const int tid = tid_fresh(), wid = __builtin_amdgcn_readfirstlane(tid >> 6), lane = tid & 63, wr = wid >> 2, wc = wid & 3, fr = lane & 15, fq = lane >> 4;
    unsigned voffA[2], voffB[2];
#pragma unroll
    for (int i = 0; i < 2; ++i) { int R, C; stage_rc(tid * 16 + i * 8192, R, C); voffA[i] = (unsigned)(R * lda + C) * 2u; voffB[i] = (unsigned)(R * ldb + C) * 2u; }
    const size_t kstep = (size_t)(BK * 2), hstepA = (size_t)HALF * lda * 2, hstepB = (size_t)HALF * ldb * 2;
    const unsigned ldsw = (unsigned)wid * 1024u;
    const int aoff = lds_byte(wr * 64 + fr, fq * 8), boff = lds_byte(wc * 32 + fr, fq * 8);
#define SA(b, h) (((b) * 2 + (h)) * HTB)
#define SB(b, h) ((4 + (b) * 2 + (h)) * HTB)
#define STAGE(bufoff, gbase, voff) do { _Pragma("unroll") for (int _i = 0; _i < 2; ++_i) \
        __builtin_amdgcn_global_load_lds((const unsigned*)((const char*)(gbase) + (voff)[_i]), (LAS unsigned*)(lds + (bufoff) + ldsw + _i * 8192), 16, 0, 0); } while (0)
#define LDA(dst, b, h) do { _Pragma("unroll") for (int m = 0; m < 4; ++m) _Pragma("unroll") for (int k = 0; k < 2; ++k) dst[m][k] = *(const LAS bf16x8*)(lds + SA(b, h) + aoff + m * 2048 + k * 1024); } while (0)
#define LDB(dst, b, h) do { _Pragma("unroll") for (int n = 0; n < 2; ++n) _Pragma("unroll") for (int k = 0; k < 2; ++k) dst[n][k] = *(const LAS bf16x8*)(lds + SB(b, h) + boff + n * 2048 + k * 1024); } while (0)
#define MMA(ai, bj, At, Bt_) do { __builtin_amdgcn_s_setprio(1); _Pragma("unroll") for (int m = 0; m < 4; ++m) _Pragma("unroll") for (int n = 0; n < 2; ++n) _Pragma("unroll") for (int k = 0; k < 2; ++k) \
        acc[ai][bj][m][n] = __builtin_amdgcn_mfma_f32_16x16x32_bf16(Bt_[n][k], At[m][k], acc[ai][bj][m][n], 0, 0, 0); __builtin_amdgcn_s_setprio(0); } while (0)
#define WAIT_V(n) asm volatile("s_waitcnt vmcnt(" #n ")" ::: "memory")
#define WAIT_L(n) asm volatile("s_waitcnt lgkmcnt(" #n ")" ::: "memory")
#define BAR __builtin_amdgcn_s_barrier()
#define SCHED __builtin_amdgcn_sched_barrier(0)
    f32x4 acc[2][2][4][2];
#pragma unroll
    for (int a = 0; a < 2; ++a)
#pragma unroll
        for (int b = 0; b < 2; ++b)
#pragma unroll
            for (int m = 0; m < 4; ++m)
#pragma unroll
                for (int n = 0; n < 2; ++n) acc[a][b][m][n] = (f32x4){0.f, 0.f, 0.f, 0.f};
    bf16x8 At[4][2], B0[2][2], B1[2][2];
    const int nt = K / BK;
    const char* cA = (const char*)A + (size_t)brow * lda * 2; const char* cB = (const char*)Bt + (size_t)bcol * ldb * 2;
    STAGE(SB(0, 0), cB, voffB); STAGE(SA(0, 0), cA, voffA); STAGE(SB(0, 1), cB + hstepB, voffB); STAGE(SA(0, 1), cA + hstepA, voffA);
    if (wr == 1) BAR;
    WAIT_V(4); BAR;
    STAGE(SB(1, 0), cB + kstep, voffB); STAGE(SA(1, 0), cA + kstep, voffA); STAGE(SB(1, 1), cB + hstepB + kstep, voffB);
    WAIT_V(6); BAR;
    for (int t = 0; t < nt - 2; t += 2) {
        const char* a1 = cA + (size_t)(t + 1) * kstep;
        const char* a2 = cA + (size_t)(t + 2) * kstep; const char* b2 = cB + (size_t)(t + 2) * kstep;
        const char* a3 = a2 + kstep; const char* b3 = b2 + kstep;
        LDB(B0, 0, 0); SCHED; LDA(At, 0, 0); STAGE(SA(1, 1), a1 + hstepA, voffA);
        WAIT_L(8); BAR; WAIT_L(0); MMA(0, 0, At, B0); BAR; SCHED;
        LDB(B1, 0, 1); STAGE(SB(0, 0), b2, voffB);
        BAR; WAIT_L(0); MMA(0, 1, At, B1); BAR;
        LDA(At, 0, 1); STAGE(SA(0, 0), a2, voffA);
        BAR; WAIT_L(0); MMA(1, 0, At, B0); BAR; SCHED;
        STAGE(SB(0, 1), b2 + hstepB, voffB);
        WAIT_V(6); BAR; MMA(1, 1, At, B1); BAR;
        LDB(B0, 1, 0); SCHED; LDA(At, 1, 0); STAGE(SA(0, 1), a2 + hstepA, voffA);
        WAIT_L(8); BAR; WAIT_L(0); MMA(0, 0, At, B0); BAR; SCHED;
        LDB(B1, 1, 1); STAGE(SB(1, 0), b3, voffB);
        BAR; WAIT_L(0); MMA(0, 1, At, B1); BAR;
        LDA(At, 1, 1); STAGE(SA(1, 0), a3, voffA);
        BAR; WAIT_L(0); MMA(1, 0, At, B0); BAR; SCHED;
        STAGE(SB(1, 1), b3 + hstepB, voffB);
        WAIT_V(6); BAR; MMA(1, 1, At, B1); BAR;
    }
    { const char* a1 = cA + (size_t)(nt - 1) * kstep;
      LDB(B0, 0, 0); LDA(At, 0, 0); STAGE(SA(1, 1), a1 + hstepA, voffA);
      BAR; WAIT_L(0); MMA(0, 0, At, B0); BAR;
      LDB(B1, 0, 1); BAR; WAIT_L(0); MMA(0, 1, At, B1); BAR;
      LDA(At, 0, 1); WAIT_V(4); BAR; WAIT_L(0); MMA(1, 0, At, B0); MMA(1, 1, At, B1); BAR; }
    { LDB(B0, 1, 0); LDA(At, 1, 0); WAIT_V(2); BAR; WAIT_L(0); MMA(0, 0, At, B0); BAR;
      LDB(B1, 1, 1); WAIT_V(0); BAR; WAIT_L(0); MMA(0, 1, At, B1); BAR;
      LDA(At, 1, 1); BAR; WAIT_L(0); MMA(1, 0, At, B0); MMA(1, 1, At, B1); BAR; }
    if (wr == 0) BAR;
    epi_big(epi, acc, brow, bcol, wr, wc, fr, fq);
    __syncthreads();
#undef SA
#undef SB
#undef STAGE
#undef LDA
#undef LDB
#undef MMA
}

DEV void tile_of(int L, int nM, int nN, int& pm, int& pn) {
    const int nwg = nM * nN; int wgid = L;
    { const int q = nwg / 8, r = nwg % 8, xcd = wgid % 8, off = wgid / 8; wgid = (xcd < r ? xcd * (q + 1) : r * (q + 1) + (xcd - r) * q) + off; }
    const int nig = 8 * nN, gid = wgid / nig, fm = gid * 8, gsz = (nM - fm) < 8 ? (nM - fm) : 8;
    pm = fm + ((wgid % nig) % gsz); pn = (wgid % nig) / gsz;
}

struct EpiBf16 {
    bf16_t* dst; int ld; const float* rstd;
    struct Ld { float rs; };
    DEV void load(int row, int col, Ld& d) const { d.rs = rstd ? rstd[row] : 1.f; }
    DEV void apply(int row, int col, const f32x4& v, const Ld& d, float& ss) const {
        u32x2 o; o.x = pk2(v[0] * d.rs, v[1] * d.rs); o.y = pk2(v[2] * d.rs, v[3] * d.rs);
        *(u32x2*)(dst + (long)row * ld + col) = o;
    }
    DEV void rowdone(int row, float ss, int fq) const {}
};
struct EpiGlu {
    bf16_t* proj; const float* glu_b;
    struct Ld { u32x2 g, z; f32x4 b; };
    DEV void load(int row, int col, Ld& d) const {
        d.g = *(const u32x2*)(proj + (long)row * PLD + C_UB + col); d.z = *(const u32x2*)(proj + (long)row * PLD + C_ZB + col); d.b = *(const f32x4*)(glu_b + col);
    }
    DEV void apply(int row, int col, const f32x4& v, const Ld& d, float& ss) const {
        const float y0 = bflo(d.g.x) * sigmf(v[0] + d.b[0]) * siluf(bflo(d.z.x)), y1 = bfhi(d.g.x) * sigmf(v[1] + d.b[1]) * siluf(bfhi(d.z.x));
        const float y2 = bflo(d.g.y) * sigmf(v[2] + d.b[2]) * siluf(bflo(d.z.y)), y3 = bfhi(d.g.y) * sigmf(v[3] + d.b[3]) * siluf(bfhi(d.z.y));
        u32x2 o; o.x = pk2(y0, y1); o.y = pk2(y2, y3);
        *(u32x2*)(proj + (long)row * PLD + C_ZB + col) = o;
    }
    DEV void rowdone(int row, float ss, int fq) const {}
};
struct EpiOut {
    const float* xp; const float* xs; float* out; bf16_t* h1b; float* rss;
    struct Ld { f32x4 x; };
    DEV void load(int row, int col, Ld& d) const {
        const float* xrow = row < NPROMPT ? xp + (long)row * 1024 : xs + (long)(row - NPROMPT) * 1024;
        d.x = *(const f32x4*)(xrow + col);
    }
    DEV void apply(int row, int col, const f32x4& a, const Ld& d, float& ss) const {
        const f32x4 v = a + d.x;
        *(f32x4*)(out + (long)row * 1024 + col) = v;
        u32x2 o; o.x = pk2(v[0], v[1]); o.y = pk2(v[2], v[3]);
        *(u32x2*)(h1b + (long)row * 1024 + col) = o;
        ss += v[0] * v[0] + v[1] * v[1] + v[2] * v[2] + v[3] * v[3];
    }
    DEV void rowdone(int row, float ss, int fq) const {
        ss += __shfl_xor(ss, 16); ss += __shfl_xor(ss, 32);
        if (fq == 0) atomicAdd(rss + row, ss);
    }
};
struct EpiPle {
    float* out; const bf16_t* pp; const float* rss1; float* rss2;
    struct Ld { f32x4 h; u32x2 pv; float rs; };
    DEV void load(int row, int col, Ld& d) const {
        d.h = *(const f32x4*)(out + (long)row * 1024 + col); d.pv = *(const u32x2*)(pp + (long)row * 1024 + col); d.rs = rss1[row];
    }
    DEV void apply(int row, int col, const f32x4& a, const Ld& d, float& ss) const {
        const float rstd = rsqrtf(d.rs * (1.f / 1024.f) + EPS);
        f32x4 h = d.h;
        h[0] += bflo(d.pv.x) * sigmf(a[0] * rstd); h[1] += bfhi(d.pv.x) * sigmf(a[1] * rstd);
        h[2] += bflo(d.pv.y) * sigmf(a[2] * rstd); h[3] += bfhi(d.pv.y) * sigmf(a[3] * rstd);
        *(f32x4*)(out + (long)row * 1024 + col) = h;
        ss += h[0] * h[0] + h[1] * h[1] + h[2] * h[2] + h[3] * h[3];
    }
    DEV void rowdone(int row, float ss, int fq) const {
        ss += __shfl_xor(ss, 16); ss += __shfl_xor(ss, 32);
        if (fq == 0) atomicAdd(rss2 + row, ss);
    }
};
template <class Epi>
DEV void epi_big(const Epi& E, const f32x4 (&acc)[2][2][4][2], int brow, int bcol, int wr, int wc, int fr, int fq) {
#pragma unroll
    for (int ai = 0; ai < 2; ++ai)
#pragma unroll
        for (int mp = 0; mp < 2; ++mp) {
            typename Epi::Ld d[2][4];
#pragma unroll
            for (int mm = 0; mm < 2; ++mm)
#pragma unroll
                for (int j = 0; j < 4; ++j)
                    E.load(brow + ai * 128 + wr * 64 + (mp * 2 + mm) * 16 + fr, bcol + (j >> 1) * 128 + wc * 32 + (j & 1) * 16 + fq * 4, d[mm][j]);
#pragma unroll
            for (int mm = 0; mm < 2; ++mm) {
                const int row = brow + ai * 128 + wr * 64 + (mp * 2 + mm) * 16 + fr; float ss = 0.f;
#pragma unroll
                for (int j = 0; j < 4; ++j)
                    E.apply(row, bcol + (j >> 1) * 128 + wc * 32 + (j & 1) * 16 + fq * 4, acc[ai][j >> 1][mp * 2 + mm][j & 1], d[mm][j], ss);
                E.rowdone(row, ss, fq);
            }
        }
}
template <class Epi>
DEV void gemm_small(const bf16_t* __restrict__ A, int lda, const bf16_t* __restrict__ Bt, int ldb, int K, int row0, int col0, const Epi& E) {
    const int tid = tid_fresh(), w = tid >> 6, lane = tid & 63, fr = lane & 15, fq = lane >> 4;
    const bf16_t* ap = A + (long)(row0 + fr) * lda + fq * 8;
    const bf16_t* bp = Bt + (long)(col0 + w * 16 + fr) * ldb + fq * 8;
    f32x4 acc = (f32x4){0.f, 0.f, 0.f, 0.f};
#pragma unroll 8
    for (int k = 0; k < K; k += 32) {
        const bf16x8 a = *(const bf16x8*)(ap + k), b = *(const bf16x8*)(bp + k);
        acc = mfma16(b, a, acc);
    }
    const int row = row0 + fr, col = col0 + w * 16 + fq * 4;
    typename Epi::Ld d;
    E.load(row, col, d);
    float ss = 0.f;
    E.apply(row, col, acc, d, ss);
    E.rowdone(row, ss, fq);
}

DEV void transpose_item(const float* __restrict__ src, int ldsrc, int k0, int c0, bf16_t* __restrict__ dst, int lddst, int n0,
                        const float* __restrict__ kscale, float* scr, int lane) {
    const int cl = lane & 31, kh = lane >> 5;
    float v[32];
#pragma unroll
    for (int i = 0; i < 32; ++i) v[i] = src[(long)(k0 + 2 * i + kh) * ldsrc + c0 + cl];
    if (kscale) {
#pragma unroll
        for (int i = 0; i < 32; ++i) v[i] *= kscale[k0 + 2 * i + kh];
    }
#pragma unroll
    for (int i = 0; i < 32; ++i) scr[(2 * i + kh) * 33 + cl] = v[i];
    lds_fence();
    const int c = lane & 7;
#pragma unroll
    for (int j = 0; j < 4; ++j) {
        const int n = (lane >> 3) + 8 * j; const float* sp = scr + (8 * c) * 33 + n;
        u32x4 o; o.x = pk2(sp[0 * 33], sp[1 * 33]); o.y = pk2(sp[2 * 33], sp[3 * 33]); o.z = pk2(sp[4 * 33], sp[5 * 33]); o.w = pk2(sp[6 * 33], sp[7 * 33]);
        *(u32x4*)(dst + (long)(n0 + n) * lddst + k0 + 8 * c) = o;
    }
    lds_fence();
}

DEV void phase0(const Params& P) {
    const int tid = tid_fresh(), lane = tid & 63, wave = tid >> 6, G = gridDim.x, bid = blockIdx.x;
    char* ws = P.ws;
    float* tile = (float*)smem;
    {
        float* scr = (float*)smem + wave * (64 * 33);
        constexpr int I_IN = 144 * 16, I_OUT = 32 * 32, I_GLU = 32 * 16, I_GATE = 32 * 16, I_PPW = 32 * 4;
        constexpr int I_ALL = I_IN + I_OUT + I_GLU + I_GATE + I_PPW;
        for (int it = bid * 8 + wave; it < I_ALL; it += G * 8) {
            int r = it;
            if (r < I_IN) {
                const int nb = r >> 4, kb = r & 15, n0 = nb * 32;
                int c0;
                if (n0 < 1024) c0 = n0; else if (n0 < 2048) c0 = 2576 + (n0 - 1024); else if (n0 < 3584) c0 = 1024 + (n0 - 2048); else c0 = 3600 + (n0 - 3584);
                transpose_item(P.in[I_WIN], 4624, kb * 64, c0, (bf16_t*)(ws + W_WTIN), 1024, n0, P.in[I_GIN], scr, lane); continue;
            }
            r -= I_IN;
            if (r < I_OUT) { const int nb = r >> 5, kb = r & 31; transpose_item(P.in[I_WOUT], 1024, kb * 64, nb * 32, (bf16_t*)(ws + W_WTOUT), 2048, nb * 32, nullptr, scr, lane); continue; }
            r -= I_OUT;
            if (r < I_GLU) { const int nb = r >> 4, kb = r & 15; transpose_item(P.in[I_GLUW], 1024, kb * 64, nb * 32, (bf16_t*)(ws + W_WTGLU), 1024, nb * 32, nullptr, scr, lane); continue; }
            r -= I_GLU;
            if (r < I_GATE) { const int nb = r >> 4, kb = r & 15; transpose_item(P.in[I_WGATE], 1024, kb * 64, nb * 32, (bf16_t*)(ws + W_WTGATE), 1024, nb * 32, P.in[I_GPLE], scr, lane); continue; }
            r -= I_GATE;
            { const int nb = r >> 2, kb = r & 3; transpose_item(P.in[I_WPP], 1024, kb * 64, nb * 32, (bf16_t*)(ws + W_WTPP), 256, nb * 32, nullptr, scr, lane); }
        }
        __syncthreads();
    }
    bf16_t* wdt = (bf16_t*)smem;
    float* psum = (float*)(smem + 16 * 1032 * 2);
    float* pdt = psum + 128;
    {
        float wv[32];
#pragma unroll
        for (int i = 0; i < 32; ++i) { const int idx = tid + i * 512, k = idx >> 4, e = idx & 15; wv[i] = P.in[I_WIN][(long)k * 4624 + 2560 + e] * P.in[I_GIN][k]; }
#pragma unroll
        for (int i = 0; i < 32; ++i) { const int idx = tid + i * 512, k = idx >> 4, e = idx & 15; wdt[e * 1032 + k] = (bf16_t)(pk2(wv[i], 0.f) & 0xffffu); }
    }
    __syncthreads();
    {
        const int fr = lane & 15, fq = lane >> 4;
        bf16x8 wf[4];
#pragma unroll
        for (int j = 0; j < 4; ++j) wf[j] = *(const bf16x8*)(wdt + fr * 1032 + (wave * 4 + j) * 32 + fq * 8);
        bf16_t* xb = (bf16_t*)(ws + W_NB);
        float* dtr = (float*)(ws + W_DTR);
        float* rstdp = (float*)(ws + W_RSTD);
        for (int task = bid; task < NTOK / 16; task += G) {
            const int row = task * 16 + fr;
            const float* xr = (row < NPROMPT ? P.in[I_XP] + (long)row * 1024 : P.in[I_XS] + (long)(row - NPROMPT) * 1024) + wave * 128 + fq * 8;
            f32x4 xa[4], xc[4];
#pragma unroll
            for (int j = 0; j < 4; ++j) { xa[j] = *(const f32x4*)(xr + j * 32); xc[j] = *(const f32x4*)(xr + j * 32 + 4); }
            f32x4 acc = {0.f, 0.f, 0.f, 0.f}; float ss = 0.f;
#pragma unroll
            for (int j = 0; j < 4; ++j) {
                ss += xa[j][0] * xa[j][0] + xa[j][1] * xa[j][1] + xa[j][2] * xa[j][2] + xa[j][3] * xa[j][3] + xc[j][0] * xc[j][0] + xc[j][1] * xc[j][1] + xc[j][2] * xc[j][2] + xc[j][3] * xc[j][3];
                u32x4 q; q.x = pk2(xa[j][0], xa[j][1]); q.y = pk2(xa[j][2], xa[j][3]); q.z = pk2(xc[j][0], xc[j][1]); q.w = pk2(xc[j][2], xc[j][3]);
                *(u32x4*)(xb + (long)row * 1024 + wave * 128 + j * 32 + fq * 8) = q;
                acc = mfma16(wf[j], __builtin_bit_cast(bf16x8, q), acc);
            }
            ss += __shfl_xor(ss, 16); ss += __shfl_xor(ss, 32);
            if (fq == 0) psum[wave * 16 + fr] = ss;
            *(f32x4*)(pdt + wave * 256 + fr * 16 + fq * 4) = acc;
            __syncthreads();
            if (tid < 256) {
                const int t = tid >> 4, e = tid & 15;
                float tot = 0.f, d = 0.f;
#pragma unroll
                for (int w8 = 0; w8 < 8; ++w8) { tot += psum[w8 * 16 + t]; d += pdt[w8 * 256 + t * 16 + e]; }
                const float rstd = rsqrtf(tot * (1.f / 1024.f) + EPS);
                dtr[(long)(task * 16 + t) * 16 + e] = d * rstd;
                if (e == 0) rstdp[task * 16 + t] = rstd;
            }
            __syncthreads();
        }
    }
    bf16_t* pb = (bf16_t*)(ws + W_PB);
    for (int idx = bid * 512 + tid; idx < NTOK * 64; idx += G * 512) {
        const int row = idx >> 6, c4 = (idx & 63) * 4;
        const float* src = row < NPROMPT ? P.in[I_PP] + (long)row * 256 : P.in[I_PS] + (long)(row - NPROMPT) * 256;
        const f32x4 v = *(const f32x4*)(src + c4);
        u32x2 o; o.x = pk2(v[0], v[1]); o.y = pk2(v[2], v[3]);
        *(u32x2*)(pb + (long)row * 256 + c4) = o;
    }
    float* rss = (float*)(ws + W_RSS1);
    for (int idx = bid * 512 + tid; idx < 2 * NTOK; idx += G * 512) rss[idx] = 0.f;
    __syncthreads();
}

DEV void conv_load7(const bf16_t* __restrict__ pcol, long row0, int t0, u32x4 (&raw)[7]) {
#pragma unroll
    for (int i = 0; i < 7; ++i) {
        const int t = t0 - 3 + i;
        raw[i] = (u32x4){0u, 0u, 0u, 0u};
        if (t >= 0) raw[i] = *(const u32x4*)(pcol + (row0 - 3 + i) * PLD);
    }
}
DEV void conv_compute(const u32x4 (&rawp)[7], const float* __restrict__ cw, const float* __restrict__ cb, float (&o)[4][8]) {
    float raw[7][8];
#pragma unroll
    for (int i = 0; i < 7; ++i) {
        const u32x4 u = rawp[i];
        raw[i][0] = bflo(u.x); raw[i][1] = bfhi(u.x); raw[i][2] = bflo(u.y); raw[i][3] = bfhi(u.y);
        raw[i][4] = bflo(u.z); raw[i][5] = bfhi(u.z); raw[i][6] = bflo(u.w); raw[i][7] = bfhi(u.w);
    }
    float w[4][8], bias[8];
#pragma unroll
    for (int k = 0; k < 4; ++k) {
        const f32x4 a = *(const f32x4*)(cw + k * 1536), b = *(const f32x4*)(cw + k * 1536 + 4);
        w[k][0] = a[0]; w[k][1] = a[1]; w[k][2] = a[2]; w[k][3] = a[3]; w[k][4] = b[0]; w[k][5] = b[1]; w[k][6] = b[2]; w[k][7] = b[3];
    }
    { const f32x4 a = *(const f32x4*)(cb), b = *(const f32x4*)(cb + 4);
      bias[0] = a[0]; bias[1] = a[1]; bias[2] = a[2]; bias[3] = a[3]; bias[4] = b[0]; bias[5] = b[1]; bias[6] = b[2]; bias[7] = b[3]; }
#pragma unroll
    for (int j = 0; j < 4; ++j)
#pragma unroll
        for (int c = 0; c < 8; ++c) {
            float a = bias[c];
#pragma unroll
            for (int k = 0; k < 4; ++k) a += w[k][c] * raw[j + k][c];
            o[j][c] = siluf(a);
        }
}
DEV void conv4x8(const bf16_t* __restrict__ pcol, long row0, int t0, const float* __restrict__ hist, const float* __restrict__ cw, const float* __restrict__ cb, float (&o)[4][8]) {
    float raw[7][8];
#pragma unroll
    for (int i = 0; i < 7; ++i) {
        const int t = t0 - 3 + i;
        if (t >= 0) {
            const u32x4 u = *(const u32x4*)(pcol + (row0 - 3 + i) * PLD);
            raw[i][0] = bflo(u.x); raw[i][1] = bfhi(u.x); raw[i][2] = bflo(u.y); raw[i][3] = bfhi(u.y);
            raw[i][4] = bflo(u.z); raw[i][5] = bfhi(u.z); raw[i][6] = bflo(u.w); raw[i][7] = bfhi(u.w);
        } else if (hist) {
            const f32x4 a = *(const f32x4*)(hist + (long)(t + 3) * 1536), b = *(const f32x4*)(hist + (long)(t + 3) * 1536 + 4);
            raw[i][0] = a[0]; raw[i][1] = a[1]; raw[i][2] = a[2]; raw[i][3] = a[3]; raw[i][4] = b[0]; raw[i][5] = b[1]; raw[i][6] = b[2]; raw[i][7] = b[3];
        } else {
#pragma unroll
            for (int c = 0; c < 8; ++c) raw[i][c] = 0.f;
        }
    }
    float w[4][8], bias[8];
#pragma unroll
    for (int k = 0; k < 4; ++k) {
        const f32x4 a = *(const f32x4*)(cw + k * 1536), b = *(const f32x4*)(cw + k * 1536 + 4);
        w[k][0] = a[0]; w[k][1] = a[1]; w[k][2] = a[2]; w[k][3] = a[3]; w[k][4] = b[0]; w[k][5] = b[1]; w[k][6] = b[2]; w[k][7] = b[3];
    }
    { const f32x4 a = *(const f32x4*)(cb), b = *(const f32x4*)(cb + 4);
      bias[0] = a[0]; bias[1] = a[1]; bias[2] = a[2]; bias[3] = a[3]; bias[4] = b[0]; bias[5] = b[1]; bias[6] = b[2]; bias[7] = b[3]; }
#pragma unroll
    for (int j = 0; j < 4; ++j)
#pragma unroll
        for (int c = 0; c < 8; ++c) {
            float a = bias[c];
#pragma unroll
            for (int k = 0; k < 4; ++k) a += w[k][c] * raw[j + k][c];
            o[j][c] = siluf(a);
        }
}

constexpr int PIT = 136;
constexpr int R1_OFF = 0, R2_OFF = 128 * PIT * 2, R3_OFF = 2 * 128 * PIT * 2, R4_OFF = 3 * 128 * PIT * 2;

DEV void ssd_s1_item(const Params& P, int item) {
    const int tid = tid_fresh(), lane = tid & 63, w = tid >> 6, fr = lane & 15, fq = lane >> 4;
    const int b = item >> 5, c = (item >> 1) & 15, g = item & 1;
    char* ws = P.ws;
    const bf16_t* proj = (const bf16_t*)(ws + W_PROJ);
    const long rowc = (long)b * 2048 + c * 128;
    bf16_t* R1 = (bf16_t*)(smem + R1_OFF); bf16_t* R2 = (bf16_t*)(smem + R2_OFF); bf16_t* R3 = (bf16_t*)(smem + R3_OFF);
    float* acs = (float*)(smem + R4_OFF);
    float* dtv = acs + 1024;
    {
        const int h = g * 8 + w;
        const float bias = P.in[I_DTB][h], A = -__expf(P.in[I_ALOG][h]);
        const float* dtr = (const float*)(ws + W_DTR);
        float x0 = dtr[(rowc + 2 * lane) * 16 + h] + bias, x1 = dtr[(rowc + 2 * lane + 1) * 16 + h] + bias;
        float d0 = x0 > 20.f ? x0 : log1pf(__expf(x0)), d1 = x1 > 20.f ? x1 : log1pf(__expf(x1));
        float a0 = d0 * A, a1 = a0 + d1 * A;
        float run = a1;
#pragma unroll
        for (int o = 1; o < 64; o <<= 1) { float t = __shfl_up(run, o); if (lane >= o) run += t; }
        const float excl = run - a1;
        a0 += excl; a1 += excl;
        acs[w * 128 + 2 * lane] = a0; acs[w * 128 + 2 * lane + 1] = a1;
        dtv[w * 128 + 2 * lane] = d0; dtv[w * 128 + 2 * lane + 1] = d1;
        float* acsg = (float*)(ws + W_ACS) + (((long)b * 16 + c) * 16 + h) * 128;
        acsg[2 * lane] = a0; acsg[2 * lane + 1] = a1;
        if (lane == 63) ((float*)(ws + W_CDEC))[(b * 16 + c) * 16 + h] = __expf(a1);
    }
    {
        const int nblk = tid & 15, lq = tid >> 4, l0 = lq * 4;
#pragma unroll
        for (int j = 0; j < 2; ++j) {
            const int ch0 = 1024 + j * 256 + g * 128 + nblk * 8;
            float o[4][8];
            conv4x8(proj + C_XBC + ch0, rowc + l0, c * 128 + l0, nullptr, P.in[I_CONVW] + ch0, P.in[I_CONVB] + ch0, o);
            bf16_t* dst = j == 0 ? R2 : R1;
#pragma unroll
            for (int r = 0; r < 4; ++r) {
                u32x4 q; q.x = pk2(o[r][0], o[r][1]); q.y = pk2(o[r][2], o[r][3]); q.z = pk2(o[r][4], o[r][5]); q.w = pk2(o[r][6], o[r][7]);
                *(u32x4*)(dst + (l0 + r) * PIT + nblk * 8) = q;
            }
            if (j == 0) {
#pragma unroll
                for (int i = 0; i < 8; ++i) {
                    u32x2 q; q.x = pk2(o[0][i], o[1][i]); q.y = pk2(o[2][i], o[3][i]);
                    *(u32x2*)(R3 + (nblk * 8 + i) * PIT + l0) = q;
                }
            }
        }
    }
    __syncthreads();
    const int wr = w >> 1, wc = w & 1;
    f32x4 cbm[2][4];
#pragma unroll
    for (int m = 0; m < 2; ++m)
#pragma unroll
        for (int n = 0; n < 4; ++n) cbm[m][n] = (f32x4){0.f, 0.f, 0.f, 0.f};
#pragma unroll
    for (int ks = 0; ks < 4; ++ks) {
        bf16x8 af[2], bfm[4];
#pragma unroll
        for (int m = 0; m < 2; ++m) af[m] = *(const bf16x8*)(R1 + (wr * 32 + m * 16 + fr) * PIT + ks * 32 + fq * 8);
#pragma unroll
        for (int n = 0; n < 4; ++n) bfm[n] = *(const bf16x8*)(R2 + (wc * 64 + n * 16 + fr) * PIT + ks * 32 + fq * 8);
#pragma unroll
        for (int m = 0; m < 2; ++m)
#pragma unroll
            for (int n = 0; n < 4; ++n) cbm[m][n] = mfma16(bfm[n], af[m], cbm[m][n]);
    }
    __syncthreads();
    bf16_t* XT = R2; bf16_t* XW = R2 + 64 * PIT;
    bf16_t* ydg = (bf16_t*)(ws + W_NB);
    float* states = P.out;
    const int wp = w >> 2, wn = w & 3;
    u32x4 rawn[7];
    if (tid < 256) conv_load7(proj + C_XBC + (g * 8) * 64 + (tid & 7) * 8, rowc + (tid >> 3) * 4, c * 128 + (tid >> 3) * 4, rawn);
    for (int e = 0; e < 8; ++e) {
        const int h = g * 8 + e;
        const float dskip = P.in[I_SSDD][h];
        if (tid < 256) {
            const int pblk = tid & 7, lq = tid >> 3, l0 = lq * 4, ch0 = h * 64 + pblk * 8;
            float o[4][8];
            conv_compute(rawn, P.in[I_CONVW] + ch0, P.in[I_CONVB] + ch0, o);
            if (e < 7) conv_load7(proj + C_XBC + ch0 + 64, rowc + l0, c * 128 + l0, rawn);
            const float alast = acs[e * 128 + 127];
            float we[4];
#pragma unroll
            for (int r = 0; r < 4; ++r) we[r] = __expf(alast - acs[e * 128 + l0 + r]) * dtv[e * 128 + l0 + r];
#pragma unroll
            for (int i = 0; i < 8; ++i) {
                u32x2 q; q.x = pk2(o[0][i], o[1][i]); q.y = pk2(o[2][i], o[3][i]);
                *(u32x2*)(XT + (pblk * 8 + i) * PIT + l0) = q;
                u32x2 q2; q2.x = pk2(o[0][i] * we[0], o[1][i] * we[1]); q2.y = pk2(o[2][i] * we[2], o[3][i] * we[3]);
                *(u32x2*)(XW + (pblk * 8 + i) * PIT + l0) = q2;
            }
        }
#pragma unroll
        for (int m = 0; m < 2; ++m) {
            const int l = wr * 32 + m * 16 + fr; const float al = acs[e * 128 + l];
#pragma unroll
            for (int n = 0; n < 4; ++n) {
                const int s0 = wc * 64 + n * 16 + fq * 4;
                const f32x4 as = *(const f32x4*)(acs + e * 128 + s0), ds = *(const f32x4*)(dtv + e * 128 + s0);
                float v[4];
#pragma unroll
                for (int r = 0; r < 4; ++r) { const float t = cbm[m][n][r] * __expf(al - as[r]) * ds[r]; v[r] = (s0 + r <= l) ? t : 0.f; }
                u32x2 q; q.x = pk2(v[0], v[1]); q.y = pk2(v[2], v[3]);
                *(u32x2*)(R1 + l * PIT + s0) = q;
            }
        }
        __syncthreads();
        {
            f32x4 yd[2][2];
#pragma unroll
            for (int m = 0; m < 2; ++m)
#pragma unroll
                for (int n = 0; n < 2; ++n) yd[m][n] = (f32x4){0.f, 0.f, 0.f, 0.f};
            for (int ks = 0; ks <= wr; ++ks) {
                bf16x8 af[2], bfm[2];
#pragma unroll
                for (int m = 0; m < 2; ++m) af[m] = *(const bf16x8*)(R1 + (wr * 32 + m * 16 + fr) * PIT + ks * 32 + fq * 8);
#pragma unroll
                for (int n = 0; n < 2; ++n) bfm[n] = *(const bf16x8*)(XT + (wc * 32 + n * 16 + fr) * PIT + ks * 32 + fq * 8);
#pragma unroll
                for (int m = 0; m < 2; ++m)
#pragma unroll
                    for (int n = 0; n < 2; ++n) yd[m][n] = mfma16(bfm[n], af[m], yd[m][n]);
            }
#pragma unroll
            for (int m = 0; m < 2; ++m)
#pragma unroll
                for (int n = 0; n < 2; ++n) {
                    const int l = wr * 32 + m * 16 + fr, p0 = wc * 32 + n * 16 + fq * 4;
                    const float x0 = __uint_as_float(((unsigned)XT[(p0 + 0) * PIT + l]) << 16), x1 = __uint_as_float(((unsigned)XT[(p0 + 1) * PIT + l]) << 16);
                    const float x2 = __uint_as_float(((unsigned)XT[(p0 + 2) * PIT + l]) << 16), x3 = __uint_as_float(((unsigned)XT[(p0 + 3) * PIT + l]) << 16);
                    u32x2 q; q.x = pk2(yd[m][n][0] + dskip * x0, yd[m][n][1] + dskip * x1); q.y = pk2(yd[m][n][2] + dskip * x2, yd[m][n][3] + dskip * x3);
                    *(u32x2*)(ydg + (rowc + l) * 1024 + h * 64 + p0) = q;
                }
        }
        {
            f32x4 st[2][2];
#pragma unroll
            for (int m = 0; m < 2; ++m)
#pragma unroll
                for (int n = 0; n < 2; ++n) st[m][n] = (f32x4){0.f, 0.f, 0.f, 0.f};
#pragma unroll
            for (int ks = 0; ks < 4; ++ks) {
                bf16x8 af[2], bfm[2];
#pragma unroll
                for (int m = 0; m < 2; ++m) af[m] = *(const bf16x8*)(XW + (wp * 32 + m * 16 + fr) * PIT + ks * 32 + fq * 8);
#pragma unroll
                for (int n = 0; n < 2; ++n) bfm[n] = *(const bf16x8*)(R3 + (wn * 32 + n * 16 + fr) * PIT + ks * 32 + fq * 8);
#pragma unroll
                for (int m = 0; m < 2; ++m)
#pragma unroll
                    for (int n = 0; n < 2; ++n) st[m][n] = mfma16(bfm[n], af[m], st[m][n]);
            }
            float* sp = states + (((long)b * 16 + c) * 16 + h) * 8192;
#pragma unroll
            for (int m = 0; m < 2; ++m)
#pragma unroll
                for (int n = 0; n < 2; ++n) {
                    const int p = wp * 32 + m * 16 + fr, n0 = wn * 32 + n * 16 + fq * 4;
                    *(f32x4*)(sp + p * 128 + n0) = st[m][n];
                }
        }
        __syncthreads();
    }
}

DEV void ssd_s2(const Params& P) {
    float* states = P.out;
    const float* cdec = (const float*)(P.ws + W_CDEC);
    for (int idx = blockIdx.x * 512 + threadIdx.x; idx < 262144; idx += gridDim.x * 512) {
        const int bh = idx >> 11, q = idx & 2047, b = bh >> 4, h = bh & 15;
        f32x4 H = (f32x4){0.f, 0.f, 0.f, 0.f};
#pragma unroll
        for (int c = 0; c < 16; ++c) {
            f32x4* ptr = (f32x4*)(states + (((long)b * 16 + c) * 16 + h) * 8192) + q;
            const f32x4 s = *ptr; *ptr = H;
            const float d = cdec[(b * 16 + c) * 16 + h];
            H = H * d + s;
        }
        *((f32x4*)(P.out + O_SSDP + (long)bh * 8192) + q) = H;
    }
}

DEV void ssd_s3_item(const Params& P, int item) {
    const int tid = tid_fresh(), lane = tid & 63, w = tid >> 6, fr = lane & 15, fq = lane >> 4;
    const int b = item >> 5, c = (item >> 1) & 15, g = item & 1;
    char* ws = P.ws;
    bf16_t* proj = (bf16_t*)(ws + W_PROJ);
    const long rowc = (long)b * 2048 + c * 128;
    bf16_t* R1 = (bf16_t*)(smem + R1_OFF); bf16_t* HB = (bf16_t*)(smem + R2_OFF);
    float* ssq = (float*)(smem + R4_OFF);
    const bf16_t* ydg = (const bf16_t*)(ws + W_NB);
    const float* states = P.out;
    const float* acsg = (const float*)(ws + W_ACS);
    const int hp = tid >> 3, hn0 = (tid & 7) * 16;
    f32x4 hreg[4];
    {
        const float* sp = states + (((long)b * 16 + c) * 16 + g * 8) * 8192 + hp * 128 + hn0;
#pragma unroll
        for (int i = 0; i < 4; ++i) hreg[i] = *(const f32x4*)(sp + i * 4);
    }
    __syncthreads();
    {
        const int nblk = tid & 15, lq = tid >> 4, l0 = lq * 4;
        const int ch0 = 1280 + g * 128 + nblk * 8;
        float o[4][8];
        conv4x8(proj + C_XBC + ch0, rowc + l0, c * 128 + l0, nullptr, P.in[I_CONVW] + ch0, P.in[I_CONVB] + ch0, o);
#pragma unroll
        for (int r = 0; r < 4; ++r) {
            u32x4 q; q.x = pk2(o[r][0], o[r][1]); q.y = pk2(o[r][2], o[r][3]); q.z = pk2(o[r][4], o[r][5]); q.w = pk2(o[r][6], o[r][7]);
            *(u32x4*)(R1 + (l0 + r) * PIT + nblk * 8) = q;
        }
    }
    const int wr = w >> 1, wc = w & 1;
    unsigned ypk[8][2][2][2];
    float ssl[2] = {0.f, 0.f};
#pragma unroll
    for (int e = 0; e < 8; ++e) {
        const int h = g * 8 + e;
        bf16_t* hb = HB + (e & 1) * 64 * PIT;
        {
            u32x4 q0, q1;
            q0.x = pk2(hreg[0][0], hreg[0][1]); q0.y = pk2(hreg[0][2], hreg[0][3]); q0.z = pk2(hreg[1][0], hreg[1][1]); q0.w = pk2(hreg[1][2], hreg[1][3]);
            q1.x = pk2(hreg[2][0], hreg[2][1]); q1.y = pk2(hreg[2][2], hreg[2][3]); q1.z = pk2(hreg[3][0], hreg[3][1]); q1.w = pk2(hreg[3][2], hreg[3][3]);
            *(u32x4*)(hb + hp * PIT + hn0) = q0; *(u32x4*)(hb + hp * PIT + hn0 + 8) = q1;
        }
        if (e < 7) {
            const float* sp = states + (((long)b * 16 + c) * 16 + h + 1) * 8192 + hp * 128 + hn0;
#pragma unroll
            for (int i = 0; i < 4; ++i) hreg[i] = *(const f32x4*)(sp + i * 4);
        }
        u32x2 yq[2][2], zz[2][2]; float ea[2];
#pragma unroll
        for (int m = 0; m < 2; ++m) {
            const int l = wr * 32 + m * 16 + fr;
            ea[m] = acsg[(((long)b * 16 + c) * 16 + h) * 128 + l];
#pragma unroll
            for (int n = 0; n < 2; ++n) {
                const int p0 = wc * 32 + n * 16 + fq * 4;
                yq[m][n] = *(const u32x2*)(ydg + (rowc + l) * 1024 + h * 64 + p0);
                zz[m][n] = *(const u32x2*)(proj + (rowc + l) * PLD + C_ZA + h * 64 + p0);
            }
        }
        __syncthreads();
        f32x4 yo[2][2];
#pragma unroll
        for (int m = 0; m < 2; ++m)
#pragma unroll
            for (int n = 0; n < 2; ++n) yo[m][n] = (f32x4){0.f, 0.f, 0.f, 0.f};
#pragma unroll
        for (int ks = 0; ks < 4; ++ks) {
            bf16x8 af[2], bfm[2];
#pragma unroll
            for (int m = 0; m < 2; ++m) af[m] = *(const bf16x8*)(R1 + (wr * 32 + m * 16 + fr) * PIT + ks * 32 + fq * 8);
#pragma unroll
            for (int n = 0; n < 2; ++n) bfm[n] = *(const bf16x8*)(hb + (wc * 32 + n * 16 + fr) * PIT + ks * 32 + fq * 8);
#pragma unroll
            for (int m = 0; m < 2; ++m)
#pragma unroll
                for (int n = 0; n < 2; ++n) yo[m][n] = mfma16(bfm[n], af[m], yo[m][n]);
        }
#pragma unroll
        for (int m = 0; m < 2; ++m) {
            const float eam = __expf(ea[m]);
#pragma unroll
            for (int n = 0; n < 2; ++n) {
                const float v0 = (bflo(yq[m][n].x) + eam * yo[m][n][0]) * siluf(bflo(zz[m][n].x)), v1 = (bfhi(yq[m][n].x) + eam * yo[m][n][1]) * siluf(bfhi(zz[m][n].x));
                const float v2 = (bflo(yq[m][n].y) + eam * yo[m][n][2]) * siluf(bflo(zz[m][n].y)), v3 = (bfhi(yq[m][n].y) + eam * yo[m][n][3]) * siluf(bfhi(zz[m][n].y));
                ssl[m] += v0 * v0 + v1 * v1 + v2 * v2 + v3 * v3;
                ypk[e][m][n][0] = pk2(v0, v1); ypk[e][m][n][1] = pk2(v2, v3);
            }
        }
    }
#pragma unroll
    for (int m = 0; m < 2; ++m) {
        float ss = ssl[m];
        ss += __shfl_xor(ss, 16); ss += __shfl_xor(ss, 32);
        if (fq == 0) ssq[wc * 128 + wr * 32 + m * 16 + fr] = ss;
    }
    __syncthreads();
#pragma unroll
    for (int m = 0; m < 2; ++m) {
        const int l = wr * 32 + m * 16 + fr;
        const float rstd = rsqrtf((ssq[l] + ssq[128 + l]) * (1.f / 512.f) + EPS);
#pragma unroll
        for (int e = 0; e < 8; ++e)
#pragma unroll
            for (int n = 0; n < 2; ++n) {
                const int h = g * 8 + e, p0 = wc * 32 + n * 16 + fq * 4;
                const f32x4 gg = *(const f32x4*)(P.in[I_SSDG] + h * 64 + p0);
                const unsigned a0 = ypk[e][m][n][0], a1 = ypk[e][m][n][1];
                u32x2 o; o.x = pk2(bflo(a0) * rstd * gg[0], bfhi(a0) * rstd * gg[1]); o.y = pk2(bflo(a1) * rstd * gg[2], bfhi(a1) * rstd * gg[3]);
                *(u32x2*)(proj + (rowc + l) * PLD + C_ZA + h * 64 + p0) = o;
            }
    }
}

DEV void ssd_sample_item(const Params& P, int item) {
    const int tid = tid_fresh();
    const int b = item >> 1, g = item & 1;
    char* ws = P.ws;
    bf16_t* proj = (bf16_t*)(ws + W_PROJ);
    const long row0 = NPROMPT + (long)b * 4;
    float* xs = (float*)smem;
    float* Bs = xs + 2048;
    float* Cs = Bs + 512;
    float* dts = Cs + 512;
    float* das = dts + 32;
    float* vs = das + 32;
    float* red = vs + 2048;
    for (int u = tid; u < 768; u += 512) {
        int ch; float* dst; int dcol;
        if (u < 512) { ch = g * 512 + u; dst = xs; dcol = u; }
        else if (u < 640) { ch = 1024 + g * 128 + (u - 512); dst = Bs; dcol = u - 512; }
        else { ch = 1280 + g * 128 + (u - 640); dst = Cs; dcol = u - 640; }
        const int pitch = u < 512 ? 512 : 128;
        float full[7];
#pragma unroll
        for (int i = 0; i < 3; ++i) full[i] = P.in[I_CONV][((long)b * 3 + i) * 1536 + ch];
#pragma unroll
        for (int i = 0; i < 4; ++i) full[3 + i] = __uint_as_float(((unsigned)proj[(row0 + i) * PLD + C_XBC + ch]) << 16);
        const float w0 = P.in[I_CONVW][ch], w1 = P.in[I_CONVW][1536 + ch], w2 = P.in[I_CONVW][3072 + ch], w3 = P.in[I_CONVW][4608 + ch], bias = P.in[I_CONVB][ch];
#pragma unroll
        for (int t = 0; t < 4; ++t) dst[t * pitch + dcol] = siluf(bias + w0 * full[t] + w1 * full[t + 1] + w2 * full[t + 2] + w3 * full[t + 3]);
    }
    if (tid < 32) {
        const int t = tid >> 3, e = tid & 7, h = g * 8 + e;
        const float x = ((const float*)(ws + W_DTR))[(row0 + t) * 16 + h] + P.in[I_DTB][h];
        const float d = x > 20.f ? x : log1pf(__expf(x));
        dts[tid] = d; das[tid] = __expf(-d * __expf(P.in[I_ALOG][h]));
    }
    __syncthreads();
    const int p = tid >> 3, nb = tid & 7, n0 = nb * 16;
    f32x4 hn[4];
    {
        const float* sp0 = P.in[I_SSD] + (((long)b * 16 + g * 8) * 64 + p) * 128 + n0;
#pragma unroll
        for (int i = 0; i < 4; ++i) hn[i] = *(const f32x4*)(sp0 + i * 4);
    }
    for (int e = 0; e < 8; ++e) {
        const int h = g * 8 + e;
        float* op = P.out + O_SSDS + (((long)b * 16 + h) * 64 + p) * 128 + n0;
        f32x4 hv[4];
#pragma unroll
        for (int i = 0; i < 4; ++i) hv[i] = hn[i];
        if (e < 7) {
            const float* sp = P.in[I_SSD] + (((long)b * 16 + h + 1) * 64 + p) * 128 + n0;
#pragma unroll
            for (int i = 0; i < 4; ++i) hn[i] = *(const f32x4*)(sp + i * 4);
        }
        const float dsk = P.in[I_SSDD][h];
#pragma unroll
        for (int t = 0; t < 4; ++t) {
            const float dec = das[t * 8 + e], xv = xs[t * 512 + e * 64 + p], coef = dts[t * 8 + e] * xv;
            float part = 0.f;
#pragma unroll
            for (int i = 0; i < 4; ++i) {
                const f32x4 bv = *(const f32x4*)(Bs + t * 128 + n0 + i * 4), cv = *(const f32x4*)(Cs + t * 128 + n0 + i * 4);
                hv[i] = hv[i] * dec + bv * coef;
                part += hv[i][0] * cv[0] + hv[i][1] * cv[1] + hv[i][2] * cv[2] + hv[i][3] * cv[3];
            }
            part += __shfl_xor(part, 1); part += __shfl_xor(part, 2); part += __shfl_xor(part, 4);
            if (nb == 0) {
                const float z = __uint_as_float(((unsigned)proj[(row0 + t) * PLD + C_ZA + h * 64 + p]) << 16);
                vs[t * 512 + e * 64 + p] = (part + dsk * xv) * siluf(z);
            }
        }
#pragma unroll
        for (int i = 0; i < 4; ++i) *(f32x4*)(op + i * 4) = hv[i];
    }
    __syncthreads();
    {
        const int t = tid >> 7, cidx = tid & 127;
        float v[4]; float ss = 0.f;
#pragma unroll
        for (int i = 0; i < 4; ++i) { v[i] = vs[t * 512 + cidx * 4 + i]; ss += v[i] * v[i]; }
        ss = wave_sum(ss);
        if ((tid & 63) == 0) red[tid >> 6] = ss;
        __syncthreads();
        const float tot = red[t * 2] + red[t * 2 + 1];
        const float rstd = rsqrtf(tot * (1.f / 512.f) + EPS);
        const f32x4 gg = *(const f32x4*)(P.in[I_SSDG] + g * 512 + cidx * 4);
        u32x2 o; o.x = pk2(v[0] * rstd * gg[0], v[1] * rstd * gg[1]); o.y = pk2(v[2] * rstd * gg[2], v[3] * rstd * gg[3]);
        *(u32x2*)(proj + (row0 + t) * PLD + C_ZA + g * 512 + cidx * 4) = o;
    }
    __syncthreads();
}

constexpr int S5P = 20;
template <bool SAMPLE>
DEV void s5_item(const Params& P, int g, long rowbase, int bidx) {
    const int tid = tid_fresh(), lane = tid & 63, w = tid >> 6, fr = lane & 15, fq = lane >> 4;
    constexpr int TPW = SAMPLE ? 32 : 256;
    bf16_t* proj = (bf16_t*)(P.ws + W_PROJ);
    float* buf = (float*)smem + w * (128 * S5P);
    float* carry = (float*)smem + 8 * 128 * S5P;
    float* fs = carry + 1024 + w * 128;
    float ar, ai;
    {
        const float lr = P.in[I_LRE][g * 64 + lane], li = P.in[I_LIM][g * 64 + lane], delta = expf(P.in[I_LDT][g]);
        const float mag = expf(lr * delta), ang = li * delta;
        ar = mag * cosf(ang); ai = mag * sinf(ang);
        const float qre = ar - 1.f, den = lr * lr + li * li;
        fs[lane] = (qre * lr + ai * li) / den; fs[64 + lane] = (ai * lr - qre * li) / den;
    }
    lds_fence();
    bf16x8 bbf[8];
#pragma unroll
    for (int j = 0; j < 8; ++j) {
        bf16x8 z = {0, 0, 0, 0, 0, 0, 0, 0};
        if (fq < 2) {
            const int p = (j & 3) * 16 + fr;
            const float f_r = fs[p], f_i = fs[64 + p];
            const float* br = P.in[I_BRE] + ((long)(g * 64 + p)) * 16 + fq * 8;
            const float* bi = P.in[I_BIM] + ((long)(g * 64 + p)) * 16 + fq * 8;
            const f32x4 r0 = *(const f32x4*)br, r1 = *(const f32x4*)(br + 4), i0 = *(const f32x4*)bi, i1 = *(const f32x4*)(bi + 4);
            f32x4 o0, o1;
            if (j < 4) { o0 = r0 * f_r - i0 * f_i; o1 = r1 * f_r - i1 * f_i; }
            else { o0 = i0 * f_r + r0 * f_i; o1 = i1 * f_r + r1 * f_i; }
            u32x4 q; q.x = pk2(o0[0], o0[1]); q.y = pk2(o0[2], o0[3]); q.z = pk2(o1[0], o1[1]); q.w = pk2(o1[2], o1[3]);
            z = __builtin_bit_cast(bf16x8, q);
        }
        bbf[j] = z;
    }
    bf16x8 ccf[4];
#pragma unroll
    for (int ks = 0; ks < 4; ++ks) {
        const float* src = (ks < 2 ? P.in[I_CRE] : P.in[I_CIM]) + ((long)(g * 16 + fr)) * 64 + (ks & 1) * 32 + fq * 8;
        f32x4 c0 = *(const f32x4*)src, c1 = *(const f32x4*)(src + 4);
        if (ks >= 2) { c0 = -c0; c1 = -c1; }
        u32x4 q; q.x = pk2(c0[0], c0[1]); q.y = pk2(c0[2], c0[3]); q.z = pk2(c1[0], c1[1]); q.w = pk2(c1[2], c1[3]);
        ccf[ks] = __builtin_bit_cast(bf16x8, q);
    }
    const f32x4 dsk = *(const f32x4*)(P.in[I_S5D] + g * 16 + fq * 4);
    const long roww = rowbase + (long)w * TPW;
    float xr = 0.f, xi = 0.f;
    constexpr int NPASS = SAMPLE ? 1 : 2;
#pragma unroll 1
    for (int pass = 0; pass < NPASS; ++pass) {
        const bool last = (pass == NPASS - 1);
        if (!SAMPLE && pass == 1) {
            carry[w * 128 + lane] = xr; carry[w * 128 + 64 + lane] = xi;
            __syncthreads();
            float pr = ar, pi = ai;
#pragma unroll
            for (int q = 0; q < 8; ++q) { const float nr = pr * pr - pi * pi, ni = 2.f * pr * pi; pr = nr; pi = ni; }
            float sr = 0.f, si = 0.f;
            for (int ww = 0; ww < w; ++ww) {
                const float cr = carry[ww * 128 + lane], ci = carry[ww * 128 + 64 + lane];
                const float nr = pr * sr - pi * si + cr, ni = pr * si + pi * sr + ci; sr = nr; si = ni;
            }
            xr = sr; xi = si;
        }
        if (!SAMPLE && pass == 0 && w == 7) continue;
        bf16x8 ufn = {0, 0, 0, 0, 0, 0, 0, 0};
        if (fq < 2) ufn = *(const bf16x8*)(proj + (roww + fr) * PLD + C_UB + g * 16 + fq * 8);
#pragma unroll 1
        for (int sb = 0; sb < TPW / 16; ++sb) {
            const long r = roww + sb * 16;
            const bf16x8 uf = ufn;
            if (fq < 2 && sb + 1 < TPW / 16) ufn = *(const bf16x8*)(proj + (r + 16 + fr) * PLD + C_UB + g * 16 + fq * 8);
            u32x2* up = (u32x2*)(proj + (r + fr) * PLD + C_UB + g * 16 + fq * 4);
            u32x2 uu = {0u, 0u};
            if (last) uu = *up;
            const f32x4 zero = {0.f, 0.f, 0.f, 0.f};
#pragma unroll
            for (int j = 0; j < 8; ++j) {
                const f32x4 d = mfma16(uf, bbf[j], zero);
                *(f32x4*)(buf + (j * 16 + fr) * S5P + fq * 4) = d;
            }
            lds_fence();
#pragma unroll
            for (int q = 0; q < 4; ++q) {
                f32x4 br = *(const f32x4*)(buf + lane * S5P + q * 4), bi = *(const f32x4*)(buf + (64 + lane) * S5P + q * 4);
                if (SAMPLE) {
                    const long seq = (r - NPROMPT) / 4 + q;
                    xr = P.in[I_S5R][(seq * 64 + g) * 64 + lane]; xi = P.in[I_S5I][(seq * 64 + g) * 64 + lane];
                }
#pragma unroll
                for (int i = 0; i < 4; ++i) {
                    const float nr = ar * xr - ai * xi + br[i], ni = ar * xi + ai * xr + bi[i];
                    xr = nr; xi = ni; br[i] = nr; bi[i] = ni;
                }
                if (last) { *(f32x4*)(buf + lane * S5P + q * 4) = br; *(f32x4*)(buf + (64 + lane) * S5P + q * 4) = bi; }
                if (SAMPLE) {
                    const long seq = (r - NPROMPT) / 4 + q;
                    P.out[O_S5RS + (seq * 64 + g) * 64 + lane] = xr; P.out[O_S5IS + (seq * 64 + g) * 64 + lane] = xi;
                }
            }
            if (last) {
                lds_fence();
                f32x4 y = {0.f, 0.f, 0.f, 0.f};
#pragma unroll
                for (int ks = 0; ks < 4; ++ks) {
                    float xv[8];
#pragma unroll
                    for (int i = 0; i < 8; ++i) xv[i] = buf[(ks * 32 + fq * 8 + i) * S5P + fr];
                    u32x4 q; q.x = pk2(xv[0], xv[1]); q.y = pk2(xv[2], xv[3]); q.z = pk2(xv[4], xv[5]); q.w = pk2(xv[6], xv[7]);
                    y = mfma16(ccf[ks], __builtin_bit_cast(bf16x8, q), y);
                }
                const float y0 = geluf(y[0] + dsk[0] * bflo(uu.x)), y1 = geluf(y[1] + dsk[1] * bfhi(uu.x));
                const float y2 = geluf(y[2] + dsk[2] * bflo(uu.y)), y3 = geluf(y[3] + dsk[3] * bfhi(uu.y));
                u32x2 o; o.x = pk2(y0, y1); o.y = pk2(y2, y3);
                *up = o;
            }
            lds_fence();
        }
    }
    if (!SAMPLE && w == 7) {
        P.out[O_S5RP + ((long)bidx * 64 + g) * 64 + lane] = xr; P.out[O_S5IP + ((long)bidx * 64 + g) * 64 + lane] = xi;
    }
    __syncthreads();
}

__global__ void __launch_bounds__(512) hymba_fwd(Params P) {
#ifdef PROBE_K
    unsigned long long tb_[9]; int nb_ = 0;
#define TB() do { tb_[nb_++] = wall_clock64(); } while (0)
    TB();
#else
#define TB() do {} while (0)
#endif
    const int G = gridDim.x, bid = blockIdx.x;
    char* ws = P.ws;
    bf16_t* proj = (bf16_t*)(ws + W_PROJ);
    unsigned* barw = (unsigned*)(ws + W_BAR);
    volatile LAS unsigned* stw = (volatile LAS unsigned*)(smem + 131072);
    if (threadIdx.x < 4) stw[threadIdx.x] = 0u;
    __syncthreads();
    const XcdBarrier xb = xcd_barrier_post(barw, stw);
#ifndef NO_P0
    phase0(P);
#endif
    xcd_barrier(xb); TB();
#ifndef NO_P1
    for (int L = bid; L < 1188; L += G) {
        int pm, pn; tile_of(L, 66, 18, pm, pn);
        gemm_tile((const bf16_t*)(ws + W_NB), 1024, (const bf16_t*)(ws + W_WTIN), 1024, 1024, pm * 256, pn * 256, EpiBf16{proj, PLD, (const float*)(ws + W_RSTD)});
    }
    for (int L = (bid + G - 1188 % G) % G; L < 264; L += G) {
        int pm, pn; tile_of(L, 66, 4, pm, pn);
        gemm_tile((const bf16_t*)(ws + W_PB), 256, (const bf16_t*)(ws + W_WTPP), 256, 256, pm * 256, pn * 256, EpiBf16{(bf16_t*)(ws + W_PP), 1024, nullptr});
    }
#endif
    xcd_barrier(xb); TB();
    for (int idx = bid * 512 + threadIdx.x; idx < (8 + 128) * 3 * 1536; idx += G * 512) {
        const int ch = idx % 1536, sj = idx / 1536, j = sj % 3, sq = sj / 3;
        const long row = sq < 8 ? (long)sq * 2048 + 2045 + j : NPROMPT + (long)(sq - 8) * 4 + 1 + j;
        const float v = __uint_as_float(((unsigned)proj[row * PLD + C_XBC + ch]) << 16);
        if (sq < 8) P.out[O_CONVP + ((long)sq * 3 + j) * 1536 + ch] = v; else P.out[O_CONVS + ((long)(sq - 8) * 3 + j) * 1536 + ch] = v;
    }
#ifdef PROBE2
    unsigned long long tq_[5]; tq_[0] = wall_clock64();
#endif
#ifndef NO_S1
    for (int it = bid; it < 256; it += G) ssd_s1_item(P, it);
#endif
#ifdef PROBE2
    tq_[1] = wall_clock64();
#endif
#ifndef NO_SS
    for (int it = bid; it < 256; it += G) ssd_sample_item(P, it);
#endif
#ifdef PROBE2
    tq_[2] = wall_clock64();
#endif
#ifndef NO_S5P
    for (int it = bid; it < 512; it += G) s5_item<false>(P, it & 63, (long)(it >> 6) * 2048, it >> 6);
#endif
#ifdef PROBE2
    tq_[3] = wall_clock64();
#endif
#ifndef NO_S5S
    for (int it = bid; it < 128; it += G) s5_item<true>(P, it & 63, NPROMPT + (long)(it >> 6) * 256, 0);
#endif
#ifdef PROBE2
    tq_[4] = wall_clock64();
    { const unsigned long long d = tq_[PROBE2 + 1] - tq_[PROBE2], t0 = wall_clock64(); while (wall_clock64() - t0 < d) __builtin_amdgcn_s_sleep(8); }
#endif
    xcd_barrier(xb); TB();
    if (bid & 1) ssd_s2(P);
    {
        const EpiGlu eg{proj, P.in[I_GLUB]};
        for (int L = bid; L < 256; L += G) {
            int pm, pn; tile_of(L, 64, 4, pm, pn);
            gemm_tile(proj + C_UB, PLD, (const bf16_t*)(ws + W_WTGLU), 1024, 1024, pm * 256, pn * 256, eg);
        }
        for (int L = bid; L < 256; L += G)
            gemm_small(proj + C_UB, PLD, (const bf16_t*)(ws + W_WTGLU), 1024, 1024, NPROMPT + (L >> 3) * 16, (L & 7) * 128, eg);
    }
    if (!(bid & 1)) ssd_s2(P);
    xcd_barrier(xb); TB();
#ifndef NO_S3
    for (int it = bid; it < 256; it += G) ssd_s3_item(P, it);
#endif
    xcd_barrier(xb); TB();
#ifndef NO_P5
    {
        const EpiOut eo{P.in[I_XP], P.in[I_XS], P.out, (bf16_t*)(ws + W_NB), (float*)(ws + W_RSS1)};
        for (int L = bid; L < 256; L += G) {
            int pm, pn; tile_of(L, 64, 4, pm, pn);
            gemm_tile(proj, PLD, (const bf16_t*)(ws + W_WTOUT), 2048, 2048, pm * 256, pn * 256, eo);
        }
        for (int L = bid; L < 256; L += G)
            gemm_small(proj, PLD, (const bf16_t*)(ws + W_WTOUT), 2048, 2048, NPROMPT + (L >> 3) * 16, (L & 7) * 128, eo);
    }
#endif
    xcd_barrier(xb); TB();
#ifndef NO_P6
    {
        const EpiPle ep{P.out, (const bf16_t*)(ws + W_PP), (const float*)(ws + W_RSS1), (float*)(ws + W_RSS2)};
        for (int L = bid; L < 256; L += G) {
            int pm, pn; tile_of(L, 64, 4, pm, pn);
            gemm_tile((const bf16_t*)(ws + W_NB), 1024, (const bf16_t*)(ws + W_WTGATE), 1024, 1024, pm * 256, pn * 256, ep);
        }
        for (int L = bid; L < 256; L += G)
            gemm_small((const bf16_t*)(ws + W_NB), 1024, (const bf16_t*)(ws + W_WTGATE), 1024, 1024, NPROMPT + (L >> 3) * 16, (L & 7) * 128, ep);
    }
#endif
    xcd_barrier(xb); TB();
    {
        const float* rss2 = (const float*)(ws + W_RSS2);
        for (int idx = bid * 512 + threadIdx.x; idx < NTOK * 256; idx += G * 512) {
            const int row = idx >> 8, c4 = (idx & 255) * 4;
            const float rstd = rsqrtf(rss2[row] * (1.f / 1024.f) + EPS);
            f32x4* p = (f32x4*)(P.out + (long)row * 1024 + c4);
            const f32x4 gf = *(const f32x4*)(P.in[I_GFIN] + c4);
            *p = *p * rstd * gf;
        }
    }
#ifdef PROBE_K
    { TB(); const unsigned long long d = tb_[PROBE_K + 1] - tb_[PROBE_K], t0 = wall_clock64(); while (wall_clock64() - t0 < d) __builtin_amdgcn_s_sleep(8); }
#endif
}

extern "C" void kernel_launch(void* const* d_in, const int* in_sizes, int n_in, void* d_out, int out_size, void* d_ws, size_t ws_size, hipStream_t stream) {
    static int grid_blocks = 0;
    if (grid_blocks == 0) {
        if (n_in != 31 || out_size != (int)O_END || ws_size < W_END) {
            fprintf(stderr, "kernel_launch: unexpected shapes n_in %d out %d ws %zu (need %zu)\n", n_in, out_size, ws_size, (size_t)W_END);
            grid_blocks = -1; return;
        }
        int dev = 0, cus = 0, per_cu = 0;
        hipGetDevice(&dev);
        hipDeviceGetAttribute(&cus, hipDeviceAttributeMultiprocessorCount, dev);
        hipFuncSetAttribute((const void*)hymba_fwd, hipFuncAttributeMaxDynamicSharedMemorySize, LDS_BYTES);
        hipOccupancyMaxActiveBlocksPerMultiprocessor(&per_cu, (const void*)hymba_fwd, 512, LDS_BYTES);
        if (per_cu < 1) { fprintf(stderr, "kernel_launch: occupancy query says %d blocks/CU\n", per_cu); per_cu = 1; }
        grid_blocks = cus;
        (void)hipGetLastError();
    }
    if (grid_blocks < 0) return;
    if (hipMemsetAsync((char*)d_ws + W_BAR, 0, XCD_BAR_WORDS * sizeof(unsigned), stream) != hipSuccess) { fprintf(stderr, "kernel_launch: memset of the barrier words failed\n"); return; }
    Params p{};
    for (int i = 0; i < 31; ++i) p.in[i] = (const float*)d_in[i];
    p.out = (float*)d_out; p.ws = (char*)d_ws;
    void* args[] = {&p};
    hipError_t e = hipLaunchCooperativeKernel((const void*)hymba_fwd, dim3(grid_blocks), dim3(512), args, LDS_BYTES, stream);
    if (e != hipSuccess) fprintf(stderr, "cooperative launch failed: %s (grid %d)\n", hipGetErrorString(e), grid_blocks);
}
```

```cpp
#include <hip/hip_runtime.h>
#include <hip/hip_cooperative_groups.h>
#include <cstdio>
namespace cg = cooperative_groups;

typedef unsigned short bf16_t;
typedef short bf16x8 __attribute__((ext_vector_type(8)));
typedef float f32x4 __attribute__((ext_vector_type(4)));
typedef unsigned u32x2 __attribute__((ext_vector_type(2)));
typedef unsigned u32x4 __attribute__((ext_vector_type(4)));
#define DEV __device__ __forceinline__

constexpr int NPROMPT = 16384, NSAMPLE = 512, NTOK = 16896;
constexpr int PLD = 4608;
constexpr int C_ZA = 0, C_ZB = 1024, C_XBC = 2048, C_UB = 3584;
constexpr float EPS = 1e-6f;
constexpr long O_YP = 0, O_YS = 16777216, O_SSDP = 17301504, O_CONVP = 18350080, O_S5RP = 18386944, O_S5IP = 18419712,
               O_SSDS = 18452480, O_CONVS = 35229696, O_S5RS = 35819520, O_S5IS = 36343808, O_END = 36868096;
constexpr size_t W_WTIN = 0;
constexpr size_t W_WTOUT = W_WTIN + 4608ull * 1024 * 2;
constexpr size_t W_WTGLU = W_WTOUT + 1024ull * 2048 * 2;
constexpr size_t W_WTGATE = W_WTGLU + 1024ull * 1024 * 2;
constexpr size_t W_WTPP = W_WTGATE + 1024ull * 1024 * 2;
constexpr size_t W_NB = W_WTPP + 1024ull * 256 * 2;
constexpr size_t W_PB = W_NB + 16896ull * 1024 * 2;
constexpr size_t W_DTR = W_PB + 16896ull * 256 * 2;
constexpr size_t W_ACS = W_DTR + 16896ull * 16 * 4;
constexpr size_t W_CDEC = W_ACS + 16384ull * 16 * 4;
constexpr size_t W_RSS1 = W_CDEC + 8192;
constexpr size_t W_RSS2 = W_RSS1 + 16896ull * 16 * 4;
constexpr size_t W_PROJ = W_RSS2 + 16896ull * 16 * 4;
constexpr size_t W_PP = W_PROJ + 16896ull * 4608 * 2;
constexpr size_t W_RSTD = W_PP + 16896ull * 1024 * 2;
constexpr size_t W_BAR = W_RSTD + 16896ull * 4;
constexpr size_t W_END = W_BAR + 16384;

constexpr int LDS_BYTES = 131072 + 64;

struct Params {
    const float* in[31];
    float* out;
    char* ws;
};
enum { I_XP = 0, I_XS, I_PP, I_PS, I_SSD, I_CONV, I_S5R, I_S5I, I_WIN, I_GIN, I_CONVW, I_CONVB, I_DTB, I_ALOG, I_SSDD, I_SSDG,
       I_LRE, I_LIM, I_LDT, I_BRE, I_BIM, I_CRE, I_CIM, I_S5D, I_GLUW, I_GLUB, I_WOUT, I_GPLE, I_WGATE, I_WPP, I_GFIN };

extern __shared__ __attribute__((aligned(16))) char smem[];

DEV unsigned pk2(float lo, float hi) { unsigned r; asm("v_cvt_pk_bf16_f32 %0, %1, %2" : "=v"(r) : "v"(lo), "v"(hi)); return r; }
DEV float bflo(unsigned u) { return __uint_as_float(u << 16); }
DEV float bfhi(unsigned u) { return __uint_as_float(u & 0xffff0000u); }
DEV float wave_sum(float v) {
#pragma unroll
    for (int o = 1; o < 64; o <<= 1) v += __shfl_xor(v, o);
    return v;
}
DEV float siluf(float v) { return v / (1.f + __expf(-v)); }
DEV float sigmf(float v) { return 1.f / (1.f + __expf(-v)); }
DEV float geluf(float y) { float z = 0.7978845608f * (y + 0.044715f * y * y * y); return y / (1.f + __expf(-2.f * z)); }
DEV f32x4 mfma16(bf16x8 a, bf16x8 b, f32x4 c) { return __builtin_amdgcn_mfma_f32_16x16x32_bf16(a, b, c, 0, 0, 0); }
DEV int tid_fresh() { int t = threadIdx.x; asm volatile("" : "+v"(t)); return t; }
DEV void lds_fence() { asm volatile("s_waitcnt lgkmcnt(0)" ::: "memory"); }


#define XB_TMO      128
#define XB_XCNT(j)  (256  + 64 * (j))
#define XB_XSUB(j)  (1280 + 64 * (j))
#define XB_XGEN(j)  (2304 + 64 * (j))
#define XB_TOP      3328
#define XB_TOPGEN   3392
#define XCD_BAR_WORDS 3456
#define XB_SPIN_CAP (1u << 22)
#define LAS __attribute__((address_space(3)))
DEV unsigned xb_ld(unsigned* p) { return __hip_atomic_load(p, __ATOMIC_RELAXED, __HIP_MEMORY_SCOPE_AGENT); }
DEV unsigned xb_add(unsigned* p, unsigned v) { return __hip_atomic_fetch_add(p, v, __ATOMIC_RELAXED, __HIP_MEMORY_SCOPE_AGENT); }
DEV unsigned xb_xcc_id() { return (unsigned)__builtin_amdgcn_s_getreg((3 << 11) | 20) & 0xFu; }
#define XB_SPIN(cond, bar) do { unsigned _sp = 0; while (cond) { __builtin_amdgcn_s_sleep(1); \
    if ((++_sp & 255u) == 0u) { if (xb_ld(&(bar)[XB_TMO])) break; if (_sp > XB_SPIN_CAP) { atomicAdd(&(bar)[XB_TMO], 1u); break; } } } } while (0)
struct XcdBarrier { unsigned* bar; unsigned x; volatile LAS unsigned* st; };
DEV XcdBarrier xcd_barrier_post(unsigned* bar, volatile LAS unsigned* st) {
    XcdBarrier b; b.bar = bar; b.x = xb_xcc_id(); b.st = st;
    if (threadIdx.x == 0) (void)xb_add(&bar[XB_XCNT(b.x)], 1u);
    return b;
}
DEV void xcd_barrier_complete(unsigned* bar, unsigned x, unsigned& nloc, unsigned& nx) {
    const unsigned G = gridDim.x * gridDim.y * gridDim.z;
    unsigned sum, cnt, mine, sp = 0u;
    for (;;) {
        sum = 0u; cnt = 0u; mine = 0u;
#pragma unroll
        for (unsigned j = 0; j < 16; ++j) { const unsigned c = xb_ld(&bar[XB_XCNT(j)]); sum += c; cnt += (c > 0u) ? 1u : 0u; mine = (j == x) ? c : mine; }
        if (sum == G) break;
        __builtin_amdgcn_s_sleep(1);
        if ((++sp & 255u) == 0u) { if (xb_ld(&bar[XB_TMO])) break; if (sp > XB_SPIN_CAP) { atomicAdd(&bar[XB_TMO], 1u); break; } }
    }
    nloc = mine > 0u ? mine : 1u; nx = cnt > 0u ? cnt : 1u;
}
DEV void xcd_barrier(const XcdBarrier& b) {
    asm volatile("s_waitcnt vmcnt(0)" ::: "memory");
    __syncthreads();
    if (threadIdx.x == 0) {
        unsigned* bar = b.bar;
        __builtin_amdgcn_s_waitcnt(0);
        unsigned nloc = b.st[0], nx = b.st[1];
        if (nloc == 0u) { xcd_barrier_complete(bar, b.x, nloc, nx); b.st[0] = nloc; b.st[1] = nx; }
        const unsigned old = xb_add(&bar[XB_XSUB(b.x)], 1u);
        const unsigned gen = old / nloc;
        if (old + 1u == (gen + 1u) * nloc) {
            __builtin_amdgcn_fence(__ATOMIC_RELEASE, "agent");
            asm volatile("s_waitcnt vmcnt(0)" ::: "memory");
            const unsigned og = xb_add(&bar[XB_TOP], 1u);
            const unsigned tg = og / nx;
            if (og + 1u == (tg + 1u) * nx) xb_add(&bar[XB_TOPGEN], 1u);
            else XB_SPIN(xb_ld(&bar[XB_TOPGEN]) == tg, bar);
            __builtin_amdgcn_fence(__ATOMIC_ACQUIRE, "agent");
            xb_add(&bar[XB_XGEN(b.x)], 1u);
            asm volatile("s_waitcnt vmcnt(0)" ::: "memory");
        } else {
            XB_SPIN(xb_ld(&bar[XB_XGEN(b.x)]) == gen, bar);
            __builtin_amdgcn_fence(__ATOMIC_ACQUIRE, "agent");
            asm volatile("s_waitcnt vmcnt(0)" ::: "memory");
        }
    }
    __syncthreads();
}

constexpr int BM = 256, BK = 64, HALF = 128, HT = HALF * BK;
DEV int lds_byte(int r, int c) {
    int st = (r >> 4) * 2 + (c >> 5), rr = r & 15, cc = c & 31, ob = rr * 64 + cc * 2;
    return st * 1024 + (ob ^ (((ob >> 9) & 1) << 5));
}
DEV void stage_rc(int b, int& R, int& C) {
    int st = b / 1024, sb = b % 1024, swz = sb ^ (((sb >> 9) & 1) << 5);
    R = (st >> 1) * 16 + swz / 64; C = (st & 1) * 32 + (swz % 64) / 2;
}

template <class Epi>
DEV void gemm_tile(const bf16_t* __restrict__ A, int lda, const bf16_t* __restrict__ Bt, int ldb, int K, int brow, int bcol, const Epi& epi) {
    LAS unsigned char* lds = (LAS unsigned char*)smem;
    constexpr int HTB = HT * 2;
    const int tid = tid_fresh(), wid = __builtin_amdgcn_readfirstlane(tid >> 6), lane = tid & 63, wr = wid >> 2, wc = wid & 3, fr = lane & 15, fq = lane >> 4;
    unsigned voffA[2], voffB[2];
#pragma unroll
    for (int i = 0; i < 2; ++i) { int R, C; stage_rc(tid * 16 + i * 8192, R, C); voffA[i] = (unsigned)(R * lda + C) * 2u; voffB[i] = (unsigned)(R * ldb + C) * 2u; }
    const size_t kstep = (size_t)(BK * 2), hstepA = (size_t)HALF * lda * 2, hstepB = (size_t)HALF * ldb * 2;
    const unsigned ldsw = (unsigned)wid * 1024u;
    const int aoff = lds_byte(wr * 64 + fr, fq * 8), boff = lds_byte(wc * 32 + fr, fq * 8);
#define SA(b, h) (((b) * 2 + (h)) * HTB)
#define SB(b, h) ((4 + (b) * 2 + (h)) * HTB)
#define STAGE(bufoff, gbase, voff) do { _Pragma("unroll") for (int _i = 0; _i < 2; ++_i) \
        __builtin_amdgcn_global_load_lds((const unsigned*)((const char*)(gbase) + (voff)[_i]), (LAS unsigned*)(lds + (bufoff) + ldsw + _i * 8192), 16, 0, 0); } while (0)
#define LDA(dst, b, h) do { _Pragma("unroll") for (int m = 0; m < 4; ++m) _Pragma("unroll") for (int k = 0; k < 2; ++k) dst[m][k] = *(const LAS bf16x8*)(lds + SA(b, h) + aoff + m * 2048 + k * 1024); } while (0)
#define LDB(dst, b, h) do { _Pragma("unroll") for (int n = 0; n < 2; ++n) _Pragma("unroll") for (int k = 0; k < 2; ++k) dst[n][k] = *(const LAS bf16x8*)(lds + SB(b, h) + boff + n * 2048 + k * 1024); } while (0)
#define MMA(ai, bj, At, Bt_) do { __builtin_amdgcn_s_setprio(1); _Pragma("unroll") for (int m = 0; m < 4; ++m) _Pragma("unroll") for (int n = 0; n < 2; ++n) _Pragma("unroll") for (int k = 0; k < 2; ++k) \
        acc[ai][bj][m][n] = __builtin_amdgcn_mfma_f32_16x16x32_bf16(Bt_[n][k], At[m][k], acc[ai][bj][m][n], 0, 0, 0); __builtin_amdgcn_s_setprio(0); } while (0)
#define WAIT_V(n) asm volatile("s_waitcnt vmcnt(" #n ")" ::: "memory")
#define WAIT_L(n) asm volatile("s_waitcnt lgkmcnt(" #n ")" ::: "memory")
#define BAR __builtin_amdgcn_s_barrier()
#define SCHED __builtin_amdgcn_sched_barrier(0)
    f32x4 acc[2][2][4][2];
#pragma unroll
    for (int a = 0; a < 2; ++a)
#pragma unroll
        for (int b = 0; b < 2; ++b)
#pragma unroll
            for (int m = 0; m < 4; ++m)
#pragma unroll
                for (int n = 0; n < 2; ++n) acc[a][b][m][n] = (f32x4){0.f, 0.f, 0.f, 0.f};
    bf16x8 At[4][2], B0[2][2], B1[2][2];
    const int nt = K / BK;
    const char* cA = (const char*)A + (size_t)brow * lda * 2; const char* cB = (const char*)Bt + (size_t)bcol * ldb * 2;
    STAGE(SB(0, 0), cB, voffB); STAGE(SA(0, 0), cA, voffA); STAGE(SB(0, 1), cB + hstepB, voffB); STAGE(SA(0, 1), cA + hstepA, voffA);
    if (wr == 1) BAR;
    WAIT_V(4); BAR;
    STAGE(SB(1, 0), cB + kstep, voffB); STAGE(SA(1, 0), cA + kstep, voffA); STAGE(SB(1, 1), cB + hstepB + kstep, voffB);
    WAIT_V(6); BAR;
    for (int t = 0; t < nt - 2; t += 2) {
        const char* a1 = cA + (size_t)(t + 1) * kstep;
        const char* a2 = cA + (size_t)(t + 2) * kstep; const char* b2 = cB + (size_t)(t + 2) * kstep;
        const char* a3 = a2 + kstep; const char* b3 = b2 + kstep;
        LDB(B0, 0, 0); SCHED; LDA(At, 0, 0); STAGE(SA(1, 1), a1 + hstepA, voffA);
        WAIT_L(8); BAR; WAIT_L(0); MMA(0, 0, At, B0); BAR; SCHED;
        LDB(B1, 0, 1); STAGE(SB(0, 0), b2, voffB);
        BAR; WAIT_L(0); MMA(0, 1, At, B1); BAR;
        LDA(At, 0, 1); STAGE(SA(0, 0), a2, voffA);
        BAR; WAIT_L(0); MMA(1, 0, At, B0); BAR; SCHED;
        STAGE(SB(0, 1), b2 + hstepB, voffB);
        WAIT_V(6); BAR; MMA(1, 1, At, B1); BAR;
        LDB(B0, 1, 0); SCHED; LDA(At, 1, 0); STAGE(SA(0, 1), a2 + hstepA, voffA);
        WAIT_L(8); BAR; WAIT_L(0); MMA(0, 0, At, B0); BAR; SCHED;
        LDB(B1, 1, 1); STAGE(SB(1, 0), b3, voffB);
        BAR; WAIT_L(0); MMA(0, 1, At, B1); BAR;
        LDA(At, 1, 1); STAGE(SA(1, 0), a3, voffA);
        BAR; WAIT_L(0); MMA(1, 0, At, B0); BAR; SCHED;
        STAGE(SB(1, 1), b3 + hstepB, voffB);
        WAIT_V(6); BAR; MMA(1, 1, At, B1); BAR;
    }
    { const char* a1 = cA + (size_t)(nt - 1) * kstep;
      LDB(B0, 0, 0); LDA(At, 0, 0); STAGE(SA(1, 1), a1 + hstepA, voffA);
      BAR; WAIT_L(0); MMA(0, 0, At, B0); BAR;
      LDB(B1, 0, 1); BAR; WAIT_L(0); MMA(0, 1, At, B1); BAR;
      LDA(At, 0, 1); WAIT_V(4); BAR; WAIT_L(0); MMA(1, 0, At, B0); MMA(1, 1, At, B1); BAR; }
    { LDB(B0, 1, 0); LDA(At, 1, 0); WAIT_V(2); BAR; WAIT_L(0); MMA(0, 0, At, B0); BAR;
      LDB(B1, 1, 1); WAIT_V(0); BAR; WAIT_L(0); MMA(0, 1, At, B1); BAR;
      LDA(At, 1, 1); BAR; WAIT_L(0); MMA(1, 0, At, B0); MMA(1, 1, At, B1); BAR; }
    if (wr == 0) BAR;
    epi_big(epi, acc, brow, bcol, wr, wc, fr, fq);
    __syncthreads();
#undef SA
#undef SB
#undef STAGE
#undef LDA
#undef LDB
#undef MMA
}

DEV void tile_of(int L, int nM, int nN, int& pm, int& pn) {
    const int nwg = nM * nN; int wgid = L;
    { const int q = nwg / 8, r = nwg % 8, xcd = wgid % 8, off = wgid / 8; wgid = (xcd < r ? xcd * (q + 1) : r * (q + 1) + (xcd - r) * q) + off; }
    const int nig = 8 * nN, gid = wgid / nig, fm = gid * 8, gsz = (nM - fm) < 8 ? (nM - fm) : 8;
    pm = fm + ((wgid % nig) % gsz); pn = (wgid % nig) / gsz;
}

struct EpiBf16 {
    bf16_t* dst; int ld; const float* rstd;
    struct Ld { float rs; };
    DEV void load(int row, int col, Ld& d) const { d.rs = rstd ? rstd[row] : 1.f; }
    DEV void apply(int row, int col, const f32x4& v, const Ld& d, float& ss, float rowv) const {
        u32x2 o; o.x = pk2(v[0] * d.rs, v[1] * d.rs); o.y = pk2(v[2] * d.rs, v[3] * d.rs);
        *(u32x2*)(dst + (long)row * ld + col) = o;
    }
    DEV float rowload(int row) const { return 0.f; }
    DEV void rowdone(int row, float ss, int fq, int slot) const {}
    DEV void rowput(int row, float tot, int slot) const {}
};
struct EpiGlu {
    bf16_t* proj; const float* glu_b;
    struct Ld { u32x2 g, z; f32x4 b; };
    DEV void load(int row, int col, Ld& d) const {
        d.g = *(const u32x2*)(proj + (long)row * PLD + C_UB + col); d.z = *(const u32x2*)(proj + (long)row * PLD + C_ZB + col); d.b = *(const f32x4*)(glu_b + col);
    }
    DEV void apply(int row, int col, const f32x4& v, const Ld& d, float& ss, float rowv) const {
        const float y0 = bflo(d.g.x) * sigmf(v[0] + d.b[0]) * siluf(bflo(d.z.x)), y1 = bfhi(d.g.x) * sigmf(v[1] + d.b[1]) * siluf(bfhi(d.z.x));
        const float y2 = bflo(d.g.y) * sigmf(v[2] + d.b[2]) * siluf(bflo(d.z.y)), y3 = bfhi(d.g.y) * sigmf(v[3] + d.b[3]) * siluf(bfhi(d.z.y));
        u32x2 o; o.x = pk2(y0, y1); o.y = pk2(y2, y3);
        *(u32x2*)(proj + (long)row * PLD + C_ZB + col) = o;
    }
    DEV float rowload(int row) const { return 0.f; }
    DEV void rowdone(int row, float ss, int fq, int slot) const {}
    DEV void rowput(int row, float tot, int slot) const {}
};
struct EpiOut {
    const float* xp; const float* xs; bf16_t* h1b; float* rss;
    struct Ld { f32x4 x; };
    DEV void load(int row, int col, Ld& d) const {
        const float* xrow = row < NPROMPT ? xp + (long)row * 1024 : xs + (long)(row - NPROMPT) * 1024;
        d.x = *(const f32x4*)(xrow + col);
    }
    DEV void apply(int row, int col, const f32x4& a, const Ld& d, float& ss, float rowv) const {
        const f32x4 v = a + d.x;
        u32x2 o; o.x = pk2(v[0], v[1]); o.y = pk2(v[2], v[3]);
        *(u32x2*)(h1b + (long)row * 1024 + col) = o;
        const float r0 = bflo(o.x), r1 = bfhi(o.x), r2 = bflo(o.y), r3 = bfhi(o.y);
        ss += r0 * r0 + r1 * r1 + r2 * r2 + r3 * r3;
    }
    DEV float rowload(int row) const { return 0.f; }
    DEV void rowdone(int row, float ss, int fq, int slot) const {
        ss += __shfl_xor(ss, 16); ss += __shfl_xor(ss, 32);
        if (fq == 0) rss[(long)row * 16 + slot] = ss;
    }
    DEV void rowput(int row, float tot, int slot) const { rss[(long)row * 16 + slot] = tot; rss[(long)row * 16 + slot + 1] = 0.f; }
};
struct EpiPle {
    float* out; const bf16_t* h1b; const bf16_t* pp; const float* rss1; float* rss2;
    struct Ld { u32x2 h; u32x2 pv; };
    DEV void load(int row, int col, Ld& d) const {
        d.h = *(const u32x2*)(h1b + (long)row * 1024 + col); d.pv = *(const u32x2*)(pp + (long)row * 1024 + col);
    }
    DEV void apply(int row, int col, const f32x4& a, const Ld& d, float& ss, float rowv) const {
        const float rstd = rsqrtf(rowv * (1.f / 1024.f) + EPS);
        f32x4 h;
        h[0] = bflo(d.h.x) + bflo(d.pv.x) * sigmf(a[0] * rstd); h[1] = bfhi(d.h.x) + bfhi(d.pv.x) * sigmf(a[1] * rstd);
        h[2] = bflo(d.h.y) + bflo(d.pv.y) * sigmf(a[2] * rstd); h[3] = bfhi(d.h.y) + bfhi(d.pv.y) * sigmf(a[3] * rstd);
        *(f32x4*)(out + (long)row * 1024 + col) = h;
        ss += h[0] * h[0] + h[1] * h[1] + h[2] * h[2] + h[3] * h[3];
    }
    DEV float rowload(int row) const {
        const f32x4 a = *(const f32x4*)(rss1 + (long)row * 16), b = *(const f32x4*)(rss1 + (long)row * 16 + 4), c = *(const f32x4*)(rss1 + (long)row * 16 + 8), d = *(const f32x4*)(rss1 + (long)row * 16 + 12);
        return (((a[0] + a[1]) + (a[2] + a[3])) + ((b[0] + b[1]) + (b[2] + b[3]))) + (((c[0] + c[1]) + (c[2] + c[3])) + ((d[0] + d[1]) + (d[2] + d[3])));
    }
    DEV void rowdone(int row, float ss, int fq, int slot) const {
        ss += __shfl_xor(ss, 16); ss += __shfl_xor(ss, 32);
        if (fq == 0) rss2[(long)row * 16 + slot] = ss;
    }
    DEV void rowput(int row, float tot, int slot) const { rss2[(long)row * 16 + slot] = tot; rss2[(long)row * 16 + slot + 1] = 0.f; }
};
template <class Epi>
DEV void epi_big(const Epi& E, const f32x4 (&acc)[2][2][4][2], int brow, int bcol, int wr, int wc, int fr, int fq) {
#pragma unroll
    for (int ai = 0; ai < 2; ++ai)
#pragma unroll
        for (int mp = 0; mp < 2; ++mp) {
            typename Epi::Ld d[2][4]; float rv[2];
#pragma unroll
            for (int mm = 0; mm < 2; ++mm) {
                rv[mm] = E.rowload(brow + ai * 128 + wr * 64 + (mp * 2 + mm) * 16 + fr);
#pragma unroll
                for (int j = 0; j < 4; ++j)
                    E.load(brow + ai * 128 + wr * 64 + (mp * 2 + mm) * 16 + fr, bcol + (j >> 1) * 128 + wc * 32 + (j & 1) * 16 + fq * 4, d[mm][j]);
            }
#pragma unroll
            for (int mm = 0; mm < 2; ++mm) {
                const int row = brow + ai * 128 + wr * 64 + (mp * 2 + mm) * 16 + fr; float ss = 0.f;
#pragma unroll
                for (int j = 0; j < 4; ++j)
                    E.apply(row, bcol + (j >> 1) * 128 + wc * 32 + (j & 1) * 16 + fq * 4, acc[ai][j >> 1][mp * 2 + mm][j & 1], d[mm][j], ss, rv[mm]);
                E.rowdone(row, ss, fq, ((bcol >> 8) & 3) * 4 + wc);
            }
        }
}
template <class Epi>
DEV void gemm_small(const bf16_t* __restrict__ A, int lda, const bf16_t* __restrict__ Bt, int ldb, int K, int row0, int col0, const Epi& E) {
    const int tid = tid_fresh(), w = tid >> 6, lane = tid & 63, fr = lane & 15, fq = lane >> 4;
    const bf16_t* ap = A + (long)(row0 + fr) * lda + fq * 8;
    const bf16_t* bp = Bt + (long)(col0 + w * 16 + fr) * ldb + fq * 8;
    f32x4 acc = (f32x4){0.f, 0.f, 0.f, 0.f};
#pragma unroll 8
    for (int k = 0; k < K; k += 32) {
        const bf16x8 a = *(const bf16x8*)(ap + k), b = *(const bf16x8*)(bp + k);
        acc = mfma16(b, a, acc);
    }
    const int row = row0 + fr, col = col0 + w * 16 + fq * 4;
    typename Epi::Ld d;
    E.load(row, col, d);
    const float rv = E.rowload(row);
    float ss = 0.f;
    E.apply(row, col, acc, d, ss, rv);
    ss += __shfl_xor(ss, 16); ss += __shfl_xor(ss, 32);
    float* red = (float*)smem;
    __syncthreads();
    if (fq == 0) red[w * 16 + fr] = ss;
    __syncthreads();
    if (tid < 16) {
        float t = 0.f;
#pragma unroll
        for (int i = 0; i < 8; ++i) t += red[i * 16 + tid];
        E.rowput(row0 + tid, t, (col0 >> 7) * 2);
    }
    __syncthreads();
}

DEV void transpose_item(const float* __restrict__ src, int ldsrc, int k0, int c0, bf16_t* __restrict__ dst, int lddst, int n0,
                        const float* __restrict__ kscale, float* scr, int lane) {
    const int cl = lane & 31, kh = lane >> 5;
    float v[32];
#pragma unroll
    for (int i = 0; i < 32; ++i) v[i] = src[(long)(k0 + 2 * i + kh) * ldsrc + c0 + cl];
    if (kscale) {
#pragma unroll
        for (int i = 0; i < 32; ++i) v[i] *= kscale[k0 + 2 * i + kh];
    }
#pragma unroll
    for (int i = 0; i < 32; ++i) scr[(2 * i + kh) * 33 + cl] = v[i];
    lds_fence();
    const int c = lane & 7;
#pragma unroll
    for (int j = 0; j < 4; ++j) {
        const int n = (lane >> 3) + 8 * j; const float* sp = scr + (8 * c) * 33 + n;
        u32x4 o; o.x = pk2(sp[0 * 33], sp[1 * 33]); o.y = pk2(sp[2 * 33], sp[3 * 33]); o.z = pk2(sp[4 * 33], sp[5 * 33]); o.w = pk2(sp[6 * 33], sp[7 * 33]);
        *(u32x4*)(dst + (long)(n0 + n) * lddst + k0 + 8 * c) = o;
    }
    lds_fence();
}

DEV void phase0(const Params& P) {
    const int tid = tid_fresh(), lane = tid & 63, wave = tid >> 6, G = gridDim.x, bid = blockIdx.x;
    char* ws = P.ws;
    float* tile = (float*)smem;
    {
        float* scr = (float*)smem + wave * (64 * 33);
        constexpr int I_IN = 144 * 16, I_OUT = 32 * 32, I_GLU = 32 * 16, I_GATE = 32 * 16, I_PPW = 32 * 4;
        constexpr int I_ALL = I_IN + I_OUT + I_GLU + I_GATE + I_PPW;
        for (int it = bid * 8 + wave; it < I_ALL; it += G * 8) {
            int r = it;
            if (r < I_IN) {
                const int nb = r >> 4, kb = r & 15, n0 = nb * 32;
                int c0;
                if (n0 < 1024) c0 = n0; else if (n0 < 2048) c0 = 2576 + (n0 - 1024); else if (n0 < 3584) c0 = 1024 + (n0 - 2048); else c0 = 3600 + (n0 - 3584);
                transpose_item(P.in[I_WIN], 4624, kb * 64, c0, (bf16_t*)(ws + W_WTIN), 1024, n0, P.in[I_GIN], scr, lane); continue;
            }
            r -= I_IN;
            if (r < I_OUT) { const int nb = r >> 5, kb = r & 31; transpose_item(P.in[I_WOUT], 1024, kb * 64, nb * 32, (bf16_t*)(ws + W_WTOUT), 2048, nb * 32, nullptr, scr, lane); continue; }
            r -= I_OUT;
            if (r < I_GLU) { const int nb = r >> 4, kb = r & 15; transpose_item(P.in[I_GLUW], 1024, kb * 64, nb * 32, (bf16_t*)(ws + W_WTGLU), 1024, nb * 32, nullptr, scr, lane); continue; }
            r -= I_GLU;
            if (r < I_GATE) { const int nb = r >> 4, kb = r & 15; transpose_item(P.in[I_WGATE], 1024, kb * 64, nb * 32, (bf16_t*)(ws + W_WTGATE), 1024, nb * 32, P.in[I_GPLE], scr, lane); continue; }
            r -= I_GATE;
            { const int nb = r >> 2, kb = r & 3; transpose_item(P.in[I_WPP], 1024, kb * 64, nb * 32, (bf16_t*)(ws + W_WTPP), 256, nb * 32, nullptr, scr, lane); }
        }
        __syncthreads();
    }
    bf16_t* wdt = (bf16_t*)smem;
    float* psum = (float*)(smem + 16 * 1032 * 2);
    float* pdt = psum + 128;
    {
        float wv[32];
#pragma unroll
        for (int i = 0; i < 32; ++i) { const int idx = tid + i * 512, k = idx >> 4, e = idx & 15; wv[i] = P.in[I_WIN][(long)k * 4624 + 2560 + e] * P.in[I_GIN][k]; }
#pragma unroll
        for (int i = 0; i < 32; ++i) { const int idx = tid + i * 512, k = idx >> 4, e = idx & 15; wdt[e * 1032 + k] = (bf16_t)(pk2(wv[i], 0.f) & 0xffffu); }
    }
    __syncthreads();
    {
        const int fr = lane & 15, fq = lane >> 4;
        bf16x8 wf[4];
#pragma unroll
        for (int j = 0; j < 4; ++j) wf[j] = *(const bf16x8*)(wdt + fr * 1032 + (wave * 4 + j) * 32 + fq * 8);
        bf16_t* xb = (bf16_t*)(ws + W_NB);
        float* dtr = (float*)(ws + W_DTR);
        float* rstdp = (float*)(ws + W_RSTD);
        for (int task = bid; task < NTOK / 16; task += G) {
            const int row = task * 16 + fr;
            const float* xr = (row < NPROMPT ? P.in[I_XP] + (long)row * 1024 : P.in[I_XS] + (long)(row - NPROMPT) * 1024) + wave * 128 + fq * 8;
            f32x4 xa[4], xc[4];
#pragma unroll
            for (int j = 0; j < 4; ++j) { xa[j] = *(const f32x4*)(xr + j * 32); xc[j] = *(const f32x4*)(xr + j * 32 + 4); }
            f32x4 acc = {0.f, 0.f, 0.f, 0.f}; float ss = 0.f;
#pragma unroll
            for (int j = 0; j < 4; ++j) {
                ss += xa[j][0] * xa[j][0] + xa[j][1] * xa[j][1] + xa[j][2] * xa[j][2] + xa[j][3] * xa[j][3] + xc[j][0] * xc[j][0] + xc[j][1] * xc[j][1] + xc[j][2] * xc[j][2] + xc[j][3] * xc[j][3];
                u32x4 q; q.x = pk2(xa[j][0], xa[j][1]); q.y = pk2(xa[j][2], xa[j][3]); q.z = pk2(xc[j][0], xc[j][1]); q.w = pk2(xc[j][2], xc[j][3]);
                *(u32x4*)(xb + (long)row * 1024 + wave * 128 + j * 32 + fq * 8) = q;
                acc = mfma16(wf[j], __builtin_bit_cast(bf16x8, q), acc);
            }
            ss += __shfl_xor(ss, 16); ss += __shfl_xor(ss, 32);
            if (fq == 0) psum[wave * 16 + fr] = ss;
            *(f32x4*)(pdt + wave * 256 + fr * 16 + fq * 4) = acc;
            __syncthreads();
            if (tid < 256) {
                const int t = tid >> 4, e = tid & 15;
                float tot = 0.f, d = 0.f;
#pragma unroll
                for (int w8 = 0; w8 < 8; ++w8) { tot += psum[w8 * 16 + t]; d += pdt[w8 * 256 + t * 16 + e]; }
                const float rstd = rsqrtf(tot * (1.f / 1024.f) + EPS);
                dtr[(long)(task * 16 + t) * 16 + e] = d * rstd;
                if (e == 0) rstdp[task * 16 + t] = rstd;
            }
            __syncthreads();
        }
    }
    bf16_t* pb = (bf16_t*)(ws + W_PB);
    for (int idx = bid * 512 + tid; idx < NTOK * 64; idx += G * 512) {
        const int row = idx >> 6, c4 = (idx & 63) * 4;
        const float* src = row < NPROMPT ? P.in[I_PP] + (long)row * 256 : P.in[I_PS] + (long)(row - NPROMPT) * 256;
        const f32x4 v = *(const f32x4*)(src + c4);
        u32x2 o; o.x = pk2(v[0], v[1]); o.y = pk2(v[2], v[3]);
        *(u32x2*)(pb + (long)row * 256 + c4) = o;
    }
    __syncthreads();
}

DEV void conv_load7(const bf16_t* __restrict__ pcol, long row0, int t0, u32x4 (&raw)[7]) {
#pragma unroll
    for (int i = 0; i < 7; ++i) {
        const int t = t0 - 3 + i;
        raw[i] = (u32x4){0u, 0u, 0u, 0u};
        if (t >= 0) raw[i] = *(const u32x4*)(pcol + (row0 - 3 + i) * PLD);
    }
}
DEV void conv_compute(const u32x4 (&rawp)[7], const float* __restrict__ cw, const float* __restrict__ cb, float (&o)[4][8]) {
    float raw[7][8];
#pragma unroll
    for (int i = 0; i < 7; ++i) {
        const u32x4 u = rawp[i];
        raw[i][0] = bflo(u.x); raw[i][1] = bfhi(u.x); raw[i][2] = bflo(u.y); raw[i][3] = bfhi(u.y);
        raw[i][4] = bflo(u.z); raw[i][5] = bfhi(u.z); raw[i][6] = bflo(u.w); raw[i][7] = bfhi(u.w);
    }
    float w[4][8], bias[8];
#pragma unroll
    for (int k = 0; k < 4; ++k) {
        const f32x4 a = *(const f32x4*)(cw + k * 1536), b = *(const f32x4*)(cw + k * 1536 + 4);
        w[k][0] = a[0]; w[k][1] = a[1]; w[k][2] = a[2]; w[k][3] = a[3]; w[k][4] = b[0]; w[k][5] = b[1]; w[k][6] = b[2]; w[k][7] = b[3];
    }
    { const f32x4 a = *(const f32x4*)(cb), b = *(const f32x4*)(cb + 4);
      bias[0] = a[0]; bias[1] = a[1]; bias[2] = a[2]; bias[3] = a[3]; bias[4] = b[0]; bias[5] = b[1]; bias[6] = b[2]; bias[7] = b[3]; }
#pragma unroll
    for (int j = 0; j < 4; ++j)
#pragma unroll
        for (int c = 0; c < 8; ++c) {
            float a = bias[c];
#pragma unroll
            for (int k = 0; k < 4; ++k) a += w[k][c] * raw[j + k][c];
            o[j][c] = siluf(a);
        }
}
DEV void conv_compute_lds(const u32x4 (&rawp)[7], const float* cwl, float (&o)[4][8]) {
    float raw[7][8];
#pragma unroll
    for (int i = 0; i < 7; ++i) {
        const u32x4 u = rawp[i];
        raw[i][0] = bflo(u.x); raw[i][1] = bfhi(u.x); raw[i][2] = bflo(u.y); raw[i][3] = bfhi(u.y);
        raw[i][4] = bflo(u.z); raw[i][5] = bfhi(u.z); raw[i][6] = bflo(u.w); raw[i][7] = bfhi(u.w);
    }
    float w[5][8];
#pragma unroll
    for (int k = 0; k < 5; ++k) {
        const f32x4 a = *(const f32x4*)(cwl + k * 512), b = *(const f32x4*)(cwl + k * 512 + 4);
        w[k][0] = a[0]; w[k][1] = a[1]; w[k][2] = a[2]; w[k][3] = a[3]; w[k][4] = b[0]; w[k][5] = b[1]; w[k][6] = b[2]; w[k][7] = b[3];
    }
#pragma unroll
    for (int j = 0; j < 4; ++j)
#pragma unroll
        for (int c = 0; c < 8; ++c) {
            float a = w[4][c];
#pragma unroll
            for (int k = 0; k < 4; ++k) a += w[k][c] * raw[j + k][c];
            o[j][c] = siluf(a);
        }
}
DEV void conv4x8(const bf16_t* __restrict__ pcol, long row0, int t0, const float* __restrict__ hist, const float* __restrict__ cw, const float* __restrict__ cb, float (&o)[4][8]) {
    float raw[7][8];
#pragma unroll
    for (int i = 0; i < 7; ++i) {
        const int t = t0 - 3 + i;
        if (t >= 0) {
            const u32x4 u = *(const u32x4*)(pcol + (row0 - 3 + i) * PLD);
            raw[i][0] = bflo(u.x); raw[i][1] = bfhi(u.x); raw[i][2] = bflo(u.y); raw[i][3] = bfhi(u.y);
            raw[i][4] = bflo(u.z); raw[i][5] = bfhi(u.z); raw[i][6] = bflo(u.w); raw[i][7] = bfhi(u.w);
        } else if (hist) {
            const f32x4 a = *(const f32x4*)(hist + (long)(t + 3) * 1536), b = *(const f32x4*)(hist + (long)(t + 3) * 1536 + 4);
            raw[i][0] = a[0]; raw[i][1] = a[1]; raw[i][2] = a[2]; raw[i][3] = a[3]; raw[i][4] = b[0]; raw[i][5] = b[1]; raw[i][6] = b[2]; raw[i][7] = b[3];
        } else {
#pragma unroll
            for (int c = 0; c < 8; ++c) raw[i][c] = 0.f;
        }
    }
    float w[4][8], bias[8];
#pragma unroll
    for (int k = 0; k < 4; ++k) {
        const f32x4 a = *(const f32x4*)(cw + k * 1536), b = *(const f32x4*)(cw + k * 1536 + 4);
        w[k][0] = a[0]; w[k][1] = a[1]; w[k][2] = a[2]; w[k][3] = a[3]; w[k][4] = b[0]; w[k][5] = b[1]; w[k][6] = b[2]; w[k][7] = b[3];
    }
    { const f32x4 a = *(const f32x4*)(cb), b = *(const f32x4*)(cb + 4);
      bias[0] = a[0]; bias[1] = a[1]; bias[2] = a[2]; bias[3] = a[3]; bias[4] = b[0]; bias[5] = b[1]; bias[6] = b[2]; bias[7] = b[3]; }
#pragma unroll
    for (int j = 0; j < 4; ++j)
#pragma unroll
        for (int c = 0; c < 8; ++c) {
            float a = bias[c];
#pragma unroll
            for (int k = 0; k < 4; ++k) a += w[k][c] * raw[j + k][c];
            o[j][c] = siluf(a);
        }
}

constexpr int PIT = 136;
constexpr int R1_OFF = 0, R2_OFF = 128 * PIT * 2, R3_OFF = 2 * 128 * PIT * 2, R4_OFF = 3 * 128 * PIT * 2;

DEV void ssd_s1_item(const Params& P, int item) {
    const int tid = tid_fresh(), lane = tid & 63, w = tid >> 6, fr = lane & 15, fq = lane >> 4;
    const int b = item >> 5, c = (item >> 1) & 15, g = item & 1;
    char* ws = P.ws;
    const bf16_t* proj = (const bf16_t*)(ws + W_PROJ);
    const long rowc = (long)b * 2048 + c * 128;
    bf16_t* R1 = (bf16_t*)(smem + R1_OFF); bf16_t* R2 = (bf16_t*)(smem + R2_OFF); bf16_t* R3 = (bf16_t*)(smem + R3_OFF);
    float* acs = (float*)(smem + R4_OFF);
    float* dtv = acs + 1024;
    {
        const int h = g * 8 + w;
        const float bias = P.in[I_DTB][h], A = -__expf(P.in[I_ALOG][h]);
        const float* dtr = (const float*)(ws + W_DTR);
        float x0 = dtr[(rowc + 2 * lane) * 16 + h] + bias, x1 = dtr[(rowc + 2 * lane + 1) * 16 + h] + bias;
        float d0 = x0 > 20.f ? x0 : log1pf(__expf(x0)), d1 = x1 > 20.f ? x1 : log1pf(__expf(x1));
        float a0 = d0 * A, a1 = a0 + d1 * A;
        float run = a1;
#pragma unroll
        for (int o = 1; o < 64; o <<= 1) { float t = __shfl_up(run, o); if (lane >= o) run += t; }
        const float excl = run - a1;
        a0 += excl; a1 += excl;
        acs[w * 128 + 2 * lane] = a0; acs[w * 128 + 2 * lane + 1] = a1;
        dtv[w * 128 + 2 * lane] = d0; dtv[w * 128 + 2 * lane + 1] = d1;
        float* acsg = (float*)(ws + W_ACS) + (((long)b * 16 + c) * 16 + h) * 128;
        acsg[2 * lane] = a0; acsg[2 * lane + 1] = a1;
        if (lane == 63) ((float*)(ws + W_CDEC))[(b * 16 + c) * 16 + h] = __expf(a1);
    }
    float* cwl = (float*)(smem + R4_OFF + 8192);
    for (int u = tid; u < 5 * 512; u += 512) { const int k = u >> 9, ch = u & 511; cwl[u] = k < 4 ? P.in[I_CONVW][k * 1536 + g * 512 + ch] : P.in[I_CONVB][g * 512 + ch]; }
    {
        const int nblk = tid & 15, lq = tid >> 4, l0 = lq * 4;
#pragma unroll
        for (int j = 0; j < 2; ++j) {
            const int ch0 = 1024 + j * 256 + g * 128 + nblk * 8;
            float o[4][8];
            conv4x8(proj + C_XBC + ch0, rowc + l0, c * 128 + l0, nullptr, P.in[I_CONVW] + ch0, P.in[I_CONVB] + ch0, o);
            bf16_t* dst = j == 0 ? R2 : R1;
#pragma unroll
            for (int r = 0; r < 4; ++r) {
                u32x4 q; q.x = pk2(o[r][0], o[r][1]); q.y = pk2(o[r][2], o[r][3]); q.z = pk2(o[r][4], o[r][5]); q.w = pk2(o[r][6], o[r][7]);
                *(u32x4*)(dst + (l0 + r) * PIT + nblk * 8) = q;
            }
            if (j == 0) {
#pragma unroll
                for (int i = 0; i < 8; ++i) {
                    u32x2 q; q.x = pk2(o[0][i], o[1][i]); q.y = pk2(o[2][i], o[3][i]);
                    *(u32x2*)(R3 + (nblk * 8 + i) * PIT + l0) = q;
                }
            }
        }
    }
    __syncthreads();
    const int wr = w >> 1, wc = w & 1;
    f32x4 cbm[2][4];
#pragma unroll
    for (int m = 0; m < 2; ++m)
#pragma unroll
        for (int n = 0; n < 4; ++n) cbm[m][n] = (f32x4){0.f, 0.f, 0.f, 0.f};
#pragma unroll
    for (int ks = 0; ks < 4; ++ks) {
        bf16x8 af[2], bfm[4];
#pragma unroll
        for (int m = 0; m < 2; ++m) af[m] = *(const bf16x8*)(R1 + (wr * 32 + m * 16 + fr) * PIT + ks * 32 + fq * 8);
#pragma unroll
        for (int n = 0; n < 4; ++n) bfm[n] = *(const bf16x8*)(R2 + (wc * 64 + n * 16 + fr) * PIT + ks * 32 + fq * 8);
#pragma unroll
        for (int m = 0; m < 2; ++m)
#pragma unroll
            for (int n = 0; n < 4; ++n) cbm[m][n] = mfma16(bfm[n], af[m], cbm[m][n]);
    }
    __syncthreads();
    bf16_t* XT = R2; bf16_t* XW = R2 + 64 * PIT;
    bf16_t* ydg = (bf16_t*)(ws + W_NB);
    float* states = P.out;
    const int wp = w >> 2, wn = w & 3;
    u32x4 rawn[7];
    if (tid < 256) conv_load7(proj + C_XBC + (g * 8) * 64 + (tid & 7) * 8, rowc + (tid >> 3) * 4, c * 128 + (tid >> 3) * 4, rawn);
    for (int e = 0; e < 8; ++e) {
        const int h = g * 8 + e;
        const float dskip = P.in[I_SSDD][h];
        if (tid < 256) {
            const int pblk = tid & 7, lq = tid >> 3, l0 = lq * 4, ch0 = h * 64 + pblk * 8;
            float o[4][8];
            conv_compute_lds(rawn, cwl + e * 64 + pblk * 8, o);
            if (e < 7) conv_load7(proj + C_XBC + ch0 + 64, rowc + l0, c * 128 + l0, rawn);
            const float alast = acs[e * 128 + 127];
            float we[4];
#pragma unroll
            for (int r = 0; r < 4; ++r) we[r] = __expf(alast - acs[e * 128 + l0 + r]) * dtv[e * 128 + l0 + r];
#pragma unroll
            for (int i = 0; i < 8; ++i) {
                u32x2 q; q.x = pk2(o[0][i], o[1][i]); q.y = pk2(o[2][i], o[3][i]);
                *(u32x2*)(XT + (pblk * 8 + i) * PIT + l0) = q;
                u32x2 q2; q2.x = pk2(o[0][i] * we[0], o[1][i] * we[1]); q2.y = pk2(o[2][i] * we[2], o[3][i] * we[3]);
                *(u32x2*)(XW + (pblk * 8 + i) * PIT + l0) = q2;
            }
        }
#pragma unroll
        for (int m = 0; m < 2; ++m) {
            const int l = wr * 32 + m * 16 + fr; const float al = acs[e * 128 + l];
#pragma unroll
            for (int n = 0; n < 4; ++n) {
                const int s0 = wc * 64 + n * 16 + fq * 4;
                const f32x4 as = *(const f32x4*)(acs + e * 128 + s0), ds = *(const f32x4*)(dtv + e * 128 + s0);
                float v[4];
#pragma unroll
                for (int r = 0; r < 4; ++r) { const float t = cbm[m][n][r] * __expf(al - as[r]) * ds[r]; v[r] = (s0 + r <= l) ? t : 0.f; }
                u32x2 q; q.x = pk2(v[0], v[1]); q.y = pk2(v[2], v[3]);
                *(u32x2*)(R1 + l * PIT + s0) = q;
            }
        }
        __syncthreads();
        {
            f32x4 yd[2][2];
#pragma unroll
            for (int m = 0; m < 2; ++m)
#pragma unroll
                for (int n = 0; n < 2; ++n) yd[m][n] = (f32x4){0.f, 0.f, 0.f, 0.f};
            for (int ks = 0; ks <= wr; ++ks) {
                bf16x8 af[2], bfm[2];
#pragma unroll
                for (int m = 0; m < 2; ++m) af[m] = *(const bf16x8*)(R1 + (wr * 32 + m * 16 + fr) * PIT + ks * 32 + fq * 8);
#pragma unroll
                for (int n = 0; n < 2; ++n) bfm[n] = *(const bf16x8*)(XT + (wc * 32 + n * 16 + fr) * PIT + ks * 32 + fq * 8);
#pragma unroll
                for (int m = 0; m < 2; ++m)
#pragma unroll
                    for (int n = 0; n < 2; ++n) yd[m][n] = mfma16(bfm[n], af[m], yd[m][n]);
            }
#pragma unroll
            for (int m = 0; m < 2; ++m)
#pragma unroll
                for (int n = 0; n < 2; ++n) {
                    const int l = wr * 32 + m * 16 + fr, p0 = wc * 32 + n * 16 + fq * 4;
                    const float x0 = __uint_as_float(((unsigned)XT[(p0 + 0) * PIT + l]) << 16), x1 = __uint_as_float(((unsigned)XT[(p0 + 1) * PIT + l]) << 16);
                    const float x2 = __uint_as_float(((unsigned)XT[(p0 + 2) * PIT + l]) << 16), x3 = __uint_as_float(((unsigned)XT[(p0 + 3) * PIT + l]) << 16);
                    u32x2 q; q.x = pk2(yd[m][n][0] + dskip * x0, yd[m][n][1] + dskip * x1); q.y = pk2(yd[m][n][2] + dskip * x2, yd[m][n][3] + dskip * x3);
                    *(u32x2*)(ydg + (rowc + l) * 1024 + h * 64 + p0) = q;
                }
        }
        {
            f32x4 st[2][2];
#pragma unroll
            for (int m = 0; m < 2; ++m)
#pragma unroll
                for (int n = 0; n < 2; ++n) st[m][n] = (f32x4){0.f, 0.f, 0.f, 0.f};
#pragma unroll
            for (int ks = 0; ks < 4; ++ks) {
                bf16x8 af[2], bfm[2];
#pragma unroll
                for (int m = 0; m < 2; ++m) af[m] = *(const bf16x8*)(XW + (wp * 32 + m * 16 + fr) * PIT + ks * 32 + fq * 8);
#pragma unroll
                for (int n = 0; n < 2; ++n) bfm[n] = *(const bf16x8*)(R3 + (wn * 32 + n * 16 + fr) * PIT + ks * 32 + fq * 8);
#pragma unroll
                for (int m = 0; m < 2; ++m)
#pragma unroll
                    for (int n = 0; n < 2; ++n) st[m][n] = mfma16(bfm[n], af[m], st[m][n]);
            }
            float* sp = states + (((long)b * 16 + c) * 16 + h) * 8192;
#pragma unroll
            for (int m = 0; m < 2; ++m)
#pragma unroll
                for (int n = 0; n < 2; ++n) {
                    const int p = wp * 32 + m * 16 + fr, n0 = wn * 32 + n * 16 + fq * 4;
                    *(f32x4*)(sp + p * 128 + n0) = st[m][n];
                }
        }
        __syncthreads();
    }
}

DEV void ssd_s2(const Params& P) {
    float* states = P.out;
    const float* cdec = (const float*)(P.ws + W_CDEC);
    for (int idx = blockIdx.x * 512 + threadIdx.x; idx < 262144; idx += gridDim.x * 512) {
        const int bh = idx >> 11, q = idx & 2047, b = bh >> 4, h = bh & 15;
        f32x4 H = (f32x4){0.f, 0.f, 0.f, 0.f};
#pragma unroll
        for (int c = 0; c < 16; ++c) {
            f32x4* ptr = (f32x4*)(states + (((long)b * 16 + c) * 16 + h) * 8192) + q;
            const f32x4 s = *ptr; *ptr = H;
            const float d = cdec[(b * 16 + c) * 16 + h];
            H = H * d + s;
        }
        *((f32x4*)(P.out + O_SSDP + (long)bh * 8192) + q) = H;
    }
}

DEV void ssd_s3_item(const Params& P, int item) {
    const int tid = tid_fresh(), lane = tid & 63, w = tid >> 6, fr = lane & 15, fq = lane >> 4;
    const int b = item >> 5, c = (item >> 1) & 15, g = item & 1;
    char* ws = P.ws;
    bf16_t* proj = (bf16_t*)(ws + W_PROJ);
    const long rowc = (long)b * 2048 + c * 128;
    bf16_t* R1 = (bf16_t*)(smem + R1_OFF); bf16_t* HB = (bf16_t*)(smem + R2_OFF);
    float* ssq = (float*)(smem + R4_OFF);
    const bf16_t* ydg = (const bf16_t*)(ws + W_NB);
    const float* states = P.out;
    const float* acsg = (const float*)(ws + W_ACS);
    const int hp = tid >> 3, hn0 = (tid & 7) * 16;
    f32x4 hreg[4];
    {
        const float* sp = states + (((long)b * 16 + c) * 16 + g * 8) * 8192 + hp * 128 + hn0;
#pragma unroll
        for (int i = 0; i < 4; ++i) hreg[i] = *(const f32x4*)(sp + i * 4);
    }
    __syncthreads();
    {
        const int nblk = tid & 15, lq = tid >> 4, l0 = lq * 4;
        const int ch0 = 1280 + g * 128 + nblk * 8;
        float o[4][8];
        conv4x8(proj + C_XBC + ch0, rowc + l0, c * 128 + l0, nullptr, P.in[I_CONVW] + ch0, P.in[I_CONVB] + ch0, o);
#pragma unroll
        for (int r = 0; r < 4; ++r) {
            u32x4 q; q.x = pk2(o[r][0], o[r][1]); q.y = pk2(o[r][2], o[r][3]); q.z = pk2(o[r][4], o[r][5]); q.w = pk2(o[r][6], o[r][7]);
            *(u32x4*)(R1 + (l0 + r) * PIT + nblk * 8) = q;
        }
    }
    const int wr = w >> 1, wc = w & 1;
    unsigned ypk[8][2][2][2];
    float ssl[2] = {0.f, 0.f};
#pragma unroll
    for (int e = 0; e < 8; ++e) {
        const int h = g * 8 + e;
        bf16_t* hb = HB + (e & 1) * 64 * PIT;
        {
            u32x4 q0, q1;
            q0.x = pk2(hreg[0][0], hreg[0][1]); q0.y = pk2(hreg[0][2], hreg[0][3]); q0.z = pk2(hreg[1][0], hreg[1][1]); q0.w = pk2(hreg[1][2], hreg[1][3]);
            q1.x = pk2(hreg[2][0], hreg[2][1]); q1.y = pk2(hreg[2][2], hreg[2][3]); q1.z = pk2(hreg[3][0], hreg[3][1]); q1.w = pk2(hreg[3][2], hreg[3][3]);
            *(u32x4*)(hb + hp * PIT + hn0) = q0; *(u32x4*)(hb + hp * PIT + hn0 + 8) = q1;
        }
        if (e < 7) {
            const float* sp = states + (((long)b * 16 + c) * 16 + h + 1) * 8192 + hp * 128 + hn0;
#pragma unroll
            for (int i = 0; i < 4; ++i) hreg[i] = *(const f32x4*)(sp + i * 4);
        }
        u32x2 yq[2][2], zz[2][2]; float ea[2];
#pragma unroll
        for (int m = 0; m < 2; ++m) {
            const int l = wr * 32 + m * 16 + fr;
            ea[m] = acsg[(((long)b * 16 + c) * 16 + h) * 128 + l];
#pragma unroll
            for (int n = 0; n < 2; ++n) {
                const int p0 = wc * 32 + n * 16 + fq * 4;
                yq[m][n] = *(const u32x2*)(ydg + (rowc + l) * 1024 + h * 64 + p0);
                zz[m][n] = *(const u32x2*)(proj + (rowc + l) * PLD + C_ZA + h * 64 + p0);
            }
        }
        __syncthreads();
        f32x4 yo[2][2];
#pragma unroll
        for (int m = 0; m < 2; ++m)
#pragma unroll
            for (int n = 0; n < 2; ++n) yo[m][n] = (f32x4){0.f, 0.f, 0.f, 0.f};
#pragma unroll
        for (int ks = 0; ks < 4; ++ks) {
            bf16x8 af[2], bfm[2];
#pragma unroll
            for (int m = 0; m < 2; ++m) af[m] = *(const bf16x8*)(R1 + (wr * 32 + m * 16 + fr) * PIT + ks * 32 + fq * 8);
#pragma unroll
            for (int n = 0; n < 2; ++n) bfm[n] = *(const bf16x8*)(hb + (wc * 32 + n * 16 + fr) * PIT + ks * 32 + fq * 8);
#pragma unroll
            for (int m = 0; m < 2; ++m)
#pragma unroll
                for (int n = 0; n < 2; ++n) yo[m][n] = mfma16(bfm[n], af[m], yo[m][n]);
        }
#pragma unroll
        for (int m = 0; m < 2; ++m) {
            const float eam = __expf(ea[m]);
#pragma unroll
            for (int n = 0; n < 2; ++n) {
                const float v0 = (bflo(yq[m][n].x) + eam * yo[m][n][0]) * siluf(bflo(zz[m][n].x)), v1 = (bfhi(yq[m][n].x) + eam * yo[m][n][1]) * siluf(bfhi(zz[m][n].x));
                const float v2 = (bflo(yq[m][n].y) + eam * yo[m][n][2]) * siluf(bflo(zz[m][n].y)), v3 = (bfhi(yq[m][n].y) + eam * yo[m][n][3]) * siluf(bfhi(zz[m][n].y));
                ssl[m] += v0 * v0 + v1 * v1 + v2 * v2 + v3 * v3;
                ypk[e][m][n][0] = pk2(v0, v1); ypk[e][m][n][1] = pk2(v2, v3);
            }
        }
    }
#pragma unroll
    for (int m = 0; m < 2; ++m) {
        float ss = ssl[m];
        ss += __shfl_xor(ss, 16); ss += __shfl_xor(ss, 32);
        if (fq == 0) ssq[wc * 128 + wr * 32 + m * 16 + fr] = ss;
    }
    __syncthreads();
#pragma unroll
    for (int m = 0; m < 2; ++m) {
        const int l = wr * 32 + m * 16 + fr;
        const float rstd = rsqrtf((ssq[l] + ssq[128 + l]) * (1.f / 512.f) + EPS);
#pragma unroll
        for (int e = 0; e < 8; ++e)
#pragma unroll
            for (int n = 0; n < 2; ++n) {
                const int h = g * 8 + e, p0 = wc * 32 + n * 16 + fq * 4;
                const f32x4 gg = *(const f32x4*)(P.in[I_SSDG] + h * 64 + p0);
                const unsigned a0 = ypk[e][m][n][0], a1 = ypk[e][m][n][1];
                u32x2 o; o.x = pk2(bflo(a0) * rstd * gg[0], bfhi(a0) * rstd * gg[1]); o.y = pk2(bflo(a1) * rstd * gg[2], bfhi(a1) * rstd * gg[3]);
                *(u32x2*)(proj + (rowc + l) * PLD + C_ZA + h * 64 + p0) = o;
            }
    }
}

DEV void ssd_sample_item(const Params& P, int item) {
    const int tid = tid_fresh();
    const int b = item >> 1, g = item & 1;
    char* ws = P.ws;
    bf16_t* proj = (bf16_t*)(ws + W_PROJ);
    const long row0 = NPROMPT + (long)b * 4;
    float* xs = (float*)smem;
    float* Bs = xs + 2048;
    float* Cs = Bs + 512;
    float* dts = Cs + 512;
    float* das = dts + 32;
    float* vs = das + 32;
    float* red = vs + 2048;
    float* zs = red + 32;
    for (int u = tid; u < 768; u += 512) {
        int ch; float* dst; int dcol;
        if (u < 512) { ch = g * 512 + u; dst = xs; dcol = u; }
        else if (u < 640) { ch = 1024 + g * 128 + (u - 512); dst = Bs; dcol = u - 512; }
        else { ch = 1280 + g * 128 + (u - 640); dst = Cs; dcol = u - 640; }
        const int pitch = u < 512 ? 512 : 128;
        float full[7];
#pragma unroll
        for (int i = 0; i < 3; ++i) full[i] = P.in[I_CONV][((long)b * 3 + i) * 1536 + ch];
#pragma unroll
        for (int i = 0; i < 4; ++i) full[3 + i] = __uint_as_float(((unsigned)proj[(row0 + i) * PLD + C_XBC + ch]) << 16);
        const float w0 = P.in[I_CONVW][ch], w1 = P.in[I_CONVW][1536 + ch], w2 = P.in[I_CONVW][3072 + ch], w3 = P.in[I_CONVW][4608 + ch], bias = P.in[I_CONVB][ch];
#pragma unroll
        for (int t = 0; t < 4; ++t) dst[t * pitch + dcol] = siluf(bias + w0 * full[t] + w1 * full[t + 1] + w2 * full[t + 2] + w3 * full[t + 3]);
    }
    for (int u = tid; u < 4 * 256; u += 512) {
        const int t = u >> 8, c2 = (u & 255) * 2;
        const unsigned zz = *(const unsigned*)(proj + (row0 + t) * PLD + C_ZA + g * 512 + c2);
        zs[t * 512 + c2] = bflo(zz); zs[t * 512 + c2 + 1] = bfhi(zz);
    }
    if (tid < 32) {
        const int t = tid >> 3, e = tid & 7, h = g * 8 + e;
        const float x = ((const float*)(ws + W_DTR))[(row0 + t) * 16 + h] + P.in[I_DTB][h];
        const float d = x > 20.f ? x : log1pf(__expf(x));
        dts[tid] = d; das[tid] = __expf(-d * __expf(P.in[I_ALOG][h]));
    }
    __syncthreads();
    const int p = tid >> 3, nb = tid & 7, n0 = nb * 16;
    f32x4 hn[4];
    {
        const float* sp0 = P.in[I_SSD] + (((long)b * 16 + g * 8) * 64 + p) * 128 + n0;
#pragma unroll
        for (int i = 0; i < 4; ++i) hn[i] = *(const f32x4*)(sp0 + i * 4);
    }
    for (int e = 0; e < 8; ++e) {
        const int h = g * 8 + e;
        float* op = P.out + O_SSDS + (((long)b * 16 + h) * 64 + p) * 128 + n0;
        f32x4 hv[4];
#pragma unroll
        for (int i = 0; i < 4; ++i) hv[i] = hn[i];
        if (e < 7) {
            const float* sp = P.in[I_SSD] + (((long)b * 16 + h + 1) * 64 + p) * 128 + n0;
#pragma unroll
            for (int i = 0; i < 4; ++i) hn[i] = *(const f32x4*)(sp + i * 4);
        }
        const float dsk = P.in[I_SSDD][h];
#pragma unroll
        for (int t = 0; t < 4; ++t) {
            const float dec = das[t * 8 + e], xv = xs[t * 512 + e * 64 + p], coef = dts[t * 8 + e] * xv;
            float part = 0.f;
#pragma unroll
            for (int i = 0; i < 4; ++i) {
                const f32x4 bv = *(const f32x4*)(Bs + t * 128 + n0 + i * 4), cv = *(const f32x4*)(Cs + t * 128 + n0 + i * 4);
                hv[i] = hv[i] * dec + bv * coef;
                part += hv[i][0] * cv[0] + hv[i][1] * cv[1] + hv[i][2] * cv[2] + hv[i][3] * cv[3];
            }
            part += __shfl_xor(part, 1); part += __shfl_xor(part, 2); part += __shfl_xor(part, 4);
            if (nb == 0) {
                const float z = zs[t * 512 + e * 64 + p];
                vs[t * 512 + e * 64 + p] = (part + dsk * xv) * siluf(z);
            }
        }
#pragma unroll
        for (int i = 0; i < 4; ++i) *(f32x4*)(op + i * 4) = hv[i];
    }
    __syncthreads();
    {
        const int t = tid >> 7, cidx = tid & 127;
        float v[4]; float ss = 0.f;
#pragma unroll
        for (int i = 0; i < 4; ++i) { v[i] = vs[t * 512 + cidx * 4 + i]; ss += v[i] * v[i]; }
        ss = wave_sum(ss);
        if ((tid & 63) == 0) red[tid >> 6] = ss;
        __syncthreads();
        const float tot = red[t * 2] + red[t * 2 + 1];
        const float rstd = rsqrtf(tot * (1.f / 512.f) + EPS);
        const f32x4 gg = *(const f32x4*)(P.in[I_SSDG] + g * 512 + cidx * 4);
        u32x2 o; o.x = pk2(v[0] * rstd * gg[0], v[1] * rstd * gg[1]); o.y = pk2(v[2] * rstd * gg[2], v[3] * rstd * gg[3]);
        *(u32x2*)(proj + (row0 + t) * PLD + C_ZA + g * 512 + cidx * 4) = o;
    }
    __syncthreads();
}

constexpr int S5P = 20;
template <bool SAMPLE>
DEV void s5_item(const Params& P, int g, long rowbase, int bidx) {
    const int tid = tid_fresh(), lane = tid & 63, w = tid >> 6, fr = lane & 15, fq = lane >> 4;
    constexpr int TPW = SAMPLE ? 32 : 256;
    bf16_t* proj = (bf16_t*)(P.ws + W_PROJ);
    float* buf = (float*)smem + w * (128 * S5P);
    float* carry = (float*)smem + 8 * 128 * S5P;
    float* fs = carry + 1024 + w * 128;
    float ar, ai;
    {
        const float lr = P.in[I_LRE][g * 64 + lane], li = P.in[I_LIM][g * 64 + lane], delta = expf(P.in[I_LDT][g]);
        const float mag = expf(lr * delta), ang = li * delta;
        ar = mag * cosf(ang); ai = mag * sinf(ang);
        const float qre = ar - 1.f, den = lr * lr + li * li;
        fs[lane] = (qre * lr + ai * li) / den; fs[64 + lane] = (ai * lr - qre * li) / den;
    }
    lds_fence();
    bf16x8 bbf[8];
#pragma unroll
    for (int j = 0; j < 8; ++j) {
        bf16x8 z = {0, 0, 0, 0, 0, 0, 0, 0};
        if (fq < 2) {
            const int p = (j & 3) * 16 + fr;
            const float f_r = fs[p], f_i = fs[64 + p];
            const float* br = P.in[I_BRE] + ((long)(g * 64 + p)) * 16 + fq * 8;
            const float* bi = P.in[I_BIM] + ((long)(g * 64 + p)) * 16 + fq * 8;
            const f32x4 r0 = *(const f32x4*)br, r1 = *(const f32x4*)(br + 4), i0 = *(const f32x4*)bi, i1 = *(const f32x4*)(bi + 4);
            f32x4 o0, o1;
            if (j < 4) { o0 = r0 * f_r - i0 * f_i; o1 = r1 * f_r - i1 * f_i; }
            else { o0 = i0 * f_r + r0 * f_i; o1 = i1 * f_r + r1 * f_i; }
            u32x4 q; q.x = pk2(o0[0], o0[1]); q.y = pk2(o0[2], o0[3]); q.z = pk2(o1[0], o1[1]); q.w = pk2(o1[2], o1[3]);
            z = __builtin_bit_cast(bf16x8, q);
        }
        bbf[j] = z;
    }
    bf16x8 ccf[4];
#pragma unroll
    for (int ks = 0; ks < 4; ++ks) {
        const float* src = (ks < 2 ? P.in[I_CRE] : P.in[I_CIM]) + ((long)(g * 16 + fr)) * 64 + (ks & 1) * 32 + fq * 8;
        f32x4 c0 = *(const f32x4*)src, c1 = *(const f32x4*)(src + 4);
        if (ks >= 2) { c0 = -c0; c1 = -c1; }
        u32x4 q; q.x = pk2(c0[0], c0[1]); q.y = pk2(c0[2], c0[3]); q.z = pk2(c1[0], c1[1]); q.w = pk2(c1[2], c1[3]);
        ccf[ks] = __builtin_bit_cast(bf16x8, q);
    }
    const f32x4 dsk = *(const f32x4*)(P.in[I_S5D] + g * 16 + fq * 4);
    const long roww = rowbase + (long)w * TPW;
    float xr = 0.f, xi = 0.f;
    float sre[8], sim[8];
#pragma unroll
    for (int j = 0; j < 8; ++j) { sre[j] = 0.f; sim[j] = 0.f; }
    if (SAMPLE) {
#pragma unroll
        for (int j = 0; j < 8; ++j) {
            const long seq = (roww - NPROMPT) / 4 + j;
            sre[j] = P.in[I_S5R][(seq * 64 + g) * 64 + lane]; sim[j] = P.in[I_S5I][(seq * 64 + g) * 64 + lane];
        }
    }
    constexpr int NPASS = SAMPLE ? 1 : 2;
#pragma unroll 1
    for (int pass = 0; pass < NPASS; ++pass) {
        const bool last = (pass == NPASS - 1);
        if (!SAMPLE && pass == 1) {
            carry[w * 128 + lane] = xr; carry[w * 128 + 64 + lane] = xi;
            __syncthreads();
            float pr = ar, pi = ai;
#pragma unroll
            for (int q = 0; q < 8; ++q) { const float nr = pr * pr - pi * pi, ni = 2.f * pr * pi; pr = nr; pi = ni; }
            float sr = 0.f, si = 0.f;
            for (int ww = 0; ww < w; ++ww) {
                const float cr = carry[ww * 128 + lane], ci = carry[ww * 128 + 64 + lane];
                const float nr = pr * sr - pi * si + cr, ni = pr * si + pi * sr + ci; sr = nr; si = ni;
            }
            xr = sr; xi = si;
        }
        if (!SAMPLE && pass == 0 && w == 7) continue;
        bf16x8 ufn = {0, 0, 0, 0, 0, 0, 0, 0};
        if (fq < 2) ufn = *(const bf16x8*)(proj + (roww + fr) * PLD + C_UB + g * 16 + fq * 8);
#pragma unroll 1
        for (int sb = 0; sb < TPW / 16; ++sb) {
            const long r = roww + sb * 16;
            const bf16x8 uf = ufn;
            if (fq < 2 && sb + 1 < TPW / 16) ufn = *(const bf16x8*)(proj + (r + 16 + fr) * PLD + C_UB + g * 16 + fq * 8);
            u32x2* up = (u32x2*)(proj + (r + fr) * PLD + C_UB + g * 16 + fq * 4);
            u32x2 uu = {0u, 0u};
            if (last) uu = *up;
            const f32x4 zero = {0.f, 0.f, 0.f, 0.f};
#pragma unroll
            for (int j = 0; j < 8; ++j) {
                const f32x4 d = mfma16(uf, bbf[j], zero);
                *(f32x4*)(buf + (j * 16 + fr) * S5P + fq * 4) = d;
            }
            lds_fence();
#pragma unroll
            for (int q = 0; q < 4; ++q) {
                f32x4 br = *(const f32x4*)(buf + lane * S5P + q * 4), bi = *(const f32x4*)(buf + (64 + lane) * S5P + q * 4);
                if (SAMPLE) {
#pragma unroll
                    for (int j = 0; j < 8; ++j) if (j == sb * 4 + q) { xr = sre[j]; xi = sim[j]; }
                }
#pragma unroll
                for (int i = 0; i < 4; ++i) {
                    const float nr = ar * xr - ai * xi + br[i], ni = ar * xi + ai * xr + bi[i];
                    xr = nr; xi = ni; br[i] = nr; bi[i] = ni;
                }
                if (last) { *(f32x4*)(buf + lane * S5P + q * 4) = br; *(f32x4*)(buf + (64 + lane) * S5P + q * 4) = bi; }
                if (SAMPLE) {
                    const long seq = (r - NPROMPT) / 4 + q;
                    P.out[O_S5RS + (seq * 64 + g) * 64 + lane] = xr; P.out[O_S5IS + (seq * 64 + g) * 64 + lane] = xi;
                }
            }
            if (last) {
                lds_fence();
                f32x4 y = {0.f, 0.f, 0.f, 0.f};
#pragma unroll
                for (int ks = 0; ks < 4; ++ks) {
                    float xv[8];
#pragma unroll
                    for (int i = 0; i < 8; ++i) xv[i] = buf[(ks * 32 + fq * 8 + i) * S5P + fr];
                    u32x4 q; q.x = pk2(xv[0], xv[1]); q.y = pk2(xv[2], xv[3]); q.z = pk2(xv[4], xv[5]); q.w = pk2(xv[6], xv[7]);
                    y = mfma16(ccf[ks], __builtin_bit_cast(bf16x8, q), y);
                }
                const float y0 = geluf(y[0] + dsk[0] * bflo(uu.x)), y1 = geluf(y[1] + dsk[1] * bfhi(uu.x));
                const float y2 = geluf(y[2] + dsk[2] * bflo(uu.y)), y3 = geluf(y[3] + dsk[3] * bfhi(uu.y));
                u32x2 o; o.x = pk2(y0, y1); o.y = pk2(y2, y3);
                *up = o;
            }
            lds_fence();
        }
    }
    if (!SAMPLE && w == 7) {
        P.out[O_S5RP + ((long)bidx * 64 + g) * 64 + lane] = xr; P.out[O_S5IP + ((long)bidx * 64 + g) * 64 + lane] = xi;
    }
    __syncthreads();
}

__global__ void __launch_bounds__(512) hymba_fwd(Params P) {
#ifdef PROBE_K
    unsigned long long tb_[9]; int nb_ = 0;
#define TB() do { tb_[nb_++] = wall_clock64(); } while (0)
    TB();
#else
#define TB() do {} while (0)
#endif
    const int G = gridDim.x, bid = blockIdx.x;
    char* ws = P.ws;
    bf16_t* proj = (bf16_t*)(ws + W_PROJ);
    unsigned* barw = (unsigned*)(ws + W_BAR);
    volatile LAS unsigned* stw = (volatile LAS unsigned*)(smem + 131072);
    if (threadIdx.x < 4) stw[threadIdx.x] = 0u;
    __syncthreads();
    const XcdBarrier xb = xcd_barrier_post(barw, stw);
#ifndef NO_P0
    phase0(P);
#endif
    xcd_barrier(xb); TB();
#ifndef NO_P1
    for (int L = bid; L < 1188; L += G) {
        int pm, pn; tile_of(L, 66, 18, pm, pn);
        gemm_tile((const bf16_t*)(ws + W_NB), 1024, (const bf16_t*)(ws + W_WTIN), 1024, 1024, pm * 256, pn * 256, EpiBf16{proj, PLD, (const float*)(ws + W_RSTD)});
    }
    for (int L = (bid + G - 1188 % G) % G; L < 264; L += G) {
        int pm, pn; tile_of(L, 66, 4, pm, pn);
        gemm_tile((const bf16_t*)(ws + W_PB), 256, (const bf16_t*)(ws + W_WTPP), 256, 256, pm * 256, pn * 256, EpiBf16{(bf16_t*)(ws + W_PP), 1024, nullptr});
    }
#endif
    xcd_barrier(xb); TB();
    for (int idx = bid * 512 + threadIdx.x; idx < (8 + 128) * 3 * 1536; idx += G * 512) {
        const int ch = idx % 1536, sj = idx / 1536, j = sj % 3, sq = sj / 3;
        const long row = sq < 8 ? (long)sq * 2048 + 2045 + j : NPROMPT + (long)(sq - 8) * 4 + 1 + j;
        const float v = __uint_as_float(((unsigned)proj[row * PLD + C_XBC + ch]) << 16);
        if (sq < 8) P.out[O_CONVP + ((long)sq * 3 + j) * 1536 + ch] = v; else P.out[O_CONVS + ((long)(sq - 8) * 3 + j) * 1536 + ch] = v;
    }
#ifdef PROBE2
    unsigned long long tq_[5]; tq_[0] = wall_clock64();
#endif
#ifndef NO_S1
    for (int it = bid; it < 256; it += G) ssd_s1_item(P, it);
#endif
#ifdef PROBE2
    tq_[1] = wall_clock64();
#endif
#ifndef NO_SS
    for (int it = bid; it < 256; it += G) ssd_sample_item(P, it);
#endif
#ifdef PROBE2
    tq_[2] = wall_clock64();
#endif
#ifndef NO_S5P
    for (int it = bid; it < 512; it += G) s5_item<false>(P, it & 63, (long)(it >> 6) * 2048, it >> 6);
#endif
#ifdef PROBE2
    tq_[3] = wall_clock64();
#endif
#ifndef NO_S5S
    for (int it = bid; it < 128; it += G) s5_item<true>(P, it & 63, NPROMPT + (long)(it >> 6) * 256, 0);
#endif
#ifdef PROBE2
    tq_[4] = wall_clock64();
    { const unsigned long long d = tq_[PROBE2 + 1] - tq_[PROBE2], t0 = wall_clock64(); while (wall_clock64() - t0 < d) __builtin_amdgcn_s_sleep(8); }
#endif
    xcd_barrier(xb); TB();
    if (bid & 1) ssd_s2(P);
    {
        const EpiGlu eg{proj, P.in[I_GLUB]};
        for (int L = bid; L < 256; L += G) {
            int pm, pn; tile_of(L, 64, 4, pm, pn);
            gemm_tile(proj + C_UB, PLD, (const bf16_t*)(ws + W_WTGLU), 1024, 1024, pm * 256, pn * 256, eg);
        }
        for (int L = bid; L < 256; L += G)
            gemm_small(proj + C_UB, PLD, (const bf16_t*)(ws + W_WTGLU), 1024, 1024, NPROMPT + (L >> 3) * 16, (L & 7) * 128, eg);
    }
    if (!(bid & 1)) ssd_s2(P);
    xcd_barrier(xb); TB();
#ifndef NO_S3
    for (int it = bid; it < 256; it += G) ssd_s3_item(P, it);
#endif
    xcd_barrier(xb); TB();
#ifndef NO_P5
    {
        const EpiOut eo{P.in[I_XP], P.in[I_XS], (bf16_t*)(ws + W_NB), (float*)(ws + W_RSS1)};
        if (bid & 1)
            for (int L = bid; L < 256; L += G)
                gemm_small(proj, PLD, (const bf16_t*)(ws + W_WTOUT), 2048, 2048, NPROMPT + (L >> 3) * 16, (L & 7) * 128, eo);
        for (int L = bid; L < 256; L += G) {
            int pm, pn; tile_of(L, 64, 4, pm, pn);
            gemm_tile(proj, PLD, (const bf16_t*)(ws + W_WTOUT), 2048, 2048, pm * 256, pn * 256, eo);
        }
        if (!(bid & 1))
            for (int L = bid; L < 256; L += G)
                gemm_small(proj, PLD, (const bf16_t*)(ws + W_WTOUT), 2048, 2048, NPROMPT + (L >> 3) * 16, (L & 7) * 128, eo);
    }
#endif
    xcd_barrier(xb); TB();
#ifndef NO_P6
    {
        const EpiPle ep{P.out, (const bf16_t*)(ws + W_NB), (const bf16_t*)(ws + W_PP), (const float*)(ws + W_RSS1), (float*)(ws + W_RSS2)};
        if (bid & 1)
            for (int L = bid; L < 256; L += G)
                gemm_small((const bf16_t*)(ws + W_NB), 1024, (const bf16_t*)(ws + W_WTGATE), 1024, 1024, NPROMPT + (L >> 3) * 16, (L & 7) * 128, ep);
        for (int L = bid; L < 256; L += G) {
            int pm, pn; tile_of(L, 64, 4, pm, pn);
            gemm_tile((const bf16_t*)(ws + W_NB), 1024, (const bf16_t*)(ws + W_WTGATE), 1024, 1024, pm * 256, pn * 256, ep);
        }
        if (!(bid & 1))
            for (int L = bid; L < 256; L += G)
                gemm_small((const bf16_t*)(ws + W_NB), 1024, (const bf16_t*)(ws + W_WTGATE), 1024, 1024, NPROMPT + (L >> 3) * 16, (L & 7) * 128, ep);
    }
#endif
    xcd_barrier(xb); TB();
    {
        const float* rss2 = (const float*)(ws + W_RSS2);
        for (int idx = bid * 512 + threadIdx.x; idx < NTOK * 256; idx += G * 512) {
            const int row = idx >> 8, c4 = (idx & 255) * 4;
            const f32x4 r0 = *(const f32x4*)(rss2 + (long)row * 16), r1 = *(const f32x4*)(rss2 + (long)row * 16 + 4), r2 = *(const f32x4*)(rss2 + (long)row * 16 + 8), r3 = *(const f32x4*)(rss2 + (long)row * 16 + 12);
            const float tot = (((r0[0] + r0[1]) + (r0[2] + r0[3])) + ((r1[0] + r1[1]) + (r1[2] + r1[3]))) + (((r2[0] + r2[1]) + (r2[2] + r2[3])) + ((r3[0] + r3[1]) + (r3[2] + r3[3])));
            const float rstd = rsqrtf(tot * (1.f / 1024.f) + EPS);
            f32x4* p = (f32x4*)(P.out + (long)row * 1024 + c4);
            const f32x4 gf = *(const f32x4*)(P.in[I_GFIN] + c4);
            *p = *p * rstd * gf;
        }
    }
#ifdef PROBE_K
    { TB(); const unsigned long long d = tb_[PROBE_K + 1] - tb_[PROBE_K], t0 = wall_clock64(); while (wall_clock64() - t0 < d) __builtin_amdgcn_s_sleep(8); }
#endif
}

extern "C" void kernel_launch(void* const* d_in, const int* in_sizes, int n_in, void* d_out, int out_size, void* d_ws, size_t ws_size, hipStream_t stream) {
    static int grid_blocks = 0;
    if (grid_blocks == 0) {
        if (n_in != 31 || out_size != (int)O_END || ws_size < W_END) {
            fprintf(stderr, "kernel_launch: unexpected shapes n_in %d out %d ws %zu (need %zu)\n", n_in, out_size, ws_size, (size_t)W_END);
            grid_blocks = -1; return;
        }
        int dev = 0, cus = 0, per_cu = 0;
        hipGetDevice(&dev);
        hipDeviceGetAttribute(&cus, hipDeviceAttributeMultiprocessorCount, dev);
        hipFuncSetAttribute((const void*)hymba_fwd, hipFuncAttributeMaxDynamicSharedMemorySize, LDS_BYTES);
        hipOccupancyMaxActiveBlocksPerMultiprocessor(&per_cu, (const void*)hymba_fwd, 512, LDS_BYTES);
        if (per_cu < 1) { fprintf(stderr, "kernel_launch: occupancy query says %d blocks/CU\n", per_cu); per_cu = 1; }
        grid_blocks = cus;
        (void)hipGetLastError();
    }
    if (grid_blocks < 0) return;
    if (hipMemsetAsync((char*)d_ws + W_BAR, 0, XCD_BAR_WORDS * sizeof(unsigned), stream) != hipSuccess) { fprintf(stderr, "kernel_launch: memset of the barrier words failed\n"); return; }
    Params p{};
    for (int i = 0; i < 31; ++i) p.in[i] = (const float*)d_in[i];
    p.out = (float*)d_out; p.ws = (char*)d_ws;
    void* args[] = {&p};
    hipError_t e = hipLaunchCooperativeKernel((const void*)hymba_fwd, dim3(grid_blocks), dim3(512), args, LDS_BYTES, stream);
    if (e != hipSuccess) fprintf(stderr, "cooperative launch failed: %s (grid %d)\n", hipGetErrorString(e), grid_blocks);
}
```

```cpp
#include <hip/hip_runtime.h>
#include <hip/hip_cooperative_groups.h>
#include <cstdio>
namespace cg = cooperative_groups;

typedef unsigned short bf16_t;
typedef short bf16x8 __attribute__((ext_vector_type(8)));
typedef float f32x4 __attribute__((ext_vector_type(4)));
typedef unsigned u32x2 __attribute__((ext_vector_type(2)));
typedef unsigned u32x4 __attribute__((ext_vector_type(4)));
#define DEV __device__ __forceinline__

constexpr int NPROMPT = 16384, NSAMPLE = 512, NTOK = 16896;
constexpr int PLD = 4608;
constexpr int C_ZA = 0, C_ZB = 1024, C_XBC = 2048, C_UB = 3584;
constexpr float EPS = 1e-6f;
constexpr long O_YP = 0, O_YS = 16777216, O_SSDP = 17301504, O_CONVP = 18350080, O_S5RP = 18386944, O_S5IP = 18419712,
               O_SSDS = 18452480, O_CONVS = 35229696, O_S5RS = 35819520, O_S5IS = 36343808, O_END = 36868096;
constexpr size_t W_WTIN = 0;
constexpr size_t W_WTOUT = W_WTIN + 4608ull * 1024 * 2;
constexpr size_t W_WTGLU = W_WTOUT + 1024ull * 2048 * 2;
constexpr size_t W_WTGATE = W_WTGLU + 1024ull * 1024 * 2;
constexpr size_t W_WTPP = W_WTGATE + 1024ull * 1024 * 2;
constexpr size_t W_NB = W_WTPP + 1024ull * 256 * 2;
constexpr size_t W_PB = W_NB + 16896ull * 1024 * 2;
constexpr size_t W_DTR = W_PB + 16896ull * 256 * 2;
constexpr size_t W_ACS = W_DTR + 16896ull * 16 * 4;
constexpr size_t W_CDEC = W_ACS + 16384ull * 16 * 4;
constexpr size_t W_RSS1 = W_CDEC + 8192;
constexpr size_t W_RSS2 = W_RSS1 + 16896ull * 16 * 4;
constexpr size_t W_PROJ = W_RSS2 + 16896ull * 16 * 4;
constexpr size_t W_PP = W_PROJ + 16896ull * 4608 * 2;
constexpr size_t W_RSTD = W_PP + 16896ull * 1024 * 2;
constexpr size_t W_BAR = W_RSTD + 16896ull * 4;
constexpr size_t W_END = W_BAR + 16384;

constexpr int LDS_BYTES = 131072 + 64;

struct Params {
    const float* in[31];
    float* out;
    char* ws;
};
enum { I_XP = 0, I_XS, I_PP, I_PS, I_SSD, I_CONV, I_S5R, I_S5I, I_WIN, I_GIN, I_CONVW, I_CONVB, I_DTB, I_ALOG, I_SSDD, I_SSDG,
       I_LRE, I_LIM, I_LDT, I_BRE, I_BIM, I_CRE, I_CIM, I_S5D, I_GLUW, I_GLUB, I_WOUT, I_GPLE, I_WGATE, I_WPP, I_GFIN };

extern __shared__ __attribute__((aligned(16))) char smem[];

DEV unsigned pk2(float lo, float hi) { unsigned r; asm("v_cvt_pk_bf16_f32 %0, %1, %2" : "=v"(r) : "v"(lo), "v"(hi)); return r; }
DEV float bflo(unsigned u) { return __uint_as_float(u << 16); }
DEV float bfhi(unsigned u) { return __uint_as_float(u & 0xffff0000u); }
DEV float wave_sum(float v) {
#pragma unroll
    for (int o = 1; o < 64; o <<= 1) v += __shfl_xor(v, o);
    return v;
}
DEV float siluf(float v) { return v / (1.f + __expf(-v)); }
DEV float sigmf(float v) { return 1.f / (1.f + __expf(-v)); }
DEV float geluf(float y) { float z = 0.7978845608f * (y + 0.044715f * y * y * y); return y / (1.f + __expf(-2.f * z)); }
DEV f32x4 mfma16(bf16x8 a, bf16x8 b, f32x4 c) { return __builtin_amdgcn_mfma_f32_16x16x32_bf16(a, b, c, 0, 0, 0); }
DEV int tid_fresh() { int t = threadIdx.x; asm volatile("" : "+v"(t)); return t; }
DEV void lds_fence() { asm volatile("s_waitcnt lgkmcnt(0)" ::: "memory"); }


#define XB_TMO      128
#define XB_XCNT(j)  (256  + 64 * (j))
#define XB_XSUB(j)  (1280 + 64 * (j))
#define XB_XGEN(j)  (2304 + 64 * (j))
#define XB_TOP      3328
#define XB_TOPGEN   3392
#define XCD_BAR_WORDS 3456
#define XB_SPIN_CAP (1u << 22)
#define LAS __attribute__((address_space(3)))
DEV unsigned xb_ld(unsigned* p) { return __hip_atomic_load(p, __ATOMIC_RELAXED, __HIP_MEMORY_SCOPE_AGENT); }
DEV unsigned xb_add(unsigned* p, unsigned v) { return __hip_atomic_fetch_add(p, v, __ATOMIC_RELAXED, __HIP_MEMORY_SCOPE_AGENT); }
DEV unsigned xb_xcc_id() { return (unsigned)__builtin_amdgcn_s_getreg((3 << 11) | 20) & 0xFu; }
#define XB_SPIN(cond, bar) do { unsigned _sp = 0; while (cond) { __builtin_amdgcn_s_sleep(1); \
    if ((++_sp & 255u) == 0u) { if (xb_ld(&(bar)[XB_TMO])) break; if (_sp > XB_SPIN_CAP) { atomicAdd(&(bar)[XB_TMO], 1u); break; } } } } while (0)
struct XcdBarrier { unsigned* bar; unsigned x; volatile LAS unsigned* st; };
DEV XcdBarrier xcd_barrier_post(unsigned* bar, volatile LAS unsigned* st) {
    XcdBarrier b; b.bar = bar; b.x = xb_xcc_id(); b.st = st;
    if (threadIdx.x == 0) (void)xb_add(&bar[XB_XCNT(b.x)], 1u);
    return b;
}
DEV void xcd_barrier_complete(unsigned* bar, unsigned x, unsigned& nloc, unsigned& nx) {
    const unsigned G = gridDim.x * gridDim.y * gridDim.z;
    unsigned sum, cnt, mine, sp = 0u;
    for (;;) {
        sum = 0u; cnt = 0u; mine = 0u;
#pragma unroll
        for (unsigned j = 0; j < 16; ++j) { const unsigned c = xb_ld(&bar[XB_XCNT(j)]); sum += c; cnt += (c > 0u) ? 1u : 0u; mine = (j == x) ? c : mine; }
        if (sum == G) break;
        __builtin_amdgcn_s_sleep(1);
        if ((++sp & 255u) == 0u) { if (xb_ld(&bar[XB_TMO])) break; if (sp > XB_SPIN_CAP) { atomicAdd(&bar[XB_TMO], 1u); break; } }
    }
    nloc = mine > 0u ? mine : 1u; nx = cnt > 0u ? cnt : 1u;
}
DEV void xcd_barrier(const XcdBarrier& b) {
    asm volatile("s_waitcnt vmcnt(0)" ::: "memory");
    __syncthreads();
    if (threadIdx.x == 0) {
        unsigned* bar = b.bar;
        __builtin_amdgcn_s_waitcnt(0);
        unsigned nloc = b.st[0], nx = b.st[1];
        if (nloc == 0u) { xcd_barrier_complete(bar, b.x, nloc, nx); b.st[0] = nloc; b.st[1] = nx; }
        const unsigned old = xb_add(&bar[XB_XSUB(b.x)], 1u);
        const unsigned gen = old / nloc;
        if (old + 1u == (gen + 1u) * nloc) {
            __builtin_amdgcn_fence(__ATOMIC_RELEASE, "agent");
            asm volatile("s_waitcnt vmcnt(0)" ::: "memory");
            const unsigned og = xb_add(&bar[XB_TOP], 1u);
            const unsigned tg = og / nx;
            if (og + 1u == (tg + 1u) * nx) xb_add(&bar[XB_TOPGEN], 1u);
            else XB_SPIN(xb_ld(&bar[XB_TOPGEN]) == tg, bar);
            __builtin_amdgcn_fence(__ATOMIC_ACQUIRE, "agent");
            xb_add(&bar[XB_XGEN(b.x)], 1u);
            asm volatile("s_waitcnt vmcnt(0)" ::: "memory");
        } else {
            XB_SPIN(xb_ld(&bar[XB_XGEN(b.x)]) == gen, bar);
            __builtin_amdgcn_fence(__ATOMIC_ACQUIRE, "agent");
            asm volatile("s_waitcnt vmcnt(0)" ::: "memory");
        }
    }
    __syncthreads();
}

constexpr int BM = 256, BK = 64, HALF = 128, HT = HALF * BK;
DEV int lds_byte(int r, int c) {
    int st = (r >> 4) * 2 + (c >> 5), rr = r & 15, cc = c & 31, ob = rr * 64 + cc * 2;
    return st * 1024 + (ob ^ (((ob >> 9) & 1) << 5));
}
DEV void stage_rc(int b, int& R, int& C) {
    int st = b / 1024, sb = b % 1024, swz = sb ^ (((sb >> 9) & 1) << 5);
    R = (st >> 1) * 16 + swz / 64; C = (st & 1) * 32 + (swz % 64) / 2;
}

template <class Epi>
DEV void gemm_tile(const bf16_t* __restrict__ A, int lda, const bf16_t* __restrict__ Bt, int ldb, int K, int brow, int bcol, const Epi& epi) {
    LAS unsigned char* lds = (LAS unsigned char*)smem;
    constexpr int HTB = HT * 2;
    const int tid = tid_fresh(), wid = __builtin_amdgcn_readfirstlane(tid >> 6), lane = tid & 63, wr = wid >> 2, wc = wid & 3, fr = lane & 15, fq = lane >> 4;
    unsigned voffA[2], voffB[2];
#pragma unroll
    for (int i = 0; i < 2; ++i) { int R, C; stage_rc(tid * 16 + i * 8192, R, C); voffA[i] = (unsigned)(R * lda + C) * 2u; voffB[i] = (unsigned)(R * ldb + C) * 2u; }
    const size_t kstep = (size_t)(BK * 2), hstepA = (size_t)HALF * lda * 2, hstepB = (size_t)HALF * ldb * 2;
    const unsigned ldsw = (unsigned)wid * 1024u;
    const int aoff = lds_byte(wr * 64 + fr, fq * 8), boff = lds_byte(wc * 32 + fr, fq * 8);
#define SA(b, h) (((b) * 2 + (h)) * HTB)
#define SB(b, h) ((4 + (b) * 2 + (h)) * HTB)
#define STAGE(bufoff, gbase, voff) do { _Pragma("unroll") for (int _i = 0; _i < 2; ++_i) \
        __builtin_amdgcn_global_load_lds((const unsigned*)((const char*)(gbase) + (voff)[_i]), (LAS unsigned*)(lds + (bufoff) + ldsw + _i * 8192), 16, 0, 0); } while (0)
#define LDA(dst, b, h) do { _Pragma("unroll") for (int m = 0; m < 4; ++m) _Pragma("unroll") for (int k = 0; k < 2; ++k) dst[m][k] = *(const LAS bf16x8*)(lds + SA(b, h) + aoff + m * 2048 + k * 1024); } while (0)
#define LDB(dst, b, h) do { _Pragma("unroll") for (int n = 0; n < 2; ++n) _Pragma("unroll") for (int k = 0; k < 2; ++k) dst[n][k] = *(const LAS bf16x8*)(lds + SB(b, h) + boff + n * 2048 + k * 1024); } while (0)
#define MMA(ai, bj, At, Bt_) do { __builtin_amdgcn_s_setprio(1); _Pragma("unroll") for (int m = 0; m < 4; ++m) _Pragma("unroll") for (int n = 0; n < 2; ++n) _Pragma("unroll") for (int k = 0; k < 2; ++k) \
        acc[ai][bj][m][n] = __builtin_amdgcn_mfma_f32_16x16x32_bf16(Bt_[n][k], At[m][k], acc[ai][bj][m][n], 0, 0, 0); __builtin_amdgcn_s_setprio(0); } while (0)
#define WAIT_V(n) asm volatile("s_waitcnt vmcnt(" #n ")" ::: "memory")
#define WAIT_L(n) asm volatile("s_waitcnt lgkmcnt(" #n ")" ::: "memory")
#define BAR __builtin_amdgcn_s_barrier()
#define SCHED __builtin_amdgcn_sched_barrier(0)
    f32x4 acc[2][2][4][2];
#pragma unroll
    for (int a = 0; a < 2; ++a)
#pragma unroll
        for (int b = 0; b < 2; ++b)
#pragma unroll
            for (int m = 0; m < 4; ++m)
#pragma unroll
                for (int n = 0; n < 2; ++n) acc[a][b][m][n] = (f32x4){0.f, 0.f, 0.f, 0.f};
    bf16x8 At[4][2], B0[2][2], B1[2][2];
    const int nt = K / BK;
    const char* cA = (const char*)A + (size_t)brow * lda * 2; const char* cB = (const char*)Bt + (size_t)bcol * ldb * 2;
    STAGE(SB(0, 0), cB, voffB); STAGE(SA(0, 0), cA, voffA); STAGE(SB(0, 1), cB + hstepB, voffB); STAGE(SA(0, 1), cA + hstepA, voffA);
    if (wr == 1) BAR;
    WAIT_V(4); BAR;
    STAGE(SB(1, 0), cB + kstep, voffB); STAGE(SA(1, 0), cA + kstep, voffA); STAGE(SB(1, 1), cB + hstepB + kstep, voffB);
    WAIT_V(6); BAR;
    for (int t = 0; t < nt - 2; t += 2) {
        const char* a1 = cA + (size_t)(t + 1) * kstep;
        const char* a2 = cA + (size_t)(t + 2) * kstep; const char* b2 = cB + (size_t)(t + 2) * kstep;
        const char* a3 = a2 + kstep; const char* b3 = b2 + kstep;
        LDB(B0, 0, 0); SCHED; LDA(At, 0, 0); STAGE(SA(1, 1), a1 + hstepA, voffA);
        WAIT_L(8); BAR; WAIT_L(0); MMA(0, 0, At, B0); BAR; SCHED;
        LDB(B1, 0, 1); STAGE(SB(0, 0), b2, voffB);
        BAR; WAIT_L(0); MMA(0, 1, At, B1); BAR;
        LDA(At, 0, 1); STAGE(SA(0, 0), a2, voffA);
        BAR; WAIT_L(0); MMA(1, 0, At, B0); BAR; SCHED;
        STAGE(SB(0, 1), b2 + hstepB, voffB);
        WAIT_V(6); BAR; MMA(1, 1, At, B1); BAR;
        LDB(B0, 1, 0); SCHED; LDA(At, 1, 0); STAGE(SA(0, 1), a2 + hstepA, voffA);
        WAIT_L(8); BAR; WAIT_L(0); MMA(0, 0, At, B0); BAR; SCHED;
        LDB(B1, 1, 1); STAGE(SB(1, 0), b3, voffB);
        BAR; WAIT_L(0); MMA(0, 1, At, B1); BAR;
        LDA(At, 1, 1); STAGE(SA(1, 0), a3, voffA);
        BAR; WAIT_L(0); MMA(1, 0, At, B0); BAR; SCHED;
        STAGE(SB(1, 1), b3 + hstepB, voffB);
        WAIT_V(6); BAR; MMA(1, 1, At, B1); BAR;
    }
    { const char* a1 = cA + (size_t)(nt - 1) * kstep;
      LDB(B0, 0, 0); LDA(At, 0, 0); STAGE(SA(1, 1), a1 + hstepA, voffA);
      BAR; WAIT_L(0); MMA(0, 0, At, B0); BAR;
      LDB(B1, 0, 1); BAR; WAIT_L(0); MMA(0, 1, At, B1); BAR;
      LDA(At, 0, 1); WAIT_V(4); BAR; WAIT_L(0); MMA(1, 0, At, B0); MMA(1, 1, At, B1); BAR; }
    { LDB(B0, 1, 0); LDA(At, 1, 0); WAIT_V(2); BAR; WAIT_L(0); MMA(0, 0, At, B0); BAR;
      LDB(B1, 1, 1); WAIT_V(0); BAR; WAIT_L(0); MMA(0, 1, At, B1); BAR;
      LDA(At, 1, 1); BAR; WAIT_L(0); MMA(1, 0, At, B0); MMA(1, 1, At, B1); BAR; }
    if (wr == 0) BAR;
    epi_big(epi, acc, brow, bcol, wr, wc, fr, fq);
    __syncthreads();
#undef SA
#undef SB
#undef STAGE
#undef LDA
#undef LDB
#undef MMA
}

DEV void tile_of(int L, int nM, int nN, int& pm, int& pn) {
    const int nwg = nM * nN; int wgid = L;
    { const int q = nwg / 8, r = nwg % 8, xcd = wgid % 8, off = wgid / 8; wgid = (xcd < r ? xcd * (q + 1) : r * (q + 1) + (xcd - r) * q) + off; }
    const int nig = 8 * nN, gid = wgid / nig, fm = gid * 8, gsz = (nM - fm) < 8 ? (nM - fm) : 8;
    pm = fm + ((wgid % nig) % gsz); pn = (wgid % nig) / gsz;
}

struct EpiBf16 {
    bf16_t* dst; int ld; const float* rstd;
    struct Ld { float rs; };
    DEV void load(int row, int col, Ld& d) const { d.rs = rstd ? rstd[row] : 1.f; }
    DEV void apply(int row, int col, const f32x4& v, const Ld& d, float& ss, float rowv) const {
        u32x2 o; o.x = pk2(v[0] * d.rs, v[1] * d.rs); o.y = pk2(v[2] * d.rs, v[3] * d.rs);
        *(u32x2*)(dst + (long)row * ld + col) = o;
    }
    DEV float rowload(int row) const { return 0.f; }
    DEV void rowdone(int row, float ss, int fq, int slot) const {}
    DEV void rowput(int row, float tot, int slot) const {}
};
struct EpiGlu {
    bf16_t* proj; const float* glu_b;
    struct Ld { u32x2 g, z; f32x4 b; };
    DEV void load(int row, int col, Ld& d) const {
        d.g = *(const u32x2*)(proj + (long)row * PLD + C_UB + col); d.z = *(const u32x2*)(proj + (long)row * PLD + C_ZB + col); d.b = *(const f32x4*)(glu_b + col);
    }
    DEV void apply(int row, int col, const f32x4& v, const Ld& d, float& ss, float rowv) const {
        const float y0 = bflo(d.g.x) * sigmf(v[0] + d.b[0]) * siluf(bflo(d.z.x)), y1 = bfhi(d.g.x) * sigmf(v[1] + d.b[1]) * siluf(bfhi(d.z.x));
        const float y2 = bflo(d.g.y) * sigmf(v[2] + d.b[2]) * siluf(bflo(d.z.y)), y3 = bfhi(d.g.y) * sigmf(v[3] + d.b[3]) * siluf(bfhi(d.z.y));
        u32x2 o; o.x = pk2(y0, y1); o.y = pk2(y2, y3);
        *(u32x2*)(proj + (long)row * PLD + C_ZB + col) = o;
    }
    DEV float rowload(int row) const { return 0.f; }
    DEV void rowdone(int row, float ss, int fq, int slot) const {}
    DEV void rowput(int row, float tot, int slot) const {}
};
struct EpiOut {
    const float* xp; const float* xs; bf16_t* h1b; float* rss;
    struct Ld { f32x4 x; };
    DEV void load(int row, int col, Ld& d) const {
        const float* xrow = row < NPROMPT ? xp + (long)row * 1024 : xs + (long)(row - NPROMPT) * 1024;
        d.x = *(const f32x4*)(xrow + col);
    }
    DEV void apply(int row, int col, const f32x4& a, const Ld& d, float& ss, float rowv) const {
        const f32x4 v = a + d.x;
        u32x2 o; o.x = pk2(v[0], v[1]); o.y = pk2(v[2], v[3]);
        *(u32x2*)(h1b + (long)row * 1024 + col) = o;
        const float r0 = bflo(o.x), r1 = bfhi(o.x), r2 = bflo(o.y), r3 = bfhi(o.y);
        ss += r0 * r0 + r1 * r1 + r2 * r2 + r3 * r3;
    }
    DEV float rowload(int row) const { return 0.f; }
    DEV void rowdone(int row, float ss, int fq, int slot) const {
        ss += __shfl_xor(ss, 16); ss += __shfl_xor(ss, 32);
        if (fq == 0) rss[(long)row * 16 + slot] = ss;
    }
    DEV void rowput(int row, float tot, int slot) const { rss[(long)row * 16 + slot] = tot; rss[(long)row * 16 + slot + 1] = 0.f; }
};
struct EpiPle {
    float* out; const bf16_t* h1b; const bf16_t* pp; const float* rss1; float* rss2;
    struct Ld { u32x2 h; u32x2 pv; };
    DEV void load(int row, int col, Ld& d) const {
        d.h = *(const u32x2*)(h1b + (long)row * 1024 + col); d.pv = *(const u32x2*)(pp + (long)row * 1024 + col);
    }
    DEV void apply(int row, int col, const f32x4& a, const Ld& d, float& ss, float rowv) const {
        const float rstd = rsqrtf(rowv * (1.f / 1024.f) + EPS);
        f32x4 h;
        h[0] = bflo(d.h.x) + bflo(d.pv.x) * sigmf(a[0] * rstd); h[1] = bfhi(d.h.x) + bfhi(d.pv.x) * sigmf(a[1] * rstd);
        h[2] = bflo(d.h.y) + bflo(d.pv.y) * sigmf(a[2] * rstd); h[3] = bfhi(d.h.y) + bfhi(d.pv.y) * sigmf(a[3] * rstd);
        *(f32x4*)(out + (long)row * 1024 + col) = h;
        ss += h[0] * h[0] + h[1] * h[1] + h[2] * h[2] + h[3] * h[3];
    }
    DEV float rowload(int row) const {
        const f32x4 a = *(const f32x4*)(rss1 + (long)row * 16), b = *(const f32x4*)(rss1 + (long)row * 16 + 4), c = *(const f32x4*)(rss1 + (long)row * 16 + 8), d = *(const f32x4*)(rss1 + (long)row * 16 + 12);
        return (((a[0] + a[1]) + (a[2] + a[3])) + ((b[0] + b[1]) + (b[2] + b[3]))) + (((c[0] + c[1]) + (c[2] + c[3])) + ((d[0] + d[1]) + (d[2] + d[3])));
    }
    DEV void rowdone(int row, float ss, int fq, int slot) const {
        ss += __shfl_xor(ss, 16); ss += __shfl_xor(ss, 32);
        if (fq == 0) rss2[(long)row * 16 + slot] = ss;
    }
    DEV void rowput(int row, float tot, int slot) const { rss2[(long)row * 16 + slot] = tot; rss2[(long)row * 16 + slot + 1] = 0.f; }
};
template <class Epi>
DEV void epi_big(const Epi& E, const f32x4 (&acc)[2][2][4][2], int brow, int bcol, int wr, int wc, int fr, int fq) {
#pragma unroll
    for (int ai = 0; ai < 2; ++ai)
#pragma unroll
        for (int mp = 0; mp < 2; ++mp) {
            typename Epi::Ld d[2][4]; float rv[2];
#pragma unroll
            for (int mm = 0; mm < 2; ++mm) {
                rv[mm] = E.rowload(brow + ai * 128 + wr * 64 + (mp * 2 + mm) * 16 + fr);
#pragma unroll
                for (int j = 0; j < 4; ++j)
                    E.load(brow + ai * 128 + wr * 64 + (mp * 2 + mm) * 16 + fr, bcol + (j >> 1) * 128 + wc * 32 + (j & 1) * 16 + fq * 4, d[mm][j]);
            }
#pragma unroll
            for (int mm = 0; mm < 2; ++mm) {
                const int row = brow + ai * 128 + wr * 64 + (mp * 2 + mm) * 16 + fr; float ss = 0.f;
#pragma unroll
                for (int j = 0; j < 4; ++j)
                    E.apply(row, bcol + (j >> 1) * 128 + wc * 32 + (j & 1) * 16 + fq * 4, acc[ai][j >> 1][mp * 2 + mm][j & 1], d[mm][j], ss, rv[mm]);
                E.rowdone(row, ss, fq, ((bcol >> 8) & 3) * 4 + wc);
            }
        }
}
template <class Epi>
DEV void gemm_small(const bf16_t* __restrict__ A, int lda, const bf16_t* __restrict__ Bt, int ldb, int K, int row0, int col0, const Epi& E) {
    const int tid = tid_fresh(), w = tid >> 6, lane = tid & 63, fr = lane & 15, fq = lane >> 4;
    const bf16_t* ap = A + (long)(row0 + fr) * lda + fq * 8;
    const bf16_t* bp = Bt + (long)(col0 + w * 16 + fr) * ldb + fq * 8;
    f32x4 acc = (f32x4){0.f, 0.f, 0.f, 0.f};
#pragma unroll 8
    for (int k = 0; k < K; k += 32) {
        const bf16x8 a = *(const bf16x8*)(ap + k), b = *(const bf16x8*)(bp + k);
        acc = mfma16(b, a, acc);
    }
    const int row = row0 + fr, col = col0 + w * 16 + fq * 4;
    typename Epi::Ld d;
    E.load(row, col, d);
    const float rv = E.rowload(row);
    float ss = 0.f;
    E.apply(row, col, acc, d, ss, rv);
    ss += __shfl_xor(ss, 16); ss += __shfl_xor(ss, 32);
    float* red = (float*)smem;
    __syncthreads();
    if (fq == 0) red[w * 16 + fr] = ss;
    __syncthreads();
    if (tid < 16) {
        float t = 0.f;
#pragma unroll
        for (int i = 0; i < 8; ++i) t += red[i * 16 + tid];
        E.rowput(row0 + tid, t, (col0 >> 7) * 2);
    }
    __syncthreads();
}

DEV void transpose_item(const float* __restrict__ src, int ldsrc, int k0, int c0, bf16_t* __restrict__ dst, int lddst, int n0,
                        const float* __restrict__ kscale, float* scr, int lane) {
    const int cl = lane & 31, kh = lane >> 5;
    float v[32];
#pragma unroll
    for (int i = 0; i < 32; ++i) v[i] = src[(long)(k0 + 2 * i + kh) * ldsrc + c0 + cl];
    if (kscale) {
#pragma unroll
        for (int i = 0; i < 32; ++i) v[i] *= kscale[k0 + 2 * i + kh];
    }
#pragma unroll
    for (int i = 0; i < 32; ++i) scr[(2 * i + kh) * 33 + cl] = v[i];
    lds_fence();
    const int c = lane & 7;
#pragma unroll
    for (int j = 0; j < 4; ++j) {
        const int n = (lane >> 3) + 8 * j; const float* sp = scr + (8 * c) * 33 + n;
        u32x4 o; o.x = pk2(sp[0 * 33], sp[1 * 33]); o.y = pk2(sp[2 * 33], sp[3 * 33]); o.z = pk2(sp[4 * 33], sp[5 * 33]); o.w = pk2(sp[6 * 33], sp[7 * 33]);
        *(u32x4*)(dst + (long)(n0 + n) * lddst + k0 + 8 * c) = o;
    }
    lds_fence();
}

DEV void phase0(const Params& P) {
    const int tid = tid_fresh(), lane = tid & 63, wave = tid >> 6, G = gridDim.x, bid = blockIdx.x;
    char* ws = P.ws;
    float* tile = (float*)smem;
    {
        float* scr = (float*)smem + wave * (64 * 33);
        constexpr int I_IN = 144 * 16, I_OUT = 32 * 32, I_GLU = 32 * 16, I_GATE = 32 * 16, I_PPW = 32 * 4;
        constexpr int I_ALL = I_IN + I_OUT + I_GLU + I_GATE + I_PPW;
        for (int it = bid * 8 + wave; it < I_ALL; it += G * 8) {
            int r = it;
            if (r < I_IN) {
                const int nb = r >> 4, kb = r & 15, n0 = nb * 32;
                int c0;
                if (n0 < 1024) c0 = n0; else if (n0 < 2048) c0 = 2576 + (n0 - 1024); else if (n0 < 3584) c0 = 1024 + (n0 - 2048); else c0 = 3600 + (n0 - 3584);
                transpose_item(P.in[I_WIN], 4624, kb * 64, c0, (bf16_t*)(ws + W_WTIN), 1024, n0, P.in[I_GIN], scr, lane); continue;
            }
            r -= I_IN;
            if (r < I_OUT) { const int nb = r >> 5, kb = r & 31; transpose_item(P.in[I_WOUT], 1024, kb * 64, nb * 32, (bf16_t*)(ws + W_WTOUT), 2048, nb * 32, nullptr, scr, lane); continue; }
            r -= I_OUT;
            if (r < I_GLU) { const int nb = r >> 4, kb = r & 15; transpose_item(P.in[I_GLUW], 1024, kb * 64, nb * 32, (bf16_t*)(ws + W_WTGLU), 1024, nb * 32, nullptr, scr, lane); continue; }
            r -= I_GLU;
            if (r < I_GATE) { const int nb = r >> 4, kb = r & 15; transpose_item(P.in[I_WGATE], 1024, kb * 64, nb * 32, (bf16_t*)(ws + W_WTGATE), 1024, nb * 32, P.in[I_GPLE], scr, lane); continue; }
            r -= I_GATE;
            { const int nb = r >> 2, kb = r & 3; transpose_item(P.in[I_WPP], 1024, kb * 64, nb * 32, (bf16_t*)(ws + W_WTPP), 256, nb * 32, nullptr, scr, lane); }
        }
        __syncthreads();
    }
    bf16_t* wdt = (bf16_t*)smem;
    float* psum = (float*)(smem + 16 * 1032 * 2);
    float* pdt = psum + 128;
    {
        float wv[32];
#pragma unroll
        for (int i = 0; i < 32; ++i) { const int idx = tid + i * 512, k = idx >> 4, e = idx & 15; wv[i] = P.in[I_WIN][(long)k * 4624 + 2560 + e] * P.in[I_GIN][k]; }
#pragma unroll
        for (int i = 0; i < 32; ++i) { const int idx = tid + i * 512, k = idx >> 4, e = idx & 15; wdt[e * 1032 + k] = (bf16_t)(pk2(wv[i], 0.f) & 0xffffu); }
    }
    __syncthreads();
    {
        const int fr = lane & 15, fq = lane >> 4;
        bf16x8 wf[4];
#pragma unroll
        for (int j = 0; j < 4; ++j) wf[j] = *(const bf16x8*)(wdt + fr * 1032 + (wave * 4 + j) * 32 + fq * 8);
        bf16_t* xb = (bf16_t*)(ws + W_NB);
        float* dtr = (float*)(ws + W_DTR);
        float* rstdp = (float*)(ws + W_RSTD);
        f32x4 xan[4], xcn[4];
        if (bid < NTOK / 16) {
            const int row = bid * 16 + fr;
            const float* xr = (row < NPROMPT ? P.in[I_XP] + (long)row * 1024 : P.in[I_XS] + (long)(row - NPROMPT) * 1024) + wave * 128 + fq * 8;
#pragma unroll
            for (int j = 0; j < 4; ++j) { xan[j] = *(const f32x4*)(xr + j * 32); xcn[j] = *(const f32x4*)(xr + j * 32 + 4); }
        }
        for (int task = bid; task < NTOK / 16; task += G) {
            const int row = task * 16 + fr;
            f32x4 xa[4], xc[4];
#pragma unroll
            for (int j = 0; j < 4; ++j) { xa[j] = xan[j]; xc[j] = xcn[j]; }
            if (task + G < NTOK / 16) {
                const int rown = (task + G) * 16 + fr;
                const float* xr = (rown < NPROMPT ? P.in[I_XP] + (long)rown * 1024 : P.in[I_XS] + (long)(rown - NPROMPT) * 1024) + wave * 128 + fq * 8;
#pragma unroll
                for (int j = 0; j < 4; ++j) { xan[j] = *(const f32x4*)(xr + j * 32); xcn[j] = *(const f32x4*)(xr + j * 32 + 4); }
            }
            f32x4 acc = {0.f, 0.f, 0.f, 0.f}; float ss = 0.f;
#pragma unroll
            for (int j = 0; j < 4; ++j) {
                ss += xa[j][0] * xa[j][0] + xa[j][1] * xa[j][1] + xa[j][2] * xa[j][2] + xa[j][3] * xa[j][3] + xc[j][0] * xc[j][0] + xc[j][1] * xc[j][1] + xc[j][2] * xc[j][2] + xc[j][3] * xc[j][3];
                u32x4 q; q.x = pk2(xa[j][0], xa[j][1]); q.y = pk2(xa[j][2], xa[j][3]); q.z = pk2(xc[j][0], xc[j][1]); q.w = pk2(xc[j][2], xc[j][3]);
                *(u32x4*)(xb + (long)row * 1024 + wave * 128 + j * 32 + fq * 8) = q;
                acc = mfma16(wf[j], __builtin_bit_cast(bf16x8, q), acc);
            }
            ss += __shfl_xor(ss, 16); ss += __shfl_xor(ss, 32);
            if (fq == 0) psum[wave * 16 + fr] = ss;
            *(f32x4*)(pdt + wave * 256 + fr * 16 + fq * 4) = acc;
            __syncthreads();
            if (tid < 256) {
                const int t = tid >> 4, e = tid & 15;
                float tot = 0.f, d = 0.f;
#pragma unroll
                for (int w8 = 0; w8 < 8; ++w8) { tot += psum[w8 * 16 + t]; d += pdt[w8 * 256 + t * 16 + e]; }
                const float rstd = rsqrtf(tot * (1.f / 1024.f) + EPS);
                dtr[(long)(task * 16 + t) * 16 + e] = d * rstd;
                if (e == 0) rstdp[task * 16 + t] = rstd;
            }
            __syncthreads();
        }
    }
    bf16_t* pb = (bf16_t*)(ws + W_PB);
    for (int idx = bid * 512 + tid; idx < NTOK * 64; idx += G * 512) {
        const int row = idx >> 6, c4 = (idx & 63) * 4;
        const float* src = row < NPROMPT ? P.in[I_PP] + (long)row * 256 : P.in[I_PS] + (long)(row - NPROMPT) * 256;
        const f32x4 v = *(const f32x4*)(src + c4);
        u32x2 o; o.x = pk2(v[0], v[1]); o.y = pk2(v[2], v[3]);
        *(u32x2*)(pb + (long)row * 256 + c4) = o;
    }
    __syncthreads();
}

DEV void conv_load7(const bf16_t* __restrict__ pcol, long row0, int t0, u32x4 (&raw)[7]) {
#pragma unroll
    for (int i = 0; i < 7; ++i) {
        const int t = t0 - 3 + i;
        raw[i] = (u32x4){0u, 0u, 0u, 0u};
        if (t >= 0) raw[i] = *(const u32x4*)(pcol + (row0 - 3 + i) * PLD);
    }
}
DEV void conv_compute(const u32x4 (&rawp)[7], const float* __restrict__ cw, const float* __restrict__ cb, float (&o)[4][8]) {
    float raw[7][8];
#pragma unroll
    for (int i = 0; i < 7; ++i) {
        const u32x4 u = rawp[i];
        raw[i][0] = bflo(u.x); raw[i][1] = bfhi(u.x); raw[i][2] = bflo(u.y); raw[i][3] = bfhi(u.y);
        raw[i][4] = bflo(u.z); raw[i][5] = bfhi(u.z); raw[i][6] = bflo(u.w); raw[i][7] = bfhi(u.w);
    }
    float w[4][8], bias[8];
#pragma unroll
    for (int k = 0; k < 4; ++k) {
        const f32x4 a = *(const f32x4*)(cw + k * 1536), b = *(const f32x4*)(cw + k * 1536 + 4);
        w[k][0] = a[0]; w[k][1] = a[1]; w[k][2] = a[2]; w[k][3] = a[3]; w[k][4] = b[0]; w[k][5] = b[1]; w[k][6] = b[2]; w[k][7] = b[3];
    }
    { const f32x4 a = *(const f32x4*)(cb), b = *(const f32x4*)(cb + 4);
      bias[0] = a[0]; bias[1] = a[1]; bias[2] = a[2]; bias[3] = a[3]; bias[4] = b[0]; bias[5] = b[1]; bias[6] = b[2]; bias[7] = b[3]; }
#pragma unroll
    for (int j = 0; j < 4; ++j)
#pragma unroll
        for (int c = 0; c < 8; ++c) {
            float a = bias[c];
#pragma unroll
            for (int k = 0; k < 4; ++k) a += w[k][c] * raw[j + k][c];
            o[j][c] = siluf(a);
        }
}
DEV void conv_compute_lds(const u32x4 (&rawp)[7], const float* cwl, float (&o)[4][8]) {
    float raw[7][8];
#pragma unroll
    for (int i = 0; i < 7; ++i) {
        const u32x4 u = rawp[i];
        raw[i][0] = bflo(u.x); raw[i][1] = bfhi(u.x); raw[i][2] = bflo(u.y); raw[i][3] = bfhi(u.y);
        raw[i][4] = bflo(u.z); raw[i][5] = bfhi(u.z); raw[i][6] = bflo(u.w); raw[i][7] = bfhi(u.w);
    }
    float w[5][8];
#pragma unroll
    for (int k = 0; k < 5; ++k) {
        const f32x4 a = *(const f32x4*)(cwl + k * 512), b = *(const f32x4*)(cwl + k * 512 + 4);
        w[k][0] = a[0]; w[k][1] = a[1]; w[k][2] = a[2]; w[k][3] = a[3]; w[k][4] = b[0]; w[k][5] = b[1]; w[k][6] = b[2]; w[k][7] = b[3];
    }
#pragma unroll
    for (int j = 0; j < 4; ++j)
#pragma unroll
        for (int c = 0; c < 8; ++c) {
            float a = w[4][c];
#pragma unroll
            for (int k = 0; k < 4; ++k) a += w[k][c] * raw[j + k][c];
            o[j][c] = siluf(a);
        }
}
DEV void conv4x8(const bf16_t* __restrict__ pcol, long row0, int t0, const float* __restrict__ hist, const float* __restrict__ cw, const float* __restrict__ cb, float (&o)[4][8]) {
    float raw[7][8];
#pragma unroll
    for (int i = 0; i < 7; ++i) {
        const int t = t0 - 3 + i;
        if (t >= 0) {
            const u32x4 u = *(const u32x4*)(pcol + (row0 - 3 + i) * PLD);
            raw[i][0] = bflo(u.x); raw[i][1] = bfhi(u.x); raw[i][2] = bflo(u.y); raw[i][3] = bfhi(u.y);
            raw[i][4] = bflo(u.z); raw[i][5] = bfhi(u.z); raw[i][6] = bflo(u.w); raw[i][7] = bfhi(u.w);
        } else if (hist) {
            const f32x4 a = *(const f32x4*)(hist + (long)(t + 3) * 1536), b = *(const f32x4*)(hist + (long)(t + 3) * 1536 + 4);
            raw[i][0] = a[0]; raw[i][1] = a[1]; raw[i][2] = a[2]; raw[i][3] = a[3]; raw[i][4] = b[0]; raw[i][5] = b[1]; raw[i][6] = b[2]; raw[i][7] = b[3];
        } else {
#pragma unroll
            for (int c = 0; c < 8; ++c) raw[i][c] = 0.f;
        }
    }
    float w[4][8], bias[8];
#pragma unroll
    for (int k = 0; k < 4; ++k) {
        const f32x4 a = *(const f32x4*)(cw + k * 1536), b = *(const f32x4*)(cw + k * 1536 + 4);
        w[k][0] = a[0]; w[k][1] = a[1]; w[k][2] = a[2]; w[k][3] = a[3]; w[k][4] = b[0]; w[k][5] = b[1]; w[k][6] = b[2]; w[k][7] = b[3];
    }
    { const f32x4 a = *(const f32x4*)(cb), b = *(const f32x4*)(cb + 4);
      bias[0] = a[0]; bias[1] = a[1]; bias[2] = a[2]; bias[3] = a[3]; bias[4] = b[0]; bias[5] = b[1]; bias[6] = b[2]; bias[7] = b[3]; }
#pragma unroll
    for (int j = 0; j < 4; ++j)
#pragma unroll
        for (int c = 0; c < 8; ++c) {
            float a = bias[c];
#pragma unroll
            for (int k = 0; k < 4; ++k) a += w[k][c] * raw[j + k][c];
            o[j][c] = siluf(a);
        }
}

constexpr int PIT = 136;
constexpr int R1_OFF = 0, R2_OFF = 128 * PIT * 2, R3_OFF = 2 * 128 * PIT * 2, R4_OFF = 3 * 128 * PIT * 2;

DEV void ssd_s1_item(const Params& P, int item) {
    const int tid = tid_fresh(), lane = tid & 63, w = tid >> 6, fr = lane & 15, fq = lane >> 4;
    const int b = item >> 5, c = (item >> 1) & 15, g = item & 1;
    char* ws = P.ws;
    const bf16_t* proj = (const bf16_t*)(ws + W_PROJ);
    const long rowc = (long)b * 2048 + c * 128;
    bf16_t* R1 = (bf16_t*)(smem + R1_OFF); bf16_t* R2 = (bf16_t*)(smem + R2_OFF); bf16_t* R3 = (bf16_t*)(smem + R3_OFF);
    float* acs = (float*)(smem + R4_OFF);
    float* dtv = acs + 1024;
    {
        const int h = g * 8 + w;
        const float bias = P.in[I_DTB][h], A = -__expf(P.in[I_ALOG][h]);
        const float* dtr = (const float*)(ws + W_DTR);
        float x0 = dtr[(rowc + 2 * lane) * 16 + h] + bias, x1 = dtr[(rowc + 2 * lane + 1) * 16 + h] + bias;
        float d0 = x0 > 20.f ? x0 : log1pf(__expf(x0)), d1 = x1 > 20.f ? x1 : log1pf(__expf(x1));
        float a0 = d0 * A, a1 = a0 + d1 * A;
        float run = a1;
#pragma unroll
        for (int o = 1; o < 64; o <<= 1) { float t = __shfl_up(run, o); if (lane >= o) run += t; }
        const float excl = run - a1;
        a0 += excl; a1 += excl;
        acs[w * 128 + 2 * lane] = a0; acs[w * 128 + 2 * lane + 1] = a1;
        dtv[w * 128 + 2 * lane] = d0; dtv[w * 128 + 2 * lane + 1] = d1;
        float* acsg = (float*)(ws + W_ACS) + (((long)b * 16 + c) * 16 + h) * 128;
        acsg[2 * lane] = a0; acsg[2 * lane + 1] = a1;
        if (lane == 63) ((float*)(ws + W_CDEC))[(b * 16 + c) * 16 + h] = __expf(a1);
    }
    float* cwl = (float*)(smem + R4_OFF + 8192);
    for (int u = tid; u < 5 * 512; u += 512) { const int k = u >> 9, ch = u & 511; cwl[u] = k < 4 ? P.in[I_CONVW][k * 1536 + g * 512 + ch] : P.in[I_CONVB][g * 512 + ch]; }
    {
        const int nblk = tid & 15, lq = tid >> 4, l0 = lq * 4;
#pragma unroll
        for (int j = 0; j < 2; ++j) {
            const int ch0 = 1024 + j * 256 + g * 128 + nblk * 8;
            float o[4][8];
            conv4x8(proj + C_XBC + ch0, rowc + l0, c * 128 + l0, nullptr, P.in[I_CONVW] + ch0, P.in[I_CONVB] + ch0, o);
            bf16_t* dst = j == 0 ? R2 : R1;
#pragma unroll
            for (int r = 0; r < 4; ++r) {
                u32x4 q; q.x = pk2(o[r][0], o[r][1]); q.y = pk2(o[r][2], o[r][3]); q.z = pk2(o[r][4], o[r][5]); q.w = pk2(o[r][6], o[r][7]);
                *(u32x4*)(dst + (l0 + r) * PIT + nblk * 8) = q;
            }
            if (j == 0) {
#pragma unroll
                for (int i = 0; i < 8; ++i) {
                    u32x2 q; q.x = pk2(o[0][i], o[1][i]); q.y = pk2(o[2][i], o[3][i]);
                    *(u32x2*)(R3 + (nblk * 8 + i) * PIT + l0) = q;
                }
            }
        }
    }
    __syncthreads();
    const int wr = w >> 1, wc = w & 1;
    f32x4 cbm[2][4];
#pragma unroll
    for (int m = 0; m < 2; ++m)
#pragma unroll
        for (int n = 0; n < 4; ++n) cbm[m][n] = (f32x4){0.f, 0.f, 0.f, 0.f};
#pragma unroll
    for (int ks = 0; ks < 4; ++ks) {
        bf16x8 af[2], bfm[4];
#pragma unroll
        for (int m = 0; m < 2; ++m) af[m] = *(const bf16x8*)(R1 + (wr * 32 + m * 16 + fr) * PIT + ks * 32 + fq * 8);
#pragma unroll
        for (int n = 0; n < 4; ++n) bfm[n] = *(const bf16x8*)(R2 + (wc * 64 + n * 16 + fr) * PIT + ks * 32 + fq * 8);
#pragma unroll
        for (int m = 0; m < 2; ++m)
#pragma unroll
            for (int n = 0; n < 4; ++n) cbm[m][n] = mfma16(bfm[n], af[m], cbm[m][n]);
    }
    __syncthreads();
    bf16_t* XT = R2; bf16_t* XW = R2 + 64 * PIT;
    bf16_t* ydg = (bf16_t*)(ws + W_NB);
    float* states = P.out;
    const int wp = w >> 2, wn = w & 3;
    u32x4 rawn[7];
    if (tid < 256) conv_load7(proj + C_XBC + (g * 8) * 64 + (tid & 7) * 8, rowc + (tid >> 3) * 4, c * 128 + (tid >> 3) * 4, rawn);
    for (int e = 0; e < 8; ++e) {
        const int h = g * 8 + e;
        const float dskip = P.in[I_SSDD][h];
        if (tid < 256) {
            const int pblk = tid & 7, lq = tid >> 3, l0 = lq * 4, ch0 = h * 64 + pblk * 8;
            float o[4][8];
            conv_compute_lds(rawn, cwl + e * 64 + pblk * 8, o);
            if (e < 7) conv_load7(proj + C_XBC + ch0 + 64, rowc + l0, c * 128 + l0, rawn);
            const float alast = acs[e * 128 + 127];
            float we[4];
#pragma unroll
            for (int r = 0; r < 4; ++r) we[r] = __expf(alast - acs[e * 128 + l0 + r]) * dtv[e * 128 + l0 + r];
#pragma unroll
            for (int i = 0; i < 8; ++i) {
                u32x2 q; q.x = pk2(o[0][i], o[1][i]); q.y = pk2(o[2][i], o[3][i]);
                *(u32x2*)(XT + (pblk * 8 + i) * PIT + l0) = q;
                u32x2 q2; q2.x = pk2(o[0][i] * we[0], o[1][i] * we[1]); q2.y = pk2(o[2][i] * we[2], o[3][i] * we[3]);
                *(u32x2*)(XW + (pblk * 8 + i) * PIT + l0) = q2;
            }
        }
#pragma unroll
        for (int m = 0; m < 2; ++m) {
            const int l = wr * 32 + m * 16 + fr; const float al = acs[e * 128 + l];
#pragma unroll
            for (int n = 0; n < 4; ++n) {
                const int s0 = wc * 64 + n * 16 + fq * 4;
                const f32x4 as = *(const f32x4*)(acs + e * 128 + s0), ds = *(const f32x4*)(dtv + e * 128 + s0);
                float v[4];
#pragma unroll
                for (int r = 0; r < 4; ++r) { const float t = cbm[m][n][r] * __expf(al - as[r]) * ds[r]; v[r] = (s0 + r <= l) ? t : 0.f; }
                u32x2 q; q.x = pk2(v[0], v[1]); q.y = pk2(v[2], v[3]);
                *(u32x2*)(R1 + l * PIT + s0) = q;
            }
        }
        __syncthreads();
        {
            f32x4 yd[2][2];
#pragma unroll
            for (int m = 0; m < 2; ++m)
#pragma unroll
                for (int n = 0; n < 2; ++n) yd[m][n] = (f32x4){0.f, 0.f, 0.f, 0.f};
            for (int ks = 0; ks <= wr; ++ks) {
                bf16x8 af[2], bfm[2];
#pragma unroll
                for (int m = 0; m < 2; ++m) af[m] = *(const bf16x8*)(R1 + (wr * 32 + m * 16 + fr) * PIT + ks * 32 + fq * 8);
#pragma unroll
                for (int n = 0; n < 2; ++n) bfm[n] = *(const bf16x8*)(XT + (wc * 32 + n * 16 + fr) * PIT + ks * 32 + fq * 8);
#pragma unroll
                for (int m = 0; m < 2; ++m)
#pragma unroll
                    for (int n = 0; n < 2; ++n) yd[m][n] = mfma16(bfm[n], af[m], yd[m][n]);
            }
#pragma unroll
            for (int m = 0; m < 2; ++m)
#pragma unroll
                for (int n = 0; n < 2; ++n) {
                    const int l = wr * 32 + m * 16 + fr, p0 = wc * 32 + n * 16 + fq * 4;
                    const float x0 = __uint_as_float(((unsigned)XT[(p0 + 0) * PIT + l]) << 16), x1 = __uint_as_float(((unsigned)XT[(p0 + 1) * PIT + l]) << 16);
                    const float x2 = __uint_as_float(((unsigned)XT[(p0 + 2) * PIT + l]) << 16), x3 = __uint_as_float(((unsigned)XT[(p0 + 3) * PIT + l]) << 16);
                    u32x2 q; q.x = pk2(yd[m][n][0] + dskip * x0, yd[m][n][1] + dskip * x1); q.y = pk2(yd[m][n][2] + dskip * x2, yd[m][n][3] + dskip * x3);
                    *(u32x2*)(ydg + (rowc + l) * 1024 + h * 64 + p0) = q;
                }
        }
        {
            f32x4 st[2][2];
#pragma unroll
            for (int m = 0; m < 2; ++m)
#pragma unroll
                for (int n = 0; n < 2; ++n) st[m][n] = (f32x4){0.f, 0.f, 0.f, 0.f};
#pragma unroll
            for (int ks = 0; ks < 4; ++ks) {
                bf16x8 af[2], bfm[2];
#pragma unroll
                for (int m = 0; m < 2; ++m) af[m] = *(const bf16x8*)(XW + (wp * 32 + m * 16 + fr) * PIT + ks * 32 + fq * 8);
#pragma unroll
                for (int n = 0; n < 2; ++n) bfm[n] = *(const bf16x8*)(R3 + (wn * 32 + n * 16 + fr) * PIT + ks * 32 + fq * 8);
#pragma unroll
                for (int m = 0; m < 2; ++m)
#pragma unroll
                    for (int n = 0; n < 2; ++n) st[m][n] = mfma16(bfm[n], af[m], st[m][n]);
            }
            float* sp = states + (((long)b * 16 + c) * 16 + h) * 8192;
#pragma unroll
            for (int m = 0; m < 2; ++m)
#pragma unroll
                for (int n = 0; n < 2; ++n) {
                    const int p = wp * 32 + m * 16 + fr, n0 = wn * 32 + n * 16 + fq * 4;
                    *(f32x4*)(sp + p * 128 + n0) = st[m][n];
                }
        }
        __syncthreads();
    }
}

DEV void ssd_s2(const Params& P) {
    float* states = P.out;
    const float* cdec = (const float*)(P.ws + W_CDEC);
    for (int idx = blockIdx.x * 512 + threadIdx.x; idx < 262144; idx += gridDim.x * 512) {
        const int bh = idx >> 11, q = idx & 2047, b = bh >> 4, h = bh & 15;
        f32x4 H = (f32x4){0.f, 0.f, 0.f, 0.f};
#pragma unroll
        for (int c = 0; c < 16; ++c) {
            f32x4* ptr = (f32x4*)(states + (((long)b * 16 + c) * 16 + h) * 8192) + q;
            const f32x4 s = *ptr; *ptr = H;
            const float d = cdec[(b * 16 + c) * 16 + h];
            H = H * d + s;
        }
        *((f32x4*)(P.out + O_SSDP + (long)bh * 8192) + q) = H;
    }
}

DEV void ssd_s3_item(const Params& P, int item) {
    const int tid = tid_fresh(), lane = tid & 63, w = tid >> 6, fr = lane & 15, fq = lane >> 4;
    const int b = item >> 5, c = (item >> 1) & 15, g = item & 1;
    char* ws = P.ws;
    bf16_t* proj = (bf16_t*)(ws + W_PROJ);
    const long rowc = (long)b * 2048 + c * 128;
    bf16_t* R1 = (bf16_t*)(smem + R1_OFF); bf16_t* HB = (bf16_t*)(smem + R2_OFF);
    float* ssq = (float*)(smem + R4_OFF);
    const bf16_t* ydg = (const bf16_t*)(ws + W_NB);
    const float* states = P.out;
    const float* acsg = (const float*)(ws + W_ACS);
    const int hp = tid >> 3, hn0 = (tid & 7) * 16;
    f32x4 hreg[4];
    {
        const float* sp = states + (((long)b * 16 + c) * 16 + g * 8) * 8192 + hp * 128 + hn0;
#pragma unroll
        for (int i = 0; i < 4; ++i) hreg[i] = *(const f32x4*)(sp + i * 4);
    }
    __syncthreads();
    {
        const int nblk = tid & 15, lq = tid >> 4, l0 = lq * 4;
        const int ch0 = 1280 + g * 128 + nblk * 8;
        float o[4][8];
        conv4x8(proj + C_XBC + ch0, rowc + l0, c * 128 + l0, nullptr, P.in[I_CONVW] + ch0, P.in[I_CONVB] + ch0, o);
#pragma unroll
        for (int r = 0; r < 4; ++r) {
            u32x4 q; q.x = pk2(o[r][0], o[r][1]); q.y = pk2(o[r][2], o[r][3]); q.z = pk2(o[r][4], o[r][5]); q.w = pk2(o[r][6], o[r][7]);
            *(u32x4*)(R1 + (l0 + r) * PIT + nblk * 8) = q;
        }
    }
    const int wr = w >> 1, wc = w & 1;
    unsigned ypk[8][2][2][2];
    float ssl[2] = {0.f, 0.f};
#pragma unroll
    for (int e = 0; e < 8; ++e) {
        const int h = g * 8 + e;
        bf16_t* hb = HB + (e & 1) * 64 * PIT;
        {
            u32x4 q0, q1;
            q0.x = pk2(hreg[0][0], hreg[0][1]); q0.y = pk2(hreg[0][2], hreg[0][3]); q0.z = pk2(hreg[1][0], hreg[1][1]); q0.w = pk2(hreg[1][2], hreg[1][3]);
            q1.x = pk2(hreg[2][0], hreg[2][1]); q1.y = pk2(hreg[2][2], hreg[2][3]); q1.z = pk2(hreg[3][0], hreg[3][1]); q1.w = pk2(hreg[3][2], hreg[3][3]);
            *(u32x4*)(hb + hp * PIT + hn0) = q0; *(u32x4*)(hb + hp * PIT + hn0 + 8) = q1;
        }
        if (e < 7) {
            const float* sp = states + (((long)b * 16 + c) * 16 + h + 1) * 8192 + hp * 128 + hn0;
#pragma unroll
            for (int i = 0; i < 4; ++i) hreg[i] = *(const f32x4*)(sp + i * 4);
        }
        u32x2 yq[2][2], zz[2][2]; float ea[2];
#pragma unroll
        for (int m = 0; m < 2; ++m) {
            const int l = wr * 32 + m * 16 + fr;
            ea[m] = acsg[(((long)b * 16 + c) * 16 + h) * 128 + l];
#pragma unroll
            for (int n = 0; n < 2; ++n) {
                const int p0 = wc * 32 + n * 16 + fq * 4;
                yq[m][n] = *(const u32x2*)(ydg + (rowc + l) * 1024 + h * 64 + p0);
                zz[m][n] = *(const u32x2*)(proj + (rowc + l) * PLD + C_ZA + h * 64 + p0);
            }
        }
        __syncthreads();
        f32x4 yo[2][2];
#pragma unroll
        for (int m = 0; m < 2; ++m)
#pragma unroll
            for (int n = 0; n < 2; ++n) yo[m][n] = (f32x4){0.f, 0.f, 0.f, 0.f};
#pragma unroll
        for (int ks = 0; ks < 4; ++ks) {
            bf16x8 af[2], bfm[2];
#pragma unroll
            for (int m = 0; m < 2; ++m) af[m] = *(const bf16x8*)(R1 + (wr * 32 + m * 16 + fr) * PIT + ks * 32 + fq * 8);
#pragma unroll
            for (int n = 0; n < 2; ++n) bfm[n] = *(const bf16x8*)(hb + (wc * 32 + n * 16 + fr) * PIT + ks * 32 + fq * 8);
#pragma unroll
            for (int m = 0; m < 2; ++m)
#pragma unroll
                for (int n = 0; n < 2; ++n) yo[m][n] = mfma16(bfm[n], af[m], yo[m][n]);
        }
#pragma unroll
        for (int m = 0; m < 2; ++m) {
            const float eam = __expf(ea[m]);
#pragma unroll
            for (int n = 0; n < 2; ++n) {
                const float v0 = (bflo(yq[m][n].x) + eam * yo[m][n][0]) * siluf(bflo(zz[m][n].x)), v1 = (bfhi(yq[m][n].x) + eam * yo[m][n][1]) * siluf(bfhi(zz[m][n].x));
                const float v2 = (bflo(yq[m][n].y) + eam * yo[m][n][2]) * siluf(bflo(zz[m][n].y)), v3 = (bfhi(yq[m][n].y) + eam * yo[m][n][3]) * siluf(bfhi(zz[m][n].y));
                ssl[m] += v0 * v0 + v1 * v1 + v2 * v2 + v3 * v3;
                ypk[e][m][n][0] = pk2(v0, v1); ypk[e][m][n][1] = pk2(v2, v3);
            }
        }
    }
#pragma unroll
    for (int m = 0; m < 2; ++m) {
        float ss = ssl[m];
        ss += __shfl_xor(ss, 16); ss += __shfl_xor(ss, 32);
        if (fq == 0) ssq[wc * 128 + wr * 32 + m * 16 + fr] = ss;
    }
    f32x4 ggv[8][2];
#pragma unroll
    for (int e = 0; e < 8; ++e)
#pragma unroll
        for (int n = 0; n < 2; ++n) ggv[e][n] = *(const f32x4*)(P.in[I_SSDG] + (g * 8 + e) * 64 + wc * 32 + n * 16 + fq * 4);
    __syncthreads();
#pragma unroll
    for (int m = 0; m < 2; ++m) {
        const int l = wr * 32 + m * 16 + fr;
        const float rstd = rsqrtf((ssq[l] + ssq[128 + l]) * (1.f / 512.f) + EPS);
#pragma unroll
        for (int e = 0; e < 8; ++e)
#pragma unroll
            for (int n = 0; n < 2; ++n) {
                const int h = g * 8 + e, p0 = wc * 32 + n * 16 + fq * 4;
                const f32x4 gg = ggv[e][n];
                const unsigned a0 = ypk[e][m][n][0], a1 = ypk[e][m][n][1];
                u32x2 o; o.x = pk2(bflo(a0) * rstd * gg[0], bfhi(a0) * rstd * gg[1]); o.y = pk2(bflo(a1) * rstd * gg[2], bfhi(a1) * rstd * gg[3]);
                *(u32x2*)(proj + (rowc + l) * PLD + C_ZA + h * 64 + p0) = o;
            }
    }
}

DEV void ssd_sample_item(const Params& P, int item) {
    const int tid = tid_fresh();
    const int b = item >> 1, g = item & 1;
    char* ws = P.ws;
    bf16_t* proj = (bf16_t*)(ws + W_PROJ);
    const long row0 = NPROMPT + (long)b * 4;
    float* xs = (float*)smem;
    float* Bs = xs + 2048;
    float* Cs = Bs + 512;
    float* dts = Cs + 512;
    float* das = dts + 32;
    float* vs = das + 32;
    float* red = vs + 2048;
    float* zs = red + 32;
    for (int u = tid; u < 768; u += 512) {
        int ch; float* dst; int dcol;
        if (u < 512) { ch = g * 512 + u; dst = xs; dcol = u; }
        else if (u < 640) { ch = 1024 + g * 128 + (u - 512); dst = Bs; dcol = u - 512; }
        else { ch = 1280 + g * 128 + (u - 640); dst = Cs; dcol = u - 640; }
        const int pitch = u < 512 ? 512 : 128;
        float full[7];
#pragma unroll
        for (int i = 0; i < 3; ++i) full[i] = P.in[I_CONV][((long)b * 3 + i) * 1536 + ch];
#pragma unroll
        for (int i = 0; i < 4; ++i) full[3 + i] = __uint_as_float(((unsigned)proj[(row0 + i) * PLD + C_XBC + ch]) << 16);
        const float w0 = P.in[I_CONVW][ch], w1 = P.in[I_CONVW][1536 + ch], w2 = P.in[I_CONVW][3072 + ch], w3 = P.in[I_CONVW][4608 + ch], bias = P.in[I_CONVB][ch];
#pragma unroll
        for (int t = 0; t < 4; ++t) dst[t * pitch + dcol] = siluf(bias + w0 * full[t] + w1 * full[t + 1] + w2 * full[t + 2] + w3 * full[t + 3]);
    }
    for (int u = tid; u < 4 * 256; u += 512) {
        const int t = u >> 8, c2 = (u & 255) * 2;
        const unsigned zz = *(const unsigned*)(proj + (row0 + t) * PLD + C_ZA + g * 512 + c2);
        zs[t * 512 + c2] = bflo(zz); zs[t * 512 + c2 + 1] = bfhi(zz);
    }
    if (tid < 32) {
        const int t = tid >> 3, e = tid & 7, h = g * 8 + e;
        const float x = ((const float*)(ws + W_DTR))[(row0 + t) * 16 + h] + P.in[I_DTB][h];
        const float d = x > 20.f ? x : log1pf(__expf(x));
        dts[tid] = d; das[tid] = __expf(-d * __expf(P.in[I_ALOG][h]));
    }
    __syncthreads();
    const int p = tid >> 3, nb = tid & 7, n0 = nb * 16;
    f32x4 hn[4];
    {
        const float* sp0 = P.in[I_SSD] + (((long)b * 16 + g * 8) * 64 + p) * 128 + n0;
#pragma unroll
        for (int i = 0; i < 4; ++i) hn[i] = *(const f32x4*)(sp0 + i * 4);
    }
    for (int e = 0; e < 8; ++e) {
        const int h = g * 8 + e;
        float* op = P.out + O_SSDS + (((long)b * 16 + h) * 64 + p) * 128 + n0;
        f32x4 hv[4];
#pragma unroll
        for (int i = 0; i < 4; ++i) hv[i] = hn[i];
        if (e < 7) {
            const float* sp = P.in[I_SSD] + (((long)b * 16 + h + 1) * 64 + p) * 128 + n0;
#pragma unroll
            for (int i = 0; i < 4; ++i) hn[i] = *(const f32x4*)(sp + i * 4);
        }
        const float dsk = P.in[I_SSDD][h];
#pragma unroll
        for (int t = 0; t < 4; ++t) {
            const float dec = das[t * 8 + e], xv = xs[t * 512 + e * 64 + p], coef = dts[t * 8 + e] * xv;
            float part = 0.f;
#pragma unroll
            for (int i = 0; i < 4; ++i) {
                const f32x4 bv = *(const f32x4*)(Bs + t * 128 + n0 + i * 4), cv = *(const f32x4*)(Cs + t * 128 + n0 + i * 4);
                hv[i] = hv[i] * dec + bv * coef;
                part += hv[i][0] * cv[0] + hv[i][1] * cv[1] + hv[i][2] * cv[2] + hv[i][3] * cv[3];
            }
            part += __shfl_xor(part, 1); part += __shfl_xor(part, 2); part += __shfl_xor(part, 4);
            if (nb == 0) {
                const float z = zs[t * 512 + e * 64 + p];
                vs[t * 512 + e * 64 + p] = (part + dsk * xv) * siluf(z);
            }
        }
#pragma unroll
        for (int i = 0; i < 4; ++i) *(f32x4*)(op + i * 4) = hv[i];
    }
    __syncthreads();
    {
        const int t = tid >> 7, cidx = tid & 127;
        float v[4]; float ss = 0.f;
#pragma unroll
        for (int i = 0; i < 4; ++i) { v[i] = vs[t * 512 + cidx * 4 + i]; ss += v[i] * v[i]; }
        ss = wave_sum(ss);
        if ((tid & 63) == 0) red[tid >> 6] = ss;
        __syncthreads();
        const float tot = red[t * 2] + red[t * 2 + 1];
        const float rstd = rsqrtf(tot * (1.f / 512.f) + EPS);
        const f32x4 gg = *(const f32x4*)(P.in[I_SSDG] + g * 512 + cidx * 4);
        u32x2 o; o.x = pk2(v[0] * rstd * gg[0], v[1] * rstd * gg[1]); o.y = pk2(v[2] * rstd * gg[2], v[3] * rstd * gg[3]);
        *(u32x2*)(proj + (row0 + t) * PLD + C_ZA + g * 512 + cidx * 4) = o;
    }
    __syncthreads();
}

constexpr int S5P = 20;
template <bool SAMPLE>
DEV void s5_item(const Params& P, int g, long rowbase, int bidx) {
    const int tid = tid_fresh(), lane = tid & 63, w = tid >> 6, fr = lane & 15, fq = lane >> 4;
    constexpr int TPW = SAMPLE ? 16 : 256;
    bf16_t* proj = (bf16_t*)(P.ws + W_PROJ);
    float* buf = (float*)smem + w * (128 * S5P);
    float* carry = (float*)smem + 8 * 128 * S5P;
    float* fs = carry + 1024 + w * 128;
    float ar, ai;
    {
        const float lr = P.in[I_LRE][g * 64 + lane], li = P.in[I_LIM][g * 64 + lane], delta = expf(P.in[I_LDT][g]);
        const float mag = expf(lr * delta), ang = li * delta;
        ar = mag * cosf(ang); ai = mag * sinf(ang);
        const float qre = ar - 1.f, den = lr * lr + li * li;
        fs[lane] = (qre * lr + ai * li) / den; fs[64 + lane] = (ai * lr - qre * li) / den;
    }
    lds_fence();
    bf16x8 bbf[8];
#pragma unroll
    for (int j = 0; j < 8; ++j) {
        bf16x8 z = {0, 0, 0, 0, 0, 0, 0, 0};
        if (fq < 2) {
            const int p = (j & 3) * 16 + fr;
            const float f_r = fs[p], f_i = fs[64 + p];
            const float* br = P.in[I_BRE] + ((long)(g * 64 + p)) * 16 + fq * 8;
            const float* bi = P.in[I_BIM] + ((long)(g * 64 + p)) * 16 + fq * 8;
            const f32x4 r0 = *(const f32x4*)br, r1 = *(const f32x4*)(br + 4), i0 = *(const f32x4*)bi, i1 = *(const f32x4*)(bi + 4);
            f32x4 o0, o1;
            if (j < 4) { o0 = r0 * f_r - i0 * f_i; o1 = r1 * f_r - i1 * f_i; }
            else { o0 = i0 * f_r + r0 * f_i; o1 = i1 * f_r + r1 * f_i; }
            u32x4 q; q.x = pk2(o0[0], o0[1]); q.y = pk2(o0[2], o0[3]); q.z = pk2(o1[0], o1[1]); q.w = pk2(o1[2], o1[3]);
            z = __builtin_bit_cast(bf16x8, q);
        }
        bbf[j] = z;
    }
    bf16x8 ccf[4];
#pragma unroll
    for (int ks = 0; ks < 4; ++ks) {
        const float* src = (ks < 2 ? P.in[I_CRE] : P.in[I_CIM]) + ((long)(g * 16 + fr)) * 64 + (ks & 1) * 32 + fq * 8;
        f32x4 c0 = *(const f32x4*)src, c1 = *(const f32x4*)(src + 4);
        if (ks >= 2) { c0 = -c0; c1 = -c1; }
        u32x4 q; q.x = pk2(c0[0], c0[1]); q.y = pk2(c0[2], c0[3]); q.z = pk2(c1[0], c1[1]); q.w = pk2(c1[2], c1[3]);
        ccf[ks] = __builtin_bit_cast(bf16x8, q);
    }
    const f32x4 dsk = *(const f32x4*)(P.in[I_S5D] + g * 16 + fq * 4);
    const long roww = rowbase + (long)w * TPW;
    float xr = 0.f, xi = 0.f;
    float sre[8], sim[8];
#pragma unroll
    for (int j = 0; j < 8; ++j) { sre[j] = 0.f; sim[j] = 0.f; }
    if (SAMPLE) {
#pragma unroll
        for (int j = 0; j < TPW / 4; ++j) {
            const long seq = (roww - NPROMPT) / 4 + j;
            sre[j] = P.in[I_S5R][(seq * 64 + g) * 64 + lane]; sim[j] = P.in[I_S5I][(seq * 64 + g) * 64 + lane];
        }
    }
    constexpr int NPASS = SAMPLE ? 1 : 2;
#pragma unroll 1
    for (int pass = 0; pass < NPASS; ++pass) {
        const bool last = (pass == NPASS - 1);
        if (!SAMPLE && pass == 1) {
            carry[w * 128 + lane] = xr; carry[w * 128 + 64 + lane] = xi;
            __syncthreads();
            float pr = ar, pi = ai;
#pragma unroll
            for (int q = 0; q < 8; ++q) { const float nr = pr * pr - pi * pi, ni = 2.f * pr * pi; pr = nr; pi = ni; }
            float sr = 0.f, si = 0.f;
            for (int ww = 0; ww < w; ++ww) {
                const float cr = carry[ww * 128 + lane], ci = carry[ww * 128 + 64 + lane];
                const float nr = pr * sr - pi * si + cr, ni = pr * si + pi * sr + ci; sr = nr; si = ni;
            }
            xr = sr; xi = si;
        }
        if (!SAMPLE && pass == 0 && w == 7) continue;
        bf16x8 ufn = {0, 0, 0, 0, 0, 0, 0, 0};
        if (fq < 2) ufn = *(const bf16x8*)(proj + (roww + fr) * PLD + C_UB + g * 16 + fq * 8);
#pragma unroll 1
        for (int sb = 0; sb < TPW / 16; ++sb) {
            const long r = roww + sb * 16;
            const bf16x8 uf = ufn;
            if (fq < 2 && sb + 1 < TPW / 16) ufn = *(const bf16x8*)(proj + (r + 16 + fr) * PLD + C_UB + g * 16 + fq * 8);
            u32x2* up = (u32x2*)(proj + (r + fr) * PLD + C_UB + g * 16 + fq * 4);
            u32x2 uu = {0u, 0u};
            if (last) uu = *up;
            const f32x4 zero = {0.f, 0.f, 0.f, 0.f};
#pragma unroll
            for (int j = 0; j < 8; ++j) {
                const f32x4 d = mfma16(uf, bbf[j], zero);
                *(f32x4*)(buf + (j * 16 + fr) * S5P + fq * 4) = d;
            }
            lds_fence();
#pragma unroll
            for (int q = 0; q < 4; ++q) {
                f32x4 br = *(const f32x4*)(buf + lane * S5P + q * 4), bi = *(const f32x4*)(buf + (64 + lane) * S5P + q * 4);
                if (SAMPLE) {
#pragma unroll
                    for (int j = 0; j < 8; ++j) if (j == sb * 4 + q) { xr = sre[j]; xi = sim[j]; }
                }
#pragma unroll
                for (int i = 0; i < 4; ++i) {
                    const float nr = ar * xr - ai * xi + br[i], ni = ar * xi + ai * xr + bi[i];
                    xr = nr; xi = ni; br[i] = nr; bi[i] = ni;
                }
                if (last) { *(f32x4*)(buf + lane * S5P + q * 4) = br; *(f32x4*)(buf + (64 + lane) * S5P + q * 4) = bi; }
                if (SAMPLE) {
                    const long seq = (r - NPROMPT) / 4 + q;
                    P.out[O_S5RS + (seq * 64 + g) * 64 + lane] = xr; P.out[O_S5IS + (seq * 64 + g) * 64 + lane] = xi;
                }
            }
            if (last) {
                lds_fence();
                f32x4 y = {0.f, 0.f, 0.f, 0.f};
#pragma unroll
                for (int ks = 0; ks < 4; ++ks) {
                    float xv[8];
#pragma unroll
                    for (int i = 0; i < 8; ++i) xv[i] = buf[(ks * 32 + fq * 8 + i) * S5P + fr];
                    u32x4 q; q.x = pk2(xv[0], xv[1]); q.y = pk2(xv[2], xv[3]); q.z = pk2(xv[4], xv[5]); q.w = pk2(xv[6], xv[7]);
                    y = mfma16(ccf[ks], __builtin_bit_cast(bf16x8, q), y);
                }
                const float y0 = geluf(y[0] + dsk[0] * bflo(uu.x)), y1 = geluf(y[1] + dsk[1] * bfhi(uu.x));
                const float y2 = geluf(y[2] + dsk[2] * bflo(uu.y)), y3 = geluf(y[3] + dsk[3] * bfhi(uu.y));
                u32x2 o; o.x = pk2(y0, y1); o.y = pk2(y2, y3);
                *up = o;
            }
            lds_fence();
        }
    }
    if (!SAMPLE && w == 7) {
        P.out[O_S5RP + ((long)bidx * 64 + g) * 64 + lane] = xr; P.out[O_S5IP + ((long)bidx * 64 + g) * 64 + lane] = xi;
    }
    __syncthreads();
}

__global__ void __launch_bounds__(512) hymba_fwd(Params P) {
#ifdef PROBE_K
    unsigned long long tb_[9]; int nb_ = 0;
#define TB() do { tb_[nb_++] = wall_clock64(); } while (0)
    TB();
#else
#define TB() do {} while (0)
#endif
    const int G = gridDim.x, bid = blockIdx.x;
    char* ws = P.ws;
    bf16_t* proj = (bf16_t*)(ws + W_PROJ);
    unsigned* barw = (unsigned*)(ws + W_BAR);
    volatile LAS unsigned* stw = (volatile LAS unsigned*)(smem + 131072);
    if (threadIdx.x < 4) stw[threadIdx.x] = 0u;
    __syncthreads();
    const XcdBarrier xb = xcd_barrier_post(barw, stw);
#ifndef NO_P0
    phase0(P);
#endif
    xcd_barrier(xb); TB();
#ifndef NO_P1
    for (int L = bid; L < 1188; L += G) {
        int pm, pn; tile_of(L, 66, 18, pm, pn);
        gemm_tile((const bf16_t*)(ws + W_NB), 1024, (const bf16_t*)(ws + W_WTIN), 1024, 1024, pm * 256, pn * 256, EpiBf16{proj, PLD, (const float*)(ws + W_RSTD)});
    }
    for (int L = (bid + G - 1188 % G) % G; L < 264; L += G) {
        int pm, pn; tile_of(L, 66, 4, pm, pn);
        gemm_tile((const bf16_t*)(ws + W_PB), 256, (const bf16_t*)(ws + W_WTPP), 256, 256, pm * 256, pn * 256, EpiBf16{(bf16_t*)(ws + W_PP), 1024, nullptr});
    }
#endif
    xcd_barrier(xb); TB();
    for (int idx = bid * 512 + threadIdx.x; idx < (8 + 128) * 3 * 192; idx += G * 512) {
        const int c8 = (idx % 192) * 8, sj = idx / 192, j = sj % 3, sq = sj / 3;
        const long row = sq < 8 ? (long)sq * 2048 + 2045 + j : NPROMPT + (long)(sq - 8) * 4 + 1 + j;
        const u32x4 u = *(const u32x4*)(proj + row * PLD + C_XBC + c8);
        float* dst = sq < 8 ? P.out + O_CONVP + ((long)sq * 3 + j) * 1536 + c8 : P.out + O_CONVS + ((long)(sq - 8) * 3 + j) * 1536 + c8;
        *(f32x4*)dst = (f32x4){bflo(u.x), bfhi(u.x), bflo(u.y), bfhi(u.y)};
        *(f32x4*)(dst + 4) = (f32x4){bflo(u.z), bfhi(u.z), bflo(u.w), bfhi(u.w)};
    }
#ifdef PROBE2
    unsigned long long tq_[5]; tq_[0] = wall_clock64();
#endif
#ifndef NO_S1
    for (int it = bid; it < 256; it += G) ssd_s1_item(P, it);
#endif
#ifdef PROBE2
    tq_[1] = wall_clock64();
#endif
#ifndef NO_SS
    for (int it = bid; it < 256; it += G) ssd_sample_item(P, it);
#endif
#ifdef PROBE2
    tq_[2] = wall_clock64();
#endif
#ifndef NO_S5P
    for (int it = bid; it < 512; it += G) s5_item<false>(P, it & 63, (long)(it >> 6) * 2048, it >> 6);
#endif
#ifdef PROBE2
    tq_[3] = wall_clock64();
#endif
#ifndef NO_S5S
    for (int it = bid; it < 256; it += G) s5_item<true>(P, it & 63, NPROMPT + (long)(it >> 6) * 128, 0);
#endif
#ifdef PROBE2
    tq_[4] = wall_clock64();
    { const unsigned long long d = tq_[PROBE2 + 1] - tq_[PROBE2], t0 = wall_clock64(); while (wall_clock64() - t0 < d) __builtin_amdgcn_s_sleep(8); }
#endif
    xcd_barrier(xb); TB();
    if (bid & 1) ssd_s2(P);
    {
        const EpiGlu eg{proj, P.in[I_GLUB]};
        for (int L = bid; L < 256; L += G) {
            int pm, pn; tile_of(L, 64, 4, pm, pn);
            gemm_tile(proj + C_UB, PLD, (const bf16_t*)(ws + W_WTGLU), 1024, 1024, pm * 256, pn * 256, eg);
        }
        for (int L = bid; L < 256; L += G)
            gemm_small(proj + C_UB, PLD, (const bf16_t*)(ws + W_WTGLU), 1024, 1024, NPROMPT + (L >> 3) * 16, (L & 7) * 128, eg);
    }
    if (!(bid & 1)) ssd_s2(P);
    xcd_barrier(xb); TB();
#ifndef NO_S3
    for (int it = bid; it < 256; it += G) ssd_s3_item(P, it);
#endif
    xcd_barrier(xb); TB();
#ifndef NO_P5
    {
        const EpiOut eo{P.in[I_XP], P.in[I_XS], (bf16_t*)(ws + W_NB), (float*)(ws + W_RSS1)};
        if (bid & 1)
            for (int L = bid; L < 256; L += G)
                gemm_small(proj, PLD, (const bf16_t*)(ws + W_WTOUT), 2048, 2048, NPROMPT + (L >> 3) * 16, (L & 7) * 128, eo);
        for (int L = bid; L < 256; L += G) {
            int pm, pn; tile_of(L, 64, 4, pm, pn);
            gemm_tile(proj, PLD, (const bf16_t*)(ws + W_WTOUT), 2048, 2048, pm * 256, pn * 256, eo);
        }
        if (!(bid & 1))
            for (int L = bid; L < 256; L += G)
                gemm_small(proj, PLD, (const bf16_t*)(ws + W_WTOUT), 2048, 2048, NPROMPT + (L >> 3) * 16, (L & 7) * 128, eo);
    }
#endif
    xcd_barrier(xb); TB();
#ifndef NO_P6
    {
        const EpiPle ep{P.out, (const bf16_t*)(ws + W_NB), (const bf16_t*)(ws + W_PP), (const float*)(ws + W_RSS1), (float*)(ws + W_RSS2)};
        if (bid & 1)
            for (int L = bid; L < 256; L += G)
                gemm_small((const bf16_t*)(ws + W_NB), 1024, (const bf16_t*)(ws + W_WTGATE), 1024, 1024, NPROMPT + (L >> 3) * 16, (L & 7) * 128, ep);
        for (int L = bid; L < 256; L += G) {
            int pm, pn; tile_of(L, 64, 4, pm, pn);
            gemm_tile((const bf16_t*)(ws + W_NB), 1024, (const bf16_t*)(ws + W_WTGATE), 1024, 1024, pm * 256, pn * 256, ep);
        }
        if (!(bid & 1))
            for (int L = bid; L < 256; L += G)
                gemm_small((const bf16_t*)(ws + W_NB), 1024, (const bf16_t*)(ws + W_WTGATE), 1024, 1024, NPROMPT + (L >> 3) * 16, (L & 7) * 128, ep);
    }
#endif
    xcd_barrier(xb); TB();
    {
        const float* rss2 = (const float*)(ws + W_RSS2);
        for (int idx = bid * 512 + threadIdx.x; idx < NTOK * 256; idx += G * 512) {
            const int row = idx >> 8, c4 = (idx & 255) * 4;
            const f32x4 r0 = *(const f32x4*)(rss2 + (long)row * 16), r1 = *(const f32x4*)(rss2 + (long)row * 16 + 4), r2 = *(const f32x4*)(rss2 + (long)row * 16 + 8), r3 = *(const f32x4*)(rss2 + (long)row * 16 + 12);
            const float tot = (((r0[0] + r0[1]) + (r0[2] + r0[3])) + ((r1[0] + r1[1]) + (r1[2] + r1[3]))) + (((r2[0] + r2[1]) + (r2[2] + r2[3])) + ((r3[0] + r3[1]) + (r3[2] + r3[3])));
            const float rstd = rsqrtf(tot * (1.f / 1024.f) + EPS);
            f32x4* p = (f32x4*)(P.out + (long)row * 1024 + c4);
            const f32x4 gf = *(const f32x4*)(P.in[I_GFIN] + c4);
            *p = *p * rstd * gf;
        }
    }
#ifdef PROBE_K
    { TB(); const unsigned long long d = tb_[PROBE_K + 1] - tb_[PROBE_K], t0 = wall_clock64(); while (wall_clock64() - t0 < d) __builtin_amdgcn_s_sleep(8); }
#endif
}

extern "C" void kernel_launch(void* const* d_in, const int* in_sizes, int n_in, void* d_out, int out_size, void* d_ws, size_t ws_size, hipStream_t stream) {
    static int grid_blocks = 0;
    if (grid_blocks == 0) {
        if (n_in != 31 || out_size != (int)O_END || ws_size < W_END) {
            fprintf(stderr, "kernel_launch: unexpected shapes n_in %d out %d ws %zu (need %zu)\n", n_in, out_size, ws_size, (size_t)W_END);
            grid_blocks = -1; return;
        }
        int dev = 0, cus = 0, per_cu = 0;
        hipGetDevice(&dev);
        hipDeviceGetAttribute(&cus, hipDeviceAttributeMultiprocessorCount, dev);
        hipFuncSetAttribute((const void*)hymba_fwd, hipFuncAttributeMaxDynamicSharedMemorySize, LDS_BYTES);
        hipOccupancyMaxActiveBlocksPerMultiprocessor(&per_cu, (const void*)hymba_fwd, 512, LDS_BYTES);
        if (per_cu < 1) { fprintf(stderr, "kernel_launch: occupancy query says %d blocks/CU\n", per_cu); per_cu = 1; }
        grid_blocks = cus;
        (void)hipGetLastError();
    }
    if (grid_blocks < 0) return;
    if (hipMemsetAsync((char*)d_ws + W_BAR, 0, XCD_BAR_WORDS * sizeof(unsigned), stream) != hipSuccess) { fprintf(stderr, "kernel_launch: memset of the barrier words failed\n"); return; }
    Params p{};
    for (int i = 0; i < 31; ++i) p.in[i] = (const float*)d_in[i];
    p.out = (float*)d_out; p.ws = (char*)d_ws;
    void* args[] = {&p};
    hipError_t e = hipLaunchCooperativeKernel((const void*)hymba_fwd, dim3(grid_blocks), dim3(512), args, LDS_BYTES, stream);
    if (e != hipSuccess) fprintf(stderr, "cooperative launch failed: %s (grid %d)\n", hipGetErrorString(e), grid_blocks);
}
```

```cpp
#include <hip/hip_runtime.h>
#include <hip/hip_cooperative_groups.h>
#include <cstdio>
namespace cg = cooperative_groups;

typedef unsigned short bf16_t;
typedef short bf16x8 __attribute__((ext_vector_type(8)));
typedef float f32x4 __attribute__((ext_vector_type(4)));
typedef unsigned u32x2 __attribute__((ext_vector_type(2)));
typedef unsigned u32x4 __attribute__((ext_vector_type(4)));
#define DEV __device__ __forceinline__

constexpr int NPROMPT = 16384, NSAMPLE = 512, NTOK = 16896;
constexpr int PLD = 4608;
constexpr int C_ZA = 0, C_ZB = 1024, C_XBC = 2048, C_UB = 3584;
constexpr float EPS = 1e-6f;
constexpr long O_YP = 0, O_YS = 16777216, O_SSDP = 17301504, O_CONVP = 18350080, O_S5RP = 18386944, O_S5IP = 18419712,
               O_SSDS = 18452480, O_CONVS = 35229696, O_S5RS = 35819520, O_S5IS = 36343808, O_END = 36868096;
constexpr size_t W_WTIN = 0;
constexpr size_t W_WTOUT = W_WTIN + 4608ull * 1024 * 2;
constexpr size_t W_WTGLU = W_WTOUT + 1024ull * 2048 * 2;
constexpr size_t W_WTGATE = W_WTGLU + 1024ull * 1024 * 2;
constexpr size_t W_WTPP = W_WTGATE + 1024ull * 1024 * 2;
constexpr size_t W_NB = W_WTPP + 1024ull * 256 * 2;
constexpr size_t W_PB = W_NB + 16896ull * 1024 * 2;
constexpr size_t W_DTR = W_PB + 16896ull * 256 * 2;
constexpr size_t W_ACS = W_DTR + 16896ull * 16 * 4;
constexpr size_t W_CDEC = W_ACS + 16384ull * 16 * 4;
constexpr size_t W_RSS1 = W_CDEC + 8192;
constexpr size_t W_RSS2 = W_RSS1 + 16896ull * 16 * 4;
constexpr size_t W_PROJ = W_RSS2 + 16896ull * 16 * 4;
constexpr size_t W_PP = W_PROJ + 16896ull * 4608 * 2;
constexpr size_t W_RSTD = W_PP + 16896ull * 1024 * 2;
constexpr size_t W_BAR = W_RSTD + 16896ull * 4;
constexpr size_t W_END = W_BAR + 16384;

constexpr int LDS_BYTES = 131072 + 64;

struct Params {
    const float* in[31];
    float* out;
    char* ws;
};
enum { I_XP = 0, I_XS, I_PP, I_PS, I_SSD, I_CONV, I_S5R, I_S5I, I_WIN, I_GIN, I_CONVW, I_CONVB, I_DTB, I_ALOG, I_SSDD, I_SSDG,
       I_LRE, I_LIM, I_LDT, I_BRE, I_BIM, I_CRE, I_CIM, I_S5D, I_GLUW, I_GLUB, I_WOUT, I_GPLE, I_WGATE, I_WPP, I_GFIN };

extern __shared__ __attribute__((aligned(16))) char smem[];

DEV unsigned pk2(float lo, float hi) { unsigned r; asm("v_cvt_pk_bf16_f32 %0, %1, %2" : "=v"(r) : "v"(lo), "v"(hi)); return r; }
DEV float bflo(unsigned u) { return __uint_as_float(u << 16); }
DEV float bfhi(unsigned u) { return __uint_as_float(u & 0xffff0000u); }
DEV float wave_sum(float v) {
#pragma unroll
    for (int o = 1; o < 64; o <<= 1) v += __shfl_xor(v, o);
    return v;
}
DEV float siluf(float v) { return v / (1.f + __expf(-v)); }
DEV float sigmf(float v) { return 1.f / (1.f + __expf(-v)); }
DEV float geluf(float y) { float z = 0.7978845608f * (y + 0.044715f * y * y * y); return y / (1.f + __expf(-2.f * z)); }
DEV f32x4 mfma16(bf16x8 a, bf16x8 b, f32x4 c) { return __builtin_amdgcn_mfma_f32_16x16x32_bf16(a, b, c, 0, 0, 0); }
DEV int tid_fresh() { int t = threadIdx.x; asm volatile("" : "+v"(t)); return t; }
DEV void lds_fence() { asm volatile("s_waitcnt lgkmcnt(0)" ::: "memory"); }


#define XB_TMO      128
#define XB_XCNT(j)  (256  + 64 * (j))
#define XB_XSUB(j)  (1280 + 64 * (j))
#define XB_XGEN(j)  (2304 + 64 * (j))
#define XB_TOP      3328
#define XB_TOPGEN   3392
#define XCD_BAR_WORDS 3456
#define XB_SPIN_CAP (1u << 22)
#define LAS __attribute__((address_space(3)))
DEV unsigned xb_ld(unsigned* p) { return __hip_atomic_load(p, __ATOMIC_RELAXED, __HIP_MEMORY_SCOPE_AGENT); }
DEV unsigned xb_add(unsigned* p, unsigned v) { return __hip_atomic_fetch_add(p, v, __ATOMIC_RELAXED, __HIP_MEMORY_SCOPE_AGENT); }
DEV unsigned xb_xcc_id() { return (unsigned)__builtin_amdgcn_s_getreg((3 << 11) | 20) & 0xFu; }
#define XB_SPIN(cond, bar) do { unsigned _sp = 0; while (cond) { __builtin_amdgcn_s_sleep(1); \
    if ((++_sp & 255u) == 0u) { if (xb_ld(&(bar)[XB_TMO])) break; if (_sp > XB_SPIN_CAP) { atomicAdd(&(bar)[XB_TMO], 1u); break; } } } } while (0)
struct XcdBarrier { unsigned* bar; unsigned x; volatile LAS unsigned* st; };
DEV XcdBarrier xcd_barrier_post(unsigned* bar, volatile LAS unsigned* st) {
    XcdBarrier b; b.bar = bar; b.x = xb_xcc_id(); b.st = st;
    if (threadIdx.x == 0) (void)xb_add(&bar[XB_XCNT(b.x)], 1u);
    return b;
}
DEV void xcd_barrier_complete(unsigned* bar, unsigned x, unsigned& nloc, unsigned& nx) {
    const unsigned G = gridDim.x * gridDim.y * gridDim.z;
    unsigned sum, cnt, mine, sp = 0u;
    for (;;) {
        sum = 0u; cnt = 0u; mine = 0u;
#pragma unroll
        for (unsigned j = 0; j < 16; ++j) { const unsigned c = xb_ld(&bar[XB_XCNT(j)]); sum += c; cnt += (c > 0u) ? 1u : 0u; mine = (j == x) ? c : mine; }
        if (sum == G) break;
        __builtin_amdgcn_s_sleep(1);
        if ((++sp & 255u) == 0u) { if (xb_ld(&bar[XB_TMO])) break; if (sp > XB_SPIN_CAP) { atomicAdd(&bar[XB_TMO], 1u); break; } }
    }
    nloc = mine > 0u ? mine : 1u; nx = cnt > 0u ? cnt : 1u;
}
DEV void xcd_barrier(const XcdBarrier& b) {
    asm volatile("s_waitcnt vmcnt(0)" ::: "memory");
    __syncthreads();
    if (threadIdx.x == 0) {
        unsigned* bar = b.bar;
        __builtin_amdgcn_s_waitcnt(0);
        unsigned nloc = b.st[0], nx = b.st[1];
        if (nloc == 0u) { xcd_barrier_complete(bar, b.x, nloc, nx); b.st[0] = nloc; b.st[1] = nx; }
        const unsigned old = xb_add(&bar[XB_XSUB(b.x)], 1u);
        const unsigned gen = old / nloc;
        if (old + 1u == (gen + 1u) * nloc) {
            __builtin_amdgcn_fence(__ATOMIC_RELEASE, "agent");
            asm volatile("s_waitcnt vmcnt(0)" ::: "memory");
            const unsigned og = xb_add(&bar[XB_TOP], 1u);
            const unsigned tg = og / nx;
            if (og + 1u == (tg + 1u) * nx) xb_add(&bar[XB_TOPGEN], 1u);
            else XB_SPIN(xb_ld(&bar[XB_TOPGEN]) == tg, bar);
            __builtin_amdgcn_fence(__ATOMIC_ACQUIRE, "agent");
            xb_add(&bar[XB_XGEN(b.x)], 1u);
            asm volatile("s_waitcnt vmcnt(0)" ::: "memory");
        } else {
            XB_SPIN(xb_ld(&bar[XB_XGEN(b.x)]) == gen, bar);
            __builtin_amdgcn_fence(__ATOMIC_ACQUIRE, "agent");
            asm volatile("s_waitcnt vmcnt(0)" ::: "memory");
        }
    }
    __syncthreads();
}

constexpr int BM = 256, BK = 64, HALF = 128, HT = HALF * BK;
DEV int lds_byte(int r, int c) {
    int st = (r >> 4) * 2 + (c >> 5), rr = r & 15, cc = c & 31, ob = rr * 64 + cc * 2;
    return st * 1024 + (ob ^ (((ob >> 9) & 1) << 5));
}
DEV void stage_rc(int b, int& R, int& C) {
    int st = b / 1024, sb = b % 1024, swz = sb ^ (((sb >> 9) & 1) << 5);
    R = (st >> 1) * 16 + swz / 64; C = (st & 1) * 32 + (swz % 64) / 2;
}

template <class Epi>
DEV void gemm_tile(const bf16_t* __restrict__ A, int lda, const bf16_t* __restrict__ Bt, int ldb, int K, int brow, int bcol, const Epi& epi) {
    LAS unsigned char* lds = (LAS unsigned char*)smem;
    constexpr int HTB = HT * 2;
    const int tid = tid_fresh(), wid = __builtin_amdgcn_readfirstlane(tid >> 6), lane = tid & 63, wr = wid >> 2, wc = wid & 3, fr = lane & 15, fq = lane >> 4;
    unsigned voffA[2], voffB[2];
#pragma unroll
    for (int i = 0; i < 2; ++i) { int R, C; stage_rc(tid * 16 + i * 8192, R, C); voffA[i] = (unsigned)(R * lda + C) * 2u; voffB[i] = (unsigned)(R * ldb + C) * 2u; }
    const size_t kstep = (size_t)(BK * 2), hstepA = (size_t)HALF * lda * 2, hstepB = (size_t)HALF * ldb * 2;
    const unsigned ldsw = (unsigned)wid * 1024u;
    const int aoff = lds_byte(wr * 64 + fr, fq * 8), boff = lds_byte(wc * 32 + fr, fq * 8);
#define SA(b, h) (((b) * 2 + (h)) * HTB)
#define SB(b, h) ((4 + (b) * 2 + (h)) * HTB)
#define STAGE(bufoff, gbase, voff) do { _Pragma("unroll") for (int _i = 0; _i < 2; ++_i) \
        __builtin_amdgcn_global_load_lds((const unsigned*)((const char*)(gbase) + (voff)[_i]), (LAS unsigned*)(lds + (bufoff) + ldsw + _i * 8192), 16, 0, 0); } while (0)
#define LDA(dst, b, h) do { _Pragma("unroll") for (int m = 0; m < 4; ++m) _Pragma("unroll") for (int k = 0; k < 2; ++k) dst[m][k] = *(const LAS bf16x8*)(lds + SA(b, h) + aoff + m * 2048 + k * 1024); } while (0)
#define LDB(dst, b, h) do { _Pragma("unroll") for (int n = 0; n < 2; ++n) _Pragma("unroll") for (int k = 0; k < 2; ++k) dst[n][k] = *(const LAS bf16x8*)(lds + SB(b, h) + boff + n * 2048 + k * 1024); } while (0)
#define MMA(ai, bj, At, Bt_) do { __builtin_amdgcn_s_setprio(1); _Pragma("unroll") for (int m = 0; m < 4; ++m) _Pragma("unroll") for (int n = 0; n < 2; ++n) _Pragma("unroll") for (int k = 0; k < 2; ++k) \
        acc[ai][bj][m][n] = __builtin_amdgcn_mfma_f32_16x16x32_bf16(Bt_[n][k], At[m][k], acc[ai][bj][m][n], 0, 0, 0); __builtin_amdgcn_s_setprio(0); } while (0)
#define WAIT_V(n) asm volatile("s_waitcnt vmcnt(" #n ")" ::: "memory")
#define WAIT_L(n) asm volatile("s_waitcnt lgkmcnt(" #n ")" ::: "memory")
#define BAR __builtin_amdgcn_s_barrier()
#define SCHED __builtin_amdgcn_sched_barrier(0)
    f32x4 acc[2][2][4][2];
#pragma unroll
    for (int a = 0; a < 2; ++a)
#pragma unroll
        for (int b = 0; b < 2; ++b)
#pragma unroll
            for (int m = 0; m < 4; ++m)
#pragma unroll
                for (int n = 0; n < 2; ++n) acc[a][b][m][n] = (f32x4){0.f, 0.f, 0.f, 0.f};
    bf16x8 At[4][2], B0[2][2], B1[2][2];
    const int nt = K / BK;
    const char* cA = (const char*)A + (size_t)brow * lda * 2; const char* cB = (const char*)Bt + (size_t)bcol * ldb * 2;
    STAGE(SB(0, 0), cB, voffB); STAGE(SA(0, 0), cA, voffA); STAGE(SB(0, 1), cB + hstepB, voffB); STAGE(SA(0, 1), cA + hstepA, voffA);
    if (wr == 1) BAR;
    WAIT_V(4); BAR;
    STAGE(SB(1, 0), cB + kstep, voffB); STAGE(SA(1, 0), cA + kstep, voffA); STAGE(SB(1, 1), cB + hstepB + kstep, voffB);
    WAIT_V(6); BAR;
    for (int t = 0; t < nt - 2; t += 2) {
        const char* a1 = cA + (size_t)(t + 1) * kstep;
        const char* a2 = cA + (size_t)(t + 2) * kstep; const char* b2 = cB + (size_t)(t + 2) * kstep;
        const char* a3 = a2 + kstep; const char* b3 = b2 + kstep;
        LDB(B0, 0, 0); SCHED; LDA(At, 0, 0); STAGE(SA(1, 1), a1 + hstepA, voffA);
        WAIT_L(8); BAR; WAIT_L(0); MMA(0, 0, At, B0); BAR; SCHED;
        LDB(B1, 0, 1); STAGE(SB(0, 0), b2, voffB);
        BAR; WAIT_L(0); MMA(0, 1, At, B1); BAR;
        LDA(At, 0, 1); STAGE(SA(0, 0), a2, voffA);
        BAR; WAIT_L(0); MMA(1, 0, At, B0); BAR; SCHED;
        STAGE(SB(0, 1), b2 + hstepB, voffB);
        WAIT_V(6); BAR; MMA(1, 1, At, B1); BAR;
        LDB(B0, 1, 0); SCHED; LDA(At, 1, 0); STAGE(SA(0, 1), a2 + hstepA, voffA);
        WAIT_L(8); BAR; WAIT_L(0); MMA(0, 0, At, B0); BAR; SCHED;
        LDB(B1, 1, 1); STAGE(SB(1, 0), b3, voffB);
        BAR; WAIT_L(0); MMA(0, 1, At, B1); BAR;
        LDA(At, 1, 1); STAGE(SA(1, 0), a3, voffA);
        BAR; WAIT_L(0); MMA(1, 0, At, B0); BAR; SCHED;
        STAGE(SB(1, 1), b3 + hstepB, voffB);
        WAIT_V(6); BAR; MMA(1, 1, At, B1); BAR;
    }
    { const char* a1 = cA + (size_t)(nt - 1) * kstep;
      LDB(B0, 0, 0); LDA(At, 0, 0); STAGE(SA(1, 1), a1 + hstepA, voffA);
      BAR; WAIT_L(0); MMA(0, 0, At, B0); BAR;
      LDB(B1, 0, 1); BAR; WAIT_L(0); MMA(0, 1, At, B1); BAR;
      LDA(At, 0, 1); WAIT_V(4); BAR; WAIT_L(0); MMA(1, 0, At, B0); MMA(1, 1, At, B1); BAR; }
    { LDB(B0, 1, 0); LDA(At, 1, 0); WAIT_V(2); BAR; WAIT_L(0); MMA(0, 0, At, B0); BAR;
      LDB(B1, 1, 1); WAIT_V(0); BAR; WAIT_L(0); MMA(0, 1, At, B1); BAR;
      LDA(At, 1, 1); BAR; WAIT_L(0); MMA(1, 0, At, B0); MMA(1, 1, At, B1); BAR; }
    if (wr == 0) BAR;
    epi_big(epi, acc, brow, bcol, wr, wc, fr, fq);
    __syncthreads();
#undef SA
#undef SB
#undef STAGE
#undef LDA
#undef LDB
#undef MMA
}

DEV void tile_of(int L, int nM, int nN, int& pm, int& pn) {
    const int nwg = nM * nN; int wgid = L;
    { const int q = nwg / 8, r = nwg % 8, xcd = wgid % 8, off = wgid / 8; wgid = (xcd < r ? xcd * (q + 1) : r * (q + 1) + (xcd - r) * q) + off; }
    const int nig = 8 * nN, gid = wgid / nig, fm = gid * 8, gsz = (nM - fm) < 8 ? (nM - fm) : 8;
    pm = fm + ((wgid % nig) % gsz); pn = (wgid % nig) / gsz;
}

struct EpiBf16 {
    bf16_t* dst; int ld; const float* rstd;
    struct Ld { float rs; };
    DEV void load(int row, int col, Ld& d) const { d.rs = rstd ? rstd[row] : 1.f; }
    DEV void apply(int row, int col, const f32x4& v, const Ld& d, float& ss, float rowv) const {
        u32x2 o; o.x = pk2(v[0] * d.rs, v[1] * d.rs); o.y = pk2(v[2] * d.rs, v[3] * d.rs);
        *(u32x2*)(dst + (long)row * ld + col) = o;
    }
    DEV float rowload(int row) const { return 0.f; }
    DEV void rowdone(int row, float ss, int fq, int slot) const {}
    DEV void rowput(int row, float tot, int slot) const {}
};
struct EpiGlu {
    bf16_t* proj; const float* glu_b;
    struct Ld { u32x2 g, z; f32x4 b; };
    DEV void load(int row, int col, Ld& d) const {
        d.g = *(const u32x2*)(proj + (long)row * PLD + C_UB + col); d.z = *(const u32x2*)(proj + (long)row * PLD + C_ZB + col); d.b = *(const f32x4*)(glu_b + col);
    }
    DEV void apply(int row, int col, const f32x4& v, const Ld& d, float& ss, float rowv) const {
        const float y0 = bflo(d.g.x) * sigmf(v[0] + d.b[0]) * siluf(bflo(d.z.x)), y1 = bfhi(d.g.x) * sigmf(v[1] + d.b[1]) * siluf(bfhi(d.z.x));
        const float y2 = bflo(d.g.y) * sigmf(v[2] + d.b[2]) * siluf(bflo(d.z.y)), y3 = bfhi(d.g.y) * sigmf(v[3] + d.b[3]) * siluf(bfhi(d.z.y));
        u32x2 o; o.x = pk2(y0, y1); o.y = pk2(y2, y3);
        *(u32x2*)(proj + (long)row * PLD + C_ZB + col) = o;
    }
    DEV float rowload(int row) const { return 0.f; }
    DEV void rowdone(int row, float ss, int fq, int slot) const {}
    DEV void rowput(int row, float tot, int slot) const {}
};
struct EpiOut {
    const float* xp; const float* xs; bf16_t* h1b; float* rss;
    struct Ld { f32x4 x; };
    DEV void load(int row, int col, Ld& d) const {
        const float* xrow = row < NPROMPT ? xp + (long)row * 1024 : xs + (long)(row - NPROMPT) * 1024;
        d.x = *(const f32x4*)(xrow + col);
    }
    DEV void apply(int row, int col, const f32x4& a, const Ld& d, float& ss, float rowv) const {
        const f32x4 v = a + d.x;
        u32x2 o; o.x = pk2(v[0], v[1]); o.y = pk2(v[2], v[3]);
        *(u32x2*)(h1b + (long)row * 1024 + col) = o;
        const float r0 = bflo(o.x), r1 = bfhi(o.x), r2 = bflo(o.y), r3 = bfhi(o.y);
        ss += r0 * r0 + r1 * r1 + r2 * r2 + r3 * r3;
    }
    DEV float rowload(int row) const { return 0.f; }
    DEV void rowdone(int row, float ss, int fq, int slot) const {
        ss += __shfl_xor(ss, 16); ss += __shfl_xor(ss, 32);
        if (fq == 0) rss[(long)row * 16 + slot] = ss;
    }
    DEV void rowput(int row, float tot, int slot) const { rss[(long)row * 16 + slot] = tot; rss[(long)row * 16 + slot + 1] = 0.f; }
};
struct EpiPle {
    float* out; const bf16_t* h1b; const bf16_t* pp; const float* rss1; float* rss2;
    struct Ld { u32x2 h; u32x2 pv; };
    DEV void load(int row, int col, Ld& d) const {
        d.h = *(const u32x2*)(h1b + (long)row * 1024 + col); d.pv = *(const u32x2*)(pp + (long)row * 1024 + col);
    }
    DEV void apply(int row, int col, const f32x4& a, const Ld& d, float& ss, float rowv) const {
        const float rstd = rsqrtf(rowv * (1.f / 1024.f) + EPS);
        f32x4 h;
        h[0] = bflo(d.h.x) + bflo(d.pv.x) * sigmf(a[0] * rstd); h[1] = bfhi(d.h.x) + bfhi(d.pv.x) * sigmf(a[1] * rstd);
        h[2] = bflo(d.h.y) + bflo(d.pv.y) * sigmf(a[2] * rstd); h[3] = bfhi(d.h.y) + bfhi(d.pv.y) * sigmf(a[3] * rstd);
        *(f32x4*)(out + (long)row * 1024 + col) = h;
        ss += h[0] * h[0] + h[1] * h[1] + h[2] * h[2] + h[3] * h[3];
    }
    DEV float rowload(int row) const {
        const f32x4 a = *(const f32x4*)(rss1 + (long)row * 16), b = *(const f32x4*)(rss1 + (long)row * 16 + 4), c = *(const f32x4*)(rss1 + (long)row * 16 + 8), d = *(const f32x4*)(rss1 + (long)row * 16 + 12);
        return (((a[0] + a[1]) + (a[2] + a[3])) + ((b[0] + b[1]) + (b[2] + b[3]))) + (((c[0] + c[1]) + (c[2] + c[3])) + ((d[0] + d[1]) + (d[2] + d[3])));
    }
    DEV void rowdone(int row, float ss, int fq, int slot) const {
        ss += __shfl_xor(ss, 16); ss += __shfl_xor(ss, 32);
        if (fq == 0) rss2[(long)row * 16 + slot] = ss;
    }
    DEV void rowput(int row, float tot, int slot) const { rss2[(long)row * 16 + slot] = tot; rss2[(long)row * 16 + slot + 1] = 0.f; }
};
template <class Epi>
DEV void epi_big(const Epi& E, const f32x4 (&acc)[2][2][4][2], int brow, int bcol, int wr, int wc, int fr, int fq) {
#pragma unroll
    for (int ai = 0; ai < 2; ++ai)
#pragma unroll
        for (int mp = 0; mp < 2; ++mp) {
            typename Epi::Ld d[2][4]; float rv[2];
#pragma unroll
            for (int mm = 0; mm < 2; ++mm) {
                rv[mm] = E.rowload(brow + ai * 128 + wr * 64 + (mp * 2 + mm) * 16 + fr);
#pragma unroll
                for (int j = 0; j < 4; ++j)
                    E.load(brow + ai * 128 + wr * 64 + (mp * 2 + mm) * 16 + fr, bcol + (j >> 1) * 128 + wc * 32 + (j & 1) * 16 + fq * 4, d[mm][j]);
            }
#pragma unroll
            for (int mm = 0; mm < 2; ++mm) {
                const int row = brow + ai * 128 + wr * 64 + (mp * 2 + mm) * 16 + fr; float ss = 0.f;
#pragma unroll
                for (int j = 0; j < 4; ++j)
                    E.apply(row, bcol + (j >> 1) * 128 + wc * 32 + (j & 1) * 16 + fq * 4, acc[ai][j >> 1][mp * 2 + mm][j & 1], d[mm][j], ss, rv[mm]);
                E.rowdone(row, ss, fq, ((bcol >> 8) & 3) * 4 + wc);
            }
        }
}
template <class Epi>
DEV void gemm_small(const bf16_t* __restrict__ A, int lda, const bf16_t* __restrict__ Bt, int ldb, int K, int row0, int col0, const Epi& E) {
    const int tid = tid_fresh(), w = tid >> 6, lane = tid & 63, fr = lane & 15, fq = lane >> 4;
    const int kw = K >> 3;
    const bf16_t* ap = A + (long)(row0 + fr) * lda + w * kw + fq * 8;
    const bf16_t* bp = Bt + (long)(col0 + fr) * ldb + w * kw + fq * 8;
    f32x4 pacc[8];
#pragma unroll
    for (int n = 0; n < 8; ++n) pacc[n] = (f32x4){0.f, 0.f, 0.f, 0.f};
    for (int k0 = 0; k0 < kw; k0 += 128) {
        bf16x8 af[4], bf[4][8];
#pragma unroll
        for (int ks = 0; ks < 4; ++ks) {
            af[ks] = *(const bf16x8*)(ap + k0 + ks * 32);
#pragma unroll
            for (int n = 0; n < 8; ++n) bf[ks][n] = *(const bf16x8*)(bp + (long)n * 16 * ldb + k0 + ks * 32);
        }
#pragma unroll
        for (int ks = 0; ks < 4; ++ks)
#pragma unroll
            for (int n = 0; n < 8; ++n) pacc[n] = mfma16(bf[ks][n], af[ks], pacc[n]);
    }
    float* redk = (float*)smem;
    __syncthreads();
#pragma unroll
    for (int n = 0; n < 8; ++n) *(f32x4*)(redk + ((w * 8 + n) * 64 + lane) * 4) = pacc[n];
    __syncthreads();
    f32x4 acc = (f32x4){0.f, 0.f, 0.f, 0.f};
#pragma unroll
    for (int i = 0; i < 8; ++i) acc += *(const f32x4*)(redk + ((i * 8 + w) * 64 + lane) * 4);
    const int row = row0 + fr, col = col0 + w * 16 + fq * 4;
    typename Epi::Ld d;
    E.load(row, col, d);
    const float rv = E.rowload(row);
    float ss = 0.f;
    E.apply(row, col, acc, d, ss, rv);
    ss += __shfl_xor(ss, 16); ss += __shfl_xor(ss, 32);
    float* red = (float*)smem;
    __syncthreads();
    if (fq == 0) red[w * 16 + fr] = ss;
    __syncthreads();
    if (tid < 16) {
        float t = 0.f;
#pragma unroll
        for (int i = 0; i < 8; ++i) t += red[i * 16 + tid];
        E.rowput(row0 + tid, t, (col0 >> 7) * 2);
    }
    __syncthreads();
}

DEV void transpose_item(const float* __restrict__ src, int ldsrc, int k0, int c0, bf16_t* __restrict__ dst, int lddst, int n0,
                        const float* __restrict__ kscale, float* scr, int lane) {
    const int cl = lane & 31, kh = lane >> 5;
    float v[32];
#pragma unroll
    for (int i = 0; i < 32; ++i) v[i] = src[(long)(k0 + 2 * i + kh) * ldsrc + c0 + cl];
    if (kscale) {
#pragma unroll
        for (int i = 0; i < 32; ++i) v[i] *= kscale[k0 + 2 * i + kh];
    }
#pragma unroll
    for (int i = 0; i < 32; ++i) scr[(2 * i + kh) * 33 + cl] = v[i];
    lds_fence();
    const int c = lane & 7;
#pragma unroll
    for (int j = 0; j < 4; ++j) {
        const int n = (lane >> 3) + 8 * j; const float* sp = scr + (8 * c) * 33 + n;
        u32x4 o; o.x = pk2(sp[0 * 33], sp[1 * 33]); o.y = pk2(sp[2 * 33], sp[3 * 33]); o.z = pk2(sp[4 * 33], sp[5 * 33]); o.w = pk2(sp[6 * 33], sp[7 * 33]);
        *(u32x4*)(dst + (long)(n0 + n) * lddst + k0 + 8 * c) = o;
    }
    lds_fence();
}

DEV void phase0(const Params& P) {
    const int tid = tid_fresh(), lane = tid & 63, wave = tid >> 6, G = gridDim.x, bid = blockIdx.x;
    char* ws = P.ws;
    float* tile = (float*)smem;
    {
        float* scr = (float*)smem + wave * (64 * 33);
        constexpr int I_IN = 144 * 16, I_OUT = 32 * 32, I_GLU = 32 * 16, I_GATE = 32 * 16, I_PPW = 32 * 4;
        constexpr int I_ALL = I_IN + I_OUT + I_GLU + I_GATE + I_PPW;
        for (int it = bid * 8 + wave; it < I_ALL; it += G * 8) {
            int r = it;
            if (r < I_IN) {
                const int nb = r >> 4, kb = r & 15, n0 = nb * 32;
                int c0;
                if (n0 < 1024) c0 = n0; else if (n0 < 2048) c0 = 2576 + (n0 - 1024); else if (n0 < 3584) c0 = 1024 + (n0 - 2048); else c0 = 3600 + (n0 - 3584);
                transpose_item(P.in[I_WIN], 4624, kb * 64, c0, (bf16_t*)(ws + W_WTIN), 1024, n0, P.in[I_GIN], scr, lane); continue;
            }
            r -= I_IN;
            if (r < I_OUT) { const int nb = r >> 5, kb = r & 31; transpose_item(P.in[I_WOUT], 1024, kb * 64, nb * 32, (bf16_t*)(ws + W_WTOUT), 2048, nb * 32, nullptr, scr, lane); continue; }
            r -= I_OUT;
            if (r < I_GLU) { const int nb = r >> 4, kb = r & 15; transpose_item(P.in[I_GLUW], 1024, kb * 64, nb * 32, (bf16_t*)(ws + W_WTGLU), 1024, nb * 32, nullptr, scr, lane); continue; }
            r -= I_GLU;
            if (r < I_GATE) { const int nb = r >> 4, kb = r & 15; transpose_item(P.in[I_WGATE], 1024, kb * 64, nb * 32, (bf16_t*)(ws + W_WTGATE), 1024, nb * 32, P.in[I_GPLE], scr, lane); continue; }
            r -= I_GATE;
            { const int nb = r >> 2, kb = r & 3; transpose_item(P.in[I_WPP], 1024, kb * 64, nb * 32, (bf16_t*)(ws + W_WTPP), 256, nb * 32, nullptr, scr, lane); }
        }
        __syncthreads();
    }
    bf16_t* wdt = (bf16_t*)smem;
    float* psum = (float*)(smem + 16 * 1032 * 2);
    float* pdt = psum + 128;
    {
        float wv[32];
#pragma unroll
        for (int i = 0; i < 32; ++i) { const int idx = tid + i * 512, k = idx >> 4, e = idx & 15; wv[i] = P.in[I_WIN][(long)k * 4624 + 2560 + e] * P.in[I_GIN][k]; }
#pragma unroll
        for (int i = 0; i < 32; ++i) { const int idx = tid + i * 512, k = idx >> 4, e = idx & 15; wdt[e * 1032 + k] = (bf16_t)(pk2(wv[i], 0.f) & 0xffffu); }
    }
    __syncthreads();
    {
        const int fr = lane & 15, fq = lane >> 4;
        bf16x8 wf[4];
#pragma unroll
        for (int j = 0; j < 4; ++j) wf[j] = *(const bf16x8*)(wdt + fr * 1032 + (wave * 4 + j) * 32 + fq * 8);
        bf16_t* xb = (bf16_t*)(ws + W_NB);
        float* dtr = (float*)(ws + W_DTR);
        float* rstdp = (float*)(ws + W_RSTD);
        f32x4 xan[4], xcn[4];
        if (bid < NTOK / 16) {
            const int row = bid * 16 + fr;
            const float* xr = (row < NPROMPT ? P.in[I_XP] + (long)row * 1024 : P.in[I_XS] + (long)(row - NPROMPT) * 1024) + wave * 128 + fq * 8;
#pragma unroll
            for (int j = 0; j < 4; ++j) { xan[j] = *(const f32x4*)(xr + j * 32); xcn[j] = *(const f32x4*)(xr + j * 32 + 4); }
        }
        for (int task = bid; task < NTOK / 16; task += G) {
            const int row = task * 16 + fr;
            f32x4 xa[4], xc[4];
#pragma unroll
            for (int j = 0; j < 4; ++j) { xa[j] = xan[j]; xc[j] = xcn[j]; }
            if (task + G < NTOK / 16) {
                const int rown = (task + G) * 16 + fr;
                const float* xr = (rown < NPROMPT ? P.in[I_XP] + (long)rown * 1024 : P.in[I_XS] + (long)(rown - NPROMPT) * 1024) + wave * 128 + fq * 8;
#pragma unroll
                for (int j = 0; j < 4; ++j) { xan[j] = *(const f32x4*)(xr + j * 32); xcn[j] = *(const f32x4*)(xr + j * 32 + 4); }
            }
            f32x4 acc = {0.f, 0.f, 0.f, 0.f}; float ss = 0.f;
#pragma unroll
            for (int j = 0; j < 4; ++j) {
                ss += xa[j][0] * xa[j][0] + xa[j][1] * xa[j][1] + xa[j][2] * xa[j][2] + xa[j][3] * xa[j][3] + xc[j][0] * xc[j][0] + xc[j][1] * xc[j][1] + xc[j][2] * xc[j][2] + xc[j][3] * xc[j][3];
                u32x4 q; q.x = pk2(xa[j][0], xa[j][1]); q.y = pk2(xa[j][2], xa[j][3]); q.z = pk2(xc[j][0], xc[j][1]); q.w = pk2(xc[j][2], xc[j][3]);
                *(u32x4*)(xb + (long)row * 1024 + wave * 128 + j * 32 + fq * 8) = q;
                acc = mfma16(wf[j], __builtin_bit_cast(bf16x8, q), acc);
            }
            ss += __shfl_xor(ss, 16); ss += __shfl_xor(ss, 32);
            if (fq == 0) psum[wave * 16 + fr] = ss;
            *(f32x4*)(pdt + wave * 256 + fr * 16 + fq * 4) = acc;
            __syncthreads();
            if (tid < 256) {
                const int t = tid >> 4, e = tid & 15;
                float tot = 0.f, d = 0.f;
#pragma unroll
                for (int w8 = 0; w8 < 8; ++w8) { tot += psum[w8 * 16 + t]; d += pdt[w8 * 256 + t * 16 + e]; }
                const float rstd = rsqrtf(tot * (1.f / 1024.f) + EPS);
                dtr[(long)(task * 16 + t) * 16 + e] = d * rstd;
                if (e == 0) rstdp[task * 16 + t] = rstd;
            }
            __syncthreads();
        }
    }
    bf16_t* pb = (bf16_t*)(ws + W_PB);
    for (int idx = bid * 512 + tid; idx < NTOK * 64; idx += G * 512) {
        const int row = idx >> 6, c4 = (idx & 63) * 4;
        const float* src = row < NPROMPT ? P.in[I_PP] + (long)row * 256 : P.in[I_PS] + (long)(row - NPROMPT) * 256;
        const f32x4 v = *(const f32x4*)(src + c4);
        u32x2 o; o.x = pk2(v[0], v[1]); o.y = pk2(v[2], v[3]);
        *(u32x2*)(pb + (long)row * 256 + c4) = o;
    }
    __syncthreads();
}

DEV void conv_load7(const bf16_t* __restrict__ pcol, long row0, int t0, u32x4 (&raw)[7]) {
#pragma unroll
    for (int i = 0; i < 7; ++i) {
        const int t = t0 - 3 + i;
        raw[i] = (u32x4){0u, 0u, 0u, 0u};
        if (t >= 0) raw[i] = *(const u32x4*)(pcol + (row0 - 3 + i) * PLD);
    }
}
DEV void conv_compute(const u32x4 (&rawp)[7], const float* __restrict__ cw, const float* __restrict__ cb, float (&o)[4][8]) {
    float raw[7][8];
#pragma unroll
    for (int i = 0; i < 7; ++i) {
        const u32x4 u = rawp[i];
        raw[i][0] = bflo(u.x); raw[i][1] = bfhi(u.x); raw[i][2] = bflo(u.y); raw[i][3] = bfhi(u.y);
        raw[i][4] = bflo(u.z); raw[i][5] = bfhi(u.z); raw[i][6] = bflo(u.w); raw[i][7] = bfhi(u.w);
    }
    float w[4][8], bias[8];
#pragma unroll
    for (int k = 0; k < 4; ++k) {
        const f32x4 a = *(const f32x4*)(cw + k * 1536), b = *(const f32x4*)(cw + k * 1536 + 4);
        w[k][0] = a[0]; w[k][1] = a[1]; w[k][2] = a[2]; w[k][3] = a[3]; w[k][4] = b[0]; w[k][5] = b[1]; w[k][6] = b[2]; w[k][7] = b[3];
    }
    { const f32x4 a = *(const f32x4*)(cb), b = *(const f32x4*)(cb + 4);
      bias[0] = a[0]; bias[1] = a[1]; bias[2] = a[2]; bias[3] = a[3]; bias[4] = b[0]; bias[5] = b[1]; bias[6] = b[2]; bias[7] = b[3]; }
#pragma unroll
    for (int j = 0; j < 4; ++j)
#pragma unroll
        for (int c = 0; c < 8; ++c) {
            float a = bias[c];
#pragma unroll
            for (int k = 0; k < 4; ++k) a += w[k][c] * raw[j + k][c];
            o[j][c] = siluf(a);
        }
}
DEV void conv_compute_lds(const u32x4 (&rawp)[7], const float* cwl, float (&o)[4][8]) {
    float raw[7][8];
#pragma unroll
    for (int i = 0; i < 7; ++i) {
        const u32x4 u = rawp[i];
        raw[i][0] = bflo(u.x); raw[i][1] = bfhi(u.x); raw[i][2] = bflo(u.y); raw[i][3] = bfhi(u.y);
        raw[i][4] = bflo(u.z); raw[i][5] = bfhi(u.z); raw[i][6] = bflo(u.w); raw[i][7] = bfhi(u.w);
    }
    float w[5][8];
#pragma unroll
    for (int k = 0; k < 5; ++k) {
        const f32x4 a = *(const f32x4*)(cwl + k * 512), b = *(const f32x4*)(cwl + k * 512 + 4);
        w[k][0] = a[0]; w[k][1] = a[1]; w[k][2] = a[2]; w[k][3] = a[3]; w[k][4] = b[0]; w[k][5] = b[1]; w[k][6] = b[2]; w[k][7] = b[3];
    }
#pragma unroll
    for (int j = 0; j < 4; ++j)
#pragma unroll
        for (int c = 0; c < 8; ++c) {
            float a = w[4][c];
#pragma unroll
            for (int k = 0; k < 4; ++k) a += w[k][c] * raw[j + k][c];
            o[j][c] = siluf(a);
        }
}
DEV void conv4x8(const bf16_t* __restrict__ pcol, long row0, int t0, const float* __restrict__ hist, const float* __restrict__ cw, const float* __restrict__ cb, float (&o)[4][8]) {
    float raw[7][8];
#pragma unroll
    for (int i = 0; i < 7; ++i) {
        const int t = t0 - 3 + i;
        if (t >= 0) {
            const u32x4 u = *(const u32x4*)(pcol + (row0 - 3 + i) * PLD);
            raw[i][0] = bflo(u.x); raw[i][1] = bfhi(u.x); raw[i][2] = bflo(u.y); raw[i][3] = bfhi(u.y);
            raw[i][4] = bflo(u.z); raw[i][5] = bfhi(u.z); raw[i][6] = bflo(u.w); raw[i][7] = bfhi(u.w);
        } else if (hist) {
            const f32x4 a = *(const f32x4*)(hist + (long)(t + 3) * 1536), b = *(const f32x4*)(hist + (long)(t + 3) * 1536 + 4);
            raw[i][0] = a[0]; raw[i][1] = a[1]; raw[i][2] = a[2]; raw[i][3] = a[3]; raw[i][4] = b[0]; raw[i][5] = b[1]; raw[i][6] = b[2]; raw[i][7] = b[3];
        } else {
#pragma unroll
            for (int c = 0; c < 8; ++c) raw[i][c] = 0.f;
        }
    }
    float w[4][8], bias[8];
#pragma unroll
    for (int k = 0; k < 4; ++k) {
        const f32x4 a = *(const f32x4*)(cw + k * 1536), b = *(const f32x4*)(cw + k * 1536 + 4);
        w[k][0] = a[0]; w[k][1] = a[1]; w[k][2] = a[2]; w[k][3] = a[3]; w[k][4] = b[0]; w[k][5] = b[1]; w[k][6] = b[2]; w[k][7] = b[3];
    }
    { const f32x4 a = *(const f32x4*)(cb), b = *(const f32x4*)(cb + 4);
      bias[0] = a[0]; bias[1] = a[1]; bias[2] = a[2]; bias[3] = a[3]; bias[4] = b[0]; bias[5] = b[1]; bias[6] = b[2]; bias[7] = b[3]; }
#pragma unroll
    for (int j = 0; j < 4; ++j)
#pragma unroll
        for (int c = 0; c < 8; ++c) {
            float a = bias[c];
#pragma unroll
            for (int k = 0; k < 4; ++k) a += w[k][c] * raw[j + k][c];
            o[j][c] = siluf(a);
        }
}

constexpr int PIT = 136;
constexpr int R1_OFF = 0, R2_OFF = 128 * PIT * 2, R3_OFF = 2 * 128 * PIT * 2, R4_OFF = 3 * 128 * PIT * 2;

DEV void ssd_s1_item(const Params& P, int item) {
    const int tid = tid_fresh(), lane = tid & 63, w = tid >> 6, fr = lane & 15, fq = lane >> 4;
    const int b = item >> 5, c = (item >> 1) & 15, g = item & 1;
    char* ws = P.ws;
    const bf16_t* proj = (const bf16_t*)(ws + W_PROJ);
    const long rowc = (long)b * 2048 + c * 128;
    bf16_t* R1 = (bf16_t*)(smem + R1_OFF); bf16_t* R2 = (bf16_t*)(smem + R2_OFF); bf16_t* R3 = (bf16_t*)(smem + R3_OFF);
    float* acs = (float*)(smem + R4_OFF);
    float* dtv = acs + 1024;
    {
        const int h = g * 8 + w;
        const float bias = P.in[I_DTB][h], A = -__expf(P.in[I_ALOG][h]);
        const float* dtr = (const float*)(ws + W_DTR);
        float x0 = dtr[(rowc + 2 * lane) * 16 + h] + bias, x1 = dtr[(rowc + 2 * lane + 1) * 16 + h] + bias;
        float d0 = x0 > 20.f ? x0 : log1pf(__expf(x0)), d1 = x1 > 20.f ? x1 : log1pf(__expf(x1));
        float a0 = d0 * A, a1 = a0 + d1 * A;
        float run = a1;
#pragma unroll
        for (int o = 1; o < 64; o <<= 1) { float t = __shfl_up(run, o); if (lane >= o) run += t; }
        const float excl = run - a1;
        a0 += excl; a1 += excl;
        acs[w * 128 + 2 * lane] = a0; acs[w * 128 + 2 * lane + 1] = a1;
        dtv[w * 128 + 2 * lane] = d0; dtv[w * 128 + 2 * lane + 1] = d1;
        float* acsg = (float*)(ws + W_ACS) + (((long)b * 16 + c) * 16 + h) * 128;
        acsg[2 * lane] = a0; acsg[2 * lane + 1] = a1;
        if (lane == 63) ((float*)(ws + W_CDEC))[(b * 16 + c) * 16 + h] = __expf(a1);
    }
    float* cwl = (float*)(smem + R4_OFF + 8192);
    for (int u = tid; u < 5 * 512; u += 512) { const int k = u >> 9, ch = u & 511; cwl[u] = k < 4 ? P.in[I_CONVW][k * 1536 + g * 512 + ch] : P.in[I_CONVB][g * 512 + ch]; }
    {
        const int nblk = tid & 15, lq = tid >> 4, l0 = lq * 4;
#pragma unroll
        for (int j = 0; j < 2; ++j) {
            const int ch0 = 1024 + j * 256 + g * 128 + nblk * 8;
            float o[4][8];
            conv4x8(proj + C_XBC + ch0, rowc + l0, c * 128 + l0, nullptr, P.in[I_CONVW] + ch0, P.in[I_CONVB] + ch0, o);
            bf16_t* dst = j == 0 ? R2 : R1;
#pragma unroll
            for (int r = 0; r < 4; ++r) {
                u32x4 q; q.x = pk2(o[r][0], o[r][1]); q.y = pk2(o[r][2], o[r][3]); q.z = pk2(o[r][4], o[r][5]); q.w = pk2(o[r][6], o[r][7]);
                *(u32x4*)(dst + (l0 + r) * PIT + nblk * 8) = q;
            }
            if (j == 0) {
#pragma unroll
                for (int i = 0; i < 8; ++i) {
                    u32x2 q; q.x = pk2(o[0][i], o[1][i]); q.y = pk2(o[2][i], o[3][i]);
                    *(u32x2*)(R3 + (nblk * 8 + i) * PIT + l0) = q;
                }
            }
        }
    }
    __syncthreads();
    const int wr = w >> 1, wc = w & 1;
    f32x4 cbm[2][4];
#pragma unroll
    for (int m = 0; m < 2; ++m)
#pragma unroll
        for (int n = 0; n < 4; ++n) cbm[m][n] = (f32x4){0.f, 0.f, 0.f, 0.f};
#pragma unroll
    for (int ks = 0; ks < 4; ++ks) {
        bf16x8 af[2], bfm[4];
#pragma unroll
        for (int m = 0; m < 2; ++m) af[m] = *(const bf16x8*)(R1 + (wr * 32 + m * 16 + fr) * PIT + ks * 32 + fq * 8);
#pragma unroll
        for (int n = 0; n < 4; ++n) bfm[n] = *(const bf16x8*)(R2 + (wc * 64 + n * 16 + fr) * PIT + ks * 32 + fq * 8);
#pragma unroll
        for (int m = 0; m < 2; ++m)
#pragma unroll
            for (int n = 0; n < 4; ++n) cbm[m][n] = mfma16(bfm[n], af[m], cbm[m][n]);
    }
    __syncthreads();
    bf16_t* XT = R2; bf16_t* XW = R2 + 64 * PIT;
    bf16_t* ydg = (bf16_t*)(ws + W_NB);
    float* states = P.out;
    const int wp = w >> 2, wn = w & 3;
    u32x4 rawn[7];
    if (tid < 256) conv_load7(proj + C_XBC + (g * 8) * 64 + (tid & 7) * 8, rowc + (tid >> 3) * 4, c * 128 + (tid >> 3) * 4, rawn);
    for (int e = 0; e < 8; ++e) {
        const int h = g * 8 + e;
        const float dskip = P.in[I_SSDD][h];
        if (tid < 256) {
            const int pblk = tid & 7, lq = tid >> 3, l0 = lq * 4, ch0 = h * 64 + pblk * 8;
            float o[4][8];
            conv_compute_lds(rawn, cwl + e * 64 + pblk * 8, o);
            if (e < 7) conv_load7(proj + C_XBC + ch0 + 64, rowc + l0, c * 128 + l0, rawn);
            const float alast = acs[e * 128 + 127];
            float we[4];
#pragma unroll
            for (int r = 0; r < 4; ++r) we[r] = __expf(alast - acs[e * 128 + l0 + r]) * dtv[e * 128 + l0 + r];
#pragma unroll
            for (int i = 0; i < 8; ++i) {
                u32x2 q; q.x = pk2(o[0][i], o[1][i]); q.y = pk2(o[2][i], o[3][i]);
                *(u32x2*)(XT + (pblk * 8 + i) * PIT + l0) = q;
                u32x2 q2; q2.x = pk2(o[0][i] * we[0], o[1][i] * we[1]); q2.y = pk2(o[2][i] * we[2], o[3][i] * we[3]);
                *(u32x2*)(XW + (pblk * 8 + i) * PIT + l0) = q2;
            }
        }
#pragma unroll
        for (int m = 0; m < 2; ++m) {
            const int l = wr * 32 + m * 16 + fr; const float al = acs[e * 128 + l];
#pragma unroll
            for (int n = 0; n < 4; ++n) {
                const int s0 = wc * 64 + n * 16 + fq * 4;
                const f32x4 as = *(const f32x4*)(acs + e * 128 + s0), ds = *(const f32x4*)(dtv + e * 128 + s0);
                float v[4];
#pragma unroll
                for (int r = 0; r < 4; ++r) { const float t = cbm[m][n][r] * __expf(al - as[r]) * ds[r]; v[r] = (s0 + r <= l) ? t : 0.f; }
                u32x2 q; q.x = pk2(v[0], v[1]); q.y = pk2(v[2], v[3]);
                *(u32x2*)(R1 + l * PIT + s0) = q;
            }
        }
        __syncthreads();
        {
            f32x4 yd[2][2];
#pragma unroll
            for (int m = 0; m < 2; ++m)
#pragma unroll
                for (int n = 0; n < 2; ++n) yd[m][n] = (f32x4){0.f, 0.f, 0.f, 0.f};
            {
                bf16x8 af[4][2], bfm[4][2];
#pragma unroll
                for (int ks = 0; ks < 4; ++ks) {
#pragma unroll
                    for (int m = 0; m < 2; ++m) af[ks][m] = *(const bf16x8*)(R1 + (wr * 32 + m * 16 + fr) * PIT + ks * 32 + fq * 8);
#pragma unroll
                    for (int n = 0; n < 2; ++n) bfm[ks][n] = *(const bf16x8*)(XT + (wc * 32 + n * 16 + fr) * PIT + ks * 32 + fq * 8);
                }
                __builtin_amdgcn_sched_barrier(0);
#pragma unroll
                for (int ks = 0; ks < 4; ++ks)
                    if (ks <= wr) {
#pragma unroll
                        for (int m = 0; m < 2; ++m)
#pragma unroll
                            for (int n = 0; n < 2; ++n) yd[m][n] = mfma16(bfm[ks][n], af[ks][m], yd[m][n]);
                    }
            }
#pragma unroll
            for (int m = 0; m < 2; ++m)
#pragma unroll
                for (int n = 0; n < 2; ++n) {
                    const int l = wr * 32 + m * 16 + fr, p0 = wc * 32 + n * 16 + fq * 4;
                    const float x0 = __uint_as_float(((unsigned)XT[(p0 + 0) * PIT + l]) << 16), x1 = __uint_as_float(((unsigned)XT[(p0 + 1) * PIT + l]) << 16);
                    const float x2 = __uint_as_float(((unsigned)XT[(p0 + 2) * PIT + l]) << 16), x3 = __uint_as_float(((unsigned)XT[(p0 + 3) * PIT + l]) << 16);
                    u32x2 q; q.x = pk2(yd[m][n][0] + dskip * x0, yd[m][n][1] + dskip * x1); q.y = pk2(yd[m][n][2] + dskip * x2, yd[m][n][3] + dskip * x3);
                    *(u32x2*)(ydg + (rowc + l) * 1024 + h * 64 + p0) = q;
                }
        }
        {
            f32x4 st[2][2];
#pragma unroll
            for (int m = 0; m < 2; ++m)
#pragma unroll
                for (int n = 0; n < 2; ++n) st[m][n] = (f32x4){0.f, 0.f, 0.f, 0.f};
            {
                bf16x8 af[4][2], bfm[4][2];
#pragma unroll
                for (int ks = 0; ks < 4; ++ks) {
#pragma unroll
                    for (int m = 0; m < 2; ++m) af[ks][m] = *(const bf16x8*)(XW + (wp * 32 + m * 16 + fr) * PIT + ks * 32 + fq * 8);
#pragma unroll
                    for (int n = 0; n < 2; ++n) bfm[ks][n] = *(const bf16x8*)(R3 + (wn * 32 + n * 16 + fr) * PIT + ks * 32 + fq * 8);
                }
                __builtin_amdgcn_sched_barrier(0);
#pragma unroll
                for (int ks = 0; ks < 4; ++ks)
#pragma unroll
                    for (int m = 0; m < 2; ++m)
#pragma unroll
                        for (int n = 0; n < 2; ++n) st[m][n] = mfma16(bfm[ks][n], af[ks][m], st[m][n]);
            }
            float* sp = states + (((long)b * 16 + c) * 16 + h) * 8192;
#pragma unroll
            for (int m = 0; m < 2; ++m)
#pragma unroll
                for (int n = 0; n < 2; ++n) {
                    const int p = wp * 32 + m * 16 + fr, n0 = wn * 32 + n * 16 + fq * 4;
                    *(f32x4*)(sp + p * 128 + n0) = st[m][n];
                }
        }
        __syncthreads();
    }
}

DEV void ssd_s2(const Params& P) {
    float* states = P.out;
    const float* cdec = (const float*)(P.ws + W_CDEC);
    for (int idx = blockIdx.x * 512 + threadIdx.x; idx < 262144; idx += gridDim.x * 512) {
        const int bh = idx >> 11, q = idx & 2047, b = bh >> 4, h = bh & 15;
        f32x4 H = (f32x4){0.f, 0.f, 0.f, 0.f};
#pragma unroll
        for (int c = 0; c < 16; ++c) {
            f32x4* ptr = (f32x4*)(states + (((long)b * 16 + c) * 16 + h) * 8192) + q;
            const f32x4 s = *ptr; *ptr = H;
            const float d = cdec[(b * 16 + c) * 16 + h];
            H = H * d + s;
        }
        *((f32x4*)(P.out + O_SSDP + (long)bh * 8192) + q) = H;
    }
}

DEV void ssd_s3_item(const Params& P, int item) {
    const int tid = tid_fresh(), lane = tid & 63, w = tid >> 6, fr = lane & 15, fq = lane >> 4;
    const int b = item >> 5, c = (item >> 1) & 15, g = item & 1;
    char* ws = P.ws;
    bf16_t* proj = (bf16_t*)(ws + W_PROJ);
    const long rowc = (long)b * 2048 + c * 128;
    bf16_t* R1 = (bf16_t*)(smem + R1_OFF); bf16_t* HB = (bf16_t*)(smem + R2_OFF);
    float* ssq = (float*)(smem + R4_OFF);
    const bf16_t* ydg = (const bf16_t*)(ws + W_NB);
    const float* states = P.out;
    const float* acsg = (const float*)(ws + W_ACS);
    const int hp = tid >> 3, hn0 = (tid & 7) * 16;
    f32x4 hreg[4];
    {
        const float* sp = states + (((long)b * 16 + c) * 16 + g * 8) * 8192 + hp * 128 + hn0;
#pragma unroll
        for (int i = 0; i < 4; ++i) hreg[i] = *(const f32x4*)(sp + i * 4);
    }
    __syncthreads();
    {
        const int nblk = tid & 15, lq = tid >> 4, l0 = lq * 4;
        const int ch0 = 1280 + g * 128 + nblk * 8;
        float o[4][8];
        conv4x8(proj + C_XBC + ch0, rowc + l0, c * 128 + l0, nullptr, P.in[I_CONVW] + ch0, P.in[I_CONVB] + ch0, o);
#pragma unroll
        for (int r = 0; r < 4; ++r) {
            u32x4 q; q.x = pk2(o[r][0], o[r][1]); q.y = pk2(o[r][2], o[r][3]); q.z = pk2(o[r][4], o[r][5]); q.w = pk2(o[r][6], o[r][7]);
            *(u32x4*)(R1 + (l0 + r) * PIT + nblk * 8) = q;
        }
    }
    const int wr = w >> 1, wc = w & 1;
    unsigned ypk[8][2][2][2];
    float ssl[2] = {0.f, 0.f};
    bf16x8 afc[4][2];
#pragma unroll
    for (int e = 0; e < 8; ++e) {
        const int h = g * 8 + e;
        bf16_t* hb = HB + (e & 1) * 64 * PIT;
        {
            u32x4 q0, q1;
            q0.x = pk2(hreg[0][0], hreg[0][1]); q0.y = pk2(hreg[0][2], hreg[0][3]); q0.z = pk2(hreg[1][0], hreg[1][1]); q0.w = pk2(hreg[1][2], hreg[1][3]);
            q1.x = pk2(hreg[2][0], hreg[2][1]); q1.y = pk2(hreg[2][2], hreg[2][3]); q1.z = pk2(hreg[3][0], hreg[3][1]); q1.w = pk2(hreg[3][2], hreg[3][3]);
            *(u32x4*)(hb + hp * PIT + hn0) = q0; *(u32x4*)(hb + hp * PIT + hn0 + 8) = q1;
        }
        if (e < 7) {
            const float* sp = states + (((long)b * 16 + c) * 16 + h + 1) * 8192 + hp * 128 + hn0;
#pragma unroll
            for (int i = 0; i < 4; ++i) hreg[i] = *(const f32x4*)(sp + i * 4);
        }
        u32x2 yq[2][2], zz[2][2]; float ea[2];
#pragma unroll
        for (int m = 0; m < 2; ++m) {
            const int l = wr * 32 + m * 16 + fr;
            ea[m] = acsg[(((long)b * 16 + c) * 16 + h) * 128 + l];
#pragma unroll
            for (int n = 0; n < 2; ++n) {
                const int p0 = wc * 32 + n * 16 + fq * 4;
                yq[m][n] = *(const u32x2*)(ydg + (rowc + l) * 1024 + h * 64 + p0);
                zz[m][n] = *(const u32x2*)(proj + (rowc + l) * PLD + C_ZA + h * 64 + p0);
            }
        }
        __syncthreads();
        if (e == 0) {
#pragma unroll
            for (int ks = 0; ks < 4; ++ks)
#pragma unroll
                for (int m = 0; m < 2; ++m) afc[ks][m] = *(const bf16x8*)(R1 + (wr * 32 + m * 16 + fr) * PIT + ks * 32 + fq * 8);
        }
        f32x4 yo[2][2];
#pragma unroll
        for (int m = 0; m < 2; ++m)
#pragma unroll
            for (int n = 0; n < 2; ++n) yo[m][n] = (f32x4){0.f, 0.f, 0.f, 0.f};
        {
            bf16x8 bfm[4][2];
#pragma unroll
            for (int ks = 0; ks < 4; ++ks)
#pragma unroll
                for (int n = 0; n < 2; ++n) bfm[ks][n] = *(const bf16x8*)(hb + (wc * 32 + n * 16 + fr) * PIT + ks * 32 + fq * 8);
            __builtin_amdgcn_sched_barrier(0);
#pragma unroll
            for (int ks = 0; ks < 4; ++ks)
#pragma unroll
                for (int m = 0; m < 2; ++m)
#pragma unroll
                    for (int n = 0; n < 2; ++n) yo[m][n] = mfma16(bfm[ks][n], afc[ks][m], yo[m][n]);
        }
#pragma unroll
        for (int m = 0; m < 2; ++m) {
            const float eam = __expf(ea[m]);
#pragma unroll
            for (int n = 0; n < 2; ++n) {
                const float v0 = (bflo(yq[m][n].x) + eam * yo[m][n][0]) * siluf(bflo(zz[m][n].x)), v1 = (bfhi(yq[m][n].x) + eam * yo[m][n][1]) * siluf(bfhi(zz[m][n].x));
                const float v2 = (bflo(yq[m][n].y) + eam * yo[m][n][2]) * siluf(bflo(zz[m][n].y)), v3 = (bfhi(yq[m][n].y) + eam * yo[m][n][3]) * siluf(bfhi(zz[m][n].y));
                ssl[m] += v0 * v0 + v1 * v1 + v2 * v2 + v3 * v3;
                ypk[e][m][n][0] = pk2(v0, v1); ypk[e][m][n][1] = pk2(v2, v3);
            }
        }
    }
#pragma unroll
    for (int m = 0; m < 2; ++m) {
        float ss = ssl[m];
        ss += __shfl_xor(ss, 16); ss += __shfl_xor(ss, 32);
        if (fq == 0) ssq[wc * 128 + wr * 32 + m * 16 + fr] = ss;
    }
    f32x4 ggv[8][2];
#pragma unroll
    for (int e = 0; e < 8; ++e)
#pragma unroll
        for (int n = 0; n < 2; ++n) ggv[e][n] = *(const f32x4*)(P.in[I_SSDG] + (g * 8 + e) * 64 + wc * 32 + n * 16 + fq * 4);
    __syncthreads();
#pragma unroll
    for (int m = 0; m < 2; ++m) {
        const int l = wr * 32 + m * 16 + fr;
        const float rstd = rsqrtf((ssq[l] + ssq[128 + l]) * (1.f / 512.f) + EPS);
#pragma unroll
        for (int e = 0; e < 8; ++e)
#pragma unroll
            for (int n = 0; n < 2; ++n) {
                const int h = g * 8 + e, p0 = wc * 32 + n * 16 + fq * 4;
                const f32x4 gg = ggv[e][n];
                const unsigned a0 = ypk[e][m][n][0], a1 = ypk[e][m][n][1];
                u32x2 o; o.x = pk2(bflo(a0) * rstd * gg[0], bfhi(a0) * rstd * gg[1]); o.y = pk2(bflo(a1) * rstd * gg[2], bfhi(a1) * rstd * gg[3]);
                *(u32x2*)(proj + (rowc + l) * PLD + C_ZA + h * 64 + p0) = o;
            }
    }
}

DEV void ssd_sample_item(const Params& P, int item) {
    const int tid = tid_fresh();
    const int b = item >> 1, g = item & 1;
    char* ws = P.ws;
    bf16_t* proj = (bf16_t*)(ws + W_PROJ);
    const long row0 = NPROMPT + (long)b * 4;
    float* xs = (float*)smem;
    float* Bs = xs + 2048;
    float* Cs = Bs + 512;
    float* dts = Cs + 512;
    float* das = dts + 32;
    float* vs = das + 32;
    float* red = vs + 2048;
    float* zs = red + 32;
    for (int u = tid; u < 768; u += 512) {
        int ch; float* dst; int dcol;
        if (u < 512) { ch = g * 512 + u; dst = xs; dcol = u; }
        else if (u < 640) { ch = 1024 + g * 128 + (u - 512); dst = Bs; dcol = u - 512; }
        else { ch = 1280 + g * 128 + (u - 640); dst = Cs; dcol = u - 640; }
        const int pitch = u < 512 ? 512 : 128;
        float full[7];
#pragma unroll
        for (int i = 0; i < 3; ++i) full[i] = P.in[I_CONV][((long)b * 3 + i) * 1536 + ch];
#pragma unroll
        for (int i = 0; i < 4; ++i) full[3 + i] = __uint_as_float(((unsigned)proj[(row0 + i) * PLD + C_XBC + ch]) << 16);
        const float w0 = P.in[I_CONVW][ch], w1 = P.in[I_CONVW][1536 + ch], w2 = P.in[I_CONVW][3072 + ch], w3 = P.in[I_CONVW][4608 + ch], bias = P.in[I_CONVB][ch];
#pragma unroll
        for (int t = 0; t < 4; ++t) dst[t * pitch + dcol] = siluf(bias + w0 * full[t] + w1 * full[t + 1] + w2 * full[t + 2] + w3 * full[t + 3]);
    }
    for (int u = tid; u < 4 * 256; u += 512) {
        const int t = u >> 8, c2 = (u & 255) * 2;
        const unsigned zz = *(const unsigned*)(proj + (row0 + t) * PLD + C_ZA + g * 512 + c2);
        zs[t * 512 + c2] = bflo(zz); zs[t * 512 + c2 + 1] = bfhi(zz);
    }
    if (tid < 32) {
        const int t = tid >> 3, e = tid & 7, h = g * 8 + e;
        const float x = ((const float*)(ws + W_DTR))[(row0 + t) * 16 + h] + P.in[I_DTB][h];
        const float d = x > 20.f ? x : log1pf(__expf(x));
        dts[tid] = d; das[tid] = __expf(-d * __expf(P.in[I_ALOG][h]));
    }
    __syncthreads();
    const int p = tid >> 3, nb = tid & 7, n0 = nb * 16;
    f32x4 hn[4];
    {
        const float* sp0 = P.in[I_SSD] + (((long)b * 16 + g * 8) * 64 + p) * 128 + n0;
#pragma unroll
        for (int i = 0; i < 4; ++i) hn[i] = *(const f32x4*)(sp0 + i * 4);
    }
    for (int e = 0; e < 8; ++e) {
        const int h = g * 8 + e;
        float* op = P.out + O_SSDS + (((long)b * 16 + h) * 64 + p) * 128 + n0;
        f32x4 hv[4];
#pragma unroll
        for (int i = 0; i < 4; ++i) hv[i] = hn[i];
        if (e < 7) {
            const float* sp = P.in[I_SSD] + (((long)b * 16 + h + 1) * 64 + p) * 128 + n0;
#pragma unroll
            for (int i = 0; i < 4; ++i) hn[i] = *(const f32x4*)(sp + i * 4);
        }
        const float dsk = P.in[I_SSDD][h];
#pragma unroll
        for (int t = 0; t < 4; ++t) {
            const float dec = das[t * 8 + e], xv = xs[t * 512 + e * 64 + p], coef = dts[t * 8 + e] * xv;
            float part = 0.f;
#pragma unroll
            for (int i = 0; i < 4; ++i) {
                const f32x4 bv = *(const f32x4*)(Bs + t * 128 + n0 + i * 4), cv = *(const f32x4*)(Cs + t * 128 + n0 + i * 4);
                hv[i] = hv[i] * dec + bv * coef;
                part += hv[i][0] * cv[0] + hv[i][1] * cv[1] + hv[i][2] * cv[2] + hv[i][3] * cv[3];
            }
            part += __shfl_xor(part, 1); part += __shfl_xor(part, 2); part += __shfl_xor(part, 4);
            if (nb == 0) {
                const float z = zs[t * 512 + e * 64 + p];
                vs[t * 512 + e * 64 + p] = (part + dsk * xv) * siluf(z);
            }
        }
#pragma unroll
        for (int i = 0; i < 4; ++i) *(f32x4*)(op + i * 4) = hv[i];
    }
    __syncthreads();
    {
        const int t = tid >> 7, cidx = tid & 127;
        float v[4]; float ss = 0.f;
#pragma unroll
        for (int i = 0; i < 4; ++i) { v[i] = vs[t * 512 + cidx * 4 + i]; ss += v[i] * v[i]; }
        ss = wave_sum(ss);
        if ((tid & 63) == 0) red[tid >> 6] = ss;
        __syncthreads();
        const float tot = red[t * 2] + red[t * 2 + 1];
        const float rstd = rsqrtf(tot * (1.f / 512.f) + EPS);
        const f32x4 gg = *(const f32x4*)(P.in[I_SSDG] + g * 512 + cidx * 4);
        u32x2 o; o.x = pk2(v[0] * rstd * gg[0], v[1] * rstd * gg[1]); o.y = pk2(v[2] * rstd * gg[2], v[3] * rstd * gg[3]);
        *(u32x2*)(proj + (row0 + t) * PLD + C_ZA + g * 512 + cidx * 4) = o;
    }
    __syncthreads();
}

constexpr int S5P = 20;
template <bool SAMPLE>
DEV void s5_item(const Params& P, int g, long rowbase, int bidx) {
    const int tid = tid_fresh(), lane = tid & 63, w = tid >> 6, fr = lane & 15, fq = lane >> 4;
    constexpr int TPW = SAMPLE ? 16 : 256;
    bf16_t* proj = (bf16_t*)(P.ws + W_PROJ);
    float* buf = (float*)smem + w * (128 * S5P);
    float* carry = (float*)smem + 8 * 128 * S5P;
    float* fs = carry + 1024 + w * 128;
    float ar, ai;
    {
        const float lr = P.in[I_LRE][g * 64 + lane], li = P.in[I_LIM][g * 64 + lane], delta = expf(P.in[I_LDT][g]);
        const float mag = expf(lr * delta), ang = li * delta;
        ar = mag * cosf(ang); ai = mag * sinf(ang);
        const float qre = ar - 1.f, den = lr * lr + li * li;
        fs[lane] = (qre * lr + ai * li) / den; fs[64 + lane] = (ai * lr - qre * li) / den;
    }
    lds_fence();
    bf16x8 bbf[8];
#pragma unroll
    for (int j = 0; j < 8; ++j) {
        bf16x8 z = {0, 0, 0, 0, 0, 0, 0, 0};
        if (fq < 2) {
            const int p = (j & 3) * 16 + fr;
            const float f_r = fs[p], f_i = fs[64 + p];
            const float* br = P.in[I_BRE] + ((long)(g * 64 + p)) * 16 + fq * 8;
            const float* bi = P.in[I_BIM] + ((long)(g * 64 + p)) * 16 + fq * 8;
            const f32x4 r0 = *(const f32x4*)br, r1 = *(const f32x4*)(br + 4), i0 = *(const f32x4*)bi, i1 = *(const f32x4*)(bi + 4);
            f32x4 o0, o1;
            if (j < 4) { o0 = r0 * f_r - i0 * f_i; o1 = r1 * f_r - i1 * f_i; }
            else { o0 = i0 * f_r + r0 * f_i; o1 = i1 * f_r + r1 * f_i; }
            u32x4 q; q.x = pk2(o0[0], o0[1]); q.y = pk2(o0[2], o0[3]); q.z = pk2(o1[0], o1[1]); q.w = pk2(o1[2], o1[3]);
            z = __builtin_bit_cast(bf16x8, q);
        }
        bbf[j] = z;
    }
    bf16x8 ccf[4];
#pragma unroll
    for (int ks = 0; ks < 4; ++ks) {
        const float* src = (ks < 2 ? P.in[I_CRE] : P.in[I_CIM]) + ((long)(g * 16 + fr)) * 64 + (ks & 1) * 32 + fq * 8;
        f32x4 c0 = *(const f32x4*)src, c1 = *(const f32x4*)(src + 4);
        if (ks >= 2) { c0 = -c0; c1 = -c1; }
        u32x4 q; q.x = pk2(c0[0], c0[1]); q.y = pk2(c0[2], c0[3]); q.z = pk2(c1[0], c1[1]); q.w = pk2(c1[2], c1[3]);
        ccf[ks] = __builtin_bit_cast(bf16x8, q);
    }
    const f32x4 dsk = *(const f32x4*)(P.in[I_S5D] + g * 16 + fq * 4);
    const long roww = rowbase + (long)w * TPW;
    float xr = 0.f, xi = 0.f;
    float sre[8], sim[8];
#pragma unroll
    for (int j = 0; j < 8; ++j) { sre[j] = 0.f; sim[j] = 0.f; }
    if (SAMPLE) {
#pragma unroll
        for (int j = 0; j < TPW / 4; ++j) {
            const long seq = (roww - NPROMPT) / 4 + j;
            sre[j] = P.in[I_S5R][(seq * 64 + g) * 64 + lane]; sim[j] = P.in[I_S5I][(seq * 64 + g) * 64 + lane];
        }
    }
    constexpr int NPASS = SAMPLE ? 1 : 2;
#pragma unroll 1
    for (int pass = 0; pass < NPASS; ++pass) {
        const bool last = (pass == NPASS - 1);
        if (!SAMPLE && pass == 1) {
            carry[w * 128 + lane] = xr; carry[w * 128 + 64 + lane] = xi;
            __syncthreads();
            float pr = ar, pi = ai;
#pragma unroll
            for (int q = 0; q < 8; ++q) { const float nr = pr * pr - pi * pi, ni = 2.f * pr * pi; pr = nr; pi = ni; }
            float sr = 0.f, si = 0.f;
            for (int ww = 0; ww < w; ++ww) {
                const float cr = carry[ww * 128 + lane], ci = carry[ww * 128 + 64 + lane];
                const float nr = pr * sr - pi * si + cr, ni = pr * si + pi * sr + ci; sr = nr; si = ni;
            }
            xr = sr; xi = si;
        }
        if (!SAMPLE && pass == 0 && w == 7) continue;
        bf16x8 ufn = {0, 0, 0, 0, 0, 0, 0, 0};
        if (fq < 2) ufn = *(const bf16x8*)(proj + (roww + fr) * PLD + C_UB + g * 16 + fq * 8);
#pragma unroll 1
        for (int sb = 0; sb < TPW / 16; ++sb) {
            const long r = roww + sb * 16;
            const bf16x8 uf = ufn;
            if (fq < 2 && sb + 1 < TPW / 16) ufn = *(const bf16x8*)(proj + (r + 16 + fr) * PLD + C_UB + g * 16 + fq * 8);
            u32x2* up = (u32x2*)(proj + (r + fr) * PLD + C_UB + g * 16 + fq * 4);
            u32x2 uu = {0u, 0u};
            if (last) uu = *up;
            const f32x4 zero = {0.f, 0.f, 0.f, 0.f};
#pragma unroll
            for (int j = 0; j < 8; ++j) {
                const f32x4 d = mfma16(uf, bbf[j], zero);
                *(f32x4*)(buf + (j * 16 + fr) * S5P + fq * 4) = d;
            }
            lds_fence();
            {
                f32x4 brv[4], biv[4];
#pragma unroll
                for (int q = 0; q < 4; ++q) { brv[q] = *(const f32x4*)(buf + lane * S5P + q * 4); biv[q] = *(const f32x4*)(buf + (64 + lane) * S5P + q * 4); }
                __builtin_amdgcn_sched_barrier(0);
#pragma unroll
                for (int q = 0; q < 4; ++q) {
                    if (SAMPLE) {
#pragma unroll
                        for (int j = 0; j < 8; ++j) if (j == sb * 4 + q) { xr = sre[j]; xi = sim[j]; }
                    }
#pragma unroll
                    for (int i = 0; i < 4; ++i) {
                        const float nr = ar * xr - ai * xi + brv[q][i], ni = ar * xi + ai * xr + biv[q][i];
                        xr = nr; xi = ni; brv[q][i] = nr; biv[q][i] = ni;
                    }
                    if (SAMPLE) {
                        const long seq = (r - NPROMPT) / 4 + q;
                        P.out[O_S5RS + (seq * 64 + g) * 64 + lane] = xr; P.out[O_S5IS + (seq * 64 + g) * 64 + lane] = xi;
                    }
                }
                if (last) {
#pragma unroll
                    for (int q = 0; q < 4; ++q) { *(f32x4*)(buf + lane * S5P + q * 4) = brv[q]; *(f32x4*)(buf + (64 + lane) * S5P + q * 4) = biv[q]; }
                }
            }
            if (last) {
                lds_fence();
                f32x4 y = {0.f, 0.f, 0.f, 0.f};
                float xv[4][8];
#pragma unroll
                for (int ks = 0; ks < 4; ++ks)
#pragma unroll
                    for (int i = 0; i < 8; ++i) xv[ks][i] = buf[(ks * 32 + fq * 8 + i) * S5P + fr];
                __builtin_amdgcn_sched_barrier(0);
#pragma unroll
                for (int ks = 0; ks < 4; ++ks) {
                    u32x4 q; q.x = pk2(xv[ks][0], xv[ks][1]); q.y = pk2(xv[ks][2], xv[ks][3]); q.z = pk2(xv[ks][4], xv[ks][5]); q.w = pk2(xv[ks][6], xv[ks][7]);
                    y = mfma16(ccf[ks], __builtin_bit_cast(bf16x8, q), y);
                }
                const float y0 = geluf(y[0] + dsk[0] * bflo(uu.x)), y1 = geluf(y[1] + dsk[1] * bfhi(uu.x));
                const float y2 = geluf(y[2] + dsk[2] * bflo(uu.y)), y3 = geluf(y[3] + dsk[3] * bfhi(uu.y));
                u32x2 o; o.x = pk2(y0, y1); o.y = pk2(y2, y3);
                *up = o;
            }
            lds_fence();
        }
    }
    if (!SAMPLE && w == 7) {
        P.out[O_S5RP + ((long)bidx * 64 + g) * 64 + lane] = xr; P.out[O_S5IP + ((long)bidx * 64 + g) * 64 + lane] = xi;
    }
    __syncthreads();
}

__global__ void __launch_bounds__(512) hymba_fwd(Params P) {
#ifdef PROBE_K
    unsigned long long tb_[9]; int nb_ = 0;
#define TB() do { tb_[nb_++] = wall_clock64(); } while (0)
    TB();
#else
#define TB() do {} while (0)
#endif
    const int G = gridDim.x, bid = blockIdx.x;
    char* ws = P.ws;
    bf16_t* proj = (bf16_t*)(ws + W_PROJ);
    unsigned* barw = (unsigned*)(ws + W_BAR);
    volatile LAS unsigned* stw = (volatile LAS unsigned*)(smem + 131072);
    if (threadIdx.x < 4) stw[threadIdx.x] = 0u;
    __syncthreads();
    const XcdBarrier xb = xcd_barrier_post(barw, stw);
#ifndef NO_P0
    phase0(P);
#endif
    xcd_barrier(xb); TB();
#ifndef NO_P1
    for (int L = bid; L < 1188; L += G) {
        int pm, pn; tile_of(L, 66, 18, pm, pn);
        gemm_tile((const bf16_t*)(ws + W_NB), 1024, (const bf16_t*)(ws + W_WTIN), 1024, 1024, pm * 256, pn * 256, EpiBf16{proj, PLD, (const float*)(ws + W_RSTD)});
    }
    for (int L = (bid + G - 1188 % G) % G; L < 264; L += G) {
        int pm, pn; tile_of(L, 66, 4, pm, pn);
        gemm_tile((const bf16_t*)(ws + W_PB), 256, (const bf16_t*)(ws + W_WTPP), 256, 256, pm * 256, pn * 256, EpiBf16{(bf16_t*)(ws + W_PP), 1024, nullptr});
    }
#endif
    xcd_barrier(xb); TB();
    for (int idx = bid * 512 + threadIdx.x; idx < (8 + 128) * 3 * 192; idx += G * 512) {
        const int c8 = (idx % 192) * 8, sj = idx / 192, j = sj % 3, sq = sj / 3;
        const long row = sq < 8 ? (long)sq * 2048 + 2045 + j : NPROMPT + (long)(sq - 8) * 4 + 1 + j;
        const u32x4 u = *(const u32x4*)(proj + row * PLD + C_XBC + c8);
        float* dst = sq < 8 ? P.out + O_CONVP + ((long)sq * 3 + j) * 1536 + c8 : P.out + O_CONVS + ((long)(sq - 8) * 3 + j) * 1536 + c8;
        *(f32x4*)dst = (f32x4){bflo(u.x), bfhi(u.x), bflo(u.y), bfhi(u.y)};
        *(f32x4*)(dst + 4) = (f32x4){bflo(u.z), bfhi(u.z), bflo(u.w), bfhi(u.w)};
    }
#ifdef PROBE2
    unsigned long long tq_[5]; tq_[0] = wall_clock64();
#endif
#ifndef NO_S1
    for (int it = bid; it < 256; it += G) ssd_s1_item(P, it);
#endif
#ifdef PROBE2
    tq_[1] = wall_clock64();
#endif
#ifndef NO_SS
    for (int it = bid; it < 256; it += G) ssd_sample_item(P, it);
#endif
#ifdef PROBE2
    tq_[2] = wall_clock64();
#endif
#ifndef NO_S5P
    for (int it = bid; it < 512; it += G) s5_item<false>(P, it & 63, (long)(it >> 6) * 2048, it >> 6);
#endif
#ifdef PROBE2
    tq_[3] = wall_clock64();
#endif
#ifndef NO_S5S
    for (int it = bid; it < 256; it += G) s5_item<true>(P, it & 63, NPROMPT + (long)(it >> 6) * 128, 0);
#endif
#ifdef PROBE2
    tq_[4] = wall_clock64();
    { const unsigned long long d = tq_[PROBE2 + 1] - tq_[PROBE2], t0 = wall_clock64(); while (wall_clock64() - t0 < d) __builtin_amdgcn_s_sleep(8); }
#endif
    xcd_barrier(xb); TB();
    if (bid & 1) ssd_s2(P);
    {
        const EpiGlu eg{proj, P.in[I_GLUB]};
        for (int L = bid; L < 256; L += G) {
            int pm, pn; tile_of(L, 64, 4, pm, pn);
            gemm_tile(proj + C_UB, PLD, (const bf16_t*)(ws + W_WTGLU), 1024, 1024, pm * 256, pn * 256, eg);
        }
        for (int L = bid; L < 256; L += G)
            gemm_small(proj + C_UB, PLD, (const bf16_t*)(ws + W_WTGLU), 1024, 1024, NPROMPT + (L >> 3) * 16, (L & 7) * 128, eg);
    }
    if (!(bid & 1)) ssd_s2(P);
    xcd_barrier(xb); TB();
#ifndef NO_S3
    for (int it = bid; it < 256; it += G) ssd_s3_item(P, it);
#endif
    xcd_barrier(xb); TB();
#ifndef NO_P5
    {
        const EpiOut eo{P.in[I_XP], P.in[I_XS], (bf16_t*)(ws + W_NB), (float*)(ws + W_RSS1)};
        if (bid & 1)
            for (int L = bid; L < 256; L += G)
                gemm_small(proj, PLD, (const bf16_t*)(ws + W_WTOUT), 2048, 2048, NPROMPT + (L >> 3) * 16, (L & 7) * 128, eo);
        for (int L = bid; L < 256; L += G) {
            int pm, pn; tile_of(L, 64, 4, pm, pn);
            gemm_tile(proj, PLD, (const bf16_t*)(ws + W_WTOUT), 2048, 2048, pm * 256, pn * 256, eo);
        }
        if (!(bid & 1))
            for (int L = bid; L < 256; L += G)
                gemm_small(proj, PLD, (const bf16_t*)(ws + W_WTOUT), 2048, 2048, NPROMPT + (L >> 3) * 16, (L & 7) * 128, eo);
    }
#endif
    xcd_barrier(xb); TB();
#ifndef NO_P6
    {
        const EpiPle ep{P.out, (const bf16_t*)(ws + W_NB), (const bf16_t*)(ws + W_PP), (const float*)(ws + W_RSS1), (float*)(ws + W_RSS2)};
        if (bid & 1)
            for (int L = bid; L < 256; L += G)
                gemm_small((const bf16_t*)(ws + W_NB), 1024, (const bf16_t*)(ws + W_WTGATE), 1024, 1024, NPROMPT + (L >> 3) * 16, (L & 7) * 128, ep);
        for (int L = bid; L < 256; L += G) {
            int pm, pn; tile_of(L, 64, 4, pm, pn);
            gemm_tile((const bf16_t*)(ws + W_NB), 1024, (const bf16_t*)(ws + W_WTGATE), 1024, 1024, pm * 256, pn * 256, ep);
        }
        if (!(bid & 1))
            for (int L = bid; L < 256; L += G)
                gemm_small((const bf16_t*)(ws + W_NB), 1024, (const bf16_t*)(ws + W_WTGATE), 1024, 1024, NPROMPT + (L >> 3) * 16, (L & 7) * 128, ep);
    }
#endif
    xcd_barrier(xb); TB();
    {
        const float* rss2 = (const float*)(ws + W_RSS2);
        for (int idx = bid * 512 + threadIdx.x; idx < NTOK * 256; idx += G * 512) {
            const int row = idx >> 8, c4 = (idx & 255) * 4;
            const f32x4 r0 = *(const f32x4*)(rss2 + (long)row * 16), r1 = *(const f32x4*)(rss2 + (long)row * 16 + 4), r2 = *(const f32x4*)(rss2 + (long)row * 16 + 8), r3 = *(const f32x4*)(rss2 + (long)row * 16 + 12);
            const float tot = (((r0[0] + r0[1]) + (r0[2] + r0[3])) + ((r1[0] + r1[1]) + (r1[2] + r1[3]))) + (((r2[0] + r2[1]) + (r2[2] + r2[3])) + ((r3[0] + r3[1]) + (r3[2] + r3[3])));
            const float rstd = rsqrtf(tot * (1.f / 1024.f) + EPS);
            f32x4* p = (f32x4*)(P.out + (long)row * 1024 + c4);
            const f32x4 gf = *(const f32x4*)(P.in[I_GFIN] + c4);
            *p = *p * rstd * gf;
        }
    }
#ifdef PROBE_K
    { TB(); const unsigned long long d = tb_[PROBE_K + 1] - tb_[PROBE_K], t0 = wall_clock64(); while (wall_clock64() - t0 < d) __builtin_amdgcn_s_sleep(8); }
#endif
}

extern "C" void kernel_launch(void* const* d_in, const int* in_sizes, int n_in, void* d_out, int out_size, void* d_ws, size_t ws_size, hipStream_t stream) {
    static int grid_blocks = 0;
    if (grid_blocks == 0) {
        if (n_in != 31 || out_size != (int)O_END || ws_size < W_END) {
            fprintf(stderr, "kernel_launch: unexpected shapes n_in %d out %d ws %zu (need %zu)\n", n_in, out_size, ws_size, (size_t)W_END);
            grid_blocks = -1; return;
        }
        int dev = 0, cus = 0, per_cu = 0;
        hipGetDevice(&dev);
        hipDeviceGetAttribute(&cus, hipDeviceAttributeMultiprocessorCount, dev);
        hipFuncSetAttribute((const void*)hymba_fwd, hipFuncAttributeMaxDynamicSharedMemorySize, LDS_BYTES);
        hipOccupancyMaxActiveBlocksPerMultiprocessor(&per_cu, (const void*)hymba_fwd, 512, LDS_BYTES);
        if (per_cu < 1) { fprintf(stderr, "kernel_launch: occupancy query says %d blocks/CU\n", per_cu); per_cu = 1; }
        grid_blocks = cus;
        (void)hipGetLastError();
    }
    if (grid_blocks < 0) return;
    if (hipMemsetAsync((char*)d_ws + W_BAR, 0, XCD_BAR_WORDS * sizeof(unsigned), stream) != hipSuccess) { fprintf(stderr, "kernel_launch: memset of the barrier words failed\n"); return; }
    Params p{};
    for (int i = 0; i < 31; ++i) p.in[i] = (const float*)d_in[i];
    p.out = (float*)d_out; p.ws = (char*)d_ws;
    void* args[] = {&p};
    hipError_t e = hipLaunchCooperativeKernel((const void*)hymba_fwd, dim3(grid_blocks), dim3(512), args, LDS_BYTES, stream);
    if (e != hipSuccess) fprintf(stderr, "cooperative launch failed: %s (grid %d)\n", hipGetErrorString(e), grid_blocks);
}
```

```cpp
#include <hip/hip_runtime.h>
#include <hip/hip_cooperative_groups.h>
#include <cstdio>
namespace cg = cooperative_groups;

typedef unsigned short bf16_t;
typedef short bf16x8 __attribute__((ext_vector_type(8)));
typedef float f32x4 __attribute__((ext_vector_type(4)));
typedef unsigned u32x2 __attribute__((ext_vector_type(2)));
typedef unsigned u32x4 __attribute__((ext_vector_type(4)));
#define DEV __device__ __forceinline__

constexpr int NPROMPT = 16384, NSAMPLE = 512, NTOK = 16896;
constexpr int PLD = 4608;
constexpr int C_ZA = 0, C_ZB = 1024, C_XBC = 2048, C_UB = 3584;
constexpr float EPS = 1e-6f;
constexpr long O_YP = 0, O_YS = 16777216, O_SSDP = 17301504, O_CONVP = 18350080, O_S5RP = 18386944, O_S5IP = 18419712,
               O_SSDS = 18452480, O_CONVS = 35229696, O_S5RS = 35819520, O_S5IS = 36343808, O_END = 36868096;
constexpr size_t W_WTIN = 0;
constexpr size_t W_WTOUT = W_WTIN + 4608ull * 1024 * 2;
constexpr size_t W_WTGLU = W_WTOUT + 1024ull * 2048 * 2;
constexpr size_t W_WTGATE = W_WTGLU + 1024ull * 1024 * 2;
constexpr size_t W_WTPP = W_WTGATE + 1024ull * 1024 * 2;
constexpr size_t W_NB = W_WTPP + 1024ull * 256 * 2;
constexpr size_t W_PB = W_NB + 16896ull * 1024 * 2;
constexpr size_t W_DTR = W_PB + 16896ull * 256 * 2;
constexpr size_t W_ACS = W_DTR + 16896ull * 16 * 4;
constexpr size_t W_CDEC = W_ACS + 16384ull * 16 * 4;
constexpr size_t W_RSS1 = W_CDEC + 8192;
constexpr size_t W_RSS2 = W_RSS1 + 16896ull * 16 * 4;
constexpr size_t W_PROJ = W_RSS2 + 16896ull * 16 * 4;
constexpr size_t W_PP = W_PROJ + 16896ull * 4608 * 2;
constexpr size_t W_RSTD = W_PP + 16896ull * 1024 * 2;
constexpr size_t W_BAR = W_RSTD + 16896ull * 4;
constexpr size_t W_END = W_BAR + 16384;

constexpr int LDS_BYTES = 131072 + 64;

struct Params {
    const float* in[31];
    float* out;
    char* ws;
};
enum { I_XP = 0, I_XS, I_PP, I_PS, I_SSD, I_CONV, I_S5R, I_S5I, I_WIN, I_GIN, I_CONVW, I_CONVB, I_DTB, I_ALOG, I_SSDD, I_SSDG,
       I_LRE, I_LIM, I_LDT, I_BRE, I_BIM, I_CRE, I_CIM, I_S5D, I_GLUW, I_GLUB, I_WOUT, I_GPLE, I_WGATE, I_WPP, I_GFIN };

extern __shared__ __attribute__((aligned(16))) char smem[];

DEV unsigned pk2(float lo, float hi) { unsigned r; asm("v_cvt_pk_bf16_f32 %0, %1, %2" : "=v"(r) : "v"(lo), "v"(hi)); return r; }
DEV float bflo(unsigned u) { return __uint_as_float(u << 16); }
DEV float bfhi(unsigned u) { return __uint_as_float(u & 0xffff0000u); }
DEV float wave_sum(float v) {
#pragma unroll
    for (int o = 1; o < 64; o <<= 1) v += __shfl_xor(v, o);
    return v;
}
DEV float siluf(float v) { return v * __builtin_amdgcn_rcpf(1.f + __expf(-v)); }
DEV float sigmf(float v) { return __builtin_amdgcn_rcpf(1.f + __expf(-v)); }
DEV float geluf(float y) { float z = 0.7978845608f * (y + 0.044715f * y * y * y); return y * __builtin_amdgcn_rcpf(1.f + __expf(-2.f * z)); }
DEV f32x4 mfma16(bf16x8 a, bf16x8 b, f32x4 c) { return __builtin_amdgcn_mfma_f32_16x16x32_bf16(a, b, c, 0, 0, 0); }
DEV int tid_fresh() { int t = threadIdx.x; asm volatile("" : "+v"(t)); return t; }
DEV void lds_fence() { asm volatile("s_waitcnt lgkmcnt(0)" ::: "memory"); }


#define XB_TMO      128
#define XB_XCNT(j)  (256  + 64 * (j))
#define XB_XSUB(j)  (1280 + 64 * (j))
#define XB_XGEN(j)  (2304 + 64 * (j))
#define XB_TOP      3328
#define XB_TOPGEN   3392
#define XCD_BAR_WORDS 3456
#define XB_SPIN_CAP (1u << 22)
#define LAS __attribute__((address_space(3)))
DEV unsigned xb_ld(unsigned* p) { return __hip_atomic_load(p, __ATOMIC_RELAXED, __HIP_MEMORY_SCOPE_AGENT); }
DEV unsigned xb_add(unsigned* p, unsigned v) { return __hip_atomic_fetch_add(p, v, __ATOMIC_RELAXED, __HIP_MEMORY_SCOPE_AGENT); }
DEV unsigned xb_xcc_id() { return (unsigned)__builtin_amdgcn_s_getreg((3 << 11) | 20) & 0xFu; }
#define XB_SPIN(cond, bar) do { unsigned _sp = 0; while (cond) { __builtin_amdgcn_s_sleep(1); \
    if ((++_sp & 255u) == 0u) { if (xb_ld(&(bar)[XB_TMO])) break; if (_sp > XB_SPIN_CAP) { atomicAdd(&(bar)[XB_TMO], 1u); break; } } } } while (0)
struct XcdBarrier { unsigned* bar; unsigned x; volatile LAS unsigned* st; };
DEV XcdBarrier xcd_barrier_post(unsigned* bar, volatile LAS unsigned* st) {
    XcdBarrier b; b.bar = bar; b.x = xb_xcc_id(); b.st = st;
    if (threadIdx.x == 0) (void)xb_add(&bar[XB_XCNT(b.x)], 1u);
    return b;
}
DEV void xcd_barrier_complete(unsigned* bar, unsigned x, unsigned& nloc, unsigned& nx) {
    const unsigned G = gridDim.x * gridDim.y * gridDim.z;
    unsigned sum, cnt, mine, sp = 0u;
    for (;;) {
        sum = 0u; cnt = 0u; mine = 0u;
#pragma unroll
        for (unsigned j = 0; j < 16; ++j) { const unsigned c = xb_ld(&bar[XB_XCNT(j)]); sum += c; cnt += (c > 0u) ? 1u : 0u; mine = (j == x) ? c : mine; }
        if (sum == G) break;
        __builtin_amdgcn_s_sleep(1);
        if ((++sp & 255u) == 0u) { if (xb_ld(&bar[XB_TMO])) break; if (sp > XB_SPIN_CAP) { atomicAdd(&bar[XB_TMO], 1u); break; } }
    }
    nloc = mine > 0u ? mine : 1u; nx = cnt > 0u ? cnt : 1u;
}
DEV void xcd_barrier(const XcdBarrier& b) {
    asm volatile("s_waitcnt vmcnt(0)" ::: "memory");
    __syncthreads();
    if (threadIdx.x == 0) {
        unsigned* bar = b.bar;
        __builtin_amdgcn_s_waitcnt(0);
        unsigned nloc = b.st[0], nx = b.st[1];
        if (nloc == 0u) { xcd_barrier_complete(bar, b.x, nloc, nx); b.st[0] = nloc; b.st[1] = nx; }
        const unsigned old = xb_add(&bar[XB_XSUB(b.x)], 1u);
        const unsigned gen = old / nloc;
        if (old + 1u == (gen + 1u) * nloc) {
            __builtin_amdgcn_fence(__ATOMIC_RELEASE, "agent");
            asm volatile("s_waitcnt vmcnt(0)" ::: "memory");
            const unsigned og = xb_add(&bar[XB_TOP], 1u);
            const unsigned tg = og / nx;
            if (og + 1u == (tg + 1u) * nx) xb_add(&bar[XB_TOPGEN], 1u);
            else XB_SPIN(xb_ld(&bar[XB_TOPGEN]) == tg, bar);
            __builtin_amdgcn_fence(__ATOMIC_ACQUIRE, "agent");
            xb_add(&bar[XB_XGEN(b.x)], 1u);
            asm volatile("s_waitcnt vmcnt(0)" ::: "memory");
        } else {
            XB_SPIN(xb_ld(&bar[XB_XGEN(b.x)]) == gen, bar);
            __builtin_amdgcn_fence(__ATOMIC_ACQUIRE, "agent");
            asm volatile("s_waitcnt vmcnt(0)" ::: "memory");
        }
    }
    __syncthreads();
}

constexpr int BM = 256, BK = 64, HALF = 128, HT = HALF * BK;
DEV int lds_byte(int r, int c) {
    int st = (r >> 4) * 2 + (c >> 5), rr = r & 15, cc = c & 31, ob = rr * 64 + cc * 2;
    return st * 1024 + (ob ^ (((ob >> 9) & 1) << 5));
}
DEV void stage_rc(int b, int& R, int& C) {
    int st = b / 1024, sb = b % 1024, swz = sb ^ (((sb >> 9) & 1) << 5);
    R = (st >> 1) * 16 + swz / 64; C = (st & 1) * 32 + (swz % 64) / 2;
}

template <class Epi>
DEV void gemm_tile(const bf16_t* __restrict__ A, int lda, const bf16_t* __restrict__ Bt, int ldb, int K, int brow, int bcol, const Epi& epi) {
    LAS unsigned char* lds = (LAS unsigned char*)smem;
    constexpr int HTB = HT * 2;
    const int tid = tid_fresh(), wid = __builtin_amdgcn_readfirstlane(tid >> 6), lane = tid & 63, wr = wid >> 2, wc = wid & 3, fr = lane & 15, fq = lane >> 4;
    unsigned voffA[2], voffB[2];
#pragma unroll
    for (int i = 0; i < 2; ++i) { int R, C; stage_rc(tid * 16 + i * 8192, R, C); voffA[i] = (unsigned)(R * lda + C) * 2u; voffB[i] = (unsigned)(R * ldb + C) * 2u; }
    const size_t kstep = (size_t)(BK * 2), hstepA = (size_t)HALF * lda * 2, hstepB = (size_t)HALF * ldb * 2;
    const unsigned ldsw = (unsigned)wid * 1024u;
    const int aoff = lds_byte(wr * 64 + fr, fq * 8), boff = lds_byte(wc * 32 + fr, fq * 8);
#define SA(b, h) (((b) * 2 + (h)) * HTB)
#define SB(b, h) ((4 + (b) * 2 + (h)) * HTB)
#define STAGE(bufoff, gbase, voff) do { _Pragma("unroll") for (int _i = 0; _i < 2; ++_i) \
        __builtin_amdgcn_global_load_lds((const unsigned*)((const char*)(gbase) + (voff)[_i]), (LAS unsigned*)(lds + (bufoff) + ldsw + _i * 8192), 16, 0, 0); } while (0)
#define LDA(dst, b, h) do { _Pragma("unroll") for (int m = 0; m < 4; ++m) _Pragma("unroll") for (int k = 0; k < 2; ++k) dst[m][k] = *(const LAS bf16x8*)(lds + SA(b, h) + aoff + m * 2048 + k * 1024); } while (0)
#define LDB(dst, b, h) do { _Pragma("unroll") for (int n = 0; n < 2; ++n) _Pragma("unroll") for (int k = 0; k < 2; ++k) dst[n][k] = *(const LAS bf16x8*)(lds + SB(b, h) + boff + n * 2048 + k * 1024); } while (0)
#define MMA(ai, bj, At, Bt_) do { __builtin_amdgcn_s_setprio(1); _Pragma("unroll") for (int m = 0; m < 4; ++m) _Pragma("unroll") for (int n = 0; n < 2; ++n) _Pragma("unroll") for (int k = 0; k < 2; ++k) \
        acc[ai][bj][m][n] = __builtin_amdgcn_mfma_f32_16x16x32_bf16(Bt_[n][k], At[m][k], acc[ai][bj][m][n], 0, 0, 0); __builtin_amdgcn_s_setprio(0); } while (0)
#define WAIT_V(n) asm volatile("s_waitcnt vmcnt(" #n ")" ::: "memory")
#define WAIT_L(n) asm volatile("s_waitcnt lgkmcnt(" #n ")" ::: "memory")
#define BAR __builtin_amdgcn_s_barrier()
#define SCHED __builtin_amdgcn_sched_barrier(0)
    f32x4 acc[2][2][4][2];
#pragma unroll
    for (int a = 0; a < 2; ++a)
#pragma unroll
        for (int b = 0; b < 2; ++b)
#pragma unroll
            for (int m = 0; m < 4; ++m)
#pragma unroll
                for (int n = 0; n < 2; ++n) acc[a][b][m][n] = (f32x4){0.f, 0.f, 0.f, 0.f};
    bf16x8 At[4][2], B0[2][2], B1[2][2];
    const int nt = K / BK;
    const char* cA = (const char*)A + (size_t)brow * lda * 2; const char* cB = (const char*)Bt + (size_t)bcol * ldb * 2;
    STAGE(SB(0, 0), cB, voffB); STAGE(SA(0, 0), cA, voffA); STAGE(SB(0, 1), cB + hstepB, voffB); STAGE(SA(0, 1), cA + hstepA, voffA);
    if (wr == 1) BAR;
    WAIT_V(4); BAR;
    STAGE(SB(1, 0), cB + kstep, voffB); STAGE(SA(1, 0), cA + kstep, voffA); STAGE(SB(1, 1), cB + hstepB + kstep, voffB);
    WAIT_V(6); BAR;
    for (int t = 0; t < nt - 2; t += 2) {
        const char* a1 = cA + (size_t)(t + 1) * kstep;
        const char* a2 = cA + (size_t)(t + 2) * kstep; const char* b2 = cB + (size_t)(t + 2) * kstep;
        const char* a3 = a2 + kstep; const char* b3 = b2 + kstep;
        LDB(B0, 0, 0); SCHED; LDA(At, 0, 0); STAGE(SA(1, 1), a1 + hstepA, voffA);
        WAIT_L(8); BAR; WAIT_L(0); MMA(0, 0, At, B0); BAR; SCHED;
        LDB(B1, 0, 1); STAGE(SB(0, 0), b2, voffB);
        BAR; WAIT_L(0); MMA(0, 1, At, B1); BAR;
        LDA(At, 0, 1); STAGE(SA(0, 0), a2, voffA);
        BAR; WAIT_L(0); MMA(1, 0, At, B0); BAR; SCHED;
        STAGE(SB(0, 1), b2 + hstepB, voffB);
        WAIT_V(6); BAR; MMA(1, 1, At, B1); BAR;
        LDB(B0, 1, 0); SCHED; LDA(At, 1, 0); STAGE(SA(0, 1), a2 + hstepA, voffA);
        WAIT_L(8); BAR; WAIT_L(0); MMA(0, 0, At, B0); BAR; SCHED;
        LDB(B1, 1, 1); STAGE(SB(1, 0), b3, voffB);
        BAR; WAIT_L(0); MMA(0, 1, At, B1); BAR;
        LDA(At, 1, 1); STAGE(SA(1, 0), a3, voffA);
        BAR; WAIT_L(0); MMA(1, 0, At, B0); BAR; SCHED;
        STAGE(SB(1, 1), b3 + hstepB, voffB);
        WAIT_V(6); BAR; MMA(1, 1, At, B1); BAR;
    }
    { const char* a1 = cA + (size_t)(nt - 1) * kstep;
      LDB(B0, 0, 0); LDA(At, 0, 0); STAGE(SA(1, 1), a1 + hstepA, voffA);
      BAR; WAIT_L(0); MMA(0, 0, At, B0); BAR;
      LDB(B1, 0, 1); BAR; WAIT_L(0); MMA(0, 1, At, B1); BAR;
      LDA(At, 0, 1); WAIT_V(4); BAR; WAIT_L(0); MMA(1, 0, At, B0); MMA(1, 1, At, B1); BAR; }
    { LDB(B0, 1, 0); LDA(At, 1, 0); WAIT_V(2); BAR; WAIT_L(0); MMA(0, 0, At, B0); BAR;
      LDB(B1, 1, 1); WAIT_V(0); BAR; WAIT_L(0); MMA(0, 1, At, B1); BAR;
      LDA(At, 1, 1); BAR; WAIT_L(0); MMA(1, 0, At, B0); MMA(1, 1, At, B1); BAR; }
    if (wr == 0) BAR;
    epi_big(epi, acc, brow, bcol, wr, wc, fr, fq);
    __syncthreads();
#undef SA
#undef SB
#undef STAGE
#undef LDA
#undef LDB
#undef MMA
}

DEV void tile_of(int L, int nM, int nN, int& pm, int& pn) {
    const int nwg = nM * nN; int wgid = L;
    { const int q = nwg / 8, r = nwg % 8, xcd = wgid % 8, off = wgid / 8; wgid = (xcd < r ? xcd * (q + 1) : r * (q + 1) + (xcd - r) * q) + off; }
    const int nig = 8 * nN, gid = wgid / nig, fm = gid * 8, gsz = (nM - fm) < 8 ? (nM - fm) : 8;
    pm = fm + ((wgid % nig) % gsz); pn = (wgid % nig) / gsz;
}

struct EpiBf16 {
    bf16_t* dst; int ld; const float* rstd;
    struct Ld { float rs; };
    DEV void load(int row, int col, Ld& d) const { d.rs = rstd ? rstd[row] : 1.f; }
    DEV void apply(int row, int col, const f32x4& v, const Ld& d, float& ss, float rowv) const {
        u32x2 o; o.x = pk2(v[0] * d.rs, v[1] * d.rs); o.y = pk2(v[2] * d.rs, v[3] * d.rs);
        *(u32x2*)(dst + (long)row * ld + col) = o;
    }
    DEV float rowload(int row) const { return 0.f; }
    DEV void rowdone(int row, float ss, int fq, int slot) const {}
    DEV void rowput(int row, float tot, int slot) const {}
};
struct EpiGlu {
    bf16_t* proj; const float* glu_b;
    struct Ld { u32x2 g, z; f32x4 b; };
    DEV void load(int row, int col, Ld& d) const {
        d.g = *(const u32x2*)(proj + (long)row * PLD + C_UB + col); d.z = *(const u32x2*)(proj + (long)row * PLD + C_ZB + col); d.b = *(const f32x4*)(glu_b + col);
    }
    DEV void apply(int row, int col, const f32x4& v, const Ld& d, float& ss, float rowv) const {
        const float y0 = bflo(d.g.x) * sigmf(v[0] + d.b[0]) * siluf(bflo(d.z.x)), y1 = bfhi(d.g.x) * sigmf(v[1] + d.b[1]) * siluf(bfhi(d.z.x));
        const float y2 = bflo(d.g.y) * sigmf(v[2] + d.b[2]) * siluf(bflo(d.z.y)), y3 = bfhi(d.g.y) * sigmf(v[3] + d.b[3]) * siluf(bfhi(d.z.y));
        u32x2 o; o.x = pk2(y0, y1); o.y = pk2(y2, y3);
        *(u32x2*)(proj + (long)row * PLD + C_ZB + col) = o;
    }
    DEV float rowload(int row) const { return 0.f; }
    DEV void rowdone(int row, float ss, int fq, int slot) const {}
    DEV void rowput(int row, float tot, int slot) const {}
};
struct EpiOut {
    const float* xp; const float* xs; bf16_t* h1b; float* rss;
    struct Ld { f32x4 x; };
    DEV void load(int row, int col, Ld& d) const {
        const float* xrow = row < NPROMPT ? xp + (long)row * 1024 : xs + (long)(row - NPROMPT) * 1024;
        d.x = *(const f32x4*)(xrow + col);
    }
    DEV void apply(int row, int col, const f32x4& a, const Ld& d, float& ss, float rowv) const {
        const f32x4 v = a + d.x;
        u32x2 o; o.x = pk2(v[0], v[1]); o.y = pk2(v[2], v[3]);
        *(u32x2*)(h1b + (long)row * 1024 + col) = o;
        const float r0 = bflo(o.x), r1 = bfhi(o.x), r2 = bflo(o.y), r3 = bfhi(o.y);
        ss += r0 * r0 + r1 * r1 + r2 * r2 + r3 * r3;
    }
    DEV float rowload(int row) const { return 0.f; }
    DEV void rowdone(int row, float ss, int fq, int slot) const {
        ss += __shfl_xor(ss, 16); ss += __shfl_xor(ss, 32);
        if (fq == 0) rss[(long)row * 16 + slot] = ss;
    }
    DEV void rowput(int row, float tot, int slot) const { rss[(long)row * 16 + slot] = tot; rss[(long)row * 16 + slot + 1] = 0.f; }
};
struct EpiPle {
    float* out; const bf16_t* h1b; const bf16_t* pp; const float* rss1; float* rss2;
    struct Ld { u32x2 h; u32x2 pv; };
    DEV void load(int row, int col, Ld& d) const {
        d.h = *(const u32x2*)(h1b + (long)row * 1024 + col); d.pv = *(const u32x2*)(pp + (long)row * 1024 + col);
    }
    DEV void apply(int row, int col, const f32x4& a, const Ld& d, float& ss, float rowv) const {
        const float rstd = rsqrtf(rowv * (1.f / 1024.f) + EPS);
        f32x4 h;
        h[0] = bflo(d.h.x) + bflo(d.pv.x) * sigmf(a[0] * rstd); h[1] = bfhi(d.h.x) + bfhi(d.pv.x) * sigmf(a[1] * rstd);
        h[2] = bflo(d.h.y) + bflo(d.pv.y) * sigmf(a[2] * rstd); h[3] = bfhi(d.h.y) + bfhi(d.pv.y) * sigmf(a[3] * rstd);
        *(f32x4*)(out + (long)row * 1024 + col) = h;
        ss += h[0] * h[0] + h[1] * h[1] + h[2] * h[2] + h[3] * h[3];
    }
    DEV float rowload(int row) const {
        const f32x4 a = *(const f32x4*)(rss1 + (long)row * 16), b = *(const f32x4*)(rss1 + (long)row * 16 + 4), c = *(const f32x4*)(rss1 + (long)row * 16 + 8), d = *(const f32x4*)(rss1 + (long)row * 16 + 12);
        return (((a[0] + a[1]) + (a[2] + a[3])) + ((b[0] + b[1]) + (b[2] + b[3]))) + (((c[0] + c[1]) + (c[2] + c[3])) + ((d[0] + d[1]) + (d[2] + d[3])));
    }
    DEV void rowdone(int row, float ss, int fq, int slot) const {
        ss += __shfl_xor(ss, 16); ss += __shfl_xor(ss, 32);
        if (fq == 0) rss2[(long)row * 16 + slot] = ss;
    }
    DEV void rowput(int row, float tot, int slot) const { rss2[(long)row * 16 + slot] = tot; rss2[(long)row * 16 + slot + 1] = 0.f; }
};
template <class Epi>
DEV void epi_big(const Epi& E, const f32x4 (&acc)[2][2][4][2], int brow, int bcol, int wr, int wc, int fr, int fq) {
#pragma unroll
    for (int ai = 0; ai < 2; ++ai)
#pragma unroll
        for (int mp = 0; mp < 2; ++mp) {
            typename Epi::Ld d[2][4]; float rv[2];
#pragma unroll
            for (int mm = 0; mm < 2; ++mm) {
                rv[mm] = E.rowload(brow + ai * 128 + wr * 64 + (mp * 2 + mm) * 16 + fr);
#pragma unroll
                for (int j = 0; j < 4; ++j)
                    E.load(brow + ai * 128 + wr * 64 + (mp * 2 + mm) * 16 + fr, bcol + (j >> 1) * 128 + wc * 32 + (j & 1) * 16 + fq * 4, d[mm][j]);
            }
#pragma unroll
            for (int mm = 0; mm < 2; ++mm) {
                const int row = brow + ai * 128 + wr * 64 + (mp * 2 + mm) * 16 + fr; float ss = 0.f;
#pragma unroll
                for (int j = 0; j < 4; ++j)
                    E.apply(row, bcol + (j >> 1) * 128 + wc * 32 + (j & 1) * 16 + fq * 4, acc[ai][j >> 1][mp * 2 + mm][j & 1], d[mm][j], ss, rv[mm]);
                E.rowdone(row, ss, fq, ((bcol >> 8) & 3) * 4 + wc);
            }
        }
}
template <class Epi>
DEV void gemm_small(const bf16_t* __restrict__ A, int lda, const bf16_t* __restrict__ Bt, int ldb, int K, int row0, int col0, const Epi& E) {
    const int tid = tid_fresh(), w = tid >> 6, lane = tid & 63, fr = lane & 15, fq = lane >> 4;
    const int kw = K >> 3;
    const bf16_t* ap = A + (long)(row0 + fr) * lda + w * kw + fq * 8;
    const bf16_t* bp = Bt + (long)(col0 + fr) * ldb + w * kw + fq * 8;
    f32x4 pacc[8];
#pragma unroll
    for (int n = 0; n < 8; ++n) pacc[n] = (f32x4){0.f, 0.f, 0.f, 0.f};
    for (int k0 = 0; k0 < kw; k0 += 128) {
        bf16x8 af[4], bf[4][8];
#pragma unroll
        for (int ks = 0; ks < 4; ++ks) {
            af[ks] = *(const bf16x8*)(ap + k0 + ks * 32);
#pragma unroll
            for (int n = 0; n < 8; ++n) bf[ks][n] = *(const bf16x8*)(bp + (long)n * 16 * ldb + k0 + ks * 32);
        }
#pragma unroll
        for (int ks = 0; ks < 4; ++ks)
#pragma unroll
            for (int n = 0; n < 8; ++n) pacc[n] = mfma16(bf[ks][n], af[ks], pacc[n]);
    }
    float* redk = (float*)smem;
    __syncthreads();
#pragma unroll
    for (int n = 0; n < 8; ++n) *(f32x4*)(redk + ((w * 8 + n) * 64 + lane) * 4) = pacc[n];
    __syncthreads();
    f32x4 acc = (f32x4){0.f, 0.f, 0.f, 0.f};
#pragma unroll
    for (int i = 0; i < 8; ++i) acc += *(const f32x4*)(redk + ((i * 8 + w) * 64 + lane) * 4);
    const int row = row0 + fr, col = col0 + w * 16 + fq * 4;
    typename Epi::Ld d;
    E.load(row, col, d);
    const float rv = E.rowload(row);
    float ss = 0.f;
    E.apply(row, col, acc, d, ss, rv);
    ss += __shfl_xor(ss, 16); ss += __shfl_xor(ss, 32);
    float* red = (float*)smem;
    __syncthreads();
    if (fq == 0) red[w * 16 + fr] = ss;
    __syncthreads();
    if (tid < 16) {
        float t = 0.f;
#pragma unroll
        for (int i = 0; i < 8; ++i) t += red[i * 16 + tid];
        E.rowput(row0 + tid, t, (col0 >> 7) * 2);
    }
    __syncthreads();
}

DEV void transpose_item(const float* __restrict__ src, int ldsrc, int k0, int c0, bf16_t* __restrict__ dst, int lddst, int n0,
                        const float* __restrict__ kscale, float* scr, int lane) {
    const int cl = lane & 31, kh = lane >> 5;
    float v[32];
#pragma unroll
    for (int i = 0; i < 32; ++i) v[i] = src[(long)(k0 + 2 * i + kh) * ldsrc + c0 + cl];
    if (kscale) {
#pragma unroll
        for (int i = 0; i < 32; ++i) v[i] *= kscale[k0 + 2 * i + kh];
    }
#pragma unroll
    for (int i = 0; i < 32; ++i) scr[(2 * i + kh) * 33 + cl] = v[i];
    lds_fence();
    const int c = lane & 7;
#pragma unroll
    for (int j = 0; j < 4; ++j) {
        const int n = (lane >> 3) + 8 * j; const float* sp = scr + (8 * c) * 33 + n;
        u32x4 o; o.x = pk2(sp[0 * 33], sp[1 * 33]); o.y = pk2(sp[2 * 33], sp[3 * 33]); o.z = pk2(sp[4 * 33], sp[5 * 33]); o.w = pk2(sp[6 * 33], sp[7 * 33]);
        *(u32x4*)(dst + (long)(n0 + n) * lddst + k0 + 8 * c) = o;
    }
    lds_fence();
}

DEV void phase0(const Params& P) {
    const int tid = tid_fresh(), lane = tid & 63, wave = tid >> 6, G = gridDim.x, bid = blockIdx.x;
    char* ws = P.ws;
    float* tile = (float*)smem;
    {
        float* scr = (float*)smem + wave * (64 * 33);
        constexpr int I_IN = 144 * 16, I_OUT = 32 * 32, I_GLU = 32 * 16, I_GATE = 32 * 16, I_PPW = 32 * 4;
        constexpr int I_ALL = I_IN + I_OUT + I_GLU + I_GATE + I_PPW;
        for (int it = bid * 8 + wave; it < I_ALL; it += G * 8) {
            int r = it;
            if (r < I_IN) {
                const int nb = r >> 4, kb = r & 15, n0 = nb * 32;
                int c0;
                if (n0 < 1024) c0 = n0; else if (n0 < 2048) c0 = 2576 + (n0 - 1024); else if (n0 < 3584) c0 = 1024 + (n0 - 2048); else c0 = 3600 + (n0 - 3584);
                transpose_item(P.in[I_WIN], 4624, kb * 64, c0, (bf16_t*)(ws + W_WTIN), 1024, n0, P.in[I_GIN], scr, lane); continue;
            }
            r -= I_IN;
            if (r < I_OUT) { const int nb = r >> 5, kb = r & 31; transpose_item(P.in[I_WOUT], 1024, kb * 64, nb * 32, (bf16_t*)(ws + W_WTOUT), 2048, nb * 32, nullptr, scr, lane); continue; }
            r -= I_OUT;
            if (r < I_GLU) { const int nb = r >> 4, kb = r & 15; transpose_item(P.in[I_GLUW], 1024, kb * 64, nb * 32, (bf16_t*)(ws + W_WTGLU), 1024, nb * 32, nullptr, scr, lane); continue; }
            r -= I_GLU;
            if (r < I_GATE) { const int nb = r >> 4, kb = r & 15; transpose_item(P.in[I_WGATE], 1024, kb * 64, nb * 32, (bf16_t*)(ws + W_WTGATE), 1024, nb * 32, P.in[I_GPLE], scr, lane); continue; }
            r -= I_GATE;
            { const int nb = r >> 2, kb = r & 3; transpose_item(P.in[I_WPP], 1024, kb * 64, nb * 32, (bf16_t*)(ws + W_WTPP), 256, nb * 32, nullptr, scr, lane); }
        }
        __syncthreads();
    }
    bf16_t* wdt = (bf16_t*)smem;
    float* psum = (float*)(smem + 16 * 1032 * 2);
    float* pdt = psum + 128;
    {
        float wv[32];
#pragma unroll
        for (int i = 0; i < 32; ++i) { const int idx = tid + i * 512, k = idx >> 4, e = idx & 15; wv[i] = P.in[I_WIN][(long)k * 4624 + 2560 + e] * P.in[I_GIN][k]; }
#pragma unroll
        for (int i = 0; i < 32; ++i) { const int idx = tid + i * 512, k = idx >> 4, e = idx & 15; wdt[e * 1032 + k] = (bf16_t)(pk2(wv[i], 0.f) & 0xffffu); }
    }
    __syncthreads();
    {
        const int fr = lane & 15, fq = lane >> 4;
        bf16x8 wf[4];
#pragma unroll
        for (int j = 0; j < 4; ++j) wf[j] = *(const bf16x8*)(wdt + fr * 1032 + (wave * 4 + j) * 32 + fq * 8);
        bf16_t* xb = (bf16_t*)(ws + W_NB);
        float* dtr = (float*)(ws + W_DTR);
        float* rstdp = (float*)(ws + W_RSTD);
        f32x4 xan[4], xcn[4];
        if (bid < NTOK / 16) {
            const int row = bid * 16 + fr;
            const float* xr = (row < NPROMPT ? P.in[I_XP] + (long)row * 1024 : P.in[I_XS] + (long)(row - NPROMPT) * 1024) + wave * 128 + fq * 8;
#pragma unroll
            for (int j = 0; j < 4; ++j) { xan[j] = *(const f32x4*)(xr + j * 32); xcn[j] = *(const f32x4*)(xr + j * 32 + 4); }
        }
        for (int task = bid; task < NTOK / 16; task += G) {
            const int row = task * 16 + fr;
            f32x4 xa[4], xc[4];
#pragma unroll
            for (int j = 0; j < 4; ++j) { xa[j] = xan[j]; xc[j] = xcn[j]; }
            if (task + G < NTOK / 16) {
                const int rown = (task + G) * 16 + fr;
                const float* xr = (rown < NPROMPT ? P.in[I_XP] + (long)rown * 1024 : P.in[I_XS] + (long)(rown - NPROMPT) * 1024) + wave * 128 + fq * 8;
#pragma unroll
                for (int j = 0; j < 4; ++j) { xan[j] = *(const f32x4*)(xr + j * 32); xcn[j] = *(const f32x4*)(xr + j * 32 + 4); }
            }
            f32x4 acc = {0.f, 0.f, 0.f, 0.f}; float ss = 0.f;
#pragma unroll
            for (int j = 0; j < 4; ++j) {
                ss += xa[j][0] * xa[j][0] + xa[j][1] * xa[j][1] + xa[j][2] * xa[j][2] + xa[j][3] * xa[j][3] + xc[j][0] * xc[j][0] + xc[j][1] * xc[j][1] + xc[j][2] * xc[j][2] + xc[j][3] * xc[j][3];
                u32x4 q; q.x = pk2(xa[j][0], xa[j][1]); q.y = pk2(xa[j][2], xa[j][3]); q.z = pk2(xc[j][0], xc[j][1]); q.w = pk2(xc[j][2], xc[j][3]);
                *(u32x4*)(xb + (long)row * 1024 + wave * 128 + j * 32 + fq * 8) = q;
                acc = mfma16(wf[j], __builtin_bit_cast(bf16x8, q), acc);
            }
            ss += __shfl_xor(ss, 16); ss += __shfl_xor(ss, 32);
            if (fq == 0) psum[wave * 16 + fr] = ss;
            *(f32x4*)(pdt + wave * 256 + fr * 16 + fq * 4) = acc;
            __syncthreads();
            if (tid < 256) {
                const int t = tid >> 4, e = tid & 15;
                float tot = 0.f, d = 0.f;
#pragma unroll
                for (int w8 = 0; w8 < 8; ++w8) { tot += psum[w8 * 16 + t]; d += pdt[w8 * 256 + t * 16 + e]; }
                const float rstd = rsqrtf(tot * (1.f / 1024.f) + EPS);
                dtr[(long)(task * 16 + t) * 16 + e] = d * rstd;
                if (e == 0) rstdp[task * 16 + t] = rstd;
            }
            __syncthreads();
        }
    }
    bf16_t* pb = (bf16_t*)(ws + W_PB);
    for (int idx = bid * 512 + tid; idx < NTOK * 64; idx += G * 512) {
        const int row = idx >> 6, c4 = (idx & 63) * 4;
        const float* src = row < NPROMPT ? P.in[I_PP] + (long)row * 256 : P.in[I_PS] + (long)(row - NPROMPT) * 256;
        const f32x4 v = *(const f32x4*)(src + c4);
        u32x2 o; o.x = pk2(v[0], v[1]); o.y = pk2(v[2], v[3]);
        *(u32x2*)(pb + (long)row * 256 + c4) = o;
    }
    __syncthreads();
}

DEV void conv_load7(const bf16_t* __restrict__ pcol, long row0, int t0, u32x4 (&raw)[7]) {
#pragma unroll
    for (int i = 0; i < 7; ++i) {
        const int t = t0 - 3 + i;
        raw[i] = (u32x4){0u, 0u, 0u, 0u};
        if (t >= 0) raw[i] = *(const u32x4*)(pcol + (row0 - 3 + i) * PLD);
    }
}
DEV void conv_compute(const u32x4 (&rawp)[7], const float* __restrict__ cw, const float* __restrict__ cb, float (&o)[4][8]) {
    float raw[7][8];
#pragma unroll
    for (int i = 0; i < 7; ++i) {
        const u32x4 u = rawp[i];
        raw[i][0] = bflo(u.x); raw[i][1] = bfhi(u.x); raw[i][2] = bflo(u.y); raw[i][3] = bfhi(u.y);
        raw[i][4] = bflo(u.z); raw[i][5] = bfhi(u.z); raw[i][6] = bflo(u.w); raw[i][7] = bfhi(u.w);
    }
    float w[4][8], bias[8];
#pragma unroll
    for (int k = 0; k < 4; ++k) {
        const f32x4 a = *(const f32x4*)(cw + k * 1536), b = *(const f32x4*)(cw + k * 1536 + 4);
        w[k][0] = a[0]; w[k][1] = a[1]; w[k][2] = a[2]; w[k][3] = a[3]; w[k][4] = b[0]; w[k][5] = b[1]; w[k][6] = b[2]; w[k][7] = b[3];
    }
    { const f32x4 a = *(const f32x4*)(cb), b = *(const f32x4*)(cb + 4);
      bias[0] = a[0]; bias[1] = a[1]; bias[2] = a[2]; bias[3] = a[3]; bias[4] = b[0]; bias[5] = b[1]; bias[6] = b[2]; bias[7] = b[3]; }
#pragma unroll
    for (int j = 0; j < 4; ++j)
#pragma unroll
        for (int c = 0; c < 8; ++c) {
            float a = bias[c];
#pragma unroll
            for (int k = 0; k < 4; ++k) a += w[k][c] * raw[j + k][c];
            o[j][c] = siluf(a);
        }
}
DEV void conv_compute_lds(const u32x4 (&rawp)[7], const float* cwl, float (&o)[4][8]) {
    float raw[7][8];
#pragma unroll
    for (int i = 0; i < 7; ++i) {
        const u32x4 u = rawp[i];
        raw[i][0] = bflo(u.x); raw[i][1] = bfhi(u.x); raw[i][2] = bflo(u.y); raw[i][3] = bfhi(u.y);
        raw[i][4] = bflo(u.z); raw[i][5] = bfhi(u.z); raw[i][6] = bflo(u.w); raw[i][7] = bfhi(u.w);
    }
    float w[5][8];
#pragma unroll
    for (int k = 0; k < 5; ++k) {
        const f32x4 a = *(const f32x4*)(cwl + k * 512), b = *(const f32x4*)(cwl + k * 512 + 4);
        w[k][0] = a[0]; w[k][1] = a[1]; w[k][2] = a[2]; w[k][3] = a[3]; w[k][4] = b[0]; w[k][5] = b[1]; w[k][6] = b[2]; w[k][7] = b[3];
    }
#pragma unroll
    for (int j = 0; j < 4; ++j)
#pragma unroll
        for (int c = 0; c < 8; ++c) {
            float a = w[4][c];
#pragma unroll
            for (int k = 0; k < 4; ++k) a += w[k][c] * raw[j + k][c];
            o[j][c] = siluf(a);
        }
}
DEV void conv4x8(const bf16_t* __restrict__ pcol, long row0, int t0, const float* __restrict__ hist, const float* __restrict__ cw, const float* __restrict__ cb, float (&o)[4][8]) {
    float raw[7][8];
#pragma unroll
    for (int i = 0; i < 7; ++i) {
        const int t = t0 - 3 + i;
        if (t >= 0) {
            const u32x4 u = *(const u32x4*)(pcol + (row0 - 3 + i) * PLD);
            raw[i][0] = bflo(u.x); raw[i][1] = bfhi(u.x); raw[i][2] = bflo(u.y); raw[i][3] = bfhi(u.y);
            raw[i][4] = bflo(u.z); raw[i][5] = bfhi(u.z); raw[i][6] = bflo(u.w); raw[i][7] = bfhi(u.w);
        } else if (hist) {
            const f32x4 a = *(const f32x4*)(hist + (long)(t + 3) * 1536), b = *(const f32x4*)(hist + (long)(t + 3) * 1536 + 4);
            raw[i][0] = a[0]; raw[i][1] = a[1]; raw[i][2] = a[2]; raw[i][3] = a[3]; raw[i][4] = b[0]; raw[i][5] = b[1]; raw[i][6] = b[2]; raw[i][7] = b[3];
        } else {
#pragma unroll
            for (int c = 0; c < 8; ++c) raw[i][c] = 0.f;
        }
    }
    float w[4][8], bias[8];
#pragma unroll
    for (int k = 0; k < 4; ++k) {
        const f32x4 a = *(const f32x4*)(cw + k * 1536), b = *(const f32x4*)(cw + k * 1536 + 4);
        w[k][0] = a[0]; w[k][1] = a[1]; w[k][2] = a[2]; w[k][3] = a[3]; w[k][4] = b[0]; w[k][5] = b[1]; w[k][6] = b[2]; w[k][7] = b[3];
    }
    { const f32x4 a = *(const f32x4*)(cb), b = *(const f32x4*)(cb + 4);
      bias[0] = a[0]; bias[1] = a[1]; bias[2] = a[2]; bias[3] = a[3]; bias[4] = b[0]; bias[5] = b[1]; bias[6] = b[2]; bias[7] = b[3]; }
#pragma unroll
    for (int j = 0; j < 4; ++j)
#pragma unroll
        for (int c = 0; c < 8; ++c) {
            float a = bias[c];
#pragma unroll
            for (int k = 0; k < 4; ++k) a += w[k][c] * raw[j + k][c];
            o[j][c] = siluf(a);
        }
}

constexpr int PIT = 136;
constexpr int R1_OFF = 0, R2_OFF = 128 * PIT * 2, R3_OFF = 2 * 128 * PIT * 2, R4_OFF = 3 * 128 * PIT * 2;

DEV void ssd_s1_item(const Params& P, int item) {
    const int tid = tid_fresh(), lane = tid & 63, w = tid >> 6, fr = lane & 15, fq = lane >> 4;
    const int b = item >> 5, c = (item >> 1) & 15, g = item & 1;
    char* ws = P.ws;
    const bf16_t* proj = (const bf16_t*)(ws + W_PROJ);
    const long rowc = (long)b * 2048 + c * 128;
    bf16_t* R1 = (bf16_t*)(smem + R1_OFF); bf16_t* R2 = (bf16_t*)(smem + R2_OFF); bf16_t* R3 = (bf16_t*)(smem + R3_OFF);
    float* acs = (float*)(smem + R4_OFF);
    float* dtv = acs + 1024;
    {
        const int h = g * 8 + w;
        const float bias = P.in[I_DTB][h], A = -__expf(P.in[I_ALOG][h]);
        const float* dtr = (const float*)(ws + W_DTR);
        float x0 = dtr[(rowc + 2 * lane) * 16 + h] + bias, x1 = dtr[(rowc + 2 * lane + 1) * 16 + h] + bias;
        float d0 = x0 > 20.f ? x0 : log1pf(__expf(x0)), d1 = x1 > 20.f ? x1 : log1pf(__expf(x1));
        float a0 = d0 * A, a1 = a0 + d1 * A;
        float run = a1;
#pragma unroll
        for (int o = 1; o < 64; o <<= 1) { float t = __shfl_up(run, o); if (lane >= o) run += t; }
        const float excl = run - a1;
        a0 += excl; a1 += excl;
        acs[w * 128 + 2 * lane] = a0; acs[w * 128 + 2 * lane + 1] = a1;
        dtv[w * 128 + 2 * lane] = d0; dtv[w * 128 + 2 * lane + 1] = d1;
        float* acsg = (float*)(ws + W_ACS) + (((long)b * 16 + c) * 16 + h) * 128;
        acsg[2 * lane] = a0; acsg[2 * lane + 1] = a1;
        if (lane == 63) ((float*)(ws + W_CDEC))[(b * 16 + c) * 16 + h] = __expf(a1);
    }
    float* cwl = (float*)(smem + R4_OFF + 8192);
    for (int u = tid; u < 5 * 512; u += 512) { const int k = u >> 9, ch = u & 511; cwl[u] = k < 4 ? P.in[I_CONVW][k * 1536 + g * 512 + ch] : P.in[I_CONVB][g * 512 + ch]; }
    {
        const int nblk = tid & 15, lq = tid >> 4, l0 = lq * 4;
#pragma unroll
        for (int j = 0; j < 2; ++j) {
            const int ch0 = 1024 + j * 256 + g * 128 + nblk * 8;
            float o[4][8];
            conv4x8(proj + C_XBC + ch0, rowc + l0, c * 128 + l0, nullptr, P.in[I_CONVW] + ch0, P.in[I_CONVB] + ch0, o);
            bf16_t* dst = j == 0 ? R2 : R1;
#pragma unroll
            for (int r = 0; r < 4; ++r) {
                u32x4 q; q.x = pk2(o[r][0], o[r][1]); q.y = pk2(o[r][2], o[r][3]); q.z = pk2(o[r][4], o[r][5]); q.w = pk2(o[r][6], o[r][7]);
                *(u32x4*)(dst + (l0 + r) * PIT + nblk * 8) = q;
            }
            if (j == 0) {
#pragma unroll
                for (int i = 0; i < 8; ++i) {
                    u32x2 q; q.x = pk2(o[0][i], o[1][i]); q.y = pk2(o[2][i], o[3][i]);
                    *(u32x2*)(R3 + (nblk * 8 + i) * PIT + l0) = q;
                }
            }
        }
    }
    __syncthreads();
    const int wr = w >> 1, wc = w & 1;
    f32x4 cbm[2][4];
#pragma unroll
    for (int m = 0; m < 2; ++m)
#pragma unroll
        for (int n = 0; n < 4; ++n) cbm[m][n] = (f32x4){0.f, 0.f, 0.f, 0.f};
#pragma unroll
    for (int ks = 0; ks < 4; ++ks) {
        bf16x8 af[2], bfm[4];
#pragma unroll
        for (int m = 0; m < 2; ++m) af[m] = *(const bf16x8*)(R1 + (wr * 32 + m * 16 + fr) * PIT + ks * 32 + fq * 8);
#pragma unroll
        for (int n = 0; n < 4; ++n) bfm[n] = *(const bf16x8*)(R2 + (wc * 64 + n * 16 + fr) * PIT + ks * 32 + fq * 8);
#pragma unroll
        for (int m = 0; m < 2; ++m)
#pragma unroll
            for (int n = 0; n < 4; ++n) cbm[m][n] = mfma16(bfm[n], af[m], cbm[m][n]);
    }
    __syncthreads();
    bf16_t* XT = R2; bf16_t* XW = R2 + 64 * PIT;
    bf16_t* ydg = (bf16_t*)(ws + W_NB);
    float* states = P.out;
    const int wp = w >> 2, wn = w & 3;
    u32x4 rawn[7];
    if (tid < 256) conv_load7(proj + C_XBC + (g * 8) * 64 + (tid & 7) * 8, rowc + (tid >> 3) * 4, c * 128 + (tid >> 3) * 4, rawn);
    for (int e = 0; e < 8; ++e) {
        const int h = g * 8 + e;
        const float dskip = P.in[I_SSDD][h];
        if (tid < 256) {
            const int pblk = tid & 7, lq = tid >> 3, l0 = lq * 4, ch0 = h * 64 + pblk * 8;
            float o[4][8];
            conv_compute_lds(rawn, cwl + e * 64 + pblk * 8, o);
            if (e < 7) conv_load7(proj + C_XBC + ch0 + 64, rowc + l0, c * 128 + l0, rawn);
            const float alast = acs[e * 128 + 127];
            float we[4];
#pragma unroll
            for (int r = 0; r < 4; ++r) we[r] = __expf(alast - acs[e * 128 + l0 + r]) * dtv[e * 128 + l0 + r];
#pragma unroll
            for (int i = 0; i < 8; ++i) {
                u32x2 q; q.x = pk2(o[0][i], o[1][i]); q.y = pk2(o[2][i], o[3][i]);
                *(u32x2*)(XT + (pblk * 8 + i) * PIT + l0) = q;
                u32x2 q2; q2.x = pk2(o[0][i] * we[0], o[1][i] * we[1]); q2.y = pk2(o[2][i] * we[2], o[3][i] * we[3]);
                *(u32x2*)(XW + (pblk * 8 + i) * PIT + l0) = q2;
            }
        }
#pragma unroll
        for (int m = 0; m < 2; ++m) {
            const int l = wr * 32 + m * 16 + fr; const float al = acs[e * 128 + l];
#pragma unroll
            for (int n = 0; n < 4; ++n) {
                const int s0 = wc * 64 + n * 16 + fq * 4;
                const f32x4 as = *(const f32x4*)(acs + e * 128 + s0), ds = *(const f32x4*)(dtv + e * 128 + s0);
                float v[4];
#pragma unroll
                for (int r = 0; r < 4; ++r) { const float t = cbm[m][n][r] * __expf(al - as[r]) * ds[r]; v[r] = (s0 + r <= l) ? t : 0.f; }
                u32x2 q; q.x = pk2(v[0], v[1]); q.y = pk2(v[2], v[3]);
                *(u32x2*)(R1 + l * PIT + s0) = q;
            }
        }
        __syncthreads();
        {
            f32x4 yd[2][2];
#pragma unroll
            for (int m = 0; m < 2; ++m)
#pragma unroll
                for (int n = 0; n < 2; ++n) yd[m][n] = (f32x4){0.f, 0.f, 0.f, 0.f};
            {
                bf16x8 af[4][2], bfm[4][2];
#pragma unroll
                for (int ks = 0; ks < 4; ++ks) {
#pragma unroll
                    for (int m = 0; m < 2; ++m) af[ks][m] = *(const bf16x8*)(R1 + (wr * 32 + m * 16 + fr) * PIT + ks * 32 + fq * 8);
#pragma unroll
                    for (int n = 0; n < 2; ++n) bfm[ks][n] = *(const bf16x8*)(XT + (wc * 32 + n * 16 + fr) * PIT + ks * 32 + fq * 8);
                }
                __builtin_amdgcn_sched_barrier(0);
#pragma unroll
                for (int ks = 0; ks < 4; ++ks)
                    if (ks <= wr) {
#pragma unroll
                        for (int m = 0; m < 2; ++m)
#pragma unroll
                            for (int n = 0; n < 2; ++n) yd[m][n] = mfma16(bfm[ks][n], af[ks][m], yd[m][n]);
                    }
            }
#pragma unroll
            for (int m = 0; m < 2; ++m)
#pragma unroll
                for (int n = 0; n < 2; ++n) {
                    const int l = wr * 32 + m * 16 + fr, p0 = wc * 32 + n * 16 + fq * 4;
                    const float x0 = __uint_as_float(((unsigned)XT[(p0 + 0) * PIT + l]) << 16), x1 = __uint_as_float(((unsigned)XT[(p0 + 1) * PIT + l]) << 16);
                    const float x2 = __uint_as_float(((unsigned)XT[(p0 + 2) * PIT + l]) << 16), x3 = __uint_as_float(((unsigned)XT[(p0 + 3) * PIT + l]) << 16);
                    u32x2 q; q.x = pk2(yd[m][n][0] + dskip * x0, yd[m][n][1] + dskip * x1); q.y = pk2(yd[m][n][2] + dskip * x2, yd[m][n][3] + dskip * x3);
                    *(u32x2*)(ydg + (rowc + l) * 1024 + h * 64 + p0) = q;
                }
        }
        {
            f32x4 st[2][2];
#pragma unroll
            for (int m = 0; m < 2; ++m)
#pragma unroll
                for (int n = 0; n < 2; ++n) st[m][n] = (f32x4){0.f, 0.f, 0.f, 0.f};
            {
                bf16x8 af[4][2], bfm[4][2];
#pragma unroll
                for (int ks = 0; ks < 4; ++ks) {
#pragma unroll
                    for (int m = 0; m < 2; ++m) af[ks][m] = *(const bf16x8*)(XW + (wp * 32 + m * 16 + fr) * PIT + ks * 32 + fq * 8);
#pragma unroll
                    for (int n = 0; n < 2; ++n) bfm[ks][n] = *(const bf16x8*)(R3 + (wn * 32 + n * 16 + fr) * PIT + ks * 32 + fq * 8);
                }
                __builtin_amdgcn_sched_barrier(0);
#pragma unroll
                for (int ks = 0; ks < 4; ++ks)
#pragma unroll
                    for (int m = 0; m < 2; ++m)
#pragma unroll
                        for (int n = 0; n < 2; ++n) st[m][n] = mfma16(bfm[ks][n], af[ks][m], st[m][n]);
            }
            float* sp = states + (((long)b * 16 + c) * 16 + h) * 8192;
#pragma unroll
            for (int m = 0; m < 2; ++m)
#pragma unroll
                for (int n = 0; n < 2; ++n) {
                    const int p = wp * 32 + m * 16 + fr, n0 = wn * 32 + n * 16 + fq * 4;
                    *(f32x4*)(sp + p * 128 + n0) = st[m][n];
                }
        }
        __syncthreads();
    }
}

DEV void ssd_s2(const Params& P) {
    float* states = P.out;
    const float* cdec = (const float*)(P.ws + W_CDEC);
    for (int idx = blockIdx.x * 512 + threadIdx.x; idx < 262144; idx += gridDim.x * 512) {
        const int bh = idx >> 11, q = idx & 2047, b = bh >> 4, h = bh & 15;
        f32x4 H = (f32x4){0.f, 0.f, 0.f, 0.f};
#pragma unroll
        for (int c = 0; c < 16; ++c) {
            f32x4* ptr = (f32x4*)(states + (((long)b * 16 + c) * 16 + h) * 8192) + q;
            const f32x4 s = *ptr; *ptr = H;
            const float d = cdec[(b * 16 + c) * 16 + h];
            H = H * d + s;
        }
        *((f32x4*)(P.out + O_SSDP + (long)bh * 8192) + q) = H;
    }
}

DEV void ssd_s3_item(const Params& P, int item) {
    const int tid = tid_fresh(), lane = tid & 63, w = tid >> 6, fr = lane & 15, fq = lane >> 4;
    const int b = item >> 5, c = (item >> 1) & 15, g = item & 1;
    char* ws = P.ws;
    bf16_t* proj = (bf16_t*)(ws + W_PROJ);
    const long rowc = (long)b * 2048 + c * 128;
    bf16_t* R1 = (bf16_t*)(smem + R1_OFF); bf16_t* HB = (bf16_t*)(smem + R2_OFF);
    float* ssq = (float*)(smem + R4_OFF);
    const bf16_t* ydg = (const bf16_t*)(ws + W_NB);
    const float* states = P.out;
    const float* acsg = (const float*)(ws + W_ACS);
    const int hp = tid >> 3, hn0 = (tid & 7) * 16;
    f32x4 hreg[4];
    {
        const float* sp = states + (((long)b * 16 + c) * 16 + g * 8) * 8192 + hp * 128 + hn0;
#pragma unroll
        for (int i = 0; i < 4; ++i) hreg[i] = *(const f32x4*)(sp + i * 4);
    }
    __syncthreads();
    {
        const int nblk = tid & 15, lq = tid >> 4, l0 = lq * 4;
        const int ch0 = 1280 + g * 128 + nblk * 8;
        float o[4][8];
        conv4x8(proj + C_XBC + ch0, rowc + l0, c * 128 + l0, nullptr, P.in[I_CONVW] + ch0, P.in[I_CONVB] + ch0, o);
#pragma unroll
        for (int r = 0; r < 4; ++r) {
            u32x4 q; q.x = pk2(o[r][0], o[r][1]); q.y = pk2(o[r][2], o[r][3]); q.z = pk2(o[r][4], o[r][5]); q.w = pk2(o[r][6], o[r][7]);
            *(u32x4*)(R1 + (l0 + r) * PIT + nblk * 8) = q;
        }
    }
    const int wr = w >> 1, wc = w & 1;
    unsigned ypk[8][2][2][2];
    float ssl[2] = {0.f, 0.f};
    bf16x8 afc[4][2];
#pragma unroll
    for (int e = 0; e < 8; ++e) {
        const int h = g * 8 + e;
        bf16_t* hb = HB + (e & 1) * 64 * PIT;
        {
            u32x4 q0, q1;
            q0.x = pk2(hreg[0][0], hreg[0][1]); q0.y = pk2(hreg[0][2], hreg[0][3]); q0.z = pk2(hreg[1][0], hreg[1][1]); q0.w = pk2(hreg[1][2], hreg[1][3]);
            q1.x = pk2(hreg[2][0], hreg[2][1]); q1.y = pk2(hreg[2][2], hreg[2][3]); q1.z = pk2(hreg[3][0], hreg[3][1]); q1.w = pk2(hreg[3][2], hreg[3][3]);
            *(u32x4*)(hb + hp * PIT + hn0) = q0; *(u32x4*)(hb + hp * PIT + hn0 + 8) = q1;
        }
        if (e < 7) {
            const float* sp = states + (((long)b * 16 + c) * 16 + h + 1) * 8192 + hp * 128 + hn0;
#pragma unroll
            for (int i = 0; i < 4; ++i) hreg[i] = *(const f32x4*)(sp + i * 4);
        }
        u32x2 yq[2][2], zz[2][2]; float ea[2];
#pragma unroll
        for (int m = 0; m < 2; ++m) {
            const int l = wr * 32 + m * 16 + fr;
            ea[m] = acsg[(((long)b * 16 + c) * 16 + h) * 128 + l];
#pragma unroll
            for (int n = 0; n < 2; ++n) {
                const int p0 = wc * 32 + n * 16 + fq * 4;
                yq[m][n] = *(const u32x2*)(ydg + (rowc + l) * 1024 + h * 64 + p0);
                zz[m][n] = *(const u32x2*)(proj + (rowc + l) * PLD + C_ZA + h * 64 + p0);
            }
        }
        __syncthreads();
        if (e == 0) {
#pragma unroll
            for (int ks = 0; ks < 4; ++ks)
#pragma unroll
                for (int m = 0; m < 2; ++m) afc[ks][m] = *(const bf16x8*)(R1 + (wr * 32 + m * 16 + fr) * PIT + ks * 32 + fq * 8);
        }
        f32x4 yo[2][2];
#pragma unroll
        for (int m = 0; m < 2; ++m)
#pragma unroll
            for (int n = 0; n < 2; ++n) yo[m][n] = (f32x4){0.f, 0.f, 0.f, 0.f};
        {
            bf16x8 bfm[4][2];
#pragma unroll
            for (int ks = 0; ks < 4; ++ks)
#pragma unroll
                for (int n = 0; n < 2; ++n) bfm[ks][n] = *(const bf16x8*)(hb + (wc * 32 + n * 16 + fr) * PIT + ks * 32 + fq * 8);
            __builtin_amdgcn_sched_barrier(0);
#pragma unroll
            for (int ks = 0; ks < 4; ++ks)
#pragma unroll
                for (int m = 0; m < 2; ++m)
#pragma unroll
                    for (int n = 0; n < 2; ++n) yo[m][n] = mfma16(bfm[ks][n], afc[ks][m], yo[m][n]);
        }
#pragma unroll
        for (int m = 0; m < 2; ++m) {
            const float eam = __expf(ea[m]);
#pragma unroll
            for (int n = 0; n < 2; ++n) {
                const float v0 = (bflo(yq[m][n].x) + eam * yo[m][n][0]) * siluf(bflo(zz[m][n].x)), v1 = (bfhi(yq[m][n].x) + eam * yo[m][n][1]) * siluf(bfhi(zz[m][n].x));
                const float v2 = (bflo(yq[m][n].y) + eam * yo[m][n][2]) * siluf(bflo(zz[m][n].y)), v3 = (bfhi(yq[m][n].y) + eam * yo[m][n][3]) * siluf(bfhi(zz[m][n].y));
                ssl[m] += v0 * v0 + v1 * v1 + v2 * v2 + v3 * v3;
                ypk[e][m][n][0] = pk2(v0, v1); ypk[e][m][n][1] = pk2(v2, v3);
            }
        }
    }
#pragma unroll
    for (int m = 0; m < 2; ++m) {
        float ss = ssl[m];
        ss += __shfl_xor(ss, 16); ss += __shfl_xor(ss, 32);
        if (fq == 0) ssq[wc * 128 + wr * 32 + m * 16 + fr] = ss;
    }
    f32x4 ggv[8][2];
#pragma unroll
    for (int e = 0; e < 8; ++e)
#pragma unroll
        for (int n = 0; n < 2; ++n) ggv[e][n] = *(const f32x4*)(P.in[I_SSDG] + (g * 8 + e) * 64 + wc * 32 + n * 16 + fq * 4);
    __syncthreads();
#pragma unroll
    for (int m = 0; m < 2; ++m) {
        const int l = wr * 32 + m * 16 + fr;
        const float rstd = rsqrtf((ssq[l] + ssq[128 + l]) * (1.f / 512.f) + EPS);
#pragma unroll
        for (int e = 0; e < 8; ++e)
#pragma unroll
            for (int n = 0; n < 2; ++n) {
                const int h = g * 8 + e, p0 = wc * 32 + n * 16 + fq * 4;
                const f32x4 gg = ggv[e][n];
                const unsigned a0 = ypk[e][m][n][0], a1 = ypk[e][m][n][1];
                u32x2 o; o.x = pk2(bflo(a0) * rstd * gg[0], bfhi(a0) * rstd * gg[1]); o.y = pk2(bflo(a1) * rstd * gg[2], bfhi(a1) * rstd * gg[3]);
                *(u32x2*)(proj + (rowc + l) * PLD + C_ZA + h * 64 + p0) = o;
            }
    }
}

DEV void ssd_sample_item(const Params& P, int item) {
    const int tid = tid_fresh();
    const int b = item >> 1, g = item & 1;
    char* ws = P.ws;
    bf16_t* proj = (bf16_t*)(ws + W_PROJ);
    const long row0 = NPROMPT + (long)b * 4;
    float* xs = (float*)smem;
    float* Bs = xs + 2048;
    float* Cs = Bs + 512;
    float* dts = Cs + 512;
    float* das = dts + 32;
    float* vs = das + 32;
    float* red = vs + 2048;
    float* zs = red + 32;
    for (int u = tid; u < 768; u += 512) {
        int ch; float* dst; int dcol;
        if (u < 512) { ch = g * 512 + u; dst = xs; dcol = u; }
        else if (u < 640) { ch = 1024 + g * 128 + (u - 512); dst = Bs; dcol = u - 512; }
        else { ch = 1280 + g * 128 + (u - 640); dst = Cs; dcol = u - 640; }
        const int pitch = u < 512 ? 512 : 128;
        float full[7];
#pragma unroll
        for (int i = 0; i < 3; ++i) full[i] = P.in[I_CONV][((long)b * 3 + i) * 1536 + ch];
#pragma unroll
        for (int i = 0; i < 4; ++i) full[3 + i] = __uint_as_float(((unsigned)proj[(row0 + i) * PLD + C_XBC + ch]) << 16);
        const float w0 = P.in[I_CONVW][ch], w1 = P.in[I_CONVW][1536 + ch], w2 = P.in[I_CONVW][3072 + ch], w3 = P.in[I_CONVW][4608 + ch], bias = P.in[I_CONVB][ch];
#pragma unroll
        for (int t = 0; t < 4; ++t) dst[t * pitch + dcol] = siluf(bias + w0 * full[t] + w1 * full[t + 1] + w2 * full[t + 2] + w3 * full[t + 3]);
    }
    for (int u = tid; u < 4 * 256; u += 512) {
        const int t = u >> 8, c2 = (u & 255) * 2;
        const unsigned zz = *(const unsigned*)(proj + (row0 + t) * PLD + C_ZA + g * 512 + c2);
        zs[t * 512 + c2] = bflo(zz); zs[t * 512 + c2 + 1] = bfhi(zz);
    }
    if (tid < 32) {
        const int t = tid >> 3, e = tid & 7, h = g * 8 + e;
        const float x = ((const float*)(ws + W_DTR))[(row0 + t) * 16 + h] + P.in[I_DTB][h];
        const float d = x > 20.f ? x : log1pf(__expf(x));
        dts[tid] = d; das[tid] = __expf(-d * __expf(P.in[I_ALOG][h]));
    }
    __syncthreads();
    const int p = tid >> 3, nb = tid & 7, n0 = nb * 16;
    f32x4 hn[4];
    {
        const float* sp0 = P.in[I_SSD] + (((long)b * 16 + g * 8) * 64 + p) * 128 + n0;
#pragma unroll
        for (int i = 0; i < 4; ++i) hn[i] = *(const f32x4*)(sp0 + i * 4);
    }
    for (int e = 0; e < 8; ++e) {
        const int h = g * 8 + e;
        float* op = P.out + O_SSDS + (((long)b * 16 + h) * 64 + p) * 128 + n0;
        f32x4 hv[4];
#pragma unroll
        for (int i = 0; i < 4; ++i) hv[i] = hn[i];
        if (e < 7) {
            const float* sp = P.in[I_SSD] + (((long)b * 16 + h + 1) * 64 + p) * 128 + n0;
#pragma unroll
            for (int i = 0; i < 4; ++i) hn[i] = *(const f32x4*)(sp + i * 4);
        }
        const float dsk = P.in[I_SSDD][h];
        float yv4[4], xv4[4];
#pragma unroll
        for (int t = 0; t < 4; ++t) {
            const float dec = das[t * 8 + e], xv = xs[t * 512 + e * 64 + p], coef = dts[t * 8 + e] * xv;
            float part = 0.f;
#pragma unroll
            for (int i = 0; i < 4; ++i) {
                const f32x4 bv = *(const f32x4*)(Bs + t * 128 + n0 + i * 4), cv = *(const f32x4*)(Cs + t * 128 + n0 + i * 4);
                hv[i] = hv[i] * dec + bv * coef;
                part += hv[i][0] * cv[0] + hv[i][1] * cv[1] + hv[i][2] * cv[2] + hv[i][3] * cv[3];
            }
            yv4[t] = part; xv4[t] = xv;
        }
#pragma unroll
        for (int t = 0; t < 4; ++t) yv4[t] += __shfl_xor(yv4[t], 1);
#pragma unroll
        for (int t = 0; t < 4; ++t) yv4[t] += __shfl_xor(yv4[t], 2);
#pragma unroll
        for (int t = 0; t < 4; ++t) yv4[t] += __shfl_xor(yv4[t], 4);
        if (nb == 0) {
#pragma unroll
            for (int t = 0; t < 4; ++t) vs[t * 512 + e * 64 + p] = (yv4[t] + dsk * xv4[t]) * siluf(zs[t * 512 + e * 64 + p]);
        }
#pragma unroll
        for (int i = 0; i < 4; ++i) *(f32x4*)(op + i * 4) = hv[i];
    }
    __syncthreads();
    {
        const int t = tid >> 7, cidx = tid & 127;
        float v[4]; float ss = 0.f;
#pragma unroll
        for (int i = 0; i < 4; ++i) { v[i] = vs[t * 512 + cidx * 4 + i]; ss += v[i] * v[i]; }
        ss = wave_sum(ss);
        if ((tid & 63) == 0) red[tid >> 6] = ss;
        __syncthreads();
        const float tot = red[t * 2] + red[t * 2 + 1];
        const float rstd = rsqrtf(tot * (1.f / 512.f) + EPS);
        const f32x4 gg = *(const f32x4*)(P.in[I_SSDG] + g * 512 + cidx * 4);
        u32x2 o; o.x = pk2(v[0] * rstd * gg[0], v[1] * rstd * gg[1]); o.y = pk2(v[2] * rstd * gg[2], v[3] * rstd * gg[3]);
        *(u32x2*)(proj + (row0 + t) * PLD + C_ZA + g * 512 + cidx * 4) = o;
    }
    __syncthreads();
}

constexpr int S5P = 20;
template <bool SAMPLE>
DEV void s5_item(const Params& P, int g, long rowbase, int bidx) {
    const int tid = tid_fresh(), lane = tid & 63, w = tid >> 6, fr = lane & 15, fq = lane >> 4;
    constexpr int TPW = SAMPLE ? 16 : 256;
    bf16_t* proj = (bf16_t*)(P.ws + W_PROJ);
    float* buf = (float*)smem + w * (128 * S5P);
    float* carry = (float*)smem + 8 * 128 * S5P;
    float* fs = carry + 1024 + w * 128;
    float ar, ai;
    {
        const float lr = P.in[I_LRE][g * 64 + lane], li = P.in[I_LIM][g * 64 + lane], delta = expf(P.in[I_LDT][g]);
        const float mag = expf(lr * delta), ang = li * delta;
        ar = mag * cosf(ang); ai = mag * sinf(ang);
        const float qre = ar - 1.f, den = lr * lr + li * li;
        fs[lane] = (qre * lr + ai * li) / den; fs[64 + lane] = (ai * lr - qre * li) / den;
    }
    lds_fence();
    bf16x8 bbf[8];
#pragma unroll
    for (int j = 0; j < 8; ++j) {
        bf16x8 z = {0, 0, 0, 0, 0, 0, 0, 0};
        if (fq < 2) {
            const int p = (j & 3) * 16 + fr;
            const float f_r = fs[p], f_i = fs[64 + p];
            const float* br = P.in[I_BRE] + ((long)(g * 64 + p)) * 16 + fq * 8;
            const float* bi = P.in[I_BIM] + ((long)(g * 64 + p)) * 16 + fq * 8;
            const f32x4 r0 = *(const f32x4*)br, r1 = *(const f32x4*)(br + 4), i0 = *(const f32x4*)bi, i1 = *(const f32x4*)(bi + 4);
            f32x4 o0, o1;
            if (j < 4) { o0 = r0 * f_r - i0 * f_i; o1 = r1 * f_r - i1 * f_i; }
            else { o0 = i0 * f_r + r0 * f_i; o1 = i1 * f_r + r1 * f_i; }
            u32x4 q; q.x = pk2(o0[0], o0[1]); q.y = pk2(o0[2], o0[3]); q.z = pk2(o1[0], o1[1]); q.w = pk2(o1[2], o1[3]);
            z = __builtin_bit_cast(bf16x8, q);
        }
        bbf[j] = z;
    }
    bf16x8 ccf[4];
#pragma unroll
    for (int ks = 0; ks < 4; ++ks) {
        const float* src = (ks < 2 ? P.in[I_CRE] : P.in[I_CIM]) + ((long)(g * 16 + fr)) * 64 + (ks & 1) * 32 + fq * 8;
        f32x4 c0 = *(const f32x4*)src, c1 = *(const f32x4*)(src + 4);
        if (ks >= 2) { c0 = -c0; c1 = -c1; }
        u32x4 q; q.x = pk2(c0[0], c0[1]); q.y = pk2(c0[2], c0[3]); q.z = pk2(c1[0], c1[1]); q.w = pk2(c1[2], c1[3]);
        ccf[ks] = __builtin_bit_cast(bf16x8, q);
    }
    const f32x4 dsk = *(const f32x4*)(P.in[I_S5D] + g * 16 + fq * 4);
    const long roww = rowbase + (long)w * TPW;
    float xr = 0.f, xi = 0.f;
    float sre[8], sim[8];
#pragma unroll
    for (int j = 0; j < 8; ++j) { sre[j] = 0.f; sim[j] = 0.f; }
    if (SAMPLE) {
#pragma unroll
        for (int j = 0; j < TPW / 4; ++j) {
            const long seq = (roww - NPROMPT) / 4 + j;
            sre[j] = P.in[I_S5R][(seq * 64 + g) * 64 + lane]; sim[j] = P.in[I_S5I][(seq * 64 + g) * 64 + lane];
        }
    }
    constexpr int NPASS = SAMPLE ? 1 : 2;
#pragma unroll 1
    for (int pass = 0; pass < NPASS; ++pass) {
        const bool last = (pass == NPASS - 1);
        if (!SAMPLE && pass == 1) {
            carry[w * 128 + lane] = xr; carry[w * 128 + 64 + lane] = xi;
            __syncthreads();
            float pr = ar, pi = ai;
#pragma unroll
            for (int q = 0; q < 8; ++q) { const float nr = pr * pr - pi * pi, ni = 2.f * pr * pi; pr = nr; pi = ni; }
            float sr = 0.f, si = 0.f;
            for (int ww = 0; ww < w; ++ww) {
                const float cr = carry[ww * 128 + lane], ci = carry[ww * 128 + 64 + lane];
                const float nr = pr * sr - pi * si + cr, ni = pr * si + pi * sr + ci; sr = nr; si = ni;
            }
            xr = sr; xi = si;
        }
        if (!SAMPLE && pass == 0 && w == 7) continue;
        bf16x8 ufn = {0, 0, 0, 0, 0, 0, 0, 0};
        if (fq < 2) ufn = *(const bf16x8*)(proj + (roww + fr) * PLD + C_UB + g * 16 + fq * 8);
#pragma unroll 1
        for (int sb = 0; sb < TPW / 16; ++sb) {
            const long r = roww + sb * 16;
            const bf16x8 uf = ufn;
            if (fq < 2 && sb + 1 < TPW / 16) ufn = *(const bf16x8*)(proj + (r + 16 + fr) * PLD + C_UB + g * 16 + fq * 8);
            u32x2* up = (u32x2*)(proj + (r + fr) * PLD + C_UB + g * 16 + fq * 4);
            u32x2 uu = {0u, 0u};
            if (last) uu = *up;
            const f32x4 zero = {0.f, 0.f, 0.f, 0.f};
#pragma unroll
            for (int j = 0; j < 8; ++j) {
                const f32x4 d = mfma16(uf, bbf[j], zero);
                *(f32x4*)(buf + (j * 16 + fr) * S5P + fq * 4) = d;
            }
            lds_fence();
            {
                f32x4 brv[4], biv[4];
#pragma unroll
                for (int q = 0; q < 4; ++q) { brv[q] = *(const f32x4*)(buf + lane * S5P + q * 4); biv[q] = *(const f32x4*)(buf + (64 + lane) * S5P + q * 4); }
                __builtin_amdgcn_sched_barrier(0);
#pragma unroll
                for (int q = 0; q < 4; ++q) {
                    if (SAMPLE) {
#pragma unroll
                        for (int j = 0; j < 8; ++j) if (j == sb * 4 + q) { xr = sre[j]; xi = sim[j]; }
                    }
#pragma unroll
                    for (int i = 0; i < 4; ++i) {
                        const float nr = ar * xr - ai * xi + brv[q][i], ni = ar * xi + ai * xr + biv[q][i];
                        xr = nr; xi = ni; brv[q][i] = nr; biv[q][i] = ni;
                    }
                    if (SAMPLE) {
                        const long seq = (r - NPROMPT) / 4 + q;
                        P.out[O_S5RS + (seq * 64 + g) * 64 + lane] = xr; P.out[O_S5IS + (seq * 64 + g) * 64 + lane] = xi;
                    }
                }
                if (last) {
#pragma unroll
                    for (int q = 0; q < 4; ++q) { *(f32x4*)(buf + lane * S5P + q * 4) = brv[q]; *(f32x4*)(buf + (64 + lane) * S5P + q * 4) = biv[q]; }
                }
            }
            if (last) {
                lds_fence();
                f32x4 y = {0.f, 0.f, 0.f, 0.f};
                float xv[4][8];
#pragma unroll
                for (int ks = 0; ks < 4; ++ks)
#pragma unroll
                    for (int i = 0; i < 8; ++i) xv[ks][i] = buf[(ks * 32 + fq * 8 + i) * S5P + fr];
                __builtin_amdgcn_sched_barrier(0);
#pragma unroll
                for (int ks = 0; ks < 4; ++ks) {
                    u32x4 q; q.x = pk2(xv[ks][0], xv[ks][1]); q.y = pk2(xv[ks][2], xv[ks][3]); q.z = pk2(xv[ks][4], xv[ks][5]); q.w = pk2(xv[ks][6], xv[ks][7]);
                    y = mfma16(ccf[ks], __builtin_bit_cast(bf16x8, q), y);
                }
                const float y0 = geluf(y[0] + dsk[0] * bflo(uu.x)), y1 = geluf(y[1] + dsk[1] * bfhi(uu.x));
                const float y2 = geluf(y[2] + dsk[2] * bflo(uu.y)), y3 = geluf(y[3] + dsk[3] * bfhi(uu.y));
                u32x2 o; o.x = pk2(y0, y1); o.y = pk2(y2, y3);
                *up = o;
            }
            lds_fence();
        }
    }
    if (!SAMPLE && w == 7) {
        P.out[O_S5RP + ((long)bidx * 64 + g) * 64 + lane] = xr; P.out[O_S5IP + ((long)bidx * 64 + g) * 64 + lane] = xi;
    }
    __syncthreads();
}

__global__ void __launch_bounds__(512) hymba_fwd(Params P) {
#ifdef PROBE_K
    unsigned long long tb_[9]; int nb_ = 0;
#define TB() do { tb_[nb_++] = wall_clock64(); } while (0)
    TB();
#else
#define TB() do {} while (0)
#endif
    const int G = gridDim.x, bid = blockIdx.x;
    char* ws = P.ws;
    bf16_t* proj = (bf16_t*)(ws + W_PROJ);
    unsigned* barw = (unsigned*)(ws + W_BAR);
    volatile LAS unsigned* stw = (volatile LAS unsigned*)(smem + 131072);
    if (threadIdx.x < 4) stw[threadIdx.x] = 0u;
    __syncthreads();
    const XcdBarrier xb = xcd_barrier_post(barw, stw);
#ifndef NO_P0
    phase0(P);
#endif
    xcd_barrier(xb); TB();
#ifndef NO_P1
    for (int L = bid; L < 1188; L += G) {
        int pm, pn; tile_of(L, 66, 18, pm, pn);
        gemm_tile((const bf16_t*)(ws + W_NB), 1024, (const bf16_t*)(ws + W_WTIN), 1024, 1024, pm * 256, pn * 256, EpiBf16{proj, PLD, (const float*)(ws + W_RSTD)});
    }
    for (int L = (bid + G - 1188 % G) % G; L < 264; L += G) {
        int pm, pn; tile_of(L, 66, 4, pm, pn);
        gemm_tile((const bf16_t*)(ws + W_PB), 256, (const bf16_t*)(ws + W_WTPP), 256, 256, pm * 256, pn * 256, EpiBf16{(bf16_t*)(ws + W_PP), 1024, nullptr});
    }
#endif
    xcd_barrier(xb); TB();
    for (int idx = bid * 512 + threadIdx.x; idx < (8 + 128) * 3 * 192; idx += G * 512) {
        const int c8 = (idx % 192) * 8, sj = idx / 192, j = sj % 3, sq = sj / 3;
        const long row = sq < 8 ? (long)sq * 2048 + 2045 + j : NPROMPT + (long)(sq - 8) * 4 + 1 + j;
        const u32x4 u = *(const u32x4*)(proj + row * PLD + C_XBC + c8);
        float* dst = sq < 8 ? P.out + O_CONVP + ((long)sq * 3 + j) * 1536 + c8 : P.out + O_CONVS + ((long)(sq - 8) * 3 + j) * 1536 + c8;
        *(f32x4*)dst = (f32x4){bflo(u.x), bfhi(u.x), bflo(u.y), bfhi(u.y)};
        *(f32x4*)(dst + 4) = (f32x4){bflo(u.z), bfhi(u.z), bflo(u.w), bfhi(u.w)};
    }
#ifdef PROBE2
    unsigned long long tq_[5]; tq_[0] = wall_clock64();
#endif
#ifndef NO_S1
    for (int it = bid; it < 256; it += G) ssd_s1_item(P, it);
#endif
#ifdef PROBE2
    tq_[1] = wall_clock64();
#endif
#ifndef NO_SS
    for (int it = bid; it < 256; it += G) ssd_sample_item(P, it);
#endif
#ifdef PROBE2
    tq_[2] = wall_clock64();
#endif
#ifndef NO_S5P
    for (int it = bid; it < 512; it += G) s5_item<false>(P, it & 63, (long)(it >> 6) * 2048, it >> 6);
#endif
#ifdef PROBE2
    tq_[3] = wall_clock64();
#endif
#ifndef NO_S5S
    for (int it = bid; it < 256; it += G) s5_item<true>(P, it & 63, NPROMPT + (long)(it >> 6) * 128, 0);
#endif
#ifdef PROBE2
    tq_[4] = wall_clock64();
    { const unsigned long long d = tq_[PROBE2 + 1] - tq_[PROBE2], t0 = wall_clock64(); while (wall_clock64() - t0 < d) __builtin_amdgcn_s_sleep(8); }
#endif
    xcd_barrier(xb); TB();
    if (bid & 1) ssd_s2(P);
    {
        const EpiGlu eg{proj, P.in[I_GLUB]};
        for (int L = bid; L < 256; L += G) {
            int pm, pn; tile_of(L, 64, 4, pm, pn);
            gemm_tile(proj + C_UB, PLD, (const bf16_t*)(ws + W_WTGLU), 1024, 1024, pm * 256, pn * 256, eg);
        }
        for (int L = bid; L < 256; L += G)
            gemm_small(proj + C_UB, PLD, (const bf16_t*)(ws + W_WTGLU), 1024, 1024, NPROMPT + (L >> 3) * 16, (L & 7) * 128, eg);
    }
    if (!(bid & 1)) ssd_s2(P);
    xcd_barrier(xb); TB();
#ifndef NO_S3
    for (int it = bid; it < 256; it += G) ssd_s3_item(P, it);
#endif
    xcd_barrier(xb); TB();
#ifndef NO_P5
    {
        const EpiOut eo{P.in[I_XP], P.in[I_XS], (bf16_t*)(ws + W_NB), (float*)(ws + W_RSS1)};
        if (bid & 1)
            for (int L = bid; L < 256; L += G)
                gemm_small(proj, PLD, (const bf16_t*)(ws + W_WTOUT), 2048, 2048, NPROMPT + (L >> 3) * 16, (L & 7) * 128, eo);
        for (int L = bid; L < 256; L += G) {
            int pm, pn; tile_of(L, 64, 4, pm, pn);
            gemm_tile(proj, PLD, (const bf16_t*)(ws + W_WTOUT), 2048, 2048, pm * 256, pn * 256, eo);
        }
        if (!(bid & 1))
            for (int L = bid; L < 256; L += G)
                gemm_small(proj, PLD, (const bf16_t*)(ws + W_WTOUT), 2048, 2048, NPROMPT + (L >> 3) * 16, (L & 7) * 128, eo);
    }
#endif
    xcd_barrier(xb); TB();
#ifndef NO_P6
    {
        const EpiPle ep{P.out, (const bf16_t*)(ws + W_NB), (const bf16_t*)(ws + W_PP), (const float*)(ws + W_RSS1), (float*)(ws + W_RSS2)};
        if (bid & 1)
            for (int L = bid; L < 256; L += G)
                gemm_small((const bf16_t*)(ws + W_NB), 1024, (const bf16_t*)(ws + W_WTGATE), 1024, 1024, NPROMPT + (L >> 3) * 16, (L & 7) * 128, ep);
        for (int L = bid; L < 256; L += G) {
            int pm, pn; tile_of(L, 64, 4, pm, pn);
            gemm_tile((const bf16_t*)(ws + W_NB), 1024, (const bf16_t*)(ws + W_WTGATE), 1024, 1024, pm * 256, pn * 256, ep);
        }
        if (!(bid & 1))
            for (int L = bid; L < 256; L += G)
                gemm_small((const bf16_t*)(ws + W_NB), 1024, (const bf16_t*)(ws + W_WTGATE), 1024, 1024, NPROMPT + (L >> 3) * 16, (L & 7) * 128, ep);
    }
#endif
    xcd_barrier(xb); TB();
    {
        const float* rss2 = (const float*)(ws + W_RSS2);
        for (int idx = bid * 512 + threadIdx.x; idx < NTOK * 256; idx += G * 512) {
            const int row = idx >> 8, c4 = (idx & 255) * 4;
            const f32x4 r0 = *(const f32x4*)(rss2 + (long)row * 16), r1 = *(const f32x4*)(rss2 + (long)row * 16 + 4), r2 = *(const f32x4*)(rss2 + (long)row * 16 + 8), r3 = *(const f32x4*)(rss2 + (long)row * 16 + 12);
            const float tot = (((r0[0] + r0[1]) + (r0[2] + r0[3])) + ((r1[0] + r1[1]) + (r1[2] + r1[3]))) + (((r2[0] + r2[1]) + (r2[2] + r2[3])) + ((r3[0] + r3[1]) + (r3[2] + r3[3])));
            const float rstd = rsqrtf(tot * (1.f / 1024.f) + EPS);
            f32x4* p = (f32x4*)(P.out + (long)row * 1024 + c4);
            const f32x4 gf = *(const f32x4*)(P.in[I_GFIN] + c4);
            *p = *p * rstd * gf;
        }
    }
#ifdef PROBE_K
    { TB(); const unsigned long long d = tb_[PROBE_K + 1] - tb_[PROBE_K], t0 = wall_clock64(); while (wall_clock64() - t0 < d) __builtin_amdgcn_s_sleep(8); }
#endif
}

extern "C" void kernel_launch(void* const* d_in, const int* in_sizes, int n_in, void* d_out, int out_size, void* d_ws, size_t ws_size, hipStream_t stream) {
    static int grid_blocks = 0;
    if (grid_blocks == 0) {
        if (n_in != 31 || out_size != (int)O_END || ws_size < W_END) {
            fprintf(stderr, "kernel_launch: unexpected shapes n_in %d out %d ws %zu (need %zu)\n", n_in, out_size, ws_size, (size_t)W_END);
            grid_blocks = -1; return;
        }
        int dev = 0, cus = 0, per_cu = 0;
        hipGetDevice(&dev);
        hipDeviceGetAttribute(&cus, hipDeviceAttributeMultiprocessorCount, dev);
        hipFuncSetAttribute((const void*)hymba_fwd, hipFuncAttributeMaxDynamicSharedMemorySize, LDS_BYTES);
        hipOccupancyMaxActiveBlocksPerMultiprocessor(&per_cu, (const void*)hymba_fwd, 512, LDS_BYTES);
        if (per_cu < 1) { fprintf(stderr, "kernel_launch: occupancy query says %d blocks/CU\n", per_cu); per_cu = 1; }
        grid_blocks = cus;
        (void)hipGetLastError();
    }
    if (grid_blocks < 0) return;
    if (hipMemsetAsync((char*)d_ws + W_BAR, 0, XCD_BAR_WORDS * sizeof(unsigned), stream) != hipSuccess) { fprintf(stderr, "kernel_launch: memset of the barrier words failed\n"); return; }
    Params p{};
    for (int i = 0; i < 31; ++i) p.in[i] = (const float*)d_in[i];
    p.out = (float*)d_out; p.ws = (char*)d_ws;
    void* args[] = {&p};
    hipError_t e = hipLaunchCooperativeKernel((const void*)hymba_fwd, dim3(grid_blocks), dim3(512), args, LDS_BYTES, stream);
    if (e != hipSuccess) fprintf(stderr, "cooperative launch failed: %s (grid %d)\n", hipGetErrorString(e), grid_blocks);
}
```

```cpp
#include <hip/hip_runtime.h>
#include <hip/hip_cooperative_groups.h>
#include <cstdio>
namespace cg = cooperative_groups;

typedef unsigned short bf16_t;
typedef short bf16x8 __attribute__((ext_vector_type(8)));
typedef float f32x4 __attribute__((ext_vector_type(4)));
typedef unsigned u32x2 __attribute__((ext_vector_type(2)));
typedef unsigned u32x4 __attribute__((ext_vector_type(4)));
#define DEV __device__ __forceinline__

constexpr int NPROMPT = 16384, NSAMPLE = 512, NTOK = 16896;
constexpr int PLD = 4608;
constexpr int C_ZA = 0, C_ZB = 1024, C_XBC = 2048, C_UB = 3584;
constexpr float EPS = 1e-6f;
constexpr long O_YP = 0, O_YS = 16777216, O_SSDP = 17301504, O_CONVP = 18350080, O_S5RP = 18386944, O_S5IP = 18419712,
               O_SSDS = 18452480, O_CONVS = 35229696, O_S5RS = 35819520, O_S5IS = 36343808, O_END = 36868096;
constexpr size_t W_WTIN = 0;
constexpr size_t W_WTOUT = W_WTIN + 4608ull * 1024 * 2;
constexpr size_t W_WTGLU = W_WTOUT + 1024ull * 2048 * 2;
constexpr size_t W_WTGATE = W_WTGLU + 1024ull * 1024 * 2;
constexpr size_t W_WTPP = W_WTGATE + 1024ull * 1024 * 2;
constexpr size_t W_NB = W_WTPP + 1024ull * 256 * 2;
constexpr size_t W_PB = W_NB + 16896ull * 1024 * 2;
constexpr size_t W_DTR = W_PB + 16896ull * 256 * 2;
constexpr size_t W_ACS = W_DTR + 16896ull * 16 * 4;
constexpr size_t W_CDEC = W_ACS + 16384ull * 16 * 4;
constexpr size_t W_RSS1 = W_CDEC + 8192;
constexpr size_t W_RSS2 = W_RSS1 + 16896ull * 16 * 4;
constexpr size_t W_PROJ = W_RSS2 + 16896ull * 16 * 4;
constexpr size_t W_PP = W_PROJ + 16896ull * 4608 * 2;
constexpr size_t W_RSTD = W_PP + 16896ull * 1024 * 2;
constexpr size_t W_BAR = W_RSTD + 16896ull * 4;
constexpr size_t W_END = W_BAR + 16384;

constexpr int LDS_BYTES = 131072 + 64;

struct Params {
    const float* in[31];
    float* out;
    char* ws;
};
enum { I_XP = 0, I_XS, I_PP, I_PS, I_SSD, I_CONV, I_S5R, I_S5I, I_WIN, I_GIN, I_CONVW, I_CONVB, I_DTB, I_ALOG, I_SSDD, I_SSDG,
       I_LRE, I_LIM, I_LDT, I_BRE, I_BIM, I_CRE, I_CIM, I_S5D, I_GLUW, I_GLUB, I_WOUT, I_GPLE, I_WGATE, I_WPP, I_GFIN };

extern __shared__ __attribute__((aligned(16))) char smem[];

DEV unsigned pk2(float lo, float hi) { unsigned r; asm("v_cvt_pk_bf16_f32 %0, %1, %2" : "=v"(r) : "v"(lo), "v"(hi)); return r; }
DEV float bflo(unsigned u) { return __uint_as_float(u << 16); }
DEV float bfhi(unsigned u) { return __uint_as_float(u & 0xffff0000u); }
DEV float wave_sum(float v) {
#pragma unroll
    for (int o = 1; o < 64; o <<= 1) v += __shfl_xor(v, o);
    return v;
}
DEV float siluf(float v) { return v * __builtin_amdgcn_rcpf(1.f + __expf(-v)); }
DEV float sigmf(float v) { return __builtin_amdgcn_rcpf(1.f + __expf(-v)); }
DEV float geluf(float y) { float z = 0.7978845608f * (y + 0.044715f * y * y * y); return y * __builtin_amdgcn_rcpf(1.f + __expf(-2.f * z)); }
DEV f32x4 mfma16(bf16x8 a, bf16x8 b, f32x4 c) { return __builtin_amdgcn_mfma_f32_16x16x32_bf16(a, b, c, 0, 0, 0); }
DEV int tid_fresh() { int t = threadIdx.x; asm volatile("" : "+v"(t)); return t; }
DEV void lds_fence() { asm volatile("s_waitcnt lgkmcnt(0)" ::: "memory"); }


#define XB_TMO      128
#define XB_XCNT(j)  (256  + 64 * (j))
#define XB_XSUB(j)  (1280 + 64 * (j))
#define XB_XGEN(j)  (2304 + 64 * (j))
#define XB_TOP      3328
#define XB_TOPGEN   3392
#define XCD_BAR_WORDS 3456
#define XB_SPIN_CAP (1u << 22)
#define LAS __attribute__((address_space(3)))
DEV unsigned xb_ld(unsigned* p) { return __hip_atomic_load(p, __ATOMIC_RELAXED, __HIP_MEMORY_SCOPE_AGENT); }
DEV unsigned xb_add(unsigned* p, unsigned v) { return __hip_atomic_fetch_add(p, v, __ATOMIC_RELAXED, __HIP_MEMORY_SCOPE_AGENT); }
DEV unsigned xb_xcc_id() { return (unsigned)__builtin_amdgcn_s_getreg((3 << 11) | 20) & 0xFu; }
#define XB_SPIN(cond, bar) do { unsigned _sp = 0; while (cond) { __builtin_amdgcn_s_sleep(1); \
    if ((++_sp & 255u) == 0u) { if (xb_ld(&(bar)[XB_TMO])) break; if (_sp > XB_SPIN_CAP) { atomicAdd(&(bar)[XB_TMO], 1u); break; } } } } while (0)
struct XcdBarrier { unsigned* bar; unsigned x; volatile LAS unsigned* st; };
DEV XcdBarrier xcd_barrier_post(unsigned* bar, volatile LAS unsigned* st) {
    XcdBarrier b; b.bar = bar; b.x = xb_xcc_id(); b.st = st;
    if (threadIdx.x == 0) (void)xb_add(&bar[XB_XCNT(b.x)], 1u);
    return b;
}
DEV void xcd_barrier_complete(unsigned* bar, unsigned x, unsigned& nloc, unsigned& nx) {
    const unsigned G = gridDim.x * gridDim.y * gridDim.z;
    unsigned sum, cnt, mine, sp = 0u;
    for (;;) {
        sum = 0u; cnt = 0u; mine = 0u;
#pragma unroll
        for (unsigned j = 0; j < 16; ++j) { const unsigned c = xb_ld(&bar[XB_XCNT(j)]); sum += c; cnt += (c > 0u) ? 1u : 0u; mine = (j == x) ? c : mine; }
        if (sum == G) break;
        __builtin_amdgcn_s_sleep(1);
        if ((++sp & 255u) == 0u) { if (xb_ld(&bar[XB_TMO])) break; if (sp > XB_SPIN_CAP) { atomicAdd(&bar[XB_TMO], 1u); break; } }
    }
    nloc = mine > 0u ? mine : 1u; nx = cnt > 0u ? cnt : 1u;
}
DEV void xcd_barrier(const XcdBarrier& b) {
    asm volatile("s_waitcnt vmcnt(0)" ::: "memory");
    __syncthreads();
    if (threadIdx.x == 0) {
        unsigned* bar = b.bar;
        __builtin_amdgcn_s_waitcnt(0);
        unsigned nloc = b.st[0], nx = b.st[1];
        if (nloc == 0u) { xcd_barrier_complete(bar, b.x, nloc, nx); b.st[0] = nloc; b.st[1] = nx; }
        const unsigned old = xb_add(&bar[XB_XSUB(b.x)], 1u);
        const unsigned gen = old / nloc;
        if (old + 1u == (gen + 1u) * nloc) {
            __builtin_amdgcn_fence(__ATOMIC_RELEASE, "agent");
            asm volatile("s_waitcnt vmcnt(0)" ::: "memory");
            const unsigned og = xb_add(&bar[XB_TOP], 1u);
            const unsigned tg = og / nx;
            if (og + 1u == (tg + 1u) * nx) xb_add(&bar[XB_TOPGEN], 1u);
            else XB_SPIN(xb_ld(&bar[XB_TOPGEN]) == tg, bar);
            __builtin_amdgcn_fence(__ATOMIC_ACQUIRE, "agent");
            xb_add(&bar[XB_XGEN(b.x)], 1u);
            asm volatile("s_waitcnt vmcnt(0)" ::: "memory");
        } else {
            XB_SPIN(xb_ld(&bar[XB_XGEN(b.x)]) == gen, bar);
            __builtin_amdgcn_fence(__ATOMIC_ACQUIRE, "agent");
            asm volatile("s_waitcnt vmcnt(0)" ::: "memory");
        }
    }
    __syncthreads();
}

constexpr int BM = 256, BK = 64, HALF = 128, HT = HALF * BK;
DEV int lds_byte(int r, int c) {
    int st = (r >> 4) * 2 + (c >> 5), rr = r & 15, cc = c & 31, ob = rr * 64 + cc * 2;
    return st * 1024 + (ob ^ (((ob >> 9) & 1) << 5));
}
DEV void stage_rc(int b, int& R, int& C) {
    int st = b / 1024, sb = b % 1024, swz = sb ^ (((sb >> 9) & 1) << 5);
    R = (st >> 1) * 16 + swz / 64; C = (st & 1) * 32 + (swz % 64) / 2;
}

template <class Epi>
DEV void gemm_tile(const bf16_t* __restrict__ A, int lda, const bf16_t* __restrict__ Bt, int ldb, int K, int brow, int bcol, const Epi& epi) {
    LAS unsigned char* lds = (LAS unsigned char*)smem;
    constexpr int HTB = HT * 2;
    const int tid = tid_fresh(), wid = __builtin_amdgcn_readfirstlane(tid >> 6), lane = tid & 63, wr = wid >> 2, wc = wid & 3, fr = lane & 15, fq = lane >> 4;
    unsigned voffA[2], voffB[2];
#pragma unroll
    for (int i = 0; i < 2; ++i) {
        int R, C; stage_rc(tid * 16 + i * 8192, R, C);
        const int rho = R & 31, Rb = Epi::PERM ? ((R & ~31) + 8 * ((rho & 15) >> 2) + 4 * (rho >> 4) + (rho & 3)) : R;
        voffA[i] = (unsigned)(R * lda + C) * 2u; voffB[i] = (unsigned)(Rb * ldb + C) * 2u;
    }
    const size_t kstep = (size_t)(BK * 2), hstepA = (size_t)HALF * lda * 2, hstepB = (size_t)HALF * ldb * 2;
    const unsigned ldsw = (unsigned)wid * 1024u;
    const int aoff = lds_byte(wr * 64 + fr, fq * 8), boff = lds_byte(wc * 32 + fr, fq * 8);
#define SA(b, h) (((b) * 2 + (h)) * HTB)
#define SB(b, h) ((4 + (b) * 2 + (h)) * HTB)
#define STAGE(bufoff, gbase, voff) do { _Pragma("unroll") for (int _i = 0; _i < 2; ++_i) \
        __builtin_amdgcn_global_load_lds((const unsigned*)((const char*)(gbase) + (voff)[_i]), (LAS unsigned*)(lds + (bufoff) + ldsw + _i * 8192), 16, 0, 0); } while (0)
#define LDA(dst, b, h) do { _Pragma("unroll") for (int m = 0; m < 4; ++m) _Pragma("unroll") for (int k = 0; k < 2; ++k) dst[m][k] = *(const LAS bf16x8*)(lds + SA(b, h) + aoff + m * 2048 + k * 1024); } while (0)
#define LDB(dst, b, h) do { _Pragma("unroll") for (int n = 0; n < 2; ++n) _Pragma("unroll") for (int k = 0; k < 2; ++k) dst[n][k] = *(const LAS bf16x8*)(lds + SB(b, h) + boff + n * 2048 + k * 1024); } while (0)
#define MMA(ai, bj, At, Bt_) do { __builtin_amdgcn_s_setprio(1); _Pragma("unroll") for (int m = 0; m < 4; ++m) _Pragma("unroll") for (int n = 0; n < 2; ++n) _Pragma("unroll") for (int k = 0; k < 2; ++k) \
        acc[ai][bj][m][n] = __builtin_amdgcn_mfma_f32_16x16x32_bf16(Bt_[n][k], At[m][k], acc[ai][bj][m][n], 0, 0, 0); __builtin_amdgcn_s_setprio(0); } while (0)
#define WAIT_V(n) asm volatile("s_waitcnt vmcnt(" #n ")" ::: "memory")
#define WAIT_L(n) asm volatile("s_waitcnt lgkmcnt(" #n ")" ::: "memory")
#define BAR __builtin_amdgcn_s_barrier()
#define SCHED __builtin_amdgcn_sched_barrier(0)
    f32x4 acc[2][2][4][2];
#pragma unroll
    for (int a = 0; a < 2; ++a)
#pragma unroll
        for (int b = 0; b < 2; ++b)
#pragma unroll
            for (int m = 0; m < 4; ++m)
#pragma unroll
                for (int n = 0; n < 2; ++n) acc[a][b][m][n] = (f32x4){0.f, 0.f, 0.f, 0.f};
    bf16x8 At[4][2], B0[2][2], B1[2][2];
    const int nt = K / BK;
    const char* cA = (const char*)A + (size_t)brow * lda * 2; const char* cB = (const char*)Bt + (size_t)bcol * ldb * 2;
    STAGE(SB(0, 0), cB, voffB); STAGE(SA(0, 0), cA, voffA); STAGE(SB(0, 1), cB + hstepB, voffB); STAGE(SA(0, 1), cA + hstepA, voffA);
    if (wr == 1) BAR;
    WAIT_V(4); BAR;
    STAGE(SB(1, 0), cB + kstep, voffB); STAGE(SA(1, 0), cA + kstep, voffA); STAGE(SB(1, 1), cB + hstepB + kstep, voffB);
    WAIT_V(6); BAR;
    for (int t = 0; t < nt - 2; t += 2) {
        const char* a1 = cA + (size_t)(t + 1) * kstep;
        const char* a2 = cA + (size_t)(t + 2) * kstep; const char* b2 = cB + (size_t)(t + 2) * kstep;
        const char* a3 = a2 + kstep; const char* b3 = b2 + kstep;
        LDB(B0, 0, 0); SCHED; LDA(At, 0, 0); STAGE(SA(1, 1), a1 + hstepA, voffA);
        WAIT_L(8); BAR; WAIT_L(0); MMA(0, 0, At, B0); BAR; SCHED;
        LDB(B1, 0, 1); STAGE(SB(0, 0), b2, voffB);
        BAR; WAIT_L(0); MMA(0, 1, At, B1); BAR;
        LDA(At, 0, 1); STAGE(SA(0, 0), a2, voffA);
        BAR; WAIT_L(0); MMA(1, 0, At, B0); BAR; SCHED;
        STAGE(SB(0, 1), b2 + hstepB, voffB);
        WAIT_V(6); BAR; MMA(1, 1, At, B1); BAR;
        LDB(B0, 1, 0); SCHED; LDA(At, 1, 0); STAGE(SA(0, 1), a2 + hstepA, voffA);
        WAIT_L(8); BAR; WAIT_L(0); MMA(0, 0, At, B0); BAR; SCHED;
        LDB(B1, 1, 1); STAGE(SB(1, 0), b3, voffB);
        BAR; WAIT_L(0); MMA(0, 1, At, B1); BAR;
        LDA(At, 1, 1); STAGE(SA(1, 0), a3, voffA);
        BAR; WAIT_L(0); MMA(1, 0, At, B0); BAR; SCHED;
        STAGE(SB(1, 1), b3 + hstepB, voffB);
        WAIT_V(6); BAR; MMA(1, 1, At, B1); BAR;
    }
    { const char* a1 = cA + (size_t)(nt - 1) * kstep;
      LDB(B0, 0, 0); LDA(At, 0, 0); STAGE(SA(1, 1), a1 + hstepA, voffA);
      BAR; WAIT_L(0); MMA(0, 0, At, B0); BAR;
      LDB(B1, 0, 1); BAR; WAIT_L(0); MMA(0, 1, At, B1); BAR;
      LDA(At, 0, 1); WAIT_V(4); BAR; WAIT_L(0); MMA(1, 0, At, B0); MMA(1, 1, At, B1); BAR; }
    { LDB(B0, 1, 0); LDA(At, 1, 0); WAIT_V(2); BAR; WAIT_L(0); MMA(0, 0, At, B0); BAR;
      LDB(B1, 1, 1); WAIT_V(0); BAR; WAIT_L(0); MMA(0, 1, At, B1); BAR;
      LDA(At, 1, 1); BAR; WAIT_L(0); MMA(1, 0, At, B0); MMA(1, 1, At, B1); BAR; }
    if (wr == 0) BAR;
    if constexpr (Epi::PERM) epi_big8(epi, acc, brow, bcol, wr, wc, fr, fq); else epi_big(epi, acc, brow, bcol, wr, wc, fr, fq);
    __syncthreads();
#undef SA
#undef SB
#undef STAGE
#undef LDA
#undef LDB
#undef MMA
}

DEV void tile_of(int L, int nM, int nN, int& pm, int& pn) {
    const int nwg = nM * nN; int wgid = L;
    { const int q = nwg / 8, r = nwg % 8, xcd = wgid % 8, off = wgid / 8; wgid = (xcd < r ? xcd * (q + 1) : r * (q + 1) + (xcd - r) * q) + off; }
    const int nig = 8 * nN, gid = wgid / nig, fm = gid * 8, gsz = (nM - fm) < 8 ? (nM - fm) : 8;
    pm = fm + ((wgid % nig) % gsz); pn = (wgid % nig) / gsz;
}

struct EpiBf16 {
    static constexpr bool PERM = true;
    bf16_t* dst; int ld; const float* rstd;
    DEV float rowscale(int row) const { return rstd ? rstd[row] : 1.f; }
    DEV void apply8(int row, int col8, const f32x4& v0, const f32x4& v1, float rs) const {
        u32x4 o; o.x = pk2(v0[0] * rs, v0[1] * rs); o.y = pk2(v0[2] * rs, v0[3] * rs); o.z = pk2(v1[0] * rs, v1[1] * rs); o.w = pk2(v1[2] * rs, v1[3] * rs);
        *(u32x4*)(dst + (long)row * ld + col8) = o;
    }
};
struct EpiGlu {
    static constexpr bool PERM = false;
    bf16_t* proj; const float* glu_b;
    struct Ld { u32x2 g, z; f32x4 b; };
    DEV void load(int row, int col, Ld& d) const {
        d.g = *(const u32x2*)(proj + (long)row * PLD + C_UB + col); d.z = *(const u32x2*)(proj + (long)row * PLD + C_ZB + col); d.b = *(const f32x4*)(glu_b + col);
    }
    DEV void apply(int row, int col, const f32x4& v, const Ld& d, float& ss, float rowv) const {
        const float y0 = bflo(d.g.x) * sigmf(v[0] + d.b[0]) * siluf(bflo(d.z.x)), y1 = bfhi(d.g.x) * sigmf(v[1] + d.b[1]) * siluf(bfhi(d.z.x));
        const float y2 = bflo(d.g.y) * sigmf(v[2] + d.b[2]) * siluf(bflo(d.z.y)), y3 = bfhi(d.g.y) * sigmf(v[3] + d.b[3]) * siluf(bfhi(d.z.y));
        u32x2 o; o.x = pk2(y0, y1); o.y = pk2(y2, y3);
        *(u32x2*)(proj + (long)row * PLD + C_ZB + col) = o;
    }
    DEV float rowload(int row) const { return 0.f; }
    DEV void rowdone(int row, float ss, int fq, int slot) const {}
    DEV void rowput(int row, float tot, int slot) const {}
};
struct EpiOut {
    static constexpr bool PERM = false;
    const float* xp; const float* xs; bf16_t* h1b; float* rss;
    struct Ld { f32x4 x; };
    DEV void load(int row, int col, Ld& d) const {
        const float* xrow = row < NPROMPT ? xp + (long)row * 1024 : xs + (long)(row - NPROMPT) * 1024;
        d.x = *(const f32x4*)(xrow + col);
    }
    DEV void apply(int row, int col, const f32x4& a, const Ld& d, float& ss, float rowv) const {
        const f32x4 v = a + d.x;
        u32x2 o; o.x = pk2(v[0], v[1]); o.y = pk2(v[2], v[3]);
        *(u32x2*)(h1b + (long)row * 1024 + col) = o;
        const float r0 = bflo(o.x), r1 = bfhi(o.x), r2 = bflo(o.y), r3 = bfhi(o.y);
        ss += r0 * r0 + r1 * r1 + r2 * r2 + r3 * r3;
    }
    DEV float rowload(int row) const { return 0.f; }
    DEV void rowdone(int row, float ss, int fq, int slot) const {
        ss += __shfl_xor(ss, 16); ss += __shfl_xor(ss, 32);
        if (fq == 0) rss[(long)row * 16 + slot] = ss;
    }
    DEV void rowput(int row, float tot, int slot) const { rss[(long)row * 16 + slot] = tot; rss[(long)row * 16 + slot + 1] = 0.f; }
};
struct EpiPle {
    static constexpr bool PERM = false;
    float* out; const bf16_t* h1b; const bf16_t* pp; const float* rss1; float* rss2;
    struct Ld { u32x2 h; u32x2 pv; };
    DEV void load(int row, int col, Ld& d) const {
        d.h = *(const u32x2*)(h1b + (long)row * 1024 + col); d.pv = *(const u32x2*)(pp + (long)row * 1024 + col);
    }
    DEV void apply(int row, int col, const f32x4& a, const Ld& d, float& ss, float rowv) const {
        const float rstd = rsqrtf(rowv * (1.f / 1024.f) + EPS);
        f32x4 h;
        h[0] = bflo(d.h.x) + bflo(d.pv.x) * sigmf(a[0] * rstd); h[1] = bfhi(d.h.x) + bfhi(d.pv.x) * sigmf(a[1] * rstd);
        h[2] = bflo(d.h.y) + bflo(d.pv.y) * sigmf(a[2] * rstd); h[3] = bfhi(d.h.y) + bfhi(d.pv.y) * sigmf(a[3] * rstd);
        *(f32x4*)(out + (long)row * 1024 + col) = h;
        ss += h[0] * h[0] + h[1] * h[1] + h[2] * h[2] + h[3] * h[3];
    }
    DEV float rowload(int row) const {
        const f32x4 a = *(const f32x4*)(rss1 + (long)row * 16), b = *(const f32x4*)(rss1 + (long)row * 16 + 4), c = *(const f32x4*)(rss1 + (long)row * 16 + 8), d = *(const f32x4*)(rss1 + (long)row * 16 + 12);
        return (((a[0] + a[1]) + (a[2] + a[3])) + ((b[0] + b[1]) + (b[2] + b[3]))) + (((c[0] + c[1]) + (c[2] + c[3])) + ((d[0] + d[1]) + (d[2] + d[3])));
    }
    DEV void rowdone(int row, float ss, int fq, int slot) const {
        ss += __shfl_xor(ss, 16); ss += __shfl_xor(ss, 32);
        if (fq == 0) rss2[(long)row * 16 + slot] = ss;
    }
    DEV void rowput(int row, float tot, int slot) const { rss2[(long)row * 16 + slot] = tot; rss2[(long)row * 16 + slot + 1] = 0.f; }
};
template <class Epi>
DEV void epi_big8(const Epi& E, const f32x4 (&acc)[2][2][4][2], int brow, int bcol, int wr, int wc, int fr, int fq) {
    float rs[2][4];
#pragma unroll
    for (int ai = 0; ai < 2; ++ai)
#pragma unroll
        for (int m = 0; m < 4; ++m) rs[ai][m] = E.rowscale(brow + ai * 128 + wr * 64 + m * 16 + fr);
#pragma unroll
    for (int ai = 0; ai < 2; ++ai)
#pragma unroll
        for (int m = 0; m < 4; ++m)
#pragma unroll
            for (int bj = 0; bj < 2; ++bj)
                E.apply8(brow + ai * 128 + wr * 64 + m * 16 + fr, bcol + bj * 128 + wc * 32 + 8 * fq, acc[ai][bj][m][0], acc[ai][bj][m][1], rs[ai][m]);
}
template <class Epi>
DEV void epi_big(const Epi& E, const f32x4 (&acc)[2][2][4][2], int brow, int bcol, int wr, int wc, int fr, int fq) {
#pragma unroll
    for (int ai = 0; ai < 2; ++ai)
#pragma unroll
        for (int mp = 0; mp < 2; ++mp) {
            typename Epi::Ld d[2][4]; float rv[2];
#pragma unroll
            for (int mm = 0; mm < 2; ++mm) {
                rv[mm] = E.rowload(brow + ai * 128 + wr * 64 + (mp * 2 + mm) * 16 + fr);
#pragma unroll
                for (int j = 0; j < 4; ++j)
                    E.load(brow + ai * 128 + wr * 64 + (mp * 2 + mm) * 16 + fr, bcol + (j >> 1) * 128 + wc * 32 + (j & 1) * 16 + fq * 4, d[mm][j]);
            }
#pragma unroll
            for (int mm = 0; mm < 2; ++mm) {
                const int row = brow + ai * 128 + wr * 64 + (mp * 2 + mm) * 16 + fr; float ss = 0.f;
#pragma unroll
                for (int j = 0; j < 4; ++j)
                    E.apply(row, bcol + (j >> 1) * 128 + wc * 32 + (j & 1) * 16 + fq * 4, acc[ai][j >> 1][mp * 2 + mm][j & 1], d[mm][j], ss, rv[mm]);
                E.rowdone(row, ss, fq, ((bcol >> 8) & 3) * 4 + wc);
            }
        }
}
template <class Epi>
DEV void gemm_small(const bf16_t* __restrict__ A, int lda, const bf16_t* __restrict__ Bt, int ldb, int K, int row0, int col0, const Epi& E) {
    const int tid = tid_fresh(), w = tid >> 6, lane = tid & 63, fr = lane & 15, fq = lane >> 4;
    const int kw = K >> 3;
    const bf16_t* ap = A + (long)(row0 + fr) * lda + w * kw + fq * 8;
    const bf16_t* bp = Bt + (long)(col0 + fr) * ldb + w * kw + fq * 8;
    f32x4 pacc[8];
#pragma unroll
    for (int n = 0; n < 8; ++n) pacc[n] = (f32x4){0.f, 0.f, 0.f, 0.f};
    for (int k0 = 0; k0 < kw; k0 += 128) {
        bf16x8 af[4], bf[4][8];
#pragma unroll
        for (int ks = 0; ks < 4; ++ks) {
            af[ks] = *(const bf16x8*)(ap + k0 + ks * 32);
#pragma unroll
            for (int n = 0; n < 8; ++n) bf[ks][n] = *(const bf16x8*)(bp + (long)n * 16 * ldb + k0 + ks * 32);
        }
#pragma unroll
        for (int ks = 0; ks < 4; ++ks)
#pragma unroll
            for (int n = 0; n < 8; ++n) pacc[n] = mfma16(bf[ks][n], af[ks], pacc[n]);
    }
    float* redk = (float*)smem;
    __syncthreads();
#pragma unroll
    for (int n = 0; n < 8; ++n) *(f32x4*)(redk + ((w * 8 + n) * 64 + lane) * 4) = pacc[n];
    __syncthreads();
    f32x4 acc = (f32x4){0.f, 0.f, 0.f, 0.f};
#pragma unroll
    for (int i = 0; i < 8; ++i) acc += *(const f32x4*)(redk + ((i * 8 + w) * 64 + lane) * 4);
    const int row = row0 + fr, col = col0 + w * 16 + fq * 4;
    typename Epi::Ld d;
    E.load(row, col, d);
    const float rv = E.rowload(row);
    float ss = 0.f;
    E.apply(row, col, acc, d, ss, rv);
    ss += __shfl_xor(ss, 16); ss += __shfl_xor(ss, 32);
    float* red = (float*)smem;
    __syncthreads();
    if (fq == 0) red[w * 16 + fr] = ss;
    __syncthreads();
    if (tid < 16) {
        float t = 0.f;
#pragma unroll
        for (int i = 0; i < 8; ++i) t += red[i * 16 + tid];
        E.rowput(row0 + tid, t, (col0 >> 7) * 2);
    }
    __syncthreads();
}

DEV void transpose_item(const float* __restrict__ src, int ldsrc, int k0, int c0, bf16_t* __restrict__ dst, int lddst, int n0,
                        const float* __restrict__ kscale, float* scr, int lane) {
    const int cl = lane & 31, kh = lane >> 5;
    float v[32];
#pragma unroll
    for (int i = 0; i < 32; ++i) v[i] = src[(long)(k0 + 2 * i + kh) * ldsrc + c0 + cl];
    if (kscale) {
#pragma unroll
        for (int i = 0; i < 32; ++i) v[i] *= kscale[k0 + 2 * i + kh];
    }
#pragma unroll
    for (int i = 0; i < 32; ++i) scr[(2 * i + kh) * 33 + cl] = v[i];
    lds_fence();
    const int c = lane & 7;
#pragma unroll
    for (int j = 0; j < 4; ++j) {
        const int n = (lane >> 3) + 8 * j; const float* sp = scr + (8 * c) * 33 + n;
        u32x4 o; o.x = pk2(sp[0 * 33], sp[1 * 33]); o.y = pk2(sp[2 * 33], sp[3 * 33]); o.z = pk2(sp[4 * 33], sp[5 * 33]); o.w = pk2(sp[6 * 33], sp[7 * 33]);
        *(u32x4*)(dst + (long)(n0 + n) * lddst + k0 + 8 * c) = o;
    }
    lds_fence();
}

DEV void phase0(const Params& P) {
    const int tid = tid_fresh(), lane = tid & 63, wave = tid >> 6, G = gridDim.x, bid = blockIdx.x;
    char* ws = P.ws;
    float* tile = (float*)smem;
    {
        float* scr = (float*)smem + wave * (64 * 33);
        constexpr int I_IN = 144 * 16, I_OUT = 32 * 32, I_GLU = 32 * 16, I_GATE = 32 * 16, I_PPW = 32 * 4;
        constexpr int I_ALL = I_IN + I_OUT + I_GLU + I_GATE + I_PPW;
        for (int it = bid * 8 + wave; it < I_ALL; it += G * 8) {
            int r = it;
            if (r < I_IN) {
                const int nb = r >> 4, kb = r & 15, n0 = nb * 32;
                int c0;
                if (n0 < 1024) c0 = n0; else if (n0 < 2048) c0 = 2576 + (n0 - 1024); else if (n0 < 3584) c0 = 1024 + (n0 - 2048); else c0 = 3600 + (n0 - 3584);
                transpose_item(P.in[I_WIN], 4624, kb * 64, c0, (bf16_t*)(ws + W_WTIN), 1024, n0, P.in[I_GIN], scr, lane); continue;
            }
            r -= I_IN;
            if (r < I_OUT) { const int nb = r >> 5, kb = r & 31; transpose_item(P.in[I_WOUT], 1024, kb * 64, nb * 32, (bf16_t*)(ws + W_WTOUT), 2048, nb * 32, nullptr, scr, lane); continue; }
            r -= I_OUT;
            if (r < I_GLU) { const int nb = r >> 4, kb = r & 15; transpose_item(P.in[I_GLUW], 1024, kb * 64, nb * 32, (bf16_t*)(ws + W_WTGLU), 1024, nb * 32, nullptr, scr, lane); continue; }
            r -= I_GLU;
            if (r < I_GATE) { const int nb = r >> 4, kb = r & 15; transpose_item(P.in[I_WGATE], 1024, kb * 64, nb * 32, (bf16_t*)(ws + W_WTGATE), 1024, nb * 32, P.in[I_GPLE], scr, lane); continue; }
            r -= I_GATE;
            { const int nb = r >> 2, kb = r & 3; transpose_item(P.in[I_WPP], 1024, kb * 64, nb * 32, (bf16_t*)(ws + W_WTPP), 256, nb * 32, nullptr, scr, lane); }
        }
        __syncthreads();
    }
    bf16_t* wdt = (bf16_t*)smem;
    float* psum = (float*)(smem + 16 * 1032 * 2);
    float* pdt = psum + 128;
    {
        float wv[32];
#pragma unroll
        for (int i = 0; i < 32; ++i) { const int idx = tid + i * 512, k = idx >> 4, e = idx & 15; wv[i] = P.in[I_WIN][(long)k * 4624 + 2560 + e] * P.in[I_GIN][k]; }
#pragma unroll
        for (int i = 0; i < 32; ++i) { const int idx = tid + i * 512, k = idx >> 4, e = idx & 15; wdt[e * 1032 + k] = (bf16_t)(pk2(wv[i], 0.f) & 0xffffu); }
    }
    __syncthreads();
    {
        const int fr = lane & 15, fq = lane >> 4;
        bf16x8 wf[4];
#pragma unroll
        for (int j = 0; j < 4; ++j) wf[j] = *(const bf16x8*)(wdt + fr * 1032 + (wave * 4 + j) * 32 + fq * 8);
        bf16_t* xb = (bf16_t*)(ws + W_NB);
        float* dtr = (float*)(ws + W_DTR);
        float* rstdp = (float*)(ws + W_RSTD);
        f32x4 xan[4], xcn[4];
        if (bid < NTOK / 16) {
            const int row = bid * 16 + fr;
            const float* xr = (row < NPROMPT ? P.in[I_XP] + (long)row * 1024 : P.in[I_XS] + (long)(row - NPROMPT) * 1024) + wave * 128 + fq * 8;
#pragma unroll
            for (int j = 0; j < 4; ++j) { xan[j] = *(const f32x4*)(xr + j * 32); xcn[j] = *(const f32x4*)(xr + j * 32 + 4); }
        }
        for (int task = bid; task < NTOK / 16; task += G) {
            const int row = task * 16 + fr;
            f32x4 xa[4], xc[4];
#pragma unroll
            for (int j = 0; j < 4; ++j) { xa[j] = xan[j]; xc[j] = xcn[j]; }
            if (task + G < NTOK / 16) {
                const int rown = (task + G) * 16 + fr;
                const float* xr = (rown < NPROMPT ? P.in[I_XP] + (long)rown * 1024 : P.in[I_XS] + (long)(rown - NPROMPT) * 1024) + wave * 128 + fq * 8;
#pragma unroll
                for (int j = 0; j < 4; ++j) { xan[j] = *(const f32x4*)(xr + j * 32); xcn[j] = *(const f32x4*)(xr + j * 32 + 4); }
            }
            f32x4 acc = {0.f, 0.f, 0.f, 0.f}; float ss = 0.f;
#pragma unroll
            for (int j = 0; j < 4; ++j) {
                ss += xa[j][0] * xa[j][0] + xa[j][1] * xa[j][1] + xa[j][2] * xa[j][2] + xa[j][3] * xa[j][3] + xc[j][0] * xc[j][0] + xc[j][1] * xc[j][1] + xc[j][2] * xc[j][2] + xc[j][3] * xc[j][3];
                u32x4 q; q.x = pk2(xa[j][0], xa[j][1]); q.y = pk2(xa[j][2], xa[j][3]); q.z = pk2(xc[j][0], xc[j][1]); q.w = pk2(xc[j][2], xc[j][3]);
                *(u32x4*)(xb + (long)row * 1024 + wave * 128 + j * 32 + fq * 8) = q;
                acc = mfma16(wf[j], __builtin_bit_cast(bf16x8, q), acc);
            }
            ss += __shfl_xor(ss, 16); ss += __shfl_xor(ss, 32);
            if (fq == 0) psum[wave * 16 + fr] = ss;
            *(f32x4*)(pdt + wave * 256 + fr * 16 + fq * 4) = acc;
            __syncthreads();
            if (tid < 256) {
                const int t = tid >> 4, e = tid & 15;
                float tot = 0.f, d = 0.f;
#pragma unroll
                for (int w8 = 0; w8 < 8; ++w8) { tot += psum[w8 * 16 + t]; d += pdt[w8 * 256 + t * 16 + e]; }
                const float rstd = rsqrtf(tot * (1.f / 1024.f) + EPS);
                dtr[(long)(task * 16 + t) * 16 + e] = d * rstd;
                if (e == 0) rstdp[task * 16 + t] = rstd;
            }
            __syncthreads();
        }
    }
    bf16_t* pb = (bf16_t*)(ws + W_PB);
    for (int idx = bid * 512 + tid; idx < NTOK * 64; idx += G * 512) {
        const int row = idx >> 6, c4 = (idx & 63) * 4;
        const float* src = row < NPROMPT ? P.in[I_PP] + (long)row * 256 : P.in[I_PS] + (long)(row - NPROMPT) * 256;
        const f32x4 v = *(const f32x4*)(src + c4);
        u32x2 o; o.x = pk2(v[0], v[1]); o.y = pk2(v[2], v[3]);
        *(u32x2*)(pb + (long)row * 256 + c4) = o;
    }
    __syncthreads();
}

DEV void conv_load7(const bf16_t* __restrict__ pcol, long row0, int t0, u32x4 (&raw)[7]) {
#pragma unroll
    for (int i = 0; i < 7; ++i) {
        const int t = t0 - 3 + i;
        raw[i] = (u32x4){0u, 0u, 0u, 0u};
        if (t >= 0) raw[i] = *(const u32x4*)(pcol + (row0 - 3 + i) * PLD);
    }
}
DEV void conv_compute(const u32x4 (&rawp)[7], const float* __restrict__ cw, const float* __restrict__ cb, float (&o)[4][8]) {
    float raw[7][8];
#pragma unroll
    for (int i = 0; i < 7; ++i) {
        const u32x4 u = rawp[i];
        raw[i][0] = bflo(u.x); raw[i][1] = bfhi(u.x); raw[i][2] = bflo(u.y); raw[i][3] = bfhi(u.y);
        raw[i][4] = bflo(u.z); raw[i][5] = bfhi(u.z); raw[i][6] = bflo(u.w); raw[i][7] = bfhi(u.w);
    }
    float w[4][8], bias[8];
#pragma unroll
    for (int k = 0; k < 4; ++k) {
        const f32x4 a = *(const f32x4*)(cw + k * 1536), b = *(const f32x4*)(cw + k * 1536 + 4);
        w[k][0] = a[0]; w[k][1] = a[1]; w[k][2] = a[2]; w[k][3] = a[3]; w[k][4] = b[0]; w[k][5] = b[1]; w[k][6] = b[2]; w[k][7] = b[3];
    }
    { const f32x4 a = *(const f32x4*)(cb), b = *(const f32x4*)(cb + 4);
      bias[0] = a[0]; bias[1] = a[1]; bias[2] = a[2]; bias[3] = a[3]; bias[4] = b[0]; bias[5] = b[1]; bias[6] = b[2]; bias[7] = b[3]; }
#pragma unroll
    for (int j = 0; j < 4; ++j)
#pragma unroll
        for (int c = 0; c < 8; ++c) {
            float a = bias[c];
#pragma unroll
            for (int k = 0; k < 4; ++k) a += w[k][c] * raw[j + k][c];
            o[j][c] = siluf(a);
        }
}
DEV void conv_compute_lds(const u32x4 (&rawp)[7], const float* cwl, float (&o)[4][8]) {
    float raw[7][8];
#pragma unroll
    for (int i = 0; i < 7; ++i) {
        const u32x4 u = rawp[i];
        raw[i][0] = bflo(u.x); raw[i][1] = bfhi(u.x); raw[i][2] = bflo(u.y); raw[i][3] = bfhi(u.y);
        raw[i][4] = bflo(u.z); raw[i][5] = bfhi(u.z); raw[i][6] = bflo(u.w); raw[i][7] = bfhi(u.w);
    }
    float w[5][8];
#pragma unroll
    for (int k = 0; k < 5; ++k) {
        const f32x4 a = *(const f32x4*)(cwl + k * 512), b = *(const f32x4*)(cwl + k * 512 + 4);
        w[k][0] = a[0]; w[k][1] = a[1]; w[k][2] = a[2]; w[k][3] = a[3]; w[k][4] = b[0]; w[k][5] = b[1]; w[k][6] = b[2]; w[k][7] = b[3];
    }
#pragma unroll
    for (int j = 0; j < 4; ++j)
#pragma unroll
        for (int c = 0; c < 8; ++c) {
            float a = w[4][c];
#pragma unroll
            for (int k = 0; k < 4; ++k) a += w[k][c] * raw[j + k][c];
            o[j][c] = siluf(a);
        }
}
DEV void conv4x8(const bf16_t* __restrict__ pcol, long row0, int t0, const float* __restrict__ hist, const float* __restrict__ cw, const float* __restrict__ cb, float (&o)[4][8]) {
    float raw[7][8];
#pragma unroll
    for (int i = 0; i < 7; ++i) {
        const int t = t0 - 3 + i;
        if (t >= 0) {
            const u32x4 u = *(const u32x4*)(pcol + (row0 - 3 + i) * PLD);
            raw[i][0] = bflo(u.x); raw[i][1] = bfhi(u.x); raw[i][2] = bflo(u.y); raw[i][3] = bfhi(u.y);
            raw[i][4] = bflo(u.z); raw[i][5] = bfhi(u.z); raw[i][6] = bflo(u.w); raw[i][7] = bfhi(u.w);
        } else if (hist) {
            const f32x4 a = *(const f32x4*)(hist + (long)(t + 3) * 1536), b = *(const f32x4*)(hist + (long)(t + 3) * 1536 + 4);
            raw[i][0] = a[0]; raw[i][1] = a[1]; raw[i][2] = a[2]; raw[i][3] = a[3]; raw[i][4] = b[0]; raw[i][5] = b[1]; raw[i][6] = b[2]; raw[i][7] = b[3];
        } else {
#pragma unroll
            for (int c = 0; c < 8; ++c) raw[i][c] = 0.f;
        }
    }
    float w[4][8], bias[8];
#pragma unroll
    for (int k = 0; k < 4; ++k) {
        const f32x4 a = *(const f32x4*)(cw + k * 1536), b = *(const f32x4*)(cw + k * 1536 + 4);
        w[k][0] = a[0]; w[k][1] = a[1]; w[k][2] = a[2]; w[k][3] = a[3]; w[k][4] = b[0]; w[k][5] = b[1]; w[k][6] = b[2]; w[k][7] = b[3];
    }
    { const f32x4 a = *(const f32x4*)(cb), b = *(const f32x4*)(cb + 4);
      bias[0] = a[0]; bias[1] = a[1]; bias[2] = a[2]; bias[3] = a[3]; bias[4] = b[0]; bias[5] = b[1]; bias[6] = b[2]; bias[7] = b[3]; }
#pragma unroll
    for (int j = 0; j < 4; ++j)
#pragma unroll
        for (int c = 0; c < 8; ++c) {
            float a = bias[c];
#pragma unroll
            for (int k = 0; k < 4; ++k) a += w[k][c] * raw[j + k][c];
            o[j][c] = siluf(a);
        }
}

constexpr int PIT = 136;
constexpr int R1_OFF = 0, R2_OFF = 128 * PIT * 2, R3_OFF = 2 * 128 * PIT * 2, R4_OFF = 3 * 128 * PIT * 2;

DEV void ssd_s1_item(const Params& P, int item) {
    const int tid = tid_fresh(), lane = tid & 63, w = tid >> 6, fr = lane & 15, fq = lane >> 4;
    const int b = item >> 5, c = (item >> 1) & 15, g = item & 1;
    char* ws = P.ws;
    const bf16_t* proj = (const bf16_t*)(ws + W_PROJ);
    const long rowc = (long)b * 2048 + c * 128;
    bf16_t* R1 = (bf16_t*)(smem + R1_OFF); bf16_t* R2 = (bf16_t*)(smem + R2_OFF); bf16_t* R3 = (bf16_t*)(smem + R3_OFF);
    float* acs = (float*)(smem + R4_OFF);
    float* dtv = acs + 1024;
    {
        const int h = g * 8 + w;
        const float bias = P.in[I_DTB][h], A = -__expf(P.in[I_ALOG][h]);
        const float* dtr = (const float*)(ws + W_DTR);
        float x0 = dtr[(rowc + 2 * lane) * 16 + h] + bias, x1 = dtr[(rowc + 2 * lane + 1) * 16 + h] + bias;
        float d0 = x0 > 20.f ? x0 : log1pf(__expf(x0)), d1 = x1 > 20.f ? x1 : log1pf(__expf(x1));
        float a0 = d0 * A, a1 = a0 + d1 * A;
        float run = a1;
#pragma unroll
        for (int o = 1; o < 64; o <<= 1) { float t = __shfl_up(run, o); if (lane >= o) run += t; }
        const float excl = run - a1;
        a0 += excl; a1 += excl;
        acs[w * 128 + 2 * lane] = a0; acs[w * 128 + 2 * lane + 1] = a1;
        dtv[w * 128 + 2 * lane] = d0; dtv[w * 128 + 2 * lane + 1] = d1;
        float* acsg = (float*)(ws + W_ACS) + (((long)b * 16 + c) * 16 + h) * 128;
        acsg[2 * lane] = a0; acsg[2 * lane + 1] = a1;
        if (lane == 63) ((float*)(ws + W_CDEC))[(b * 16 + c) * 16 + h] = __expf(a1);
    }
    float* cwl = (float*)(smem + R4_OFF + 8192);
    for (int u = tid; u < 5 * 512; u += 512) { const int k = u >> 9, ch = u & 511; cwl[u] = k < 4 ? P.in[I_CONVW][k * 1536 + g * 512 + ch] : P.in[I_CONVB][g * 512 + ch]; }
    {
        const int nblk = tid & 15, lq = tid >> 4, l0 = lq * 4;
#pragma unroll
        for (int j = 0; j < 2; ++j) {
            const int ch0 = 1024 + j * 256 + g * 128 + nblk * 8;
            float o[4][8];
            conv4x8(proj + C_XBC + ch0, rowc + l0, c * 128 + l0, nullptr, P.in[I_CONVW] + ch0, P.in[I_CONVB] + ch0, o);
            bf16_t* dst = j == 0 ? R2 : R1;
#pragma unroll
            for (int r = 0; r < 4; ++r) {
                u32x4 q; q.x = pk2(o[r][0], o[r][1]); q.y = pk2(o[r][2], o[r][3]); q.z = pk2(o[r][4], o[r][5]); q.w = pk2(o[r][6], o[r][7]);
                *(u32x4*)(dst + (l0 + r) * PIT + nblk * 8) = q;
            }
            if (j == 0) {
#pragma unroll
                for (int i = 0; i < 8; ++i) {
                    u32x2 q; q.x = pk2(o[0][i], o[1][i]); q.y = pk2(o[2][i], o[3][i]);
                    *(u32x2*)(R3 + (nblk * 8 + i) * PIT + l0) = q;
                }
            }
        }
    }
    __syncthreads();
    const int wr = w >> 1, wc = w & 1;
    f32x4 cbm[2][4];
#pragma unroll
    for (int m = 0; m < 2; ++m)
#pragma unroll
        for (int n = 0; n < 4; ++n) cbm[m][n] = (f32x4){0.f, 0.f, 0.f, 0.f};
#pragma unroll
    for (int ks = 0; ks < 4; ++ks) {
        bf16x8 af[2], bfm[4];
#pragma unroll
        for (int m = 0; m < 2; ++m) af[m] = *(const bf16x8*)(R1 + (wr * 32 + m * 16 + fr) * PIT + ks * 32 + fq * 8);
#pragma unroll
        for (int n = 0; n < 4; ++n) bfm[n] = *(const bf16x8*)(R2 + (wc * 64 + n * 16 + fr) * PIT + ks * 32 + fq * 8);
#pragma unroll
        for (int m = 0; m < 2; ++m)
#pragma unroll
            for (int n = 0; n < 4; ++n) cbm[m][n] = mfma16(bfm[n], af[m], cbm[m][n]);
    }
    __syncthreads();
    bf16_t* XT = R2; bf16_t* XW = R2 + 64 * PIT;
    bf16_t* ydg = (bf16_t*)(ws + W_NB);
    float* states = P.out;
    const int wp = w >> 2, wn = w & 3;
    u32x4 rawn[7];
    if (tid < 256) conv_load7(proj + C_XBC + (g * 8) * 64 + (tid & 7) * 8, rowc + (tid >> 3) * 4, c * 128 + (tid >> 3) * 4, rawn);
    for (int e = 0; e < 8; ++e) {
        const int h = g * 8 + e;
        const float dskip = P.in[I_SSDD][h];
        if (tid < 256) {
            const int pblk = tid & 7, lq = tid >> 3, l0 = lq * 4, ch0 = h * 64 + pblk * 8;
            float o[4][8];
            conv_compute_lds(rawn, cwl + e * 64 + pblk * 8, o);
            if (e < 7) conv_load7(proj + C_XBC + ch0 + 64, rowc + l0, c * 128 + l0, rawn);
            const float alast = acs[e * 128 + 127];
            float we[4];
#pragma unroll
            for (int r = 0; r < 4; ++r) we[r] = __expf(alast - acs[e * 128 + l0 + r]) * dtv[e * 128 + l0 + r];
#pragma unroll
            for (int i = 0; i < 8; ++i) {
                u32x2 q; q.x = pk2(o[0][i], o[1][i]); q.y = pk2(o[2][i], o[3][i]);
                *(u32x2*)(XT + (pblk * 8 + i) * PIT + l0) = q;
                u32x2 q2; q2.x = pk2(o[0][i] * we[0], o[1][i] * we[1]); q2.y = pk2(o[2][i] * we[2], o[3][i] * we[3]);
                *(u32x2*)(XW + (pblk * 8 + i) * PIT + l0) = q2;
            }
        }
#pragma unroll
        for (int m = 0; m < 2; ++m) {
            const int l = wr * 32 + m * 16 + fr; const float al = acs[e * 128 + l];
#pragma unroll
            for (int n = 0; n < 4; ++n) {
                const int s0 = wc * 64 + n * 16 + fq * 4;
                const f32x4 as = *(const f32x4*)(acs + e * 128 + s0), ds = *(const f32x4*)(dtv + e * 128 + s0);
                float v[4];
#pragma unroll
                for (int r = 0; r < 4; ++r) { const float t = cbm[m][n][r] * __expf(al - as[r]) * ds[r]; v[r] = (s0 + r <= l) ? t : 0.f; }
                u32x2 q; q.x = pk2(v[0], v[1]); q.y = pk2(v[2], v[3]);
                *(u32x2*)(R1 + l * PIT + s0) = q;
            }
        }
        __syncthreads();
        {
            f32x4 yd[2][2];
#pragma unroll
            for (int m = 0; m < 2; ++m)
#pragma unroll
                for (int n = 0; n < 2; ++n) yd[m][n] = (f32x4){0.f, 0.f, 0.f, 0.f};
            {
                bf16x8 af[4][2], bfm[4][2];
#pragma unroll
                for (int ks = 0; ks < 4; ++ks) {
#pragma unroll
                    for (int m = 0; m < 2; ++m) af[ks][m] = *(const bf16x8*)(R1 + (wr * 32 + m * 16 + fr) * PIT + ks * 32 + fq * 8);
#pragma unroll
                    for (int n = 0; n < 2; ++n) bfm[ks][n] = *(const bf16x8*)(XT + (wc * 32 + n * 16 + fr) * PIT + ks * 32 + fq * 8);
                }
                __builtin_amdgcn_sched_barrier(0);
#pragma unroll
                for (int ks = 0; ks < 4; ++ks)
                    if (ks <= wr) {
#pragma unroll
                        for (int m = 0; m < 2; ++m)
#pragma unroll
                            for (int n = 0; n < 2; ++n) yd[m][n] = mfma16(bfm[ks][n], af[ks][m], yd[m][n]);
                    }
            }
#pragma unroll
            for (int m = 0; m < 2; ++m)
#pragma unroll
                for (int n = 0; n < 2; ++n) {
                    const int l = wr * 32 + m * 16 + fr, p0 = wc * 32 + n * 16 + fq * 4;
                    const float x0 = __uint_as_float(((unsigned)XT[(p0 + 0) * PIT + l]) << 16), x1 = __uint_as_float(((unsigned)XT[(p0 + 1) * PIT + l]) << 16);
                    const float x2 = __uint_as_float(((unsigned)XT[(p0 + 2) * PIT + l]) << 16), x3 = __uint_as_float(((unsigned)XT[(p0 + 3) * PIT + l]) << 16);
                    u32x2 q; q.x = pk2(yd[m][n][0] + dskip * x0, yd[m][n][1] + dskip * x1); q.y = pk2(yd[m][n][2] + dskip * x2, yd[m][n][3] + dskip * x3);
                    *(u32x2*)(ydg + (rowc + l) * 1024 + h * 64 + p0) = q;
                }
        }
        {
            f32x4 st[2][2];
#pragma unroll
            for (int m = 0; m < 2; ++m)
#pragma unroll
                for (int n = 0; n < 2; ++n) st[m][n] = (f32x4){0.f, 0.f, 0.f, 0.f};
            {
                bf16x8 af[4][2], bfm[4][2];
#pragma unroll
                for (int ks = 0; ks < 4; ++ks) {
#pragma unroll
                    for (int m = 0; m < 2; ++m) af[ks][m] = *(const bf16x8*)(XW + (wp * 32 + m * 16 + fr) * PIT + ks * 32 + fq * 8);
#pragma unroll
                    for (int n = 0; n < 2; ++n) bfm[ks][n] = *(const bf16x8*)(R3 + (wn * 32 + n * 16 + fr) * PIT + ks * 32 + fq * 8);
                }
                __builtin_amdgcn_sched_barrier(0);
#pragma unroll
                for (int ks = 0; ks < 4; ++ks)
#pragma unroll
                    for (int m = 0; m < 2; ++m)
#pragma unroll
                        for (int n = 0; n < 2; ++n) st[m][n] = mfma16(bfm[ks][n], af[ks][m], st[m][n]);
            }
            float* sp = states + (((long)b * 16 + c) * 16 + h) * 8192;
#pragma unroll
            for (int m = 0; m < 2; ++m)
#pragma unroll
                for (int n = 0; n < 2; ++n) {
                    const int p = wp * 32 + m * 16 + fr, n0 = wn * 32 + n * 16 + fq * 4;
                    *(f32x4*)(sp + p * 128 + n0) = st[m][n];
                }
        }
        __syncthreads();
    }
}

DEV void ssd_s2(const Params& P) {
    float* states = P.out;
    const float* cdec = (const float*)(P.ws + W_CDEC);
    for (int idx = blockIdx.x * 512 + threadIdx.x; idx < 262144; idx += gridDim.x * 512) {
        const int bh = idx >> 11, q = idx & 2047, b = bh >> 4, h = bh & 15;
        f32x4 H = (f32x4){0.f, 0.f, 0.f, 0.f};
#pragma unroll
        for (int c = 0; c < 16; ++c) {
            f32x4* ptr = (f32x4*)(states + (((long)b * 16 + c) * 16 + h) * 8192) + q;
            const f32x4 s = *ptr; *ptr = H;
            const float d = cdec[(b * 16 + c) * 16 + h];
            H = H * d + s;
        }
        *((f32x4*)(P.out + O_SSDP + (long)bh * 8192) + q) = H;
    }
}

DEV void ssd_s3_item(const Params& P, int item) {
    const int tid = tid_fresh(), lane = tid & 63, w = tid >> 6, fr = lane & 15, fq = lane >> 4;
    const int b = item >> 5, c = (item >> 1) & 15, g = item & 1;
    char* ws = P.ws;
    bf16_t* proj = (bf16_t*)(ws + W_PROJ);
    const long rowc = (long)b * 2048 + c * 128;
    bf16_t* R1 = (bf16_t*)(smem + R1_OFF); bf16_t* HB = (bf16_t*)(smem + R2_OFF);
    float* ssq = (float*)(smem + R4_OFF);
    const bf16_t* ydg = (const bf16_t*)(ws + W_NB);
    const float* states = P.out;
    const float* acsg = (const float*)(ws + W_ACS);
    const int hp = tid >> 3, hn0 = (tid & 7) * 16;
    f32x4 hreg[4];
    {
        const float* sp = states + (((long)b * 16 + c) * 16 + g * 8) * 8192 + hp * 128 + hn0;
#pragma unroll
        for (int i = 0; i < 4; ++i) hreg[i] = *(const f32x4*)(sp + i * 4);
    }
    __syncthreads();
    {
        const int nblk = tid & 15, lq = tid >> 4, l0 = lq * 4;
        const int ch0 = 1280 + g * 128 + nblk * 8;
        float o[4][8];
        conv4x8(proj + C_XBC + ch0, rowc + l0, c * 128 + l0, nullptr, P.in[I_CONVW] + ch0, P.in[I_CONVB] + ch0, o);
#pragma unroll
        for (int r = 0; r < 4; ++r) {
            u32x4 q; q.x = pk2(o[r][0], o[r][1]); q.y = pk2(o[r][2], o[r][3]); q.z = pk2(o[r][4], o[r][5]); q.w = pk2(o[r][6], o[r][7]);
            *(u32x4*)(R1 + (l0 + r) * PIT + nblk * 8) = q;
        }
    }
    const int wr = w >> 1, wc = w & 1;
    unsigned ypk[8][2][2][2];
    float ssl[2] = {0.f, 0.f};
    bf16x8 afc[4][2];
#pragma unroll
    for (int e = 0; e < 8; ++e) {
        const int h = g * 8 + e;
        bf16_t* hb = HB + (e & 1) * 64 * PIT;
        {
            u32x4 q0, q1;
            q0.x = pk2(hreg[0][0], hreg[0][1]); q0.y = pk2(hreg[0][2], hreg[0][3]); q0.z = pk2(hreg[1][0], hreg[1][1]); q0.w = pk2(hreg[1][2], hreg[1][3]);
            q1.x = pk2(hreg[2][0], hreg[2][1]); q1.y = pk2(hreg[2][2], hreg[2][3]); q1.z = pk2(hreg[3][0], hreg[3][1]); q1.w = pk2(hreg[3][2], hreg[3][3]);
            *(u32x4*)(hb + hp * PIT + hn0) = q0; *(u32x4*)(hb + hp * PIT + hn0 + 8) = q1;
        }
        if (e < 7) {
            const float* sp = states + (((long)b * 16 + c) * 16 + h + 1) * 8192 + hp * 128 + hn0;
#pragma unroll
            for (int i = 0; i < 4; ++i) hreg[i] = *(const f32x4*)(sp + i * 4);
        }
        u32x2 yq[2][2], zz[2][2]; float ea[2];
#pragma unroll
        for (int m = 0; m < 2; ++m) {
            const int l = wr * 32 + m * 16 + fr;
            ea[m] = acsg[(((long)b * 16 + c) * 16 + h) * 128 + l];
#pragma unroll
            for (int n = 0; n < 2; ++n) {
                const int p0 = wc * 32 + n * 16 + fq * 4;
                yq[m][n] = *(const u32x2*)(ydg + (rowc + l) * 1024 + h * 64 + p0);
                zz[m][n] = *(const u32x2*)(proj + (rowc + l) * PLD + C_ZA + h * 64 + p0);
            }
        }
        __syncthreads();
        if (e == 0) {
#pragma unroll
            for (int ks = 0; ks < 4; ++ks)
#pragma unroll
                for (int m = 0; m < 2; ++m) afc[ks][m] = *(const bf16x8*)(R1 + (wr * 32 + m * 16 + fr) * PIT + ks * 32 + fq * 8);
        }
        f32x4 yo[2][2];
#pragma unroll
        for (int m = 0; m < 2; ++m)
#pragma unroll
            for (int n = 0; n < 2; ++n) yo[m][n] = (f32x4){0.f, 0.f, 0.f, 0.f};
        {
            bf16x8 bfm[4][2];
#pragma unroll
            for (int ks = 0; ks < 4; ++ks)
#pragma unroll
                for (int n = 0; n < 2; ++n) bfm[ks][n] = *(const bf16x8*)(hb + (wc * 32 + n * 16 + fr) * PIT + ks * 32 + fq * 8);
            __builtin_amdgcn_sched_barrier(0);
#pragma unroll
            for (int ks = 0; ks < 4; ++ks)
#pragma unroll
                for (int m = 0; m < 2; ++m)
#pragma unroll
                    for (int n = 0; n < 2; ++n) yo[m][n] = mfma16(bfm[ks][n], afc[ks][m], yo[m][n]);
        }
#pragma unroll
        for (int m = 0; m < 2; ++m) {
            const float eam = __expf(ea[m]);
#pragma unroll
            for (int n = 0; n < 2; ++n) {
                const float v0 = (bflo(yq[m][n].x) + eam * yo[m][n][0]) * siluf(bflo(zz[m][n].x)), v1 = (bfhi(yq[m][n].x) + eam * yo[m][n][1]) * siluf(bfhi(zz[m][n].x));
                const float v2 = (bflo(yq[m][n].y) + eam * yo[m][n][2]) * siluf(bflo(zz[m][n].y)), v3 = (bfhi(yq[m][n].y) + eam * yo[m][n][3]) * siluf(bfhi(zz[m][n].y));
                ssl[m] += v0 * v0 + v1 * v1 + v2 * v2 + v3 * v3;
                ypk[e][m][n][0] = pk2(v0, v1); ypk[e][m][n][1] = pk2(v2, v3);
            }
        }
    }
#pragma unroll
    for (int m = 0; m < 2; ++m) {
        float ss = ssl[m];
        ss += __shfl_xor(ss, 16); ss += __shfl_xor(ss, 32);
        if (fq == 0) ssq[wc * 128 + wr * 32 + m * 16 + fr] = ss;
    }
    f32x4 ggv[8][2];
#pragma unroll
    for (int e = 0; e < 8; ++e)
#pragma unroll
        for (int n = 0; n < 2; ++n) ggv[e][n] = *(const f32x4*)(P.in[I_SSDG] + (g * 8 + e) * 64 + wc * 32 + n * 16 + fq * 4);
    __syncthreads();
#pragma unroll
    for (int m = 0; m < 2; ++m) {
        const int l = wr * 32 + m * 16 + fr;
        const float rstd = rsqrtf((ssq[l] + ssq[128 + l]) * (1.f / 512.f) + EPS);
#pragma unroll
        for (int e = 0; e < 8; ++e)
#pragma unroll
            for (int n = 0; n < 2; ++n) {
                const int h = g * 8 + e, p0 = wc * 32 + n * 16 + fq * 4;
                const f32x4 gg = ggv[e][n];
                const unsigned a0 = ypk[e][m][n][0], a1 = ypk[e][m][n][1];
                u32x2 o; o.x = pk2(bflo(a0) * rstd * gg[0], bfhi(a0) * rstd * gg[1]); o.y = pk2(bflo(a1) * rstd * gg[2], bfhi(a1) * rstd * gg[3]);
                *(u32x2*)(proj + (rowc + l) * PLD + C_ZA + h * 64 + p0) = o;
            }
    }
}

DEV void ssd_sample_item(const Params& P, int item) {
    const int tid = tid_fresh();
    const int b = item >> 1, g = item & 1;
    char* ws = P.ws;
    bf16_t* proj = (bf16_t*)(ws + W_PROJ);
    const long row0 = NPROMPT + (long)b * 4;
    float* xs = (float*)smem;
    float* Bs = xs + 2048;
    float* Cs = Bs + 512;
    float* dts = Cs + 512;
    float* das = dts + 32;
    float* vs = das + 32;
    float* red = vs + 2048;
    float* zs = red + 32;
    for (int u = tid; u < 768; u += 512) {
        int ch; float* dst; int dcol;
        if (u < 512) { ch = g * 512 + u; dst = xs; dcol = u; }
        else if (u < 640) { ch = 1024 + g * 128 + (u - 512); dst = Bs; dcol = u - 512; }
        else { ch = 1280 + g * 128 + (u - 640); dst = Cs; dcol = u - 640; }
        const int pitch = u < 512 ? 512 : 128;
        float full[7];
#pragma unroll
        for (int i = 0; i < 3; ++i) full[i] = P.in[I_CONV][((long)b * 3 + i) * 1536 + ch];
#pragma unroll
        for (int i = 0; i < 4; ++i) full[3 + i] = __uint_as_float(((unsigned)proj[(row0 + i) * PLD + C_XBC + ch]) << 16);
        const float w0 = P.in[I_CONVW][ch], w1 = P.in[I_CONVW][1536 + ch], w2 = P.in[I_CONVW][3072 + ch], w3 = P.in[I_CONVW][4608 + ch], bias = P.in[I_CONVB][ch];
#pragma unroll
        for (int t = 0; t < 4; ++t) dst[t * pitch + dcol] = siluf(bias + w0 * full[t] + w1 * full[t + 1] + w2 * full[t + 2] + w3 * full[t + 3]);
    }
    for (int u = tid; u < 4 * 256; u += 512) {
        const int t = u >> 8, c2 = (u & 255) * 2;
        const unsigned zz = *(const unsigned*)(proj + (row0 + t) * PLD + C_ZA + g * 512 + c2);
        zs[t * 512 + c2] = bflo(zz); zs[t * 512 + c2 + 1] = bfhi(zz);
    }
    if (tid < 32) {
        const int t = tid >> 3, e = tid & 7, h = g * 8 + e;
        const float x = ((const float*)(ws + W_DTR))[(row0 + t) * 16 + h] + P.in[I_DTB][h];
        const float d = x > 20.f ? x : log1pf(__expf(x));
        dts[tid] = d; das[tid] = __expf(-d * __expf(P.in[I_ALOG][h]));
    }
    __syncthreads();
    const int p = tid >> 3, nb = tid & 7, n0 = nb * 16;
    f32x4 hn[4];
    {
        const float* sp0 = P.in[I_SSD] + (((long)b * 16 + g * 8) * 64 + p) * 128 + n0;
#pragma unroll
        for (int i = 0; i < 4; ++i) hn[i] = *(const f32x4*)(sp0 + i * 4);
    }
    for (int e = 0; e < 8; ++e) {
        const int h = g * 8 + e;
        float* op = P.out + O_SSDS + (((long)b * 16 + h) * 64 + p) * 128 + n0;
        f32x4 hv[4];
#pragma unroll
        for (int i = 0; i < 4; ++i) hv[i] = hn[i];
        if (e < 7) {
            const float* sp = P.in[I_SSD] + (((long)b * 16 + h + 1) * 64 + p) * 128 + n0;
#pragma unroll
            for (int i = 0; i < 4; ++i) hn[i] = *(const f32x4*)(sp + i * 4);
        }
        const float dsk = P.in[I_SSDD][h];
        float yv4[4], xv4[4];
#pragma unroll
        for (int t = 0; t < 4; ++t) {
            const float dec = das[t * 8 + e], xv = xs[t * 512 + e * 64 + p], coef = dts[t * 8 + e] * xv;
            float part = 0.f;
#pragma unroll
            for (int i = 0; i < 4; ++i) {
                const f32x4 bv = *(const f32x4*)(Bs + t * 128 + n0 + i * 4), cv = *(const f32x4*)(Cs + t * 128 + n0 + i * 4);
                hv[i] = hv[i] * dec + bv * coef;
                part += hv[i][0] * cv[0] + hv[i][1] * cv[1] + hv[i][2] * cv[2] + hv[i][3] * cv[3];
            }
            yv4[t] = part; xv4[t] = xv;
        }
#pragma unroll
        for (int t = 0; t < 4; ++t) yv4[t] += __shfl_xor(yv4[t], 1);
#pragma unroll
        for (int t = 0; t < 4; ++t) yv4[t] += __shfl_xor(yv4[t], 2);
#pragma unroll
        for (int t = 0; t < 4; ++t) yv4[t] += __shfl_xor(yv4[t], 4);
        if (nb == 0) {
#pragma unroll
            for (int t = 0; t < 4; ++t) vs[t * 512 + e * 64 + p] = (yv4[t] + dsk * xv4[t]) * siluf(zs[t * 512 + e * 64 + p]);
        }
#pragma unroll
        for (int i = 0; i < 4; ++i) *(f32x4*)(op + i * 4) = hv[i];
    }
    __syncthreads();
    {
        const int t = tid >> 7, cidx = tid & 127;
        float v[4]; float ss = 0.f;
#pragma unroll
        for (int i = 0; i < 4; ++i) { v[i] = vs[t * 512 + cidx * 4 + i]; ss += v[i] * v[i]; }
        ss = wave_sum(ss);
        if ((tid & 63) == 0) red[tid >> 6] = ss;
        __syncthreads();
        const float tot = red[t * 2] + red[t * 2 + 1];
        const float rstd = rsqrtf(tot * (1.f / 512.f) + EPS);
        const f32x4 gg = *(const f32x4*)(P.in[I_SSDG] + g * 512 + cidx * 4);
        u32x2 o; o.x = pk2(v[0] * rstd * gg[0], v[1] * rstd * gg[1]); o.y = pk2(v[2] * rstd * gg[2], v[3] * rstd * gg[3]);
        *(u32x2*)(proj + (row0 + t) * PLD + C_ZA + g * 512 + cidx * 4) = o;
    }
    __syncthreads();
}

constexpr int S5P = 20;
template <bool SAMPLE>
DEV void s5_item(const Params& P, int g, long rowbase, int bidx) {
    const int tid = tid_fresh(), lane = tid & 63, w = tid >> 6, fr = lane & 15, fq = lane >> 4;
    constexpr int TPW = SAMPLE ? 16 : 256;
    bf16_t* proj = (bf16_t*)(P.ws + W_PROJ);
    float* buf = (float*)smem + w * (128 * S5P);
    float* carry = (float*)smem + 8 * 128 * S5P;
    float* fs = carry + 1024 + w * 128;
    float ar, ai;
    {
        const float lr = P.in[I_LRE][g * 64 + lane], li = P.in[I_LIM][g * 64 + lane], delta = expf(P.in[I_LDT][g]);
        const float mag = expf(lr * delta), ang = li * delta;
        ar = mag * cosf(ang); ai = mag * sinf(ang);
        const float qre = ar - 1.f, den = lr * lr + li * li;
        fs[lane] = (qre * lr + ai * li) / den; fs[64 + lane] = (ai * lr - qre * li) / den;
    }
    lds_fence();
    bf16x8 bbf[8];
#pragma unroll
    for (int j = 0; j < 8; ++j) {
        bf16x8 z = {0, 0, 0, 0, 0, 0, 0, 0};
        if (fq < 2) {
            const int p = (j & 3) * 16 + fr;
            const float f_r = fs[p], f_i = fs[64 + p];
            const float* br = P.in[I_BRE] + ((long)(g * 64 + p)) * 16 + fq * 8;
            const float* bi = P.in[I_BIM] + ((long)(g * 64 + p)) * 16 + fq * 8;
            const f32x4 r0 = *(const f32x4*)br, r1 = *(const f32x4*)(br + 4), i0 = *(const f32x4*)bi, i1 = *(const f32x4*)(bi + 4);
            f32x4 o0, o1;
            if (j < 4) { o0 = r0 * f_r - i0 * f_i; o1 = r1 * f_r - i1 * f_i; }
            else { o0 = i0 * f_r + r0 * f_i; o1 = i1 * f_r + r1 * f_i; }
            u32x4 q; q.x = pk2(o0[0], o0[1]); q.y = pk2(o0[2], o0[3]); q.z = pk2(o1[0], o1[1]); q.w = pk2(o1[2], o1[3]);
            z = __builtin_bit_cast(bf16x8, q);
        }
        bbf[j] = z;
    }
    bf16x8 ccf[4];
#pragma unroll
    for (int ks = 0; ks < 4; ++ks) {
        const float* src = (ks < 2 ? P.in[I_CRE] : P.in[I_CIM]) + ((long)(g * 16 + fr)) * 64 + (ks & 1) * 32 + fq * 8;
        f32x4 c0 = *(const f32x4*)src, c1 = *(const f32x4*)(src + 4);
        if (ks >= 2) { c0 = -c0; c1 = -c1; }
        u32x4 q; q.x = pk2(c0[0], c0[1]); q.y = pk2(c0[2], c0[3]); q.z = pk2(c1[0], c1[1]); q.w = pk2(c1[2], c1[3]);
        ccf[ks] = __builtin_bit_cast(bf16x8, q);
    }
    const f32x4 dsk = *(const f32x4*)(P.in[I_S5D] + g * 16 + fq * 4);
    const long roww = rowbase + (long)w * TPW;
    float xr = 0.f, xi = 0.f;
    float sre[8], sim[8];
#pragma unroll
    for (int j = 0; j < 8; ++j) { sre[j] = 0.f; sim[j] = 0.f; }
    if (SAMPLE) {
#pragma unroll
        for (int j = 0; j < TPW / 4; ++j) {
            const long seq = (roww - NPROMPT) / 4 + j;
            sre[j] = P.in[I_S5R][(seq * 64 + g) * 64 + lane]; sim[j] = P.in[I_S5I][(seq * 64 + g) * 64 + lane];
        }
    }
    constexpr int NPASS = SAMPLE ? 1 : 2;
#pragma unroll 1
    for (int pass = 0; pass < NPASS; ++pass) {
        const bool last = (pass == NPASS - 1);
        if (!SAMPLE && pass == 1) {
            carry[w * 128 + lane] = xr; carry[w * 128 + 64 + lane] = xi;
            __syncthreads();
            float pr = ar, pi = ai;
#pragma unroll
            for (int q = 0; q < 8; ++q) { const float nr = pr * pr - pi * pi, ni = 2.f * pr * pi; pr = nr; pi = ni; }
            float sr = 0.f, si = 0.f;
            for (int ww = 0; ww < w; ++ww) {
                const float cr = carry[ww * 128 + lane], ci = carry[ww * 128 + 64 + lane];
                const float nr = pr * sr - pi * si + cr, ni = pr * si + pi * sr + ci; sr = nr; si = ni;
            }
            xr = sr; xi = si;
        }
        if (!SAMPLE && pass == 0 && w == 7) continue;
        bf16x8 ufn = {0, 0, 0, 0, 0, 0, 0, 0};
        if (fq < 2) ufn = *(const bf16x8*)(proj + (roww + fr) * PLD + C_UB + g * 16 + fq * 8);
#pragma unroll 1
        for (int sb = 0; sb < TPW / 16; ++sb) {
            const long r = roww + sb * 16;
            const bf16x8 uf = ufn;
            if (fq < 2 && sb + 1 < TPW / 16) ufn = *(const bf16x8*)(proj + (r + 16 + fr) * PLD + C_UB + g * 16 + fq * 8);
            u32x2* up = (u32x2*)(proj + (r + fr) * PLD + C_UB + g * 16 + fq * 4);
            u32x2 uu = {0u, 0u};
            if (last) uu = *up;
            const f32x4 zero = {0.f, 0.f, 0.f, 0.f};
#pragma unroll
            for (int j = 0; j < 8; ++j) {
                const f32x4 d = mfma16(uf, bbf[j], zero);
                *(f32x4*)(buf + (j * 16 + fr) * S5P + fq * 4) = d;
            }
            lds_fence();
            {
                f32x4 brv[4], biv[4];
#pragma unroll
                for (int q = 0; q < 4; ++q) { brv[q] = *(const f32x4*)(buf + lane * S5P + q * 4); biv[q] = *(const f32x4*)(buf + (64 + lane) * S5P + q * 4); }
                __builtin_amdgcn_sched_barrier(0);
#pragma unroll
                for (int q = 0; q < 4; ++q) {
                    if (SAMPLE) {
#pragma unroll
                        for (int j = 0; j < 8; ++j) if (j == sb * 4 + q) { xr = sre[j]; xi = sim[j]; }
                    }
#pragma unroll
                    for (int i = 0; i < 4; ++i) {
                        const float nr = ar * xr - ai * xi + brv[q][i], ni = ar * xi + ai * xr + biv[q][i];
                        xr = nr; xi = ni; brv[q][i] = nr; biv[q][i] = ni;
                    }
                    if (SAMPLE) {
                        const long seq = (r - NPROMPT) / 4 + q;
                        P.out[O_S5RS + (seq * 64 + g) * 64 + lane] = xr; P.out[O_S5IS + (seq * 64 + g) * 64 + lane] = xi;
                    }
                }
                if (last) {
#pragma unroll
                    for (int q = 0; q < 4; ++q) { *(f32x4*)(buf + lane * S5P + q * 4) = brv[q]; *(f32x4*)(buf + (64 + lane) * S5P + q * 4) = biv[q]; }
                }
            }
            if (last) {
                lds_fence();
                f32x4 y = {0.f, 0.f, 0.f, 0.f};
                float xv[4][8];
#pragma unroll
                for (int ks = 0; ks < 4; ++ks)
#pragma unroll
                    for (int i = 0; i < 8; ++i) xv[ks][i] = buf[(ks * 32 + fq * 8 + i) * S5P + fr];
                __builtin_amdgcn_sched_barrier(0);
#pragma unroll
                for (int ks = 0; ks < 4; ++ks) {
                    u32x4 q; q.x = pk2(xv[ks][0], xv[ks][1]); q.y = pk2(xv[ks][2], xv[ks][3]); q.z = pk2(xv[ks][4], xv[ks][5]); q.w = pk2(xv[ks][6], xv[ks][7]);
                    y = mfma16(ccf[ks], __builtin_bit_cast(bf16x8, q), y);
                }
                const float y0 = geluf(y[0] + dsk[0] * bflo(uu.x)), y1 = geluf(y[1] + dsk[1] * bfhi(uu.x));
                const float y2 = geluf(y[2] + dsk[2] * bflo(uu.y)), y3 = geluf(y[3] + dsk[3] * bfhi(uu.y));
                u32x2 o; o.x = pk2(y0, y1); o.y = pk2(y2, y3);
                *up = o;
            }
            lds_fence();
        }
    }
    if (!SAMPLE && w == 7) {
        P.out[O_S5RP + ((long)bidx * 64 + g) * 64 + lane] = xr; P.out[O_S5IP + ((long)bidx * 64 + g) * 64 + lane] = xi;
    }
    __syncthreads();
}

__global__ void __launch_bounds__(512) hymba_fwd(Params P) {
#ifdef PROBE_K
    unsigned long long tb_[9]; int nb_ = 0;
#define TB() do { tb_[nb_++] = wall_clock64(); } while (0)
    TB();
#else
#define TB() do {} while (0)
#endif
    const int G = gridDim.x, bid = blockIdx.x;
    char* ws = P.ws;
    bf16_t* proj = (bf16_t*)(ws + W_PROJ);
    unsigned* barw = (unsigned*)(ws + W_BAR);
    volatile LAS unsigned* stw = (volatile LAS unsigned*)(smem + 131072);
    if (threadIdx.x < 4) stw[threadIdx.x] = 0u;
    __syncthreads();
    const XcdBarrier xb = xcd_barrier_post(barw, stw);
#ifndef NO_P0
    phase0(P);
#endif
    xcd_barrier(xb); TB();
#ifndef NO_P1
    for (int L = bid; L < 1188; L += G) {
        int pm, pn; tile_of(L, 66, 18, pm, pn);
        gemm_tile((const bf16_t*)(ws + W_NB), 1024, (const bf16_t*)(ws + W_WTIN), 1024, 1024, pm * 256, pn * 256, EpiBf16{proj, PLD, (const float*)(ws + W_RSTD)});
    }
    for (int L = (bid + G - 1188 % G) % G; L < 264; L += G) {
        int pm, pn; tile_of(L, 66, 4, pm, pn);
        gemm_tile((const bf16_t*)(ws + W_PB), 256, (const bf16_t*)(ws + W_WTPP), 256, 256, pm * 256, pn * 256, EpiBf16{(bf16_t*)(ws + W_PP), 1024, nullptr});
    }
#endif
    xcd_barrier(xb); TB();
    for (int idx = bid * 512 + threadIdx.x; idx < (8 + 128) * 3 * 192; idx += G * 512) {
        const int c8 = (idx % 192) * 8, sj = idx / 192, j = sj % 3, sq = sj / 3;
        const long row = sq < 8 ? (long)sq * 2048 + 2045 + j : NPROMPT + (long)(sq - 8) * 4 + 1 + j;
        const u32x4 u = *(const u32x4*)(proj + row * PLD + C_XBC + c8);
        float* dst = sq < 8 ? P.out + O_CONVP + ((long)sq * 3 + j) * 1536 + c8 : P.out + O_CONVS + ((long)(sq - 8) * 3 + j) * 1536 + c8;
        *(f32x4*)dst = (f32x4){bflo(u.x), bfhi(u.x), bflo(u.y), bfhi(u.y)};
        *(f32x4*)(dst + 4) = (f32x4){bflo(u.z), bfhi(u.z), bflo(u.w), bfhi(u.w)};
    }
#ifdef PROBE2
    unsigned long long tq_[5]; tq_[0] = wall_clock64();
#endif
#ifndef NO_S1
    for (int it = bid; it < 256; it += G) ssd_s1_item(P, it);
#endif
#ifdef PROBE2
    tq_[1] = wall_clock64();
#endif
#ifndef NO_SS
    for (int it = bid; it < 256; it += G) ssd_sample_item(P, it);
#endif
#ifdef PROBE2
    tq_[2] = wall_clock64();
#endif
#ifndef NO_S5P
    for (int it = bid; it < 512; it += G) s5_item<false>(P, it & 63, (long)(it >> 6) * 2048, it >> 6);
#endif
#ifdef PROBE2
    tq_[3] = wall_clock64();
#endif
#ifndef NO_S5S
    for (int it = bid; it < 256; it += G) s5_item<true>(P, it & 63, NPROMPT + (long)(it >> 6) * 128, 0);
#endif
#ifdef PROBE2
    tq_[4] = wall_clock64();
    { const unsigned long long d = tq_[PROBE2 + 1] - tq_[PROBE2], t0 = wall_clock64(); while (wall_clock64() - t0 < d) __builtin_amdgcn_s_sleep(8); }
#endif
    xcd_barrier(xb); TB();
    if (bid & 1) ssd_s2(P);
    {
        const EpiGlu eg{proj, P.in[I_GLUB]};
        for (int L = bid; L < 256; L += G) {
            int pm, pn; tile_of(L, 64, 4, pm, pn);
            gemm_tile(proj + C_UB, PLD, (const bf16_t*)(ws + W_WTGLU), 1024, 1024, pm * 256, pn * 256, eg);
        }
        for (int L = bid; L < 256; L += G)
            gemm_small(proj + C_UB, PLD, (const bf16_t*)(ws + W_WTGLU), 1024, 1024, NPROMPT + (L >> 3) * 16, (L & 7) * 128, eg);
    }
    if (!(bid & 1)) ssd_s2(P);
    xcd_barrier(xb); TB();
#ifndef NO_S3
    for (int it = bid; it < 256; it += G) ssd_s3_item(P, it);
#endif
    xcd_barrier(xb); TB();
#ifndef NO_P5
    {
        const EpiOut eo{P.in[I_XP], P.in[I_XS], (bf16_t*)(ws + W_NB), (float*)(ws + W_RSS1)};
        if (bid & 1)
            for (int L = bid; L < 256; L += G)
                gemm_small(proj, PLD, (const bf16_t*)(ws + W_WTOUT), 2048, 2048, NPROMPT + (L >> 3) * 16, (L & 7) * 128, eo);
        for (int L = bid; L < 256; L += G) {
            int pm, pn; tile_of(L, 64, 4, pm, pn);
            gemm_tile(proj, PLD, (const bf16_t*)(ws + W_WTOUT), 2048, 2048, pm * 256, pn * 256, eo);
        }
        if (!(bid & 1))
            for (int L = bid; L < 256; L += G)
                gemm_small(proj, PLD, (const bf16_t*)(ws + W_WTOUT), 2048, 2048, NPROMPT + (L >> 3) * 16, (L & 7) * 128, eo);
    }
#endif
    xcd_barrier(xb); TB();
#ifndef NO_P6
    {
        const EpiPle ep{P.out, (const bf16_t*)(ws + W_NB), (const bf16_t*)(ws + W_PP), (const float*)(ws + W_RSS1), (float*)(ws + W_RSS2)};
        if (bid & 1)
            for (int L = bid; L < 256; L += G)
                gemm_small((const bf16_t*)(ws + W_NB), 1024, (const bf16_t*)(ws + W_WTGATE), 1024, 1024, NPROMPT + (L >> 3) * 16, (L & 7) * 128, ep);
        for (int L = bid; L < 256; L += G) {
            int pm, pn; tile_of(L, 64, 4, pm, pn);
            gemm_tile((const bf16_t*)(ws + W_NB), 1024, (const bf16_t*)(ws + W_WTGATE), 1024, 1024, pm * 256, pn * 256, ep);
        }
        if (!(bid & 1))
            for (int L = bid; L < 256; L += G)
                gemm_small((const bf16_t*)(ws + W_NB), 1024, (const bf16_t*)(ws + W_WTGATE), 1024, 1024, NPROMPT + (L >> 3) * 16, (L & 7) * 128, ep);
    }
#endif
    xcd_barrier(xb); TB();
    {
        const float* rss2 = (const float*)(ws + W_RSS2);
        for (int idx = bid * 512 + threadIdx.x; idx < NTOK * 256; idx += G * 512) {
            const int row = idx >> 8, c4 = (idx & 255) * 4;
            const f32x4 r0 = *(const f32x4*)(rss2 + (long)row * 16), r1 = *(const f32x4*)(rss2 + (long)row * 16 + 4), r2 = *(const f32x4*)(rss2 + (long)row * 16 + 8), r3 = *(const f32x4*)(rss2 + (long)row * 16 + 12);
            const float tot = (((r0[0] + r0[1]) + (r0[2] + r0[3])) + ((r1[0] + r1[1]) + (r1[2] + r1[3]))) + (((r2[0] + r2[1]) + (r2[2] + r2[3])) + ((r3[0] + r3[1]) + (r3[2] + r3[3])));
            const float rstd = rsqrtf(tot * (1.f / 1024.f) + EPS);
            f32x4* p = (f32x4*)(P.out + (long)row * 1024 + c4);
            const f32x4 gf = *(const f32x4*)(P.in[I_GFIN] + c4);
            *p = *p * rstd * gf;
        }
    }
#ifdef PROBE_K
    { TB(); const unsigned long long d = tb_[PROBE_K + 1] - tb_[PROBE_K], t0 = wall_clock64(); while (wall_clock64() - t0 < d) __builtin_amdgcn_s_sleep(8); }
#endif
}

extern "C" void kernel_launch(void* const* d_in, const int* in_sizes, int n_in, void* d_out, int out_size, void* d_ws, size_t ws_size, hipStream_t stream) {
    static int grid_blocks = 0;
    if (grid_blocks == 0) {
        if (n_in != 31 || out_size != (int)O_END || ws_size < W_END) {
            fprintf(stderr, "kernel_launch: unexpected shapes n_in %d out %d ws %zu (need %zu)\n", n_in, out_size, ws_size, (size_t)W_END);
            grid_blocks = -1; return;
        }
        int dev = 0, cus = 0, per_cu = 0;
        hipGetDevice(&dev);
        hipDeviceGetAttribute(&cus, hipDeviceAttributeMultiprocessorCount, dev);
        hipFuncSetAttribute((const void*)hymba_fwd, hipFuncAttributeMaxDynamicSharedMemorySize, LDS_BYTES);
        hipOccupancyMaxActiveBlocksPerMultiprocessor(&per_cu, (const void*)hymba_fwd, 512, LDS_BYTES);
        if (per_cu < 1) { fprintf(stderr, "kernel_launch: occupancy query says %d blocks/CU\n", per_cu); per_cu = 1; }
        grid_blocks = cus;
        (void)hipGetLastError();
    }
    if (grid_blocks < 0) return;
    if (hipMemsetAsync((char*)d_ws + W_BAR, 0, XCD_BAR_WORDS * sizeof(unsigned), stream) != hipSuccess) { fprintf(stderr, "kernel_launch: memset of the barrier words failed\n"); return; }
    Params p{};
    for (int i = 0; i < 31; ++i) p.in[i] = (const float*)d_in[i];
    p.out = (float*)d_out; p.ws = (char*)d_ws;
    void* args[] = {&p};
    hipError_t e = hipLaunchCooperativeKernel((const void*)hymba_fwd, dim3(grid_blocks), dim3(512), args, LDS_BYTES, stream);
    if (e != hipSuccess) fprintf(stderr, "cooperative launch failed: %s (grid %d)\n", hipGetErrorString(e), grid_blocks);
}
```

```cpp
#include <hip/hip_runtime.h>
#include <hip/hip_cooperative_groups.h>
#include <cstdio>
namespace cg = cooperative_groups;

typedef unsigned short bf16_t;
typedef short bf16x8 __attribute__((ext_vector_type(8)));
typedef float f32x4 __attribute__((ext_vector_type(4)));
typedef unsigned u32x2 __attribute__((ext_vector_type(2)));
typedef unsigned u32x4 __attribute__((ext_vector_type(4)));
#define DEV __device__ __forceinline__

constexpr int NPROMPT = 16384, NSAMPLE = 512, NTOK = 16896;
constexpr int PLD = 4608;
constexpr int C_ZA = 0, C_ZB = 1024, C_XBC = 2048, C_UB = 3584;
constexpr float EPS = 1e-6f;
constexpr long O_YP = 0, O_YS = 16777216, O_SSDP = 17301504, O_CONVP = 18350080, O_S5RP = 18386944, O_S5IP = 18419712,
               O_SSDS = 18452480, O_CONVS = 35229696, O_S5RS = 35819520, O_S5IS = 36343808, O_END = 36868096;
constexpr size_t W_WTIN = 0;
constexpr size_t W_WTOUT = W_WTIN + 4608ull * 1024 * 2;
constexpr size_t W_WTGLU = W_WTOUT + 1024ull * 2048 * 2;
constexpr size_t W_WTGATE = W_WTGLU + 1024ull * 1024 * 2;
constexpr size_t W_WTPP = W_WTGATE + 1024ull * 1024 * 2;
constexpr size_t W_NB = W_WTPP + 1024ull * 256 * 2;
constexpr size_t W_PB = W_NB + 16896ull * 1024 * 2;
constexpr size_t W_DTR = W_PB + 16896ull * 256 * 2;
constexpr size_t W_ACS = W_DTR + 16896ull * 16 * 4;
constexpr size_t W_CDEC = W_ACS + 16384ull * 16 * 4;
constexpr size_t W_RSS1 = W_CDEC + 8192;
constexpr size_t W_RSS2 = W_RSS1 + 16896ull * 16 * 4;
constexpr size_t W_PROJ = W_RSS2 + 16896ull * 16 * 4;
constexpr size_t W_PP = W_PROJ + 16896ull * 4608 * 2;
constexpr size_t W_RSTD = W_PP + 16896ull * 1024 * 2;
constexpr size_t W_BAR = W_RSTD + 16896ull * 4;
constexpr size_t W_END = W_BAR + 16384;

constexpr int LDS_BYTES = 131072 + 64;

struct Params {
    const float* in[31];
    float* out;
    char* ws;
};
enum { I_XP = 0, I_XS, I_PP, I_PS, I_SSD, I_CONV, I_S5R, I_S5I, I_WIN, I_GIN, I_CONVW, I_CONVB, I_DTB, I_ALOG, I_SSDD, I_SSDG,
       I_LRE, I_LIM, I_LDT, I_BRE, I_BIM, I_CRE, I_CIM, I_S5D, I_GLUW, I_GLUB, I_WOUT, I_GPLE, I_WGATE, I_WPP, I_GFIN };

extern __shared__ __attribute__((aligned(16))) char smem[];

DEV unsigned pk2(float lo, float hi) { unsigned r; asm("v_cvt_pk_bf16_f32 %0, %1, %2" : "=v"(r) : "v"(lo), "v"(hi)); return r; }
DEV float bflo(unsigned u) { return __uint_as_float(u << 16); }
DEV float bfhi(unsigned u) { return __uint_as_float(u & 0xffff0000u); }
DEV float wave_sum(float v) {
#pragma unroll
    for (int o = 1; o < 64; o <<= 1) v += __shfl_xor(v, o);
    return v;
}
DEV float siluf(float v) { return v * __builtin_amdgcn_rcpf(1.f + __expf(-v)); }
DEV float sigmf(float v) { return __builtin_amdgcn_rcpf(1.f + __expf(-v)); }
DEV float geluf(float y) { float z = 0.7978845608f * (y + 0.044715f * y * y * y); return y * __builtin_amdgcn_rcpf(1.f + __expf(-2.f * z)); }
DEV f32x4 mfma16(bf16x8 a, bf16x8 b, f32x4 c) { return __builtin_amdgcn_mfma_f32_16x16x32_bf16(a, b, c, 0, 0, 0); }
DEV int tid_fresh() { int t = threadIdx.x; asm volatile("" : "+v"(t)); return t; }
DEV void lds_fence() { asm volatile("s_waitcnt lgkmcnt(0)" ::: "memory"); }


#define XB_TMO      128
#define XB_XCNT(j)  (256  + 64 * (j))
#define XB_XSUB(j)  (1280 + 64 * (j))
#define XB_XGEN(j)  (2304 + 64 * (j))
#define XB_TOP      3328
#define XB_TOPGEN   3392
#define XCD_BAR_WORDS 3456
#define XB_SPIN_CAP (1u << 22)
#define LAS __attribute__((address_space(3)))
DEV unsigned xb_ld(unsigned* p) { return __hip_atomic_load(p, __ATOMIC_RELAXED, __HIP_MEMORY_SCOPE_AGENT); }
DEV unsigned xb_add(unsigned* p, unsigned v) { return __hip_atomic_fetch_add(p, v, __ATOMIC_RELAXED, __HIP_MEMORY_SCOPE_AGENT); }
DEV unsigned xb_xcc_id() { return (unsigned)__builtin_amdgcn_s_getreg((3 << 11) | 20) & 0xFu; }
#define XB_SPIN(cond, bar) do { unsigned _sp = 0; while (cond) { __builtin_amdgcn_s_sleep(1); \
    if ((++_sp & 255u) == 0u) { if (xb_ld(&(bar)[XB_TMO])) break; if (_sp > XB_SPIN_CAP) { atomicAdd(&(bar)[XB_TMO], 1u); break; } } } } while (0)
struct XcdBarrier { unsigned* bar; unsigned x; volatile LAS unsigned* st; };
DEV XcdBarrier xcd_barrier_post(unsigned* bar, volatile LAS unsigned* st) {
    XcdBarrier b; b.bar = bar; b.x = xb_xcc_id(); b.st = st;
    if (threadIdx.x == 0) (void)xb_add(&bar[XB_XCNT(b.x)], 1u);
    return b;
}
DEV void xcd_barrier_complete(unsigned* bar, unsigned x, unsigned& nloc, unsigned& nx) {
    const unsigned G = gridDim.x * gridDim.y * gridDim.z;
    unsigned sum, cnt, mine, sp = 0u;
    for (;;) {
        sum = 0u; cnt = 0u; mine = 0u;
#pragma unroll
        for (unsigned j = 0; j < 16; ++j) { const unsigned c = xb_ld(&bar[XB_XCNT(j)]); sum += c; cnt += (c > 0u) ? 1u : 0u; mine = (j == x) ? c : mine; }
        if (sum == G) break;
        __builtin_amdgcn_s_sleep(1);
        if ((++sp & 255u) == 0u) { if (xb_ld(&bar[XB_TMO])) break; if (sp > XB_SPIN_CAP) { atomicAdd(&bar[XB_TMO], 1u); break; } }
    }
    nloc = mine > 0u ? mine : 1u; nx = cnt > 0u ? cnt : 1u;
}
DEV void xcd_barrier(const XcdBarrier& b) {
    asm volatile("s_waitcnt vmcnt(0)" ::: "memory");
    __syncthreads();
    if (threadIdx.x == 0) {
        unsigned* bar = b.bar;
        __builtin_amdgcn_s_waitcnt(0);
        unsigned nloc = b.st[0], nx = b.st[1];
        if (nloc == 0u) { xcd_barrier_complete(bar, b.x, nloc, nx); b.st[0] = nloc; b.st[1] = nx; }
        const unsigned old = xb_add(&bar[XB_XSUB(b.x)], 1u);
        const unsigned gen = old / nloc;
        if (old + 1u == (gen + 1u) * nloc) {
            __builtin_amdgcn_fence(__ATOMIC_RELEASE, "agent");
            asm volatile("s_waitcnt vmcnt(0)" ::: "memory");
            const unsigned og = xb_add(&bar[XB_TOP], 1u);
            const unsigned tg = og / nx;
            if (og + 1u == (tg + 1u) * nx) xb_add(&bar[XB_TOPGEN], 1u);
            else XB_SPIN(xb_ld(&bar[XB_TOPGEN]) == tg, bar);
            __builtin_amdgcn_fence(__ATOMIC_ACQUIRE, "agent");
            xb_add(&bar[XB_XGEN(b.x)], 1u);
            asm volatile("s_waitcnt vmcnt(0)" ::: "memory");
        } else {
            XB_SPIN(xb_ld(&bar[XB_XGEN(b.x)]) == gen, bar);
            __builtin_amdgcn_fence(__ATOMIC_ACQUIRE, "agent");
            asm volatile("s_waitcnt vmcnt(0)" ::: "memory");
        }
    }
    __syncthreads();
}

constexpr int BM = 256, BK = 64, HALF = 128, HT = HALF * BK;
DEV int lds_byte(int r, int c) {
    int st = (r >> 4) * 2 + (c >> 5), rr = r & 15, cc = c & 31, ob = rr * 64 + cc * 2;
    return st * 1024 + (ob ^ (((ob >> 9) & 1) << 5));
}
DEV void stage_rc(int b, int& R, int& C) {
    int st = b / 1024, sb = b % 1024, swz = sb ^ (((sb >> 9) & 1) << 5);
    R = (st >> 1) * 16 + swz / 64; C = (st & 1) * 32 + (swz % 64) / 2;
}

template <class Epi>
DEV void gemm_tile(const bf16_t* __restrict__ A, int lda, const bf16_t* __restrict__ Bt, int ldb, int K, int brow, int bcol, const Epi& epi) {
    LAS unsigned char* lds = (LAS unsigned char*)smem;
    constexpr int HTB = HT * 2;
    const int tid = tid_fresh(), wid = __builtin_amdgcn_readfirstlane(tid >> 6), lane = tid & 63, wr = wid >> 2, wc = wid & 3, fr = lane & 15, fq = lane >> 4;
    unsigned voffA[2], voffB[2];
#pragma unroll
    for (int i = 0; i < 2; ++i) {
        int R, C; stage_rc(tid * 16 + i * 8192, R, C);
        const int rho = R & 31, Rb = Epi::PERM ? ((R & ~31) + 8 * ((rho & 15) >> 2) + 4 * (rho >> 4) + (rho & 3)) : R;
        voffA[i] = (unsigned)(R * lda + C) * 2u; voffB[i] = (unsigned)(Rb * ldb + C) * 2u;
    }
    const size_t kstep = (size_t)(BK * 2), hstepA = (size_t)HALF * lda * 2, hstepB = (size_t)HALF * ldb * 2;
    const unsigned ldsw = (unsigned)wid * 1024u;
    const int aoff = lds_byte(wr * 64 + fr, fq * 8), boff = lds_byte(wc * 32 + fr, fq * 8);
#define SA(b, h) (((b) * 2 + (h)) * HTB)
#define SB(b, h) ((4 + (b) * 2 + (h)) * HTB)
#define STAGE(bufoff, gbase, voff) do { _Pragma("unroll") for (int _i = 0; _i < 2; ++_i) \
        __builtin_amdgcn_global_load_lds((const unsigned*)((const char*)(gbase) + (voff)[_i]), (LAS unsigned*)(lds + (bufoff) + ldsw + _i * 8192), 16, 0, 0); } while (0)
#define LDA(dst, b, h) do { _Pragma("unroll") for (int m = 0; m < 4; ++m) _Pragma("unroll") for (int k = 0; k < 2; ++k) dst[m][k] = *(const LAS bf16x8*)(lds + SA(b, h) + aoff + m * 2048 + k * 1024); } while (0)
#define LDB(dst, b, h) do { _Pragma("unroll") for (int n = 0; n < 2; ++n) _Pragma("unroll") for (int k = 0; k < 2; ++k) dst[n][k] = *(const LAS bf16x8*)(lds + SB(b, h) + boff + n * 2048 + k * 1024); } while (0)
#define MMA(ai, bj, At, Bt_) do { __builtin_amdgcn_s_setprio(1); _Pragma("unroll") for (int m = 0; m < 4; ++m) _Pragma("unroll") for (int n = 0; n < 2; ++n) _Pragma("unroll") for (int k = 0; k < 2; ++k) \
        acc[ai][bj][m][n] = __builtin_amdgcn_mfma_f32_16x16x32_bf16(Bt_[n][k], At[m][k], acc[ai][bj][m][n], 0, 0, 0); __builtin_amdgcn_s_setprio(0); } while (0)
#define WAIT_V(n) asm volatile("s_waitcnt vmcnt(" #n ")" ::: "memory")
#define WAIT_L(n) asm volatile("s_waitcnt lgkmcnt(" #n ")" ::: "memory")
#define BAR __builtin_amdgcn_s_barrier()
#define SCHED __builtin_amdgcn_sched_barrier(0)
    f32x4 acc[2][2][4][2];
#pragma unroll
    for (int a = 0; a < 2; ++a)
#pragma unroll
        for (int b = 0; b < 2; ++b)
#pragma unroll
            for (int m = 0; m < 4; ++m)
#pragma unroll
                for (int n = 0; n < 2; ++n) acc[a][b][m][n] = (f32x4){0.f, 0.f, 0.f, 0.f};
    bf16x8 At[4][2], B0[2][2], B1[2][2];
    const int nt = K / BK;
    const char* cA = (const char*)A + (size_t)brow * lda * 2; const char* cB = (const char*)Bt + (size_t)bcol * ldb * 2;
    STAGE(SB(0, 0), cB, voffB); STAGE(SA(0, 0), cA, voffA); STAGE(SB(0, 1), cB + hstepB, voffB); STAGE(SA(0, 1), cA + hstepA, voffA);
    if (wr == 1) BAR;
    WAIT_V(4); BAR;
    STAGE(SB(1, 0), cB + kstep, voffB); STAGE(SA(1, 0), cA + kstep, voffA); STAGE(SB(1, 1), cB + hstepB + kstep, voffB);
    WAIT_V(6); BAR;
    for (int t = 0; t < nt - 2; t += 2) {
        const char* a1 = cA + (size_t)(t + 1) * kstep;
        const char* a2 = cA + (size_t)(t + 2) * kstep; const char* b2 = cB + (size_t)(t + 2) * kstep;
        const char* a3 = a2 + kstep; const char* b3 = b2 + kstep;
        LDB(B0, 0, 0); SCHED; LDA(At, 0, 0); STAGE(SA(1, 1), a1 + hstepA, voffA);
        WAIT_L(8); BAR; WAIT_L(0); MMA(0, 0, At, B0); BAR; SCHED;
        LDB(B1, 0, 1); STAGE(SB(0, 0), b2, voffB);
        BAR; WAIT_L(0); MMA(0, 1, At, B1); BAR;
        LDA(At, 0, 1); STAGE(SA(0, 0), a2, voffA);
        BAR; WAIT_L(0); MMA(1, 0, At, B0); BAR; SCHED;
        STAGE(SB(0, 1), b2 + hstepB, voffB);
        WAIT_V(6); BAR; MMA(1, 1, At, B1); BAR;
        LDB(B0, 1, 0); SCHED; LDA(At, 1, 0); STAGE(SA(0, 1), a2 + hstepA, voffA);
        WAIT_L(8); BAR; WAIT_L(0); MMA(0, 0, At, B0); BAR; SCHED;
        LDB(B1, 1, 1); STAGE(SB(1, 0), b3, voffB);
        BAR; WAIT_L(0); MMA(0, 1, At, B1); BAR;
        LDA(At, 1, 1); STAGE(SA(1, 0), a3, voffA);
        BAR; WAIT_L(0); MMA(1, 0, At, B0); BAR; SCHED;
        STAGE(SB(1, 1), b3 + hstepB, voffB);
        WAIT_V(6); BAR; MMA(1, 1, At, B1); BAR;
    }
    { const char* a1 = cA + (size_t)(nt - 1) * kstep;
      LDB(B0, 0, 0); LDA(At, 0, 0); STAGE(SA(1, 1), a1 + hstepA, voffA);
      BAR; WAIT_L(0); MMA(0, 0, At, B0); BAR;
      LDB(B1, 0, 1); BAR; WAIT_L(0); MMA(0, 1, At, B1); BAR;
      LDA(At, 0, 1); WAIT_V(4); BAR; WAIT_L(0); MMA(1, 0, At, B0); MMA(1, 1, At, B1); BAR; }
    { LDB(B0, 1, 0); LDA(At, 1, 0); WAIT_V(2); BAR; WAIT_L(0); MMA(0, 0, At, B0); BAR;
      LDB(B1, 1, 1); WAIT_V(0); BAR; WAIT_L(0); MMA(0, 1, At, B1); BAR;
      LDA(At, 1, 1); BAR; WAIT_L(0); MMA(1, 0, At, B0); MMA(1, 1, At, B1); BAR; }
    if (wr == 0) BAR;
    if constexpr (Epi::PERM) epi_big8(epi, acc, brow, bcol, wr, wc, fr, fq); else epi_big(epi, acc, brow, bcol, wr, wc, fr, fq);
    __syncthreads();
#undef SA
#undef SB
#undef STAGE
#undef LDA
#undef LDB
#undef MMA
}

DEV void tile_of(int L, int nM, int nN, int& pm, int& pn) {
    const int nwg = nM * nN; int wgid = L;
    { const int q = nwg / 8, r = nwg % 8, xcd = wgid % 8, off = wgid / 8; wgid = (xcd < r ? xcd * (q + 1) : r * (q + 1) + (xcd - r) * q) + off; }
    const int nig = 8 * nN, gid = wgid / nig, fm = gid * 8, gsz = (nM - fm) < 8 ? (nM - fm) : 8;
    pm = fm + ((wgid % nig) % gsz); pn = (wgid % nig) / gsz;
}

struct EpiBf16 {
    static constexpr bool PERM = true;
    bf16_t* dst; int ld; const float* rstd;
    struct Ld8 { int unused; };
    DEV void load8(int row, int col8, Ld8& d) const { d.unused = 0; }
    DEV float rowload(int row) const { return rstd ? rstd[row] : 1.f; }
    DEV void apply8(int row, int col8, const f32x4& v0, const f32x4& v1, const Ld8& d, float& ss, float rs) const {
        u32x4 o; o.x = pk2(v0[0] * rs, v0[1] * rs); o.y = pk2(v0[2] * rs, v0[3] * rs); o.z = pk2(v1[0] * rs, v1[1] * rs); o.w = pk2(v1[2] * rs, v1[3] * rs);
        *(u32x4*)(dst + (long)row * ld + col8) = o;
    }
    DEV void rowdone(int row, float ss, int fq, int slot) const {}
};
struct EpiGlu {
    static constexpr bool PERM = true;
    bf16_t* proj; const float* glu_b;
    struct Ld8 { u32x4 g, z; f32x4 b0, b1; };
    DEV void load8(int row, int col8, Ld8& d) const {
        d.g = *(const u32x4*)(proj + (long)row * PLD + C_UB + col8); d.z = *(const u32x4*)(proj + (long)row * PLD + C_ZB + col8);
        d.b0 = *(const f32x4*)(glu_b + col8); d.b1 = *(const f32x4*)(glu_b + col8 + 4);
    }
    DEV void apply8(int row, int col8, const f32x4& v0, const f32x4& v1, const Ld8& d, float& ss, float rowv) const {
        u32x4 o;
        o.x = pk2(bflo(d.g.x) * sigmf(v0[0] + d.b0[0]) * siluf(bflo(d.z.x)), bfhi(d.g.x) * sigmf(v0[1] + d.b0[1]) * siluf(bfhi(d.z.x)));
        o.y = pk2(bflo(d.g.y) * sigmf(v0[2] + d.b0[2]) * siluf(bflo(d.z.y)), bfhi(d.g.y) * sigmf(v0[3] + d.b0[3]) * siluf(bfhi(d.z.y)));
        o.z = pk2(bflo(d.g.z) * sigmf(v1[0] + d.b1[0]) * siluf(bflo(d.z.z)), bfhi(d.g.z) * sigmf(v1[1] + d.b1[1]) * siluf(bfhi(d.z.z)));
        o.w = pk2(bflo(d.g.w) * sigmf(v1[2] + d.b1[2]) * siluf(bflo(d.z.w)), bfhi(d.g.w) * sigmf(v1[3] + d.b1[3]) * siluf(bfhi(d.z.w)));
        *(u32x4*)(proj + (long)row * PLD + C_ZB + col8) = o;
    }
    struct Ld { u32x2 g, z; f32x4 b; };
    DEV void load(int row, int col, Ld& d) const {
        d.g = *(const u32x2*)(proj + (long)row * PLD + C_UB + col); d.z = *(const u32x2*)(proj + (long)row * PLD + C_ZB + col); d.b = *(const f32x4*)(glu_b + col);
    }
    DEV void apply(int row, int col, const f32x4& v, const Ld& d, float& ss, float rowv) const {
        const float y0 = bflo(d.g.x) * sigmf(v[0] + d.b[0]) * siluf(bflo(d.z.x)), y1 = bfhi(d.g.x) * sigmf(v[1] + d.b[1]) * siluf(bfhi(d.z.x));
        const float y2 = bflo(d.g.y) * sigmf(v[2] + d.b[2]) * siluf(bflo(d.z.y)), y3 = bfhi(d.g.y) * sigmf(v[3] + d.b[3]) * siluf(bfhi(d.z.y));
        u32x2 o; o.x = pk2(y0, y1); o.y = pk2(y2, y3);
        *(u32x2*)(proj + (long)row * PLD + C_ZB + col) = o;
    }
    DEV float rowload(int row) const { return 0.f; }
    DEV void rowdone(int row, float ss, int fq, int slot) const {}
    DEV void rowput(int row, float tot, int slot) const {}
};
struct EpiOut {
    static constexpr bool PERM = true;
    const float* xp; const float* xs; bf16_t* h1b; float* rss;
    struct Ld8 { f32x4 x0, x1; };
    DEV void load8(int row, int col8, Ld8& d) const {
        const float* xrow = row < NPROMPT ? xp + (long)row * 1024 : xs + (long)(row - NPROMPT) * 1024;
        d.x0 = *(const f32x4*)(xrow + col8); d.x1 = *(const f32x4*)(xrow + col8 + 4);
    }
    DEV void apply8(int row, int col8, const f32x4& a0, const f32x4& a1, const Ld8& d, float& ss, float rowv) const {
        const f32x4 v0 = a0 + d.x0, v1 = a1 + d.x1;
        u32x4 o; o.x = pk2(v0[0], v0[1]); o.y = pk2(v0[2], v0[3]); o.z = pk2(v1[0], v1[1]); o.w = pk2(v1[2], v1[3]);
        *(u32x4*)(h1b + (long)row * 1024 + col8) = o;
        const float r0 = bflo(o.x), r1 = bfhi(o.x), r2 = bflo(o.y), r3 = bfhi(o.y), r4 = bflo(o.z), r5 = bfhi(o.z), r6 = bflo(o.w), r7 = bfhi(o.w);
        ss += ((r0 * r0 + r1 * r1) + (r2 * r2 + r3 * r3)) + ((r4 * r4 + r5 * r5) + (r6 * r6 + r7 * r7));
    }
    struct Ld { f32x4 x; };
    DEV void load(int row, int col, Ld& d) const {
        const float* xrow = row < NPROMPT ? xp + (long)row * 1024 : xs + (long)(row - NPROMPT) * 1024;
        d.x = *(const f32x4*)(xrow + col);
    }
    DEV void apply(int row, int col, const f32x4& a, const Ld& d, float& ss, float rowv) const {
        const f32x4 v = a + d.x;
        u32x2 o; o.x = pk2(v[0], v[1]); o.y = pk2(v[2], v[3]);
        *(u32x2*)(h1b + (long)row * 1024 + col) = o;
        const float r0 = bflo(o.x), r1 = bfhi(o.x), r2 = bflo(o.y), r3 = bfhi(o.y);
        ss += r0 * r0 + r1 * r1 + r2 * r2 + r3 * r3;
    }
    DEV float rowload(int row) const { return 0.f; }
    DEV void rowdone(int row, float ss, int fq, int slot) const {
        ss += __shfl_xor(ss, 16); ss += __shfl_xor(ss, 32);
        if (fq == 0) rss[(long)row * 16 + slot] = ss;
    }
    DEV void rowput(int row, float tot, int slot) const { rss[(long)row * 16 + slot] = tot; rss[(long)row * 16 + slot + 1] = 0.f; }
};
struct EpiPle {
    static constexpr bool PERM = true;
    float* out; const bf16_t* h1b; const bf16_t* pp; const float* rss1; float* rss2;
    struct Ld8 { u32x4 h, pv; };
    DEV void load8(int row, int col8, Ld8& d) const {
        d.h = *(const u32x4*)(h1b + (long)row * 1024 + col8); d.pv = *(const u32x4*)(pp + (long)row * 1024 + col8);
    }
    DEV void apply8(int row, int col8, const f32x4& a0, const f32x4& a1, const Ld8& d, float& ss, float rowv) const {
        const float rstd = rsqrtf(rowv * (1.f / 1024.f) + EPS);
        f32x4 h0, h1;
        h0[0] = bflo(d.h.x) + bflo(d.pv.x) * sigmf(a0[0] * rstd); h0[1] = bfhi(d.h.x) + bfhi(d.pv.x) * sigmf(a0[1] * rstd);
        h0[2] = bflo(d.h.y) + bflo(d.pv.y) * sigmf(a0[2] * rstd); h0[3] = bfhi(d.h.y) + bfhi(d.pv.y) * sigmf(a0[3] * rstd);
        h1[0] = bflo(d.h.z) + bflo(d.pv.z) * sigmf(a1[0] * rstd); h1[1] = bfhi(d.h.z) + bfhi(d.pv.z) * sigmf(a1[1] * rstd);
        h1[2] = bflo(d.h.w) + bflo(d.pv.w) * sigmf(a1[2] * rstd); h1[3] = bfhi(d.h.w) + bfhi(d.pv.w) * sigmf(a1[3] * rstd);
        *(f32x4*)(out + (long)row * 1024 + col8) = h0; *(f32x4*)(out + (long)row * 1024 + col8 + 4) = h1;
        ss += ((h0[0] * h0[0] + h0[1] * h0[1]) + (h0[2] * h0[2] + h0[3] * h0[3])) + ((h1[0] * h1[0] + h1[1] * h1[1]) + (h1[2] * h1[2] + h1[3] * h1[3]));
    }
    struct Ld { u32x2 h; u32x2 pv; };
    DEV void load(int row, int col, Ld& d) const {
        d.h = *(const u32x2*)(h1b + (long)row * 1024 + col); d.pv = *(const u32x2*)(pp + (long)row * 1024 + col);
    }
    DEV void apply(int row, int col, const f32x4& a, const Ld& d, float& ss, float rowv) const {
        const float rstd = rsqrtf(rowv * (1.f / 1024.f) + EPS);
        f32x4 h;
        h[0] = bflo(d.h.x) + bflo(d.pv.x) * sigmf(a[0] * rstd); h[1] = bfhi(d.h.x) + bfhi(d.pv.x) * sigmf(a[1] * rstd);
        h[2] = bflo(d.h.y) + bflo(d.pv.y) * sigmf(a[2] * rstd); h[3] = bfhi(d.h.y) + bfhi(d.pv.y) * sigmf(a[3] * rstd);
        *(f32x4*)(out + (long)row * 1024 + col) = h;
        ss += h[0] * h[0] + h[1] * h[1] + h[2] * h[2] + h[3] * h[3];
    }
    DEV float rowload(int row) const {
        const f32x4 a = *(const f32x4*)(rss1 + (long)row * 16), b = *(const f32x4*)(rss1 + (long)row * 16 + 4), c = *(const f32x4*)(rss1 + (long)row * 16 + 8), d = *(const f32x4*)(rss1 + (long)row * 16 + 12);
        return (((a[0] + a[1]) + (a[2] + a[3])) + ((b[0] + b[1]) + (b[2] + b[3]))) + (((c[0] + c[1]) + (c[2] + c[3])) + ((d[0] + d[1]) + (d[2] + d[3])));
    }
    DEV void rowdone(int row, float ss, int fq, int slot) const {
        ss += __shfl_xor(ss, 16); ss += __shfl_xor(ss, 32);
        if (fq == 0) rss2[(long)row * 16 + slot] = ss;
    }
    DEV void rowput(int row, float tot, int slot) const { rss2[(long)row * 16 + slot] = tot; rss2[(long)row * 16 + slot + 1] = 0.f; }
};
template <class Epi>
DEV void epi_big8(const Epi& E, const f32x4 (&acc)[2][2][4][2], int brow, int bcol, int wr, int wc, int fr, int fq) {
#pragma unroll
    for (int ai = 0; ai < 2; ++ai)
#pragma unroll
        for (int mp = 0; mp < 2; ++mp) {
            typename Epi::Ld8 d[2][2]; float rv[2];
#pragma unroll
            for (int mm = 0; mm < 2; ++mm) {
                const int row = brow + ai * 128 + wr * 64 + (mp * 2 + mm) * 16 + fr;
                rv[mm] = E.rowload(row);
#pragma unroll
                for (int bj = 0; bj < 2; ++bj) E.load8(row, bcol + bj * 128 + wc * 32 + 8 * fq, d[mm][bj]);
            }
#pragma unroll
            for (int mm = 0; mm < 2; ++mm) {
                const int row = brow + ai * 128 + wr * 64 + (mp * 2 + mm) * 16 + fr; float ss = 0.f;
#pragma unroll
                for (int bj = 0; bj < 2; ++bj)
                    E.apply8(row, bcol + bj * 128 + wc * 32 + 8 * fq, acc[ai][bj][mp * 2 + mm][0], acc[ai][bj][mp * 2 + mm][1], d[mm][bj], ss, rv[mm]);
                E.rowdone(row, ss, fq, ((bcol >> 8) & 3) * 4 + wc);
            }
        }
}
template <class Epi>
DEV void epi_big(const Epi& E, const f32x4 (&acc)[2][2][4][2], int brow, int bcol, int wr, int wc, int fr, int fq) {
#pragma unroll
    for (int ai = 0; ai < 2; ++ai)
#pragma unroll
        for (int mp = 0; mp < 2; ++mp) {
            typename Epi::Ld d[2][4]; float rv[2];
#pragma unroll
            for (int mm = 0; mm < 2; ++mm) {
                rv[mm] = E.rowload(brow + ai * 128 + wr * 64 + (mp * 2 + mm) * 16 + fr);
#pragma unroll
                for (int j = 0; j < 4; ++j)
                    E.load(brow + ai * 128 + wr * 64 + (mp * 2 + mm) * 16 + fr, bcol + (j >> 1) * 128 + wc * 32 + (j & 1) * 16 + fq * 4, d[mm][j]);
            }
#pragma unroll
            for (int mm = 0; mm < 2; ++mm) {
                const int row = brow + ai * 128 + wr * 64 + (mp * 2 + mm) * 16 + fr; float ss = 0.f;
#pragma unroll
                for (int j = 0; j < 4; ++j)
                    E.apply(row, bcol + (j >> 1) * 128 + wc * 32 + (j & 1) * 16 + fq * 4, acc[ai][j >> 1][mp * 2 + mm][j & 1], d[mm][j], ss, rv[mm]);
                E.rowdone(row, ss, fq, ((bcol >> 8) & 3) * 4 + wc);
            }
        }
}
template <class Epi>
DEV void gemm_small(const bf16_t* __restrict__ A, int lda, const bf16_t* __restrict__ Bt, int ldb, int K, int row0, int col0, const Epi& E) {
    const int tid = tid_fresh(), w = tid >> 6, lane = tid & 63, fr = lane & 15, fq = lane >> 4;
    const int kw = K >> 3;
    const bf16_t* ap = A + (long)(row0 + fr) * lda + w * kw + fq * 8;
    const bf16_t* bp = Bt + (long)(col0 + fr) * ldb + w * kw + fq * 8;
    f32x4 pacc[8];
#pragma unroll
    for (int n = 0; n < 8; ++n) pacc[n] = (f32x4){0.f, 0.f, 0.f, 0.f};
    for (int k0 = 0; k0 < kw; k0 += 128) {
        bf16x8 af[4], bf[4][8];
#pragma unroll
        for (int ks = 0; ks < 4; ++ks) {
            af[ks] = *(const bf16x8*)(ap + k0 + ks * 32);
#pragma unroll
            for (int n = 0; n < 8; ++n) bf[ks][n] = *(const bf16x8*)(bp + (long)n * 16 * ldb + k0 + ks * 32);
        }
#pragma unroll
        for (int ks = 0; ks < 4; ++ks)
#pragma unroll
            for (int n = 0; n < 8; ++n) pacc[n] = mfma16(bf[ks][n], af[ks], pacc[n]);
    }
    float* redk = (float*)smem;
    __syncthreads();
#pragma unroll
    for (int n = 0; n < 8; ++n) *(f32x4*)(redk + ((w * 8 + n) * 64 + lane) * 4) = pacc[n];
    __syncthreads();
    f32x4 acc = (f32x4){0.f, 0.f, 0.f, 0.f};
#pragma unroll
    for (int i = 0; i < 8; ++i) acc += *(const f32x4*)(redk + ((i * 8 + w) * 64 + lane) * 4);
    const int row = row0 + fr, col = col0 + w * 16 + fq * 4;
    typename Epi::Ld d;
    E.load(row, col, d);
    const float rv = E.rowload(row);
    float ss = 0.f;
    E.apply(row, col, acc, d, ss, rv);
    ss += __shfl_xor(ss, 16); ss += __shfl_xor(ss, 32);
    float* red = (float*)smem;
    __syncthreads();
    if (fq == 0) red[w * 16 + fr] = ss;
    __syncthreads();
    if (tid < 16) {
        float t = 0.f;
#pragma unroll
        for (int i = 0; i < 8; ++i) t += red[i * 16 + tid];
        E.rowput(row0 + tid, t, (col0 >> 7) * 2);
    }
    __syncthreads();
}

DEV void transpose_item(const float* __restrict__ src, int ldsrc, int k0, int c0, bf16_t* __restrict__ dst, int lddst, int n0,
                        const float* __restrict__ kscale, float* scr, int lane) {
    const int cl = lane & 31, kh = lane >> 5;
    float v[32];
#pragma unroll
    for (int i = 0; i < 32; ++i) v[i] = src[(long)(k0 + 2 * i + kh) * ldsrc + c0 + cl];
    if (kscale) {
#pragma unroll
        for (int i = 0; i < 32; ++i) v[i] *= kscale[k0 + 2 * i + kh];
    }
#pragma unroll
    for (int i = 0; i < 32; ++i) scr[(2 * i + kh) * 33 + cl] = v[i];
    lds_fence();
    const int c = lane & 7;
#pragma unroll
    for (int j = 0; j < 4; ++j) {
        const int n = (lane >> 3) + 8 * j; const float* sp = scr + (8 * c) * 33 + n;
        u32x4 o; o.x = pk2(sp[0 * 33], sp[1 * 33]); o.y = pk2(sp[2 * 33], sp[3 * 33]); o.z = pk2(sp[4 * 33], sp[5 * 33]); o.w = pk2(sp[6 * 33], sp[7 * 33]);
        *(u32x4*)(dst + (long)(n0 + n) * lddst + k0 + 8 * c) = o;
    }
    lds_fence();
}

DEV void phase0(const Params& P) {
    const int tid = tid_fresh(), lane = tid & 63, wave = tid >> 6, G = gridDim.x, bid = blockIdx.x;
    char* ws = P.ws;
    float* tile = (float*)smem;
    {
        float* scr = (float*)smem + wave * (64 * 33);
        constexpr int I_IN = 144 * 16, I_OUT = 32 * 32, I_GLU = 32 * 16, I_GATE = 32 * 16, I_PPW = 32 * 4;
        constexpr int I_ALL = I_IN + I_OUT + I_GLU + I_GATE + I_PPW;
        for (int it = bid * 8 + wave; it < I_ALL; it += G * 8) {
            int r = it;
            if (r < I_IN) {
                const int nb = r >> 4, kb = r & 15, n0 = nb * 32;
                int c0;
                if (n0 < 1024) c0 = n0; else if (n0 < 2048) c0 = 2576 + (n0 - 1024); else if (n0 < 3584) c0 = 1024 + (n0 - 2048); else c0 = 3600 + (n0 - 3584);
                transpose_item(P.in[I_WIN], 4624, kb * 64, c0, (bf16_t*)(ws + W_WTIN), 1024, n0, P.in[I_GIN], scr, lane); continue;
            }
            r -= I_IN;
            if (r < I_OUT) { const int nb = r >> 5, kb = r & 31; transpose_item(P.in[I_WOUT], 1024, kb * 64, nb * 32, (bf16_t*)(ws + W_WTOUT), 2048, nb * 32, nullptr, scr, lane); continue; }
            r -= I_OUT;
            if (r < I_GLU) { const int nb = r >> 4, kb = r & 15; transpose_item(P.in[I_GLUW], 1024, kb * 64, nb * 32, (bf16_t*)(ws + W_WTGLU), 1024, nb * 32, nullptr, scr, lane); continue; }
            r -= I_GLU;
            if (r < I_GATE) { const int nb = r >> 4, kb = r & 15; transpose_item(P.in[I_WGATE], 1024, kb * 64, nb * 32, (bf16_t*)(ws + W_WTGATE), 1024, nb * 32, P.in[I_GPLE], scr, lane); continue; }
            r -= I_GATE;
            { const int nb = r >> 2, kb = r & 3; transpose_item(P.in[I_WPP], 1024, kb * 64, nb * 32, (bf16_t*)(ws + W_WTPP), 256, nb * 32, nullptr, scr, lane); }
        }
        __syncthreads();
    }
    bf16_t* wdt = (bf16_t*)smem;
    float* psum = (float*)(smem + 16 * 1032 * 2);
    float* pdt = psum + 128;
    {
        float wv[32];
#pragma unroll
        for (int i = 0; i < 32; ++i) { const int idx = tid + i * 512, k = idx >> 4, e = idx & 15; wv[i] = P.in[I_WIN][(long)k * 4624 + 2560 + e] * P.in[I_GIN][k]; }
#pragma unroll
        for (int i = 0; i < 32; ++i) { const int idx = tid + i * 512, k = idx >> 4, e = idx & 15; wdt[e * 1032 + k] = (bf16_t)(pk2(wv[i], 0.f) & 0xffffu); }
    }
    __syncthreads();
    {
        const int fr = lane & 15, fq = lane >> 4;
        bf16x8 wf[4];
#pragma unroll
        for (int j = 0; j < 4; ++j) wf[j] = *(const bf16x8*)(wdt + fr * 1032 + (wave * 4 + j) * 32 + fq * 8);
        bf16_t* xb = (bf16_t*)(ws + W_NB);
        float* dtr = (float*)(ws + W_DTR);
        float* rstdp = (float*)(ws + W_RSTD);
        f32x4 xan[4], xcn[4];
        if (bid < NTOK / 16) {
            const int row = bid * 16 + fr;
            const float* xr = (row < NPROMPT ? P.in[I_XP] + (long)row * 1024 : P.in[I_XS] + (long)(row - NPROMPT) * 1024) + wave * 128 + fq * 8;
#pragma unroll
            for (int j = 0; j < 4; ++j) { xan[j] = *(const f32x4*)(xr + j * 32); xcn[j] = *(const f32x4*)(xr + j * 32 + 4); }
        }
        for (int task = bid; task < NTOK / 16; task += G) {
            const int row = task * 16 + fr;
            f32x4 xa[4], xc[4];
#pragma unroll
            for (int j = 0; j < 4; ++j) { xa[j] = xan[j]; xc[j] = xcn[j]; }
            if (task + G < NTOK / 16) {
                const int rown = (task + G) * 16 + fr;
                const float* xr = (rown < NPROMPT ? P.in[I_XP] + (long)rown * 1024 : P.in[I_XS] + (long)(rown - NPROMPT) * 1024) + wave * 128 + fq * 8;
#pragma unroll
                for (int j = 0; j < 4; ++j) { xan[j] = *(const f32x4*)(xr + j * 32); xcn[j] = *(const f32x4*)(xr + j * 32 + 4); }
            }
            f32x4 acc = {0.f, 0.f, 0.f, 0.f}; float ss = 0.f;
#pragma unroll
            for (int j = 0; j < 4; ++j) {
                ss += xa[j][0] * xa[j][0] + xa[j][1] * xa[j][1] + xa[j][2] * xa[j][2] + xa[j][3] * xa[j][3] + xc[j][0] * xc[j][0] + xc[j][1] * xc[j][1] + xc[j][2] * xc[j][2] + xc[j][3] * xc[j][3];
                u32x4 q; q.x = pk2(xa[j][0], xa[j][1]); q.y = pk2(xa[j][2], xa[j][3]); q.z = pk2(xc[j][0], xc[j][1]); q.w = pk2(xc[j][2], xc[j][3]);
                *(u32x4*)(xb + (long)row * 1024 + wave * 128 + j * 32 + fq * 8) = q;
                acc = mfma16(wf[j], __builtin_bit_cast(bf16x8, q), acc);
            }
            ss += __shfl_xor(ss, 16); ss += __shfl_xor(ss, 32);
            if (fq == 0) psum[wave * 16 + fr] = ss;
            *(f32x4*)(pdt + wave * 256 + fr * 16 + fq * 4) = acc;
            __syncthreads();
            if (tid < 256) {
                const int t = tid >> 4, e = tid & 15;
                float tot = 0.f, d = 0.f;
#pragma unroll
                for (int w8 = 0; w8 < 8; ++w8) { tot += psum[w8 * 16 + t]; d += pdt[w8 * 256 + t * 16 + e]; }
                const float rstd = rsqrtf(tot * (1.f / 1024.f) + EPS);
                dtr[(long)(task * 16 + t) * 16 + e] = d * rstd;
                if (e == 0) rstdp[task * 16 + t] = rstd;
            }
            __syncthreads();
        }
    }
    bf16_t* pb = (bf16_t*)(ws + W_PB);
    for (int idx = bid * 512 + tid; idx < NTOK * 64; idx += G * 512) {
        const int row = idx >> 6, c4 = (idx & 63) * 4;
        const float* src = row < NPROMPT ? P.in[I_PP] + (long)row * 256 : P.in[I_PS] + (long)(row - NPROMPT) * 256;
        const f32x4 v = *(const f32x4*)(src + c4);
        u32x2 o; o.x = pk2(v[0], v[1]); o.y = pk2(v[2], v[3]);
        *(u32x2*)(pb + (long)row * 256 + c4) = o;
    }
    __syncthreads();
}

DEV void conv_load7(const bf16_t* __restrict__ pcol, long row0, int t0, u32x4 (&raw)[7]) {
#pragma unroll
    for (int i = 0; i < 7; ++i) {
        const int t = t0 - 3 + i;
        raw[i] = (u32x4){0u, 0u, 0u, 0u};
        if (t >= 0) raw[i] = *(const u32x4*)(pcol + (row0 - 3 + i) * PLD);
    }
}
DEV void conv_compute(const u32x4 (&rawp)[7], const float* __restrict__ cw, const float* __restrict__ cb, float (&o)[4][8]) {
    float raw[7][8];
#pragma unroll
    for (int i = 0; i < 7; ++i) {
        const u32x4 u = rawp[i];
        raw[i][0] = bflo(u.x); raw[i][1] = bfhi(u.x); raw[i][2] = bflo(u.y); raw[i][3] = bfhi(u.y);
        raw[i][4] = bflo(u.z); raw[i][5] = bfhi(u.z); raw[i][6] = bflo(u.w); raw[i][7] = bfhi(u.w);
    }
    float w[4][8], bias[8];
#pragma unroll
    for (int k = 0; k < 4; ++k) {
        const f32x4 a = *(const f32x4*)(cw + k * 1536), b = *(const f32x4*)(cw + k * 1536 + 4);
        w[k][0] = a[0]; w[k][1] = a[1]; w[k][2] = a[2]; w[k][3] = a[3]; w[k][4] = b[0]; w[k][5] = b[1]; w[k][6] = b[2]; w[k][7] = b[3];
    }
    { const f32x4 a = *(const f32x4*)(cb), b = *(const f32x4*)(cb + 4);
      bias[0] = a[0]; bias[1] = a[1]; bias[2] = a[2]; bias[3] = a[3]; bias[4] = b[0]; bias[5] = b[1]; bias[6] = b[2]; bias[7] = b[3]; }
#pragma unroll
    for (int j = 0; j < 4; ++j)
#pragma unroll
        for (int c = 0; c < 8; ++c) {
            float a = bias[c];
#pragma unroll
            for (int k = 0; k < 4; ++k) a += w[k][c] * raw[j + k][c];
            o[j][c] = siluf(a);
        }
}
DEV void conv_compute_lds(const u32x4 (&rawp)[7], const float* cwl, float (&o)[4][8]) {
    float raw[7][8];
#pragma unroll
    for (int i = 0; i < 7; ++i) {
        const u32x4 u = rawp[i];
        raw[i][0] = bflo(u.x); raw[i][1] = bfhi(u.x); raw[i][2] = bflo(u.y); raw[i][3] = bfhi(u.y);
        raw[i][4] = bflo(u.z); raw[i][5] = bfhi(u.z); raw[i][6] = bflo(u.w); raw[i][7] = bfhi(u.w);
    }
    float w[5][8];
#pragma unroll
    for (int k = 0; k < 5; ++k) {
        const f32x4 a = *(const f32x4*)(cwl + k * 512), b = *(const f32x4*)(cwl + k * 512 + 4);
        w[k][0] = a[0]; w[k][1] = a[1]; w[k][2] = a[2]; w[k][3] = a[3]; w[k][4] = b[0]; w[k][5] = b[1]; w[k][6] = b[2]; w[k][7] = b[3];
    }
#pragma unroll
    for (int j = 0; j < 4; ++j)
#pragma unroll
        for (int c = 0; c < 8; ++c) {
            float a = w[4][c];
#pragma unroll
            for (int k = 0; k < 4; ++k) a += w[k][c] * raw[j + k][c];
            o[j][c] = siluf(a);
        }
}
DEV void conv4x8(const bf16_t* __restrict__ pcol, long row0, int t0, const float* __restrict__ hist, const float* __restrict__ cw, const float* __restrict__ cb, float (&o)[4][8]) {
    float raw[7][8];
#pragma unroll
    for (int i = 0; i < 7; ++i) {
        const int t = t0 - 3 + i;
        if (t >= 0) {
            const u32x4 u = *(const u32x4*)(pcol + (row0 - 3 + i) * PLD);
            raw[i][0] = bflo(u.x); raw[i][1] = bfhi(u.x); raw[i][2] = bflo(u.y); raw[i][3] = bfhi(u.y);
            raw[i][4] = bflo(u.z); raw[i][5] = bfhi(u.z); raw[i][6] = bflo(u.w); raw[i][7] = bfhi(u.w);
        } else if (hist) {
            const f32x4 a = *(const f32x4*)(hist + (long)(t + 3) * 1536), b = *(const f32x4*)(hist + (long)(t + 3) * 1536 + 4);
            raw[i][0] = a[0]; raw[i][1] = a[1]; raw[i][2] = a[2]; raw[i][3] = a[3]; raw[i][4] = b[0]; raw[i][5] = b[1]; raw[i][6] = b[2]; raw[i][7] = b[3];
        } else {
#pragma unroll
            for (int c = 0; c < 8; ++c) raw[i][c] = 0.f;
        }
    }
    float w[4][8], bias[8];
#pragma unroll
    for (int k = 0; k < 4; ++k) {
        const f32x4 a = *(const f32x4*)(cw + k * 1536), b = *(const f32x4*)(cw + k * 1536 + 4);
        w[k][0] = a[0]; w[k][1] = a[1]; w[k][2] = a[2]; w[k][3] = a[3]; w[k][4] = b[0]; w[k][5] = b[1]; w[k][6] = b[2]; w[k][7] = b[3];
    }
    { const f32x4 a = *(const f32x4*)(cb), b = *(const f32x4*)(cb + 4);
      bias[0] = a[0]; bias[1] = a[1]; bias[2] = a[2]; bias[3] = a[3]; bias[4] = b[0]; bias[5] = b[1]; bias[6] = b[2]; bias[7] = b[3]; }
#pragma unroll
    for (int j = 0; j < 4; ++j)
#pragma unroll
        for (int c = 0; c < 8; ++c) {
            float a = bias[c];
#pragma unroll
            for (int k = 0; k < 4; ++k) a += w[k][c] * raw[j + k][c];
            o[j][c] = siluf(a);
        }
}

constexpr int PIT = 136;
constexpr int R1_OFF = 0, R2_OFF = 128 * PIT * 2, R3_OFF = 2 * 128 * PIT * 2, R4_OFF = 3 * 128 * PIT * 2;

DEV void ssd_s1_item(const Params& P, int item) {
    const int tid = tid_fresh(), lane = tid & 63, w = tid >> 6, fr = lane & 15, fq = lane >> 4;
    const int b = item >> 5, c = (item >> 1) & 15, g = item & 1;
    char* ws = P.ws;
    const bf16_t* proj = (const bf16_t*)(ws + W_PROJ);
    const long rowc = (long)b * 2048 + c * 128;
    bf16_t* R1 = (bf16_t*)(smem + R1_OFF); bf16_t* R2 = (bf16_t*)(smem + R2_OFF); bf16_t* R3 = (bf16_t*)(smem + R3_OFF);
    float* acs = (float*)(smem + R4_OFF);
    float* dtv = acs + 1024;
    {
        const int h = g * 8 + w;
        const float bias = P.in[I_DTB][h], A = -__expf(P.in[I_ALOG][h]);
        const float* dtr = (const float*)(ws + W_DTR);
        float x0 = dtr[(rowc + 2 * lane) * 16 + h] + bias, x1 = dtr[(rowc + 2 * lane + 1) * 16 + h] + bias;
        float d0 = x0 > 20.f ? x0 : log1pf(__expf(x0)), d1 = x1 > 20.f ? x1 : log1pf(__expf(x1));
        float a0 = d0 * A, a1 = a0 + d1 * A;
        float run = a1;
#pragma unroll
        for (int o = 1; o < 64; o <<= 1) { float t = __shfl_up(run, o); if (lane >= o) run += t; }
        const float excl = run - a1;
        a0 += excl; a1 += excl;
        acs[w * 128 + 2 * lane] = a0; acs[w * 128 + 2 * lane + 1] = a1;
        dtv[w * 128 + 2 * lane] = d0; dtv[w * 128 + 2 * lane + 1] = d1;
        float* acsg = (float*)(ws + W_ACS) + (((long)b * 16 + c) * 16 + h) * 128;
        acsg[2 * lane] = a0; acsg[2 * lane + 1] = a1;
        if (lane == 63) ((float*)(ws + W_CDEC))[(b * 16 + c) * 16 + h] = __expf(a1);
    }
    float* cwl = (float*)(smem + R4_OFF + 8192);
    for (int u = tid; u < 5 * 512; u += 512) { const int k = u >> 9, ch = u & 511; cwl[u] = k < 4 ? P.in[I_CONVW][k * 1536 + g * 512 + ch] : P.in[I_CONVB][g * 512 + ch]; }
    {
        const int nblk = tid & 15, lq = tid >> 4, l0 = lq * 4;
#pragma unroll
        for (int j = 0; j < 2; ++j) {
            const int ch0 = 1024 + j * 256 + g * 128 + nblk * 8;
            float o[4][8];
            conv4x8(proj + C_XBC + ch0, rowc + l0, c * 128 + l0, nullptr, P.in[I_CONVW] + ch0, P.in[I_CONVB] + ch0, o);
            bf16_t* dst = j == 0 ? R2 : R1;
#pragma unroll
            for (int r = 0; r < 4; ++r) {
                u32x4 q; q.x = pk2(o[r][0], o[r][1]); q.y = pk2(o[r][2], o[r][3]); q.z = pk2(o[r][4], o[r][5]); q.w = pk2(o[r][6], o[r][7]);
                *(u32x4*)(dst + (l0 + r) * PIT + nblk * 8) = q;
            }
            if (j == 0) {
#pragma unroll
                for (int i = 0; i < 8; ++i) {
                    u32x2 q; q.x = pk2(o[0][i], o[1][i]); q.y = pk2(o[2][i], o[3][i]);
                    *(u32x2*)(R3 + (nblk * 8 + i) * PIT + l0) = q;
                }
            }
        }
    }
    __syncthreads();
    const int wr = w >> 1, wc = w & 1;
    f32x4 cbm[2][4];
#pragma unroll
    for (int m = 0; m < 2; ++m)
#pragma unroll
        for (int n = 0; n < 4; ++n) cbm[m][n] = (f32x4){0.f, 0.f, 0.f, 0.f};
#pragma unroll
    for (int ks = 0; ks < 4; ++ks) {
        bf16x8 af[2], bfm[4];
#pragma unroll
        for (int m = 0; m < 2; ++m) af[m] = *(const bf16x8*)(R1 + (wr * 32 + m * 16 + fr) * PIT + ks * 32 + fq * 8);
#pragma unroll
        for (int n = 0; n < 4; ++n) bfm[n] = *(const bf16x8*)(R2 + (wc * 64 + n * 16 + fr) * PIT + ks * 32 + fq * 8);
#pragma unroll
        for (int m = 0; m < 2; ++m)
#pragma unroll
            for (int n = 0; n < 4; ++n) cbm[m][n] = mfma16(bfm[n], af[m], cbm[m][n]);
    }
    __syncthreads();
    bf16_t* XT = R2; bf16_t* XW = R2 + 64 * PIT;
    bf16_t* ydg = (bf16_t*)(ws + W_NB);
    float* states = P.out;
    const int wp = w >> 2, wn = w & 3;
    u32x4 rawn[7];
    if (tid < 256) conv_load7(proj + C_XBC + (g * 8) * 64 + (tid & 7) * 8, rowc + (tid >> 3) * 4, c * 128 + (tid >> 3) * 4, rawn);
    for (int e = 0; e < 8; ++e) {
        const int h = g * 8 + e;
        const float dskip = P.in[I_SSDD][h];
        if (tid < 256) {
            const int pblk = tid & 7, lq = tid >> 3, l0 = lq * 4, ch0 = h * 64 + pblk * 8;
            float o[4][8];
            conv_compute_lds(rawn, cwl + e * 64 + pblk * 8, o);
            if (e < 7) conv_load7(proj + C_XBC + ch0 + 64, rowc + l0, c * 128 + l0, rawn);
            const float alast = acs[e * 128 + 127];
            float we[4];
#pragma unroll
            for (int r = 0; r < 4; ++r) we[r] = __expf(alast - acs[e * 128 + l0 + r]) * dtv[e * 128 + l0 + r];
#pragma unroll
            for (int i = 0; i < 8; ++i) {
                u32x2 q; q.x = pk2(o[0][i], o[1][i]); q.y = pk2(o[2][i], o[3][i]);
                *(u32x2*)(XT + (pblk * 8 + i) * PIT + l0) = q;
                u32x2 q2; q2.x = pk2(o[0][i] * we[0], o[1][i] * we[1]); q2.y = pk2(o[2][i] * we[2], o[3][i] * we[3]);
                *(u32x2*)(XW + (pblk * 8 + i) * PIT + l0) = q2;
            }
        }
#pragma unroll
        for (int m = 0; m < 2; ++m) {
            const int l = wr * 32 + m * 16 + fr; const float al = acs[e * 128 + l];
#pragma unroll
            for (int n = 0; n < 4; ++n) {
                const int s0 = wc * 64 + n * 16 + fq * 4;
                const f32x4 as = *(const f32x4*)(acs + e * 128 + s0), ds = *(const f32x4*)(dtv + e * 128 + s0);
                float v[4];
#pragma unroll
                for (int r = 0; r < 4; ++r) { const float t = cbm[m][n][r] * __expf(al - as[r]) * ds[r]; v[r] = (s0 + r <= l) ? t : 0.f; }
                u32x2 q; q.x = pk2(v[0], v[1]); q.y = pk2(v[2], v[3]);
                *(u32x2*)(R1 + l * PIT + s0) = q;
            }
        }
        __syncthreads();
        {
            f32x4 yd[2][2];
#pragma unroll
            for (int m = 0; m < 2; ++m)
#pragma unroll
                for (int n = 0; n < 2; ++n) yd[m][n] = (f32x4){0.f, 0.f, 0.f, 0.f};
            {
                bf16x8 af[4][2], bfm[4][2];
#pragma unroll
                for (int ks = 0; ks < 4; ++ks) {
#pragma unroll
                    for (int m = 0; m < 2; ++m) af[ks][m] = *(const bf16x8*)(R1 + (wr * 32 + m * 16 + fr) * PIT + ks * 32 + fq * 8);
#pragma unroll
                    for (int n = 0; n < 2; ++n) bfm[ks][n] = *(const bf16x8*)(XT + (wc * 32 + n * 16 + fr) * PIT + ks * 32 + fq * 8);
                }
                __builtin_amdgcn_sched_barrier(0);
#pragma unroll
                for (int ks = 0; ks < 4; ++ks)
                    if (ks <= wr) {
#pragma unroll
                        for (int m = 0; m < 2; ++m)
#pragma unroll
                            for (int n = 0; n < 2; ++n) yd[m][n] = mfma16(bfm[ks][n], af[ks][m], yd[m][n]);
                    }
            }
#pragma unroll
            for (int m = 0; m < 2; ++m)
#pragma unroll
                for (int n = 0; n < 2; ++n) {
                    const int l = wr * 32 + m * 16 + fr, p0 = wc * 32 + n * 16 + fq * 4;
                    const float x0 = __uint_as_float(((unsigned)XT[(p0 + 0) * PIT + l]) << 16), x1 = __uint_as_float(((unsigned)XT[(p0 + 1) * PIT + l]) << 16);
                    const float x2 = __uint_as_float(((unsigned)XT[(p0 + 2) * PIT + l]) << 16), x3 = __uint_as_float(((unsigned)XT[(p0 + 3) * PIT + l]) << 16);
                    u32x2 q; q.x = pk2(yd[m][n][0] + dskip * x0, yd[m][n][1] + dskip * x1); q.y = pk2(yd[m][n][2] + dskip * x2, yd[m][n][3] + dskip * x3);
                    *(u32x2*)(ydg + (rowc + l) * 1024 + h * 64 + p0) = q;
                }
        }
        {
            f32x4 st[2][2];
#pragma unroll
            for (int m = 0; m < 2; ++m)
#pragma unroll
                for (int n = 0; n < 2; ++n) st[m][n] = (f32x4){0.f, 0.f, 0.f, 0.f};
            {
                bf16x8 af[4][2], bfm[4][2];
#pragma unroll
                for (int ks = 0; ks < 4; ++ks) {
#pragma unroll
                    for (int m = 0; m < 2; ++m) af[ks][m] = *(const bf16x8*)(XW + (wp * 32 + m * 16 + fr) * PIT + ks * 32 + fq * 8);
#pragma unroll
                    for (int n = 0; n < 2; ++n) bfm[ks][n] = *(const bf16x8*)(R3 + (wn * 32 + n * 16 + fr) * PIT + ks * 32 + fq * 8);
                }
                __builtin_amdgcn_sched_barrier(0);
#pragma unroll
                for (int ks = 0; ks < 4; ++ks)
#pragma unroll
                    for (int m = 0; m < 2; ++m)
#pragma unroll
                        for (int n = 0; n < 2; ++n) st[m][n] = mfma16(bfm[ks][n], af[ks][m], st[m][n]);
            }
            float* sp = states + (((long)b * 16 + c) * 16 + h) * 8192;
#pragma unroll
            for (int m = 0; m < 2; ++m)
#pragma unroll
                for (int n = 0; n < 2; ++n) {
                    const int p = wp * 32 + m * 16 + fr, n0 = wn * 32 + n * 16 + fq * 4;
                    *(f32x4*)(sp + p * 128 + n0) = st[m][n];
                }
        }
        __syncthreads();
    }
}

DEV void ssd_s2(const Params& P) {
    float* states = P.out;
    const float* cdec = (const float*)(P.ws + W_CDEC);
    for (int idx = blockIdx.x * 512 + threadIdx.x; idx < 262144; idx += gridDim.x * 512) {
        const int bh = idx >> 11, q = idx & 2047, b = bh >> 4, h = bh & 15;
        f32x4 H = (f32x4){0.f, 0.f, 0.f, 0.f};
#pragma unroll
        for (int c = 0; c < 16; ++c) {
            f32x4* ptr = (f32x4*)(states + (((long)b * 16 + c) * 16 + h) * 8192) + q;
            const f32x4 s = *ptr; *ptr = H;
            const float d = cdec[(b * 16 + c) * 16 + h];
            H = H * d + s;
        }
        *((f32x4*)(P.out + O_SSDP + (long)bh * 8192) + q) = H;
    }
}

DEV void ssd_s3_item(const Params& P, int item) {
    const int tid = tid_fresh(), lane = tid & 63, w = tid >> 6, fr = lane & 15, fq = lane >> 4;
    const int b = item >> 5, c = (item >> 1) & 15, g = item & 1;
    char* ws = P.ws;
    bf16_t* proj = (bf16_t*)(ws + W_PROJ);
    const long rowc = (long)b * 2048 + c * 128;
    bf16_t* R1 = (bf16_t*)(smem + R1_OFF); bf16_t* HB = (bf16_t*)(smem + R2_OFF);
    float* ssq = (float*)(smem + R4_OFF);
    const bf16_t* ydg = (const bf16_t*)(ws + W_NB);
    const float* states = P.out;
    const float* acsg = (const float*)(ws + W_ACS);
    const int hp = tid >> 3, hn0 = (tid & 7) * 16;
    f32x4 hreg[4];
    {
        const float* sp = states + (((long)b * 16 + c) * 16 + g * 8) * 8192 + hp * 128 + hn0;
#pragma unroll
        for (int i = 0; i < 4; ++i) hreg[i] = *(const f32x4*)(sp + i * 4);
    }
    __syncthreads();
    {
        const int nblk = tid & 15, lq = tid >> 4, l0 = lq * 4;
        const int ch0 = 1280 + g * 128 + nblk * 8;
        float o[4][8];
        conv4x8(proj + C_XBC + ch0, rowc + l0, c * 128 + l0, nullptr, P.in[I_CONVW] + ch0, P.in[I_CONVB] + ch0, o);
#pragma unroll
        for (int r = 0; r < 4; ++r) {
            u32x4 q; q.x = pk2(o[r][0], o[r][1]); q.y = pk2(o[r][2], o[r][3]); q.z = pk2(o[r][4], o[r][5]); q.w = pk2(o[r][6], o[r][7]);
            *(u32x4*)(R1 + (l0 + r) * PIT + nblk * 8) = q;
        }
    }
    const int wr = w >> 1, wc = w & 1;
    unsigned ypk[8][2][2][2];
    float ssl[2] = {0.f, 0.f};
    bf16x8 afc[4][2];
#pragma unroll
    for (int e = 0; e < 8; ++e) {
        const int h = g * 8 + e;
        bf16_t* hb = HB + (e & 1) * 64 * PIT;
        {
            u32x4 q0, q1;
            q0.x = pk2(hreg[0][0], hreg[0][1]); q0.y = pk2(hreg[0][2], hreg[0][3]); q0.z = pk2(hreg[1][0], hreg[1][1]); q0.w = pk2(hreg[1][2], hreg[1][3]);
            q1.x = pk2(hreg[2][0], hreg[2][1]); q1.y = pk2(hreg[2][2], hreg[2][3]); q1.z = pk2(hreg[3][0], hreg[3][1]); q1.w = pk2(hreg[3][2], hreg[3][3]);
            *(u32x4*)(hb + hp * PIT + hn0) = q0; *(u32x4*)(hb + hp * PIT + hn0 + 8) = q1;
        }
        if (e < 7) {
            const float* sp = states + (((long)b * 16 + c) * 16 + h + 1) * 8192 + hp * 128 + hn0;
#pragma unroll
            for (int i = 0; i < 4; ++i) hreg[i] = *(const f32x4*)(sp + i * 4);
        }
        u32x2 yq[2][2], zz[2][2]; float ea[2];
#pragma unroll
        for (int m = 0; m < 2; ++m) {
            const int l = wr * 32 + m * 16 + fr;
            ea[m] = acsg[(((long)b * 16 + c) * 16 + h) * 128 + l];
#pragma unroll
            for (int n = 0; n < 2; ++n) {
                const int p0 = wc * 32 + n * 16 + fq * 4;
                yq[m][n] = *(const u32x2*)(ydg + (rowc + l) * 1024 + h * 64 + p0);
                zz[m][n] = *(const u32x2*)(proj + (rowc + l) * PLD + C_ZA + h * 64 + p0);
            }
        }
        __syncthreads();
        if (e == 0) {
#pragma unroll
            for (int ks = 0; ks < 4; ++ks)
#pragma unroll
                for (int m = 0; m < 2; ++m) afc[ks][m] = *(const bf16x8*)(R1 + (wr * 32 + m * 16 + fr) * PIT + ks * 32 + fq * 8);
        }
        f32x4 yo[2][2];
#pragma unroll
        for (int m = 0; m < 2; ++m)
#pragma unroll
            for (int n = 0; n < 2; ++n) yo[m][n] = (f32x4){0.f, 0.f, 0.f, 0.f};
        {
            bf16x8 bfm[4][2];
#pragma unroll
            for (int ks = 0; ks < 4; ++ks)
#pragma unroll
                for (int n = 0; n < 2; ++n) bfm[ks][n] = *(const bf16x8*)(hb + (wc * 32 + n * 16 + fr) * PIT + ks * 32 + fq * 8);
            __builtin_amdgcn_sched_barrier(0);
#pragma unroll
            for (int ks = 0; ks < 4; ++ks)
#pragma unroll
                for (int m = 0; m < 2; ++m)
#pragma unroll
                    for (int n = 0; n < 2; ++n) yo[m][n] = mfma16(bfm[ks][n], afc[ks][m], yo[m][n]);
        }
#pragma unroll
        for (int m = 0; m < 2; ++m) {
            const float eam = __expf(ea[m]);
#pragma unroll
            for (int n = 0; n < 2; ++n) {
                const float v0 = (bflo(yq[m][n].x) + eam * yo[m][n][0]) * siluf(bflo(zz[m][n].x)), v1 = (bfhi(yq[m][n].x) + eam * yo[m][n][1]) * siluf(bfhi(zz[m][n].x));
                const float v2 = (bflo(yq[m][n].y) + eam * yo[m][n][2]) * siluf(bflo(zz[m][n].y)), v3 = (bfhi(yq[m][n].y) + eam * yo[m][n][3]) * siluf(bfhi(zz[m][n].y));
                ssl[m] += v0 * v0 + v1 * v1 + v2 * v2 + v3 * v3;
                ypk[e][m][n][0] = pk2(v0, v1); ypk[e][m][n][1] = pk2(v2, v3);
            }
        }
    }
#pragma unroll
    for (int m = 0; m < 2; ++m) {
        float ss = ssl[m];
        ss += __shfl_xor(ss, 16); ss += __shfl_xor(ss, 32);
        if (fq == 0) ssq[wc * 128 + wr * 32 + m * 16 + fr] = ss;
    }
    f32x4 ggv[8][2];
#pragma unroll
    for (int e = 0; e < 8; ++e)
#pragma unroll
        for (int n = 0; n < 2; ++n) ggv[e][n] = *(const f32x4*)(P.in[I_SSDG] + (g * 8 + e) * 64 + wc * 32 + n * 16 + fq * 4);
    __syncthreads();
#pragma unroll
    for (int m = 0; m < 2; ++m) {
        const int l = wr * 32 + m * 16 + fr;
        const float rstd = rsqrtf((ssq[l] + ssq[128 + l]) * (1.f / 512.f) + EPS);
#pragma unroll
        for (int e = 0; e < 8; ++e)
#pragma unroll
            for (int n = 0; n < 2; ++n) {
                const int h = g * 8 + e, p0 = wc * 32 + n * 16 + fq * 4;
                const f32x4 gg = ggv[e][n];
                const unsigned a0 = ypk[e][m][n][0], a1 = ypk[e][m][n][1];
                u32x2 o; o.x = pk2(bflo(a0) * rstd * gg[0], bfhi(a0) * rstd * gg[1]); o.y = pk2(bflo(a1) * rstd * gg[2], bfhi(a1) * rstd * gg[3]);
                *(u32x2*)(proj + (rowc + l) * PLD + C_ZA + h * 64 + p0) = o;
            }
    }
}

DEV void ssd_sample_item(const Params& P, int item) {
    const int tid = tid_fresh();
    const int b = item >> 1, g = item & 1;
    char* ws = P.ws;
    bf16_t* proj = (bf16_t*)(ws + W_PROJ);
    const long row0 = NPROMPT + (long)b * 4;
    float* xs = (float*)smem;
    float* Bs = xs + 2048;
    float* Cs = Bs + 512;
    float* dts = Cs + 512;
    float* das = dts + 32;
    float* vs = das + 32;
    float* red = vs + 2048;
    float* zs = red + 32;
    for (int u = tid; u < 768; u += 512) {
        int ch; float* dst; int dcol;
        if (u < 512) { ch = g * 512 + u; dst = xs; dcol = u; }
        else if (u < 640) { ch = 1024 + g * 128 + (u - 512); dst = Bs; dcol = u - 512; }
        else { ch = 1280 + g * 128 + (u - 640); dst = Cs; dcol = u - 640; }
        const int pitch = u < 512 ? 512 : 128;
        float full[7];
#pragma unroll
        for (int i = 0; i < 3; ++i) full[i] = P.in[I_CONV][((long)b * 3 + i) * 1536 + ch];
#pragma unroll
        for (int i = 0; i < 4; ++i) full[3 + i] = __uint_as_float(((unsigned)proj[(row0 + i) * PLD + C_XBC + ch]) << 16);
        const float w0 = P.in[I_CONVW][ch], w1 = P.in[I_CONVW][1536 + ch], w2 = P.in[I_CONVW][3072 + ch], w3 = P.in[I_CONVW][4608 + ch], bias = P.in[I_CONVB][ch];
#pragma unroll
        for (int t = 0; t < 4; ++t) dst[t * pitch + dcol] = siluf(bias + w0 * full[t] + w1 * full[t + 1] + w2 * full[t + 2] + w3 * full[t + 3]);
    }
    for (int u = tid; u < 4 * 256; u += 512) {
        const int t = u >> 8, c2 = (u & 255) * 2;
        const unsigned zz = *(const unsigned*)(proj + (row0 + t) * PLD + C_ZA + g * 512 + c2);
        zs[t * 512 + c2] = bflo(zz); zs[t * 512 + c2 + 1] = bfhi(zz);
    }
    if (tid < 32) {
        const int t = tid >> 3, e = tid & 7, h = g * 8 + e;
        const float x = ((const float*)(ws + W_DTR))[(row0 + t) * 16 + h] + P.in[I_DTB][h];
        const float d = x > 20.f ? x : log1pf(__expf(x));
        dts[tid] = d; das[tid] = __expf(-d * __expf(P.in[I_ALOG][h]));
    }
    __syncthreads();
    const int p = tid >> 3, nb = tid & 7, n0 = nb * 16;
    f32x4 hn[4];
    {
        const float* sp0 = P.in[I_SSD] + (((long)b * 16 + g * 8) * 64 + p) * 128 + n0;
#pragma unroll
        for (int i = 0; i < 4; ++i) hn[i] = *(const f32x4*)(sp0 + i * 4);
    }
    for (int e = 0; e < 8; ++e) {
        const int h = g * 8 + e;
        float* op = P.out + O_SSDS + (((long)b * 16 + h) * 64 + p) * 128 + n0;
        f32x4 hv[4];
#pragma unroll
        for (int i = 0; i < 4; ++i) hv[i] = hn[i];
        if (e < 7) {
            const float* sp = P.in[I_SSD] + (((long)b * 16 + h + 1) * 64 + p) * 128 + n0;
#pragma unroll
            for (int i = 0; i < 4; ++i) hn[i] = *(const f32x4*)(sp + i * 4);
        }
        const float dsk = P.in[I_SSDD][h];
        float yv4[4], xv4[4];
#pragma unroll
        for (int t = 0; t < 4; ++t) {
            const float dec = das[t * 8 + e], xv = xs[t * 512 + e * 64 + p], coef = dts[t * 8 + e] * xv;
            float part = 0.f;
#pragma unroll
            for (int i = 0; i < 4; ++i) {
                const f32x4 bv = *(const f32x4*)(Bs + t * 128 + n0 + i * 4), cv = *(const f32x4*)(Cs + t * 128 + n0 + i * 4);
                hv[i] = hv[i] * dec + bv * coef;
                part += hv[i][0] * cv[0] + hv[i][1] * cv[1] + hv[i][2] * cv[2] + hv[i][3] * cv[3];
            }
            yv4[t] = part; xv4[t] = xv;
        }
#pragma unroll
        for (int t = 0; t < 4; ++t) yv4[t] += __shfl_xor(yv4[t], 1);
#pragma unroll
        for (int t = 0; t < 4; ++t) yv4[t] += __shfl_xor(yv4[t], 2);
#pragma unroll
        for (int t = 0; t < 4; ++t) yv4[t] += __shfl_xor(yv4[t], 4);
        if (nb == 0) {
#pragma unroll
            for (int t = 0; t < 4; ++t) vs[t * 512 + e * 64 + p] = (yv4[t] + dsk * xv4[t]) * siluf(zs[t * 512 + e * 64 + p]);
        }
#pragma unroll
        for (int i = 0; i < 4; ++i) *(f32x4*)(op + i * 4) = hv[i];
    }
    __syncthreads();
    {
        const int t = tid >> 7, cidx = tid & 127;
        float v[4]; float ss = 0.f;
#pragma unroll
        for (int i = 0; i < 4; ++i) { v[i] = vs[t * 512 + cidx * 4 + i]; ss += v[i] * v[i]; }
        ss = wave_sum(ss);
        if ((tid & 63) == 0) red[tid >> 6] = ss;
        __syncthreads();
        const float tot = red[t * 2] + red[t * 2 + 1];
        const float rstd = rsqrtf(tot * (1.f / 512.f) + EPS);
        const f32x4 gg = *(const f32x4*)(P.in[I_SSDG] + g * 512 + cidx * 4);
        u32x2 o; o.x = pk2(v[0] * rstd * gg[0], v[1] * rstd * gg[1]); o.y = pk2(v[2] * rstd * gg[2], v[3] * rstd * gg[3]);
        *(u32x2*)(proj + (row0 + t) * PLD + C_ZA + g * 512 + cidx * 4) = o;
    }
    __syncthreads();
}

constexpr int S5P = 20;
template <bool SAMPLE>
DEV void s5_item(const Params& P, int g, long rowbase, int bidx) {
    const int tid = tid_fresh(), lane = tid & 63, w = tid >> 6, fr = lane & 15, fq = lane >> 4;
    constexpr int TPW = SAMPLE ? 16 : 256;
    bf16_t* proj = (bf16_t*)(P.ws + W_PROJ);
    float* buf = (float*)smem + w * (128 * S5P);
    float* carry = (float*)smem + 8 * 128 * S5P;
    float* fs = carry + 1024 + w * 128;
    float ar, ai;
    {
        const float lr = P.in[I_LRE][g * 64 + lane], li = P.in[I_LIM][g * 64 + lane], delta = expf(P.in[I_LDT][g]);
        const float mag = expf(lr * delta), ang = li * delta;
        ar = mag * cosf(ang); ai = mag * sinf(ang);
        const float qre = ar - 1.f, den = lr * lr + li * li;
        fs[lane] = (qre * lr + ai * li) / den; fs[64 + lane] = (ai * lr - qre * li) / den;
    }
    lds_fence();
    bf16x8 bbf[8];
#pragma unroll
    for (int j = 0; j < 8; ++j) {
        bf16x8 z = {0, 0, 0, 0, 0, 0, 0, 0};
        if (fq < 2) {
            const int p = (j & 3) * 16 + fr;
            const float f_r = fs[p], f_i = fs[64 + p];
            const float* br = P.in[I_BRE] + ((long)(g * 64 + p)) * 16 + fq * 8;
            const float* bi = P.in[I_BIM] + ((long)(g * 64 + p)) * 16 + fq * 8;
            const f32x4 r0 = *(const f32x4*)br, r1 = *(const f32x4*)(br + 4), i0 = *(const f32x4*)bi, i1 = *(const f32x4*)(bi + 4);
            f32x4 o0, o1;
            if (j < 4) { o0 = r0 * f_r - i0 * f_i; o1 = r1 * f_r - i1 * f_i; }
            else { o0 = i0 * f_r + r0 * f_i; o1 = i1 * f_r + r1 * f_i; }
            u32x4 q; q.x = pk2(o0[0], o0[1]); q.y = pk2(o0[2], o0[3]); q.z = pk2(o1[0], o1[1]); q.w = pk2(o1[2], o1[3]);
            z = __builtin_bit_cast(bf16x8, q);
        }
        bbf[j] = z;
    }
    bf16x8 ccf[4];
#pragma unroll
    for (int ks = 0; ks < 4; ++ks) {
        const float* src = (ks < 2 ? P.in[I_CRE] : P.in[I_CIM]) + ((long)(g * 16 + fr)) * 64 + (ks & 1) * 32 + fq * 8;
        f32x4 c0 = *(const f32x4*)src, c1 = *(const f32x4*)(src + 4);
        if (ks >= 2) { c0 = -c0; c1 = -c1; }
        u32x4 q; q.x = pk2(c0[0], c0[1]); q.y = pk2(c0[2], c0[3]); q.z = pk2(c1[0], c1[1]); q.w = pk2(c1[2], c1[3]);
        ccf[ks] = __builtin_bit_cast(bf16x8, q);
    }
    const f32x4 dsk = *(const f32x4*)(P.in[I_S5D] + g * 16 + fq * 4);
    const long roww = rowbase + (long)w * TPW;
    float xr = 0.f, xi = 0.f;
    float sre[8], sim[8];
#pragma unroll
    for (int j = 0; j < 8; ++j) { sre[j] = 0.f; sim[j] = 0.f; }
    if (SAMPLE) {
#pragma unroll
        for (int j = 0; j < TPW / 4; ++j) {
            const long seq = (roww - NPROMPT) / 4 + j;
            sre[j] = P.in[I_S5R][(seq * 64 + g) * 64 + lane]; sim[j] = P.in[I_S5I][(seq * 64 + g) * 64 + lane];
        }
    }
    constexpr int NPASS = SAMPLE ? 1 : 2;
#pragma unroll 1
    for (int pass = 0; pass < NPASS; ++pass) {
        const bool last = (pass == NPASS - 1);
        if (!SAMPLE && pass == 1) {
            carry[w * 128 + lane] = xr; carry[w * 128 + 64 + lane] = xi;
            __syncthreads();
            float pr = ar, pi = ai;
#pragma unroll
            for (int q = 0; q < 8; ++q) { const float nr = pr * pr - pi * pi, ni = 2.f * pr * pi; pr = nr; pi = ni; }
            float sr = 0.f, si = 0.f;
            for (int ww = 0; ww < w; ++ww) {
                const float cr = carry[ww * 128 + lane], ci = carry[ww * 128 + 64 + lane];
                const float nr = pr * sr - pi * si + cr, ni = pr * si + pi * sr + ci; sr = nr; si = ni;
            }
            xr = sr; xi = si;
        }
        if (!SAMPLE && pass == 0 && w == 7) continue;
        bf16x8 ufn = {0, 0, 0, 0, 0, 0, 0, 0};
        if (fq < 2) ufn = *(const bf16x8*)(proj + (roww + fr) * PLD + C_UB + g * 16 + fq * 8);
#pragma unroll 1
        for (int sb = 0; sb < TPW / 16; ++sb) {
            const long r = roww + sb * 16;
            const bf16x8 uf = ufn;
            if (fq < 2 && sb + 1 < TPW / 16) ufn = *(const bf16x8*)(proj + (r + 16 + fr) * PLD + C_UB + g * 16 + fq * 8);
            u32x2* up = (u32x2*)(proj + (r + fr) * PLD + C_UB + g * 16 + fq * 4);
            u32x2 uu = {0u, 0u};
            if (last) uu = *up;
            const f32x4 zero = {0.f, 0.f, 0.f, 0.f};
#pragma unroll
            for (int j = 0; j < 8; ++j) {
                const f32x4 d = mfma16(uf, bbf[j], zero);
                *(f32x4*)(buf + (j * 16 + fr) * S5P + fq * 4) = d;
            }
            lds_fence();
            {
                f32x4 brv[4], biv[4];
#pragma unroll
                for (int q = 0; q < 4; ++q) { brv[q] = *(const f32x4*)(buf + lane * S5P + q * 4); biv[q] = *(const f32x4*)(buf + (64 + lane) * S5P + q * 4); }
                __builtin_amdgcn_sched_barrier(0);
#pragma unroll
                for (int q = 0; q < 4; ++q) {
                    if (SAMPLE) {
#pragma unroll
                        for (int j = 0; j < 8; ++j) if (j == sb * 4 + q) { xr = sre[j]; xi = sim[j]; }
                    }
#pragma unroll
                    for (int i = 0; i < 4; ++i) {
                        const float nr = ar * xr - ai * xi + brv[q][i], ni = ar * xi + ai * xr + biv[q][i];
                        xr = nr; xi = ni; brv[q][i] = nr; biv[q][i] = ni;
                    }
                    if (SAMPLE) {
                        const long seq = (r - NPROMPT) / 4 + q;
                        P.out[O_S5RS + (seq * 64 + g) * 64 + lane] = xr; P.out[O_S5IS + (seq * 64 + g) * 64 + lane] = xi;
                    }
                }
                if (last) {
#pragma unroll
                    for (int q = 0; q < 4; ++q) { *(f32x4*)(buf + lane * S5P + q * 4) = brv[q]; *(f32x4*)(buf + (64 + lane) * S5P + q * 4) = biv[q]; }
                }
            }
            if (last) {
                lds_fence();
                f32x4 y = {0.f, 0.f, 0.f, 0.f};
                float xv[4][8];
#pragma unroll
                for (int ks = 0; ks < 4; ++ks)
#pragma unroll
                    for (int i = 0; i < 8; ++i) xv[ks][i] = buf[(ks * 32 + fq * 8 + i) * S5P + fr];
                __builtin_amdgcn_sched_barrier(0);
#pragma unroll
                for (int ks = 0; ks < 4; ++ks) {
                    u32x4 q; q.x = pk2(xv[ks][0], xv[ks][1]); q.y = pk2(xv[ks][2], xv[ks][3]); q.z = pk2(xv[ks][4], xv[ks][5]); q.w = pk2(xv[ks][6], xv[ks][7]);
                    y = mfma16(ccf[ks], __builtin_bit_cast(bf16x8, q), y);
                }
                const float y0 = geluf(y[0] + dsk[0] * bflo(uu.x)), y1 = geluf(y[1] + dsk[1] * bfhi(uu.x));
                const float y2 = geluf(y[2] + dsk[2] * bflo(uu.y)), y3 = geluf(y[3] + dsk[3] * bfhi(uu.y));
                u32x2 o; o.x = pk2(y0, y1); o.y = pk2(y2, y3);
                *up = o;
            }
            lds_fence();
        }
    }
    if (!SAMPLE && w == 7) {
        P.out[O_S5RP + ((long)bidx * 64 + g) * 64 + lane] = xr; P.out[O_S5IP + ((long)bidx * 64 + g) * 64 + lane] = xi;
    }
    __syncthreads();
}

__global__ void __launch_bounds__(512) hymba_fwd(Params P) {
#ifdef PROBE_K
    unsigned long long tb_[9]; int nb_ = 0;
#define TB() do { tb_[nb_++] = wall_clock64(); } while (0)
    TB();
#else
#define TB() do {} while (0)
#endif
    const int G = gridDim.x, bid = blockIdx.x;
    char* ws = P.ws;
    bf16_t* proj = (bf16_t*)(ws + W_PROJ);
    unsigned* barw = (unsigned*)(ws + W_BAR);
    volatile LAS unsigned* stw = (volatile LAS unsigned*)(smem + 131072);
    if (threadIdx.x < 4) stw[threadIdx.x] = 0u;
    __syncthreads();
    const XcdBarrier xb = xcd_barrier_post(barw, stw);
#ifndef NO_P0
    phase0(P);
#endif
    xcd_barrier(xb); TB();
#ifndef NO_P1
    for (int L = bid; L < 1188; L += G) {
        int pm, pn; tile_of(L, 66, 18, pm, pn);
        gemm_tile((const bf16_t*)(ws + W_NB), 1024, (const bf16_t*)(ws + W_WTIN), 1024, 1024, pm * 256, pn * 256, EpiBf16{proj, PLD, (const float*)(ws + W_RSTD)});
    }
    for (int L = (bid + G - 1188 % G) % G; L < 264; L += G) {
        int pm, pn; tile_of(L, 66, 4, pm, pn);
        gemm_tile((const bf16_t*)(ws + W_PB), 256, (const bf16_t*)(ws + W_WTPP), 256, 256, pm * 256, pn * 256, EpiBf16{(bf16_t*)(ws + W_PP), 1024, nullptr});
    }
#endif
    xcd_barrier(xb); TB();
    for (int idx = bid * 512 + threadIdx.x; idx < (8 + 128) * 3 * 192; idx += G * 512) {
        const int c8 = (idx % 192) * 8, sj = idx / 192, j = sj % 3, sq = sj / 3;
        const long row = sq < 8 ? (long)sq * 2048 + 2045 + j : NPROMPT + (long)(sq - 8) * 4 + 1 + j;
        const u32x4 u = *(const u32x4*)(proj + row * PLD + C_XBC + c8);
        float* dst = sq < 8 ? P.out + O_CONVP + ((long)sq * 3 + j) * 1536 + c8 : P.out + O_CONVS + ((long)(sq - 8) * 3 + j) * 1536 + c8;
        *(f32x4*)dst = (f32x4){bflo(u.x), bfhi(u.x), bflo(u.y), bfhi(u.y)};
        *(f32x4*)(dst + 4) = (f32x4){bflo(u.z), bfhi(u.z), bflo(u.w), bfhi(u.w)};
    }
#ifdef PROBE2
    unsigned long long tq_[5]; tq_[0] = wall_clock64();
#endif
#ifndef NO_S1
    for (int it = bid; it < 256; it += G) ssd_s1_item(P, it);
#endif
#ifdef PROBE2
    tq_[1] = wall_clock64();
#endif
#ifndef NO_SS
    for (int it = bid; it < 256; it += G) ssd_sample_item(P, it);
#endif
#ifdef PROBE2
    tq_[2] = wall_clock64();
#endif
#ifndef NO_S5P
    for (int it = bid; it < 512; it += G) s5_item<false>(P, it & 63, (long)(it >> 6) * 2048, it >> 6);
#endif
#ifdef PROBE2
    tq_[3] = wall_clock64();
#endif
#ifndef NO_S5S
    for (int it = bid; it < 256; it += G) s5_item<true>(P, it & 63, NPROMPT + (long)(it >> 6) * 128, 0);
#endif
#ifdef PROBE2
    tq_[4] = wall_clock64();
    { const unsigned long long d = tq_[PROBE2 + 1] - tq_[PROBE2], t0 = wall_clock64(); while (wall_clock64() - t0 < d) __builtin_amdgcn_s_sleep(8); }
#endif
    xcd_barrier(xb); TB();
    if (bid & 1) ssd_s2(P);
    {
        const EpiGlu eg{proj, P.in[I_GLUB]};
        for (int L = bid; L < 256; L += G) {
            int pm, pn; tile_of(L, 64, 4, pm, pn);
            gemm_tile(proj + C_UB, PLD, (const bf16_t*)(ws + W_WTGLU), 1024, 1024, pm * 256, pn * 256, eg);
        }
        for (int L = bid; L < 256; L += G)
            gemm_small(proj + C_UB, PLD, (const bf16_t*)(ws + W_WTGLU), 1024, 1024, NPROMPT + (L >> 3) * 16, (L & 7) * 128, eg);
    }
    if (!(bid & 1)) ssd_s2(P);
    xcd_barrier(xb); TB();
#ifndef NO_S3
    for (int it = bid; it < 256; it += G) ssd_s3_item(P, it);
#endif
    xcd_barrier(xb); TB();
#ifndef NO_P5
    {
        const EpiOut eo{P.in[I_XP], P.in[I_XS], (bf16_t*)(ws + W_NB), (float*)(ws + W_RSS1)};
        if (bid & 1)
            for (int L = bid; L < 256; L += G)
                gemm_small(proj, PLD, (const bf16_t*)(ws + W_WTOUT), 2048, 2048, NPROMPT + (L >> 3) * 16, (L & 7) * 128, eo);
        for (int L = bid; L < 256; L += G) {
            int pm, pn; tile_of(L, 64, 4, pm, pn);
            gemm_tile(proj, PLD, (const bf16_t*)(ws + W_WTOUT), 2048, 2048, pm * 256, pn * 256, eo);
        }
        if (!(bid & 1))
            for (int L = bid; L < 256; L += G)
                gemm_small(proj, PLD, (const bf16_t*)(ws + W_WTOUT), 2048, 2048, NPROMPT + (L >> 3) * 16, (L & 7) * 128, eo);
    }
#endif
    xcd_barrier(xb); TB();
#ifndef NO_P6
    {
        const EpiPle ep{P.out, (const bf16_t*)(ws + W_NB), (const bf16_t*)(ws + W_PP), (const float*)(ws + W_RSS1), (float*)(ws + W_RSS2)};
        if (bid & 1)
            for (int L = bid; L < 256; L += G)
                gemm_small((const bf16_t*)(ws + W_NB), 1024, (const bf16_t*)(ws + W_WTGATE), 1024, 1024, NPROMPT + (L >> 3) * 16, (L & 7) * 128, ep);
        for (int L = bid; L < 256; L += G) {
            int pm, pn; tile_of(L, 64, 4, pm, pn);
            gemm_tile((const bf16_t*)(ws + W_NB), 1024, (const bf16_t*)(ws + W_WTGATE), 1024, 1024, pm * 256, pn * 256, ep);
        }
        if (!(bid & 1))
            for (int L = bid; L < 256; L += G)
                gemm_small((const bf16_t*)(ws + W_NB), 1024, (const bf16_t*)(ws + W_WTGATE), 1024, 1024, NPROMPT + (L >> 3) * 16, (L & 7) * 128, ep);
    }
#endif
    xcd_barrier(xb); TB();
    {
        const float* rss2 = (const float*)(ws + W_RSS2);
        for (int idx = bid * 512 + threadIdx.x; idx < NTOK * 256; idx += G * 512) {
            const int row = idx >> 8, c4 = (idx & 255) * 4;
            const f32x4 r0 = *(const f32x4*)(rss2 + (long)row * 16), r1 = *(const f32x4*)(rss2 + (long)row * 16 + 4), r2 = *(const f32x4*)(rss2 + (long)row * 16 + 8), r3 = *(const f32x4*)(rss2 + (long)row * 16 + 12);
            const float tot = (((r0[0] + r0[1]) + (r0[2] + r0[3])) + ((r1[0] + r1[1]) + (r1[2] + r1[3]))) + (((r2[0] + r2[1]) + (r2[2] + r2[3])) + ((r3[0] + r3[1]) + (r3[2] + r3[3])));
            const float rstd = rsqrtf(tot * (1.f / 1024.f) + EPS);
            f32x4* p = (f32x4*)(P.out + (long)row * 1024 + c4);
            const f32x4 gf = *(const f32x4*)(P.in[I_GFIN] + c4);
            *p = *p * rstd * gf;
        }
    }
#ifdef PROBE_K
    { TB(); const unsigned long long d = tb_[PROBE_K + 1] - tb_[PROBE_K], t0 = wall_clock64(); while (wall_clock64() - t0 < d) __builtin_amdgcn_s_sleep(8); }
#endif
}

extern "C" void kernel_launch(void* const* d_in, const int* in_sizes, int n_in, void* d_out, int out_size, void* d_ws, size_t ws_size, hipStream_t stream) {
    static int grid_blocks = 0;
    if (grid_blocks == 0) {
        if (n_in != 31 || out_size != (int)O_END || ws_size < W_END) {
            fprintf(stderr, "kernel_launch: unexpected shapes n_in %d out %d ws %zu (need %zu)\n", n_in, out_size, ws_size, (size_t)W_END);
            grid_blocks = -1; return;
        }
        int dev = 0, cus = 0, per_cu = 0;
        hipGetDevice(&dev);
        hipDeviceGetAttribute(&cus, hipDeviceAttributeMultiprocessorCount, dev);
        hipFuncSetAttribute((const void*)hymba_fwd, hipFuncAttributeMaxDynamicSharedMemorySize, LDS_BYTES);
        hipOccupancyMaxActiveBlocksPerMultiprocessor(&per_cu, (const void*)hymba_fwd, 512, LDS_BYTES);
        if (per_cu < 1) { fprintf(stderr, "kernel_launch: occupancy query says %d blocks/CU\n", per_cu); per_cu = 1; }
        grid_blocks = cus;
        (void)hipGetLastError();
    }
    if (grid_blocks < 0) return;
    if (hipMemsetAsync((char*)d_ws + W_BAR, 0, XCD_BAR_WORDS * sizeof(unsigned), stream) != hipSuccess) { fprintf(stderr, "kernel_launch: memset of the barrier words failed\n"); return; }
    Params p{};
    for (int i = 0; i < 31; ++i) p.in[i] = (const float*)d_in[i];
    p.out = (float*)d_out; p.ws = (char*)d_ws;
    void* args[] = {&p};
    hipError_t e = hipLaunchCooperativeKernel((const void*)hymba_fwd, dim3(grid_blocks), dim3(512), args, LDS_BYTES, stream);
    if (e != hipSuccess) fprintf(stderr, "cooperative launch failed: %s (grid %d)\n", hipGetErrorString(e), grid_blocks);
}
```

```cpp
#include <hip/hip_runtime.h>
#include <hip/hip_cooperative_groups.h>
#include <cstdio>
namespace cg = cooperative_groups;

typedef unsigned short bf16_t;
typedef short bf16x8 __attribute__((ext_vector_type(8)));
typedef float f32x4 __attribute__((ext_vector_type(4)));
typedef unsigned u32x2 __attribute__((ext_vector_type(2)));
typedef unsigned u32x4 __attribute__((ext_vector_type(4)));
#define DEV __device__ __forceinline__

constexpr int NPROMPT = 16384, NSAMPLE = 512, NTOK = 16896;
constexpr int PLD = 4608;
constexpr int C_ZA = 0, C_ZB = 1024, C_XBC = 2048, C_UB = 3584;
constexpr float EPS = 1e-6f;
constexpr long O_YP = 0, O_YS = 16777216, O_SSDP = 17301504, O_CONVP = 18350080, O_S5RP = 18386944, O_S5IP = 18419712,
               O_SSDS = 18452480, O_CONVS = 35229696, O_S5RS = 35819520, O_S5IS = 36343808, O_END = 36868096;
constexpr size_t W_WTIN = 0;
constexpr size_t W_WTOUT = W_WTIN + 4608ull * 1024 * 2;
constexpr size_t W_WTGLU = W_WTOUT + 1024ull * 2048 * 2;
constexpr size_t W_WTGATE = W_WTGLU + 1024ull * 1024 * 2;
constexpr size_t W_WTPP = W_WTGATE + 1024ull * 1024 * 2;
constexpr size_t W_NB = W_WTPP + 1024ull * 256 * 2;
constexpr size_t W_PB = W_NB + 16896ull * 1024 * 2;
constexpr size_t W_DTR = W_PB + 16896ull * 256 * 2;
constexpr size_t W_ACS = W_DTR + 16896ull * 16 * 4;
constexpr size_t W_CDEC = W_ACS + 16384ull * 16 * 4;
constexpr size_t W_RSS1 = W_CDEC + 8192;
constexpr size_t W_RSS2 = W_RSS1 + 16896ull * 16 * 4;
constexpr size_t W_PROJ = W_RSS2 + 16896ull * 16 * 4;
constexpr size_t W_PP = W_PROJ + 16896ull * 4608 * 2;
constexpr size_t W_RSTD = W_PP + 16896ull * 1024 * 2;
constexpr size_t W_BAR = W_RSTD + 16896ull * 4;
constexpr size_t W_END = W_BAR + 16384;

constexpr int LDS_BYTES = 131072 + 64;

struct Params {
    const float* in[31];
    float* out;
    char* ws;
};
enum { I_XP = 0, I_XS, I_PP, I_PS, I_SSD, I_CONV, I_S5R, I_S5I, I_WIN, I_GIN, I_CONVW, I_CONVB, I_DTB, I_ALOG, I_SSDD, I_SSDG,
       I_LRE, I_LIM, I_LDT, I_BRE, I_BIM, I_CRE, I_CIM, I_S5D, I_GLUW, I_GLUB, I_WOUT, I_GPLE, I_WGATE, I_WPP, I_GFIN };

extern __shared__ __attribute__((aligned(16))) char smem[];

DEV unsigned pk2(float lo, float hi) { unsigned r; asm("v_cvt_pk_bf16_f32 %0, %1, %2" : "=v"(r) : "v"(lo), "v"(hi)); return r; }
DEV float bflo(unsigned u) { return __uint_as_float(u << 16); }
DEV float bfhi(unsigned u) { return __uint_as_float(u & 0xffff0000u); }
DEV float wave_sum(float v) {
#pragma unroll
    for (int o = 1; o < 64; o <<= 1) v += __shfl_xor(v, o);
    return v;
}
DEV float siluf(float v) { return v * __builtin_amdgcn_rcpf(1.f + __expf(-v)); }
DEV float sigmf(float v) { return __builtin_amdgcn_rcpf(1.f + __expf(-v)); }
DEV float sigsilu(float v, float z) { return z * __builtin_amdgcn_rcpf((1.f + __expf(-v)) * (1.f + __expf(-z))); }
DEV float geluf(float y) { float z = 0.7978845608f * (y + 0.044715f * y * y * y); return y * __builtin_amdgcn_rcpf(1.f + __expf(-2.f * z)); }
DEV f32x4 mfma16(bf16x8 a, bf16x8 b, f32x4 c) { return __builtin_amdgcn_mfma_f32_16x16x32_bf16(a, b, c, 0, 0, 0); }
DEV int tid_fresh() { int t = threadIdx.x; asm volatile("" : "+v"(t)); return t; }
DEV void lds_fence() { asm volatile("s_waitcnt lgkmcnt(0)" ::: "memory"); }


#define XB_TMO      128
#define XB_XCNT(j)  (256  + 64 * (j))
#define XB_XSUB(j)  (1280 + 64 * (j))
#define XB_XGEN(j)  (2304 + 64 * (j))
#define XB_TOP      3328
#define XB_TOPGEN   3392
#define XCD_BAR_WORDS 3456
#define XB_SPIN_CAP (1u << 22)
#define LAS __attribute__((address_space(3)))
DEV unsigned xb_ld(unsigned* p) { return __hip_atomic_load(p, __ATOMIC_RELAXED, __HIP_MEMORY_SCOPE_AGENT); }
DEV unsigned xb_add(unsigned* p, unsigned v) { return __hip_atomic_fetch_add(p, v, __ATOMIC_RELAXED, __HIP_MEMORY_SCOPE_AGENT); }
DEV unsigned xb_xcc_id() { return (unsigned)__builtin_amdgcn_s_getreg((3 << 11) | 20) & 0xFu; }
#define XB_SPIN(cond, bar) do { unsigned _sp = 0; while (cond) { __builtin_amdgcn_s_sleep(1); \
    if ((++_sp & 255u) == 0u) { if (xb_ld(&(bar)[XB_TMO])) break; if (_sp > XB_SPIN_CAP) { atomicAdd(&(bar)[XB_TMO], 1u); break; } } } } while (0)
struct XcdBarrier { unsigned* bar; unsigned x; volatile LAS unsigned* st; };
DEV XcdBarrier xcd_barrier_post(unsigned* bar, volatile LAS unsigned* st) {
    XcdBarrier b; b.bar = bar; b.x = xb_xcc_id(); b.st = st;
    if (threadIdx.x == 0) (void)xb_add(&bar[XB_XCNT(b.x)], 1u);
    return b;
}
DEV void xcd_barrier_complete(unsigned* bar, unsigned x, unsigned& nloc, unsigned& nx) {
    const unsigned G = gridDim.x * gridDim.y * gridDim.z;
    unsigned sum, cnt, mine, sp = 0u;
    for (;;) {
        sum = 0u; cnt = 0u; mine = 0u;
#pragma unroll
        for (unsigned j = 0; j < 16; ++j) { const unsigned c = xb_ld(&bar[XB_XCNT(j)]); sum += c; cnt += (c > 0u) ? 1u : 0u; mine = (j == x) ? c : mine; }
        if (sum == G) break;
        __builtin_amdgcn_s_sleep(1);
        if ((++sp & 255u) == 0u) { if (xb_ld(&bar[XB_TMO])) break; if (sp > XB_SPIN_CAP) { atomicAdd(&bar[XB_TMO], 1u); break; } }
    }
    nloc = mine > 0u ? mine : 1u; nx = cnt > 0u ? cnt : 1u;
}
DEV void xcd_barrier(const XcdBarrier& b) {
    asm volatile("s_waitcnt vmcnt(0)" ::: "memory");
    __syncthreads();
    if (threadIdx.x == 0) {
        unsigned* bar = b.bar;
        __builtin_amdgcn_s_waitcnt(0);
        unsigned nloc = b.st[0], nx = b.st[1];
        if (nloc == 0u) { xcd_barrier_complete(bar, b.x, nloc, nx); b.st[0] = nloc; b.st[1] = nx; }
        const unsigned old = xb_add(&bar[XB_XSUB(b.x)], 1u);
        const unsigned gen = old / nloc;
        if (old + 1u == (gen + 1u) * nloc) {
            __builtin_amdgcn_fence(__ATOMIC_RELEASE, "agent");
            asm volatile("s_waitcnt vmcnt(0)" ::: "memory");
            const unsigned og = xb_add(&bar[XB_TOP], 1u);
            const unsigned tg = og / nx;
            if (og + 1u == (tg + 1u) * nx) xb_add(&bar[XB_TOPGEN], 1u);
            else XB_SPIN(xb_ld(&bar[XB_TOPGEN]) == tg, bar);
            __builtin_amdgcn_fence(__ATOMIC_ACQUIRE, "agent");
            xb_add(&bar[XB_XGEN(b.x)], 1u);
            asm volatile("s_waitcnt vmcnt(0)" ::: "memory");
        } else {
            XB_SPIN(xb_ld(&bar[XB_XGEN(b.x)]) == gen, bar);
            __builtin_amdgcn_fence(__ATOMIC_ACQUIRE, "agent");
            asm volatile("s_waitcnt vmcnt(0)" ::: "memory");
        }
    }
    __syncthreads();
}

constexpr int BM = 256, BK = 64, HALF = 128, HT = HALF * BK;
DEV int lds_byte(int r, int c) {
    int st = (r >> 4) * 2 + (c >> 5), rr = r & 15, cc = c & 31, ob = rr * 64 + cc * 2;
    return st * 1024 + (ob ^ (((ob >> 9) & 1) << 5));
}
DEV void stage_rc(int b, int& R, int& C) {
    int st = b / 1024, sb = b % 1024, swz = sb ^ (((sb >> 9) & 1) << 5);
    R = (st >> 1) * 16 + swz / 64; C = (st & 1) * 32 + (swz % 64) / 2;
}

template <class Epi>
DEV void gemm_tile(const bf16_t* __restrict__ A, int lda, const bf16_t* __restrict__ Bt, int ldb, int K, int brow, int bcol, const Epi& epi) {
    LAS unsigned char* lds = (LAS unsigned char*)smem;
    constexpr int HTB = HT * 2;
    const int tid = tid_fresh(), wid = __builtin_amdgcn_readfirstlane(tid >> 6), lane = tid & 63, wr = wid >> 2, wc = wid & 3, fr = lane & 15, fq = lane >> 4;
    unsigned voffA[2], voffB[2];
#pragma unroll
    for (int i = 0; i < 2; ++i) {
        int R, C; stage_rc(tid * 16 + i * 8192, R, C);
        const int rho = R & 31, Rb = Epi::PERM ? ((R & ~31) + 8 * ((rho & 15) >> 2) + 4 * (rho >> 4) + (rho & 3)) : R;
        voffA[i] = (unsigned)(R * lda + C) * 2u; voffB[i] = (unsigned)(Rb * ldb + C) * 2u;
    }
    const size_t kstep = (size_t)(BK * 2), hstepA = (size_t)HALF * lda * 2, hstepB = (size_t)HALF * ldb * 2;
    const unsigned ldsw = (unsigned)wid * 1024u;
    const int aoff = lds_byte(wr * 64 + fr, fq * 8), boff = lds_byte(wc * 32 + fr, fq * 8);
#define SA(b, h) (((b) * 2 + (h)) * HTB)
#define SB(b, h) ((4 + (b) * 2 + (h)) * HTB)
#define STAGE(bufoff, gbase, voff) do { _Pragma("unroll") for (int _i = 0; _i < 2; ++_i) \
        __builtin_amdgcn_global_load_lds((const unsigned*)((const char*)(gbase) + (voff)[_i]), (LAS unsigned*)(lds + (bufoff) + ldsw + _i * 8192), 16, 0, 0); } while (0)
#define LDA(dst, b, h) do { _Pragma("unroll") for (int m = 0; m < 4; ++m) _Pragma("unroll") for (int k = 0; k < 2; ++k) dst[m][k] = *(const LAS bf16x8*)(lds + SA(b, h) + aoff + m * 2048 + k * 1024); } while (0)
#define LDB(dst, b, h) do { _Pragma("unroll") for (int n = 0; n < 2; ++n) _Pragma("unroll") for (int k = 0; k < 2; ++k) dst[n][k] = *(const LAS bf16x8*)(lds + SB(b, h) + boff + n * 2048 + k * 1024); } while (0)
#define MMA(ai, bj, At, Bt_) do { __builtin_amdgcn_s_setprio(1); _Pragma("unroll") for (int m = 0; m < 4; ++m) _Pragma("unroll") for (int n = 0; n < 2; ++n) _Pragma("unroll") for (int k = 0; k < 2; ++k) \
        acc[ai][bj][m][n] = __builtin_amdgcn_mfma_f32_16x16x32_bf16(Bt_[n][k], At[m][k], acc[ai][bj][m][n], 0, 0, 0); __builtin_amdgcn_s_setprio(0); } while (0)
#define WAIT_V(n) asm volatile("s_waitcnt vmcnt(" #n ")" ::: "memory")
#define WAIT_L(n) asm volatile("s_waitcnt lgkmcnt(" #n ")" ::: "memory")
#define BAR __builtin_amdgcn_s_barrier()
#define SCHED __builtin_amdgcn_sched_barrier(0)
    f32x4 acc[2][2][4][2];
#pragma unroll
    for (int a = 0; a < 2; ++a)
#pragma unroll
        for (int b = 0; b < 2; ++b)
#pragma unroll
            for (int m = 0; m < 4; ++m)
#pragma unroll
                for (int n = 0; n < 2; ++n) acc[a][b][m][n] = (f32x4){0.f, 0.f, 0.f, 0.f};
    bf16x8 At[4][2], B0[2][2], B1[2][2];
    const int nt = K / BK;
    const char* cA = (const char*)A + (size_t)brow * lda * 2; const char* cB = (const char*)Bt + (size_t)bcol * ldb * 2;
    STAGE(SB(0, 0), cB, voffB); STAGE(SA(0, 0), cA, voffA); STAGE(SB(0, 1), cB + hstepB, voffB); STAGE(SA(0, 1), cA + hstepA, voffA);
    if (wr == 1) BAR;
    WAIT_V(4); BAR;
    STAGE(SB(1, 0), cB + kstep, voffB); STAGE(SA(1, 0), cA + kstep, voffA); STAGE(SB(1, 1), cB + hstepB + kstep, voffB);
    WAIT_V(6); BAR;
    for (int t = 0; t < nt - 2; t += 2) {
        const char* a1 = cA + (size_t)(t + 1) * kstep;
        const char* a2 = cA + (size_t)(t + 2) * kstep; const char* b2 = cB + (size_t)(t + 2) * kstep;
        const char* a3 = a2 + kstep; const char* b3 = b2 + kstep;
        LDB(B0, 0, 0); SCHED; LDA(At, 0, 0); STAGE(SA(1, 1), a1 + hstepA, voffA);
        WAIT_L(8); BAR; WAIT_L(0); MMA(0, 0, At, B0); BAR; SCHED;
        LDB(B1, 0, 1); STAGE(SB(0, 0), b2, voffB);
        BAR; WAIT_L(0); MMA(0, 1, At, B1); BAR;
        LDA(At, 0, 1); STAGE(SA(0, 0), a2, voffA);
        BAR; WAIT_L(0); MMA(1, 0, At, B0); BAR; SCHED;
        STAGE(SB(0, 1), b2 + hstepB, voffB);
        WAIT_V(6); BAR; MMA(1, 1, At, B1); BAR;
        LDB(B0, 1, 0); SCHED; LDA(At, 1, 0); STAGE(SA(0, 1), a2 + hstepA, voffA);
        WAIT_L(8); BAR; WAIT_L(0); MMA(0, 0, At, B0); BAR; SCHED;
        LDB(B1, 1, 1); STAGE(SB(1, 0), b3, voffB);
        BAR; WAIT_L(0); MMA(0, 1, At, B1); BAR;
        LDA(At, 1, 1); STAGE(SA(1, 0), a3, voffA);
        BAR; WAIT_L(0); MMA(1, 0, At, B0); BAR; SCHED;
        STAGE(SB(1, 1), b3 + hstepB, voffB);
        WAIT_V(6); BAR; MMA(1, 1, At, B1); BAR;
    }
    { const char* a1 = cA + (size_t)(nt - 1) * kstep;
      LDB(B0, 0, 0); LDA(At, 0, 0); STAGE(SA(1, 1), a1 + hstepA, voffA);
      BAR; WAIT_L(0); MMA(0, 0, At, B0); BAR;
      LDB(B1, 0, 1); BAR; WAIT_L(0); MMA(0, 1, At, B1); BAR;
      LDA(At, 0, 1); WAIT_V(4); BAR; WAIT_L(0); MMA(1, 0, At, B0); MMA(1, 1, At, B1); BAR; }
    { LDB(B0, 1, 0); LDA(At, 1, 0); WAIT_V(2); BAR; WAIT_L(0); MMA(0, 0, At, B0); BAR;
      LDB(B1, 1, 1); WAIT_V(0); BAR; WAIT_L(0); MMA(0, 1, At, B1); BAR;
      LDA(At, 1, 1); BAR; WAIT_L(0); MMA(1, 0, At, B0); MMA(1, 1, At, B1); BAR; }
    if (wr == 0) BAR;
    if constexpr (Epi::PERM) epi_big8(epi, acc, brow, bcol, wr, wc, fr, fq); else epi_big(epi, acc, brow, bcol, wr, wc, fr, fq);
    __syncthreads();
#undef SA
#undef SB
#undef STAGE
#undef LDA
#undef LDB
#undef MMA
}

DEV void tile_of(int L, int nM, int nN, int& pm, int& pn) {
    const int nwg = nM * nN; int wgid = L;
    { const int q = nwg / 8, r = nwg % 8, xcd = wgid % 8, off = wgid / 8; wgid = (xcd < r ? xcd * (q + 1) : r * (q + 1) + (xcd - r) * q) + off; }
    const int nig = 8 * nN, gid = wgid / nig, fm = gid * 8, gsz = (nM - fm) < 8 ? (nM - fm) : 8;
    pm = fm + ((wgid % nig) % gsz); pn = (wgid % nig) / gsz;
}

struct EpiBf16 {
    static constexpr bool PERM = true;
    bf16_t* dst; int ld; const float* rstd;
    struct Ld8 { int unused; };
    DEV void load8(int row, int col8, Ld8& d) const { d.unused = 0; }
    DEV float rowload(int row) const { return rstd ? rstd[row] : 1.f; }
    DEV void apply8(int row, int col8, const f32x4& v0, const f32x4& v1, const Ld8& d, float& ss, float rs) const {
        u32x4 o; o.x = pk2(v0[0] * rs, v0[1] * rs); o.y = pk2(v0[2] * rs, v0[3] * rs); o.z = pk2(v1[0] * rs, v1[1] * rs); o.w = pk2(v1[2] * rs, v1[3] * rs);
        *(u32x4*)(dst + (long)row * ld + col8) = o;
    }
    DEV void rowdone(int row, float ss, int fq, int slot) const {}
};
struct EpiGlu {
    static constexpr bool PERM = true;
    bf16_t* proj; const float* glu_b;
    struct Ld8 { u32x4 g, z; f32x4 b0, b1; };
    DEV void load8(int row, int col8, Ld8& d) const {
        d.g = *(const u32x4*)(proj + (long)row * PLD + C_UB + col8); d.z = *(const u32x4*)(proj + (long)row * PLD + C_ZB + col8);
        d.b0 = *(const f32x4*)(glu_b + col8); d.b1 = *(const f32x4*)(glu_b + col8 + 4);
    }
    DEV void apply8(int row, int col8, const f32x4& v0, const f32x4& v1, const Ld8& d, float& ss, float rowv) const {
        u32x4 o;
        o.x = pk2(bflo(d.g.x) * sigsilu(v0[0] + d.b0[0], bflo(d.z.x)), bfhi(d.g.x) * sigsilu(v0[1] + d.b0[1], bfhi(d.z.x)));
        o.y = pk2(bflo(d.g.y) * sigsilu(v0[2] + d.b0[2], bflo(d.z.y)), bfhi(d.g.y) * sigsilu(v0[3] + d.b0[3], bfhi(d.z.y)));
        o.z = pk2(bflo(d.g.z) * sigsilu(v1[0] + d.b1[0], bflo(d.z.z)), bfhi(d.g.z) * sigsilu(v1[1] + d.b1[1], bfhi(d.z.z)));
        o.w = pk2(bflo(d.g.w) * sigsilu(v1[2] + d.b1[2], bflo(d.z.w)), bfhi(d.g.w) * sigsilu(v1[3] + d.b1[3], bfhi(d.z.w)));
        *(u32x4*)(proj + (long)row * PLD + C_ZB + col8) = o;
    }
    struct Ld { u32x2 g, z; f32x4 b; };
    DEV void load(int row, int col, Ld& d) const {
        d.g = *(const u32x2*)(proj + (long)row * PLD + C_UB + col); d.z = *(const u32x2*)(proj + (long)row * PLD + C_ZB + col); d.b = *(const f32x4*)(glu_b + col);
    }
    DEV void apply(int row, int col, const f32x4& v, const Ld& d, float& ss, float rowv) const {
        const float y0 = bflo(d.g.x) * sigsilu(v[0] + d.b[0], bflo(d.z.x)), y1 = bfhi(d.g.x) * sigsilu(v[1] + d.b[1], bfhi(d.z.x));
        const float y2 = bflo(d.g.y) * sigsilu(v[2] + d.b[2], bflo(d.z.y)), y3 = bfhi(d.g.y) * sigsilu(v[3] + d.b[3], bfhi(d.z.y));
        u32x2 o; o.x = pk2(y0, y1); o.y = pk2(y2, y3);
        *(u32x2*)(proj + (long)row * PLD + C_ZB + col) = o;
    }
    DEV float rowload(int row) const { return 0.f; }
    DEV void rowdone(int row, float ss, int fq, int slot) const {}
    DEV void rowput(int row, float tot, int slot) const {}
};
struct EpiOut {
    static constexpr bool PERM = true;
    const float* xp; const float* xs; bf16_t* h1b; float* rss;
    struct Ld8 { f32x4 x0, x1; };
    DEV void load8(int row, int col8, Ld8& d) const {
        const float* xrow = row < NPROMPT ? xp + (long)row * 1024 : xs + (long)(row - NPROMPT) * 1024;
        d.x0 = *(const f32x4*)(xrow + col8); d.x1 = *(const f32x4*)(xrow + col8 + 4);
    }
    DEV void apply8(int row, int col8, const f32x4& a0, const f32x4& a1, const Ld8& d, float& ss, float rowv) const {
        const f32x4 v0 = a0 + d.x0, v1 = a1 + d.x1;
        u32x4 o; o.x = pk2(v0[0], v0[1]); o.y = pk2(v0[2], v0[3]); o.z = pk2(v1[0], v1[1]); o.w = pk2(v1[2], v1[3]);
        *(u32x4*)(h1b + (long)row * 1024 + col8) = o;
        const float r0 = bflo(o.x), r1 = bfhi(o.x), r2 = bflo(o.y), r3 = bfhi(o.y), r4 = bflo(o.z), r5 = bfhi(o.z), r6 = bflo(o.w), r7 = bfhi(o.w);
        ss += ((r0 * r0 + r1 * r1) + (r2 * r2 + r3 * r3)) + ((r4 * r4 + r5 * r5) + (r6 * r6 + r7 * r7));
    }
    struct Ld { f32x4 x; };
    DEV void load(int row, int col, Ld& d) const {
        const float* xrow = row < NPROMPT ? xp + (long)row * 1024 : xs + (long)(row - NPROMPT) * 1024;
        d.x = *(const f32x4*)(xrow + col);
    }
    DEV void apply(int row, int col, const f32x4& a, const Ld& d, float& ss, float rowv) const {
        const f32x4 v = a + d.x;
        u32x2 o; o.x = pk2(v[0], v[1]); o.y = pk2(v[2], v[3]);
        *(u32x2*)(h1b + (long)row * 1024 + col) = o;
        const float r0 = bflo(o.x), r1 = bfhi(o.x), r2 = bflo(o.y), r3 = bfhi(o.y);
        ss += r0 * r0 + r1 * r1 + r2 * r2 + r3 * r3;
    }
    DEV float rowload(int row) const { return 0.f; }
    DEV void rowdone(int row, float ss, int fq, int slot) const {
        ss += __shfl_xor(ss, 16); ss += __shfl_xor(ss, 32);
        if (fq == 0) rss[(long)row * 16 + slot] = ss;
    }
    DEV void rowput(int row, float tot, int slot) const { rss[(long)row * 16 + slot] = tot; rss[(long)row * 16 + slot + 1] = 0.f; }
};
struct EpiPle {
    static constexpr bool PERM = true;
    float* out; const bf16_t* h1b; const bf16_t* pp; const float* rss1; float* rss2;
    struct Ld8 { u32x4 h, pv; };
    DEV void load8(int row, int col8, Ld8& d) const {
        d.h = *(const u32x4*)(h1b + (long)row * 1024 + col8); d.pv = *(const u32x4*)(pp + (long)row * 1024 + col8);
    }
    DEV void apply8(int row, int col8, const f32x4& a0, const f32x4& a1, const Ld8& d, float& ss, float rowv) const {
        const float rstd = rsqrtf(rowv * (1.f / 1024.f) + EPS);
        f32x4 h0, h1;
        h0[0] = bflo(d.h.x) + bflo(d.pv.x) * sigmf(a0[0] * rstd); h0[1] = bfhi(d.h.x) + bfhi(d.pv.x) * sigmf(a0[1] * rstd);
        h0[2] = bflo(d.h.y) + bflo(d.pv.y) * sigmf(a0[2] * rstd); h0[3] = bfhi(d.h.y) + bfhi(d.pv.y) * sigmf(a0[3] * rstd);
        h1[0] = bflo(d.h.z) + bflo(d.pv.z) * sigmf(a1[0] * rstd); h1[1] = bfhi(d.h.z) + bfhi(d.pv.z) * sigmf(a1[1] * rstd);
        h1[2] = bflo(d.h.w) + bflo(d.pv.w) * sigmf(a1[2] * rstd); h1[3] = bfhi(d.h.w) + bfhi(d.pv.w) * sigmf(a1[3] * rstd);
        *(f32x4*)(out + (long)row * 1024 + col8) = h0; *(f32x4*)(out + (long)row * 1024 + col8 + 4) = h1;
        ss += ((h0[0] * h0[0] + h0[1] * h0[1]) + (h0[2] * h0[2] + h0[3] * h0[3])) + ((h1[0] * h1[0] + h1[1] * h1[1]) + (h1[2] * h1[2] + h1[3] * h1[3]));
    }
    struct Ld { u32x2 h; u32x2 pv; };
    DEV void load(int row, int col, Ld& d) const {
        d.h = *(const u32x2*)(h1b + (long)row * 1024 + col); d.pv = *(const u32x2*)(pp + (long)row * 1024 + col);
    }
    DEV void apply(int row, int col, const f32x4& a, const Ld& d, float& ss, float rowv) const {
        const float rstd = rsqrtf(rowv * (1.f / 1024.f) + EPS);
        f32x4 h;
        h[0] = bflo(d.h.x) + bflo(d.pv.x) * sigmf(a[0] * rstd); h[1] = bfhi(d.h.x) + bfhi(d.pv.x) * sigmf(a[1] * rstd);
        h[2] = bflo(d.h.y) + bflo(d.pv.y) * sigmf(a[2] * rstd); h[3] = bfhi(d.h.y) + bfhi(d.pv.y) * sigmf(a[3] * rstd);
        *(f32x4*)(out + (long)row * 1024 + col) = h;
        ss += h[0] * h[0] + h[1] * h[1] + h[2] * h[2] + h[3] * h[3];
    }
    DEV float rowload(int row) const {
        const f32x4 a = *(const f32x4*)(rss1 + (long)row * 16), b = *(const f32x4*)(rss1 + (long)row * 16 + 4), c = *(const f32x4*)(rss1 + (long)row * 16 + 8), d = *(const f32x4*)(rss1 + (long)row * 16 + 12);
        return (((a[0] + a[1]) + (a[2] + a[3])) + ((b[0] + b[1]) + (b[2] + b[3]))) + (((c[0] + c[1]) + (c[2] + c[3])) + ((d[0] + d[1]) + (d[2] + d[3])));
    }
    DEV void rowdone(int row, float ss, int fq, int slot) const {
        ss += __shfl_xor(ss, 16); ss += __shfl_xor(ss, 32);
        if (fq == 0) rss2[(long)row * 16 + slot] = ss;
    }
    DEV void rowput(int row, float tot, int slot) const { rss2[(long)row * 16 + slot] = tot; rss2[(long)row * 16 + slot + 1] = 0.f; }
};
template <class Epi>
DEV void epi_big8(const Epi& E, const f32x4 (&acc)[2][2][4][2], int brow, int bcol, int wr, int wc, int fr, int fq) {
#pragma unroll
    for (int ai = 0; ai < 2; ++ai)
#pragma unroll
        for (int mp = 0; mp < 2; ++mp) {
            typename Epi::Ld8 d[2][2]; float rv[2];
#pragma unroll
            for (int mm = 0; mm < 2; ++mm) {
                const int row = brow + ai * 128 + wr * 64 + (mp * 2 + mm) * 16 + fr;
                rv[mm] = E.rowload(row);
#pragma unroll
                for (int bj = 0; bj < 2; ++bj) E.load8(row, bcol + bj * 128 + wc * 32 + 8 * fq, d[mm][bj]);
            }
#pragma unroll
            for (int mm = 0; mm < 2; ++mm) {
                const int row = brow + ai * 128 + wr * 64 + (mp * 2 + mm) * 16 + fr; float ss = 0.f;
#pragma unroll
                for (int bj = 0; bj < 2; ++bj)
                    E.apply8(row, bcol + bj * 128 + wc * 32 + 8 * fq, acc[ai][bj][mp * 2 + mm][0], acc[ai][bj][mp * 2 + mm][1], d[mm][bj], ss, rv[mm]);
                E.rowdone(row, ss, fq, ((bcol >> 8) & 3) * 4 + wc);
            }
        }
}
template <class Epi>
DEV void epi_big(const Epi& E, const f32x4 (&acc)[2][2][4][2], int brow, int bcol, int wr, int wc, int fr, int fq) {
#pragma unroll
    for (int ai = 0; ai < 2; ++ai)
#pragma unroll
        for (int mp = 0; mp < 2; ++mp) {
            typename Epi::Ld d[2][4]; float rv[2];
#pragma unroll
            for (int mm = 0; mm < 2; ++mm) {
                rv[mm] = E.rowload(brow + ai * 128 + wr * 64 + (mp * 2 + mm) * 16 + fr);
#pragma unroll
                for (int j = 0; j < 4; ++j)
                    E.load(brow + ai * 128 + wr * 64 + (mp * 2 + mm) * 16 + fr, bcol + (j >> 1) * 128 + wc * 32 + (j & 1) * 16 + fq * 4, d[mm][j]);
            }
#pragma unroll
            for (int mm = 0; mm < 2; ++mm) {
                const int row = brow + ai * 128 + wr * 64 + (mp * 2 + mm) * 16 + fr; float ss = 0.f;
#pragma unroll
                for (int j = 0; j < 4; ++j)
                    E.apply(row, bcol + (j >> 1) * 128 + wc * 32 + (j & 1) * 16 + fq * 4, acc[ai][j >> 1][mp * 2 + mm][j & 1], d[mm][j], ss, rv[mm]);
                E.rowdone(row, ss, fq, ((bcol >> 8) & 3) * 4 + wc);
            }
        }
}
template <class Epi>
DEV void gemm_small(const bf16_t* __restrict__ A, int lda, const bf16_t* __restrict__ Bt, int ldb, int K, int row0, int col0, const Epi& E) {
    const int tid = tid_fresh(), w = tid >> 6, lane = tid & 63, fr = lane & 15, fq = lane >> 4;
    const int kw = K >> 3;
    const bf16_t* ap = A + (long)(row0 + fr) * lda + w * kw + fq * 8;
    const bf16_t* bp = Bt + (long)(col0 + fr) * ldb + w * kw + fq * 8;
    const int row = row0 + fr, col = col0 + w * 16 + fq * 4;
    typename Epi::Ld d;
    E.load(row, col, d);
    const float rv = E.rowload(row);
    f32x4 pacc[8];
#pragma unroll
    for (int n = 0; n < 8; ++n) pacc[n] = (f32x4){0.f, 0.f, 0.f, 0.f};
    for (int k0 = 0; k0 < kw; k0 += 128) {
        bf16x8 af[4], bf[4][8];
#pragma unroll
        for (int ks = 0; ks < 4; ++ks) {
            af[ks] = *(const bf16x8*)(ap + k0 + ks * 32);
#pragma unroll
            for (int n = 0; n < 8; ++n) bf[ks][n] = *(const bf16x8*)(bp + (long)n * 16 * ldb + k0 + ks * 32);
        }
#pragma unroll
        for (int ks = 0; ks < 4; ++ks)
#pragma unroll
            for (int n = 0; n < 8; ++n) pacc[n] = mfma16(bf[ks][n], af[ks], pacc[n]);
    }
    float* redk = (float*)smem;
    __syncthreads();
#pragma unroll
    for (int n = 0; n < 8; ++n) *(f32x4*)(redk + ((w * 8 + n) * 64 + lane) * 4) = pacc[n];
    __syncthreads();
    f32x4 acc = (f32x4){0.f, 0.f, 0.f, 0.f};
#pragma unroll
    for (int i = 0; i < 8; ++i) acc += *(const f32x4*)(redk + ((i * 8 + w) * 64 + lane) * 4);
    float ss = 0.f;
    E.apply(row, col, acc, d, ss, rv);
    ss += __shfl_xor(ss, 16); ss += __shfl_xor(ss, 32);
    float* red = (float*)smem;
    __syncthreads();
    if (fq == 0) red[w * 16 + fr] = ss;
    __syncthreads();
    if (tid < 16) {
        float t = 0.f;
#pragma unroll
        for (int i = 0; i < 8; ++i) t += red[i * 16 + tid];
        E.rowput(row0 + tid, t, (col0 >> 7) * 2);
    }
    __syncthreads();
}

DEV void transpose_item(const float* __restrict__ src, int ldsrc, int k0, int c0, bf16_t* __restrict__ dst, int lddst, int n0,
                        const float* __restrict__ kscale, float* scr, int lane) {
    const int cl = lane & 31, kh = lane >> 5;
    float v[32];
#pragma unroll
    for (int i = 0; i < 32; ++i) v[i] = src[(long)(k0 + 2 * i + kh) * ldsrc + c0 + cl];
    if (kscale) {
#pragma unroll
        for (int i = 0; i < 32; ++i) v[i] *= kscale[k0 + 2 * i + kh];
    }
#pragma unroll
    for (int i = 0; i < 32; ++i) scr[(2 * i + kh) * 33 + cl] = v[i];
    lds_fence();
    const int c = lane & 7;
#pragma unroll
    for (int j = 0; j < 4; ++j) {
        const int n = (lane >> 3) + 8 * j; const float* sp = scr + (8 * c) * 33 + n;
        u32x4 o; o.x = pk2(sp[0 * 33], sp[1 * 33]); o.y = pk2(sp[2 * 33], sp[3 * 33]); o.z = pk2(sp[4 * 33], sp[5 * 33]); o.w = pk2(sp[6 * 33], sp[7 * 33]);
        *(u32x4*)(dst + (long)(n0 + n) * lddst + k0 + 8 * c) = o;
    }
    lds_fence();
}

DEV void phase0(const Params& P) {
    const int tid = tid_fresh(), lane = tid & 63, wave = tid >> 6, G = gridDim.x, bid = blockIdx.x;
    char* ws = P.ws;
    float* tile = (float*)smem;
    {
        float* scr = (float*)smem + wave * (64 * 33);
        constexpr int I_IN = 144 * 16, I_OUT = 32 * 32, I_GLU = 32 * 16, I_GATE = 32 * 16, I_PPW = 32 * 4;
        constexpr int I_ALL = I_IN + I_OUT + I_GLU + I_GATE + I_PPW;
        for (int it = bid * 8 + wave; it < I_ALL; it += G * 8) {
            int r = it;
            if (r < I_IN) {
                const int nb = r >> 4, kb = r & 15, n0 = nb * 32;
                int c0;
                if (n0 < 1024) c0 = n0; else if (n0 < 2048) c0 = 2576 + (n0 - 1024); else if (n0 < 3584) c0 = 1024 + (n0 - 2048); else c0 = 3600 + (n0 - 3584);
                transpose_item(P.in[I_WIN], 4624, kb * 64, c0, (bf16_t*)(ws + W_WTIN), 1024, n0, P.in[I_GIN], scr, lane); continue;
            }
            r -= I_IN;
            if (r < I_OUT) { const int nb = r >> 5, kb = r & 31; transpose_item(P.in[I_WOUT], 1024, kb * 64, nb * 32, (bf16_t*)(ws + W_WTOUT), 2048, nb * 32, nullptr, scr, lane); continue; }
            r -= I_OUT;
            if (r < I_GLU) { const int nb = r >> 4, kb = r & 15; transpose_item(P.in[I_GLUW], 1024, kb * 64, nb * 32, (bf16_t*)(ws + W_WTGLU), 1024, nb * 32, nullptr, scr, lane); continue; }
            r -= I_GLU;
            if (r < I_GATE) { const int nb = r >> 4, kb = r & 15; transpose_item(P.in[I_WGATE], 1024, kb * 64, nb * 32, (bf16_t*)(ws + W_WTGATE), 1024, nb * 32, P.in[I_GPLE], scr, lane); continue; }
            r -= I_GATE;
            { const int nb = r >> 2, kb = r & 3; transpose_item(P.in[I_WPP], 1024, kb * 64, nb * 32, (bf16_t*)(ws + W_WTPP), 256, nb * 32, nullptr, scr, lane); }
        }
        __syncthreads();
    }
    bf16_t* wdt = (bf16_t*)smem;
    float* psum = (float*)(smem + 16 * 1032 * 2);
    float* pdt = psum + 128;
    {
        float wv[32];
#pragma unroll
        for (int i = 0; i < 32; ++i) { const int idx = tid + i * 512, k = idx >> 4, e = idx & 15; wv[i] = P.in[I_WIN][(long)k * 4624 + 2560 + e] * P.in[I_GIN][k]; }
#pragma unroll
        for (int i = 0; i < 32; ++i) { const int idx = tid + i * 512, k = idx >> 4, e = idx & 15; wdt[e * 1032 + k] = (bf16_t)(pk2(wv[i], 0.f) & 0xffffu); }
    }
    __syncthreads();
    {
        const int fr = lane & 15, fq = lane >> 4;
        bf16x8 wf[4];
#pragma unroll
        for (int j = 0; j < 4; ++j) wf[j] = *(const bf16x8*)(wdt + fr * 1032 + (wave * 4 + j) * 32 + fq * 8);
        bf16_t* xb = (bf16_t*)(ws + W_NB);
        float* dtr = (float*)(ws + W_DTR);
        float* rstdp = (float*)(ws + W_RSTD);
        f32x4 xan[4], xcn[4];
        if (bid < NTOK / 16) {
            const int row = bid * 16 + fr;
            const float* xr = (row < NPROMPT ? P.in[I_XP] + (long)row * 1024 : P.in[I_XS] + (long)(row - NPROMPT) * 1024) + wave * 128 + fq * 8;
#pragma unroll
            for (int j = 0; j < 4; ++j) { xan[j] = *(const f32x4*)(xr + j * 32); xcn[j] = *(const f32x4*)(xr + j * 32 + 4); }
        }
        for (int task = bid; task < NTOK / 16; task += G) {
            const int row = task * 16 + fr;
            f32x4 xa[4], xc[4];
#pragma unroll
            for (int j = 0; j < 4; ++j) { xa[j] = xan[j]; xc[j] = xcn[j]; }
            if (task + G < NTOK / 16) {
                const int rown = (task + G) * 16 + fr;
                const float* xr = (rown < NPROMPT ? P.in[I_XP] + (long)rown * 1024 : P.in[I_XS] + (long)(rown - NPROMPT) * 1024) + wave * 128 + fq * 8;
#pragma unroll
                for (int j = 0; j < 4; ++j) { xan[j] = *(const f32x4*)(xr + j * 32); xcn[j] = *(const f32x4*)(xr + j * 32 + 4); }
            }
            f32x4 acc = {0.f, 0.f, 0.f, 0.f}; float ss = 0.f;
#pragma unroll
            for (int j = 0; j < 4; ++j) {
                ss += xa[j][0] * xa[j][0] + xa[j][1] * xa[j][1] + xa[j][2] * xa[j][2] + xa[j][3] * xa[j][3] + xc[j][0] * xc[j][0] + xc[j][1] * xc[j][1] + xc[j][2] * xc[j][2] + xc[j][3] * xc[j][3];
                u32x4 q; q.x = pk2(xa[j][0], xa[j][1]); q.y = pk2(xa[j][2], xa[j][3]); q.z = pk2(xc[j][0], xc[j][1]); q.w = pk2(xc[j][2], xc[j][3]);
                *(u32x4*)(xb + (long)row * 1024 + wave * 128 + j * 32 + fq * 8) = q;
                acc = mfma16(wf[j], __builtin_bit_cast(bf16x8, q), acc);
            }
            ss += __shfl_xor(ss, 16); ss += __shfl_xor(ss, 32);
            if (fq == 0) psum[wave * 16 + fr] = ss;
            *(f32x4*)(pdt + wave * 256 + fr * 16 + fq * 4) = acc;
            __syncthreads();
            if (tid < 256) {
                const int t = tid >> 4, e = tid & 15;
                float tot = 0.f, d = 0.f;
#pragma unroll
                for (int w8 = 0; w8 < 8; ++w8) { tot += psum[w8 * 16 + t]; d += pdt[w8 * 256 + t * 16 + e]; }
                const float rstd = rsqrtf(tot * (1.f / 1024.f) + EPS);
                dtr[(long)(task * 16 + t) * 16 + e] = d * rstd;
                if (e == 0) rstdp[task * 16 + t] = rstd;
            }
            __syncthreads();
        }
    }
    bf16_t* pb = (bf16_t*)(ws + W_PB);
    for (int idx = bid * 512 + tid; idx < NTOK * 64; idx += G * 512) {
        const int row = idx >> 6, c4 = (idx & 63) * 4;
        const float* src = row < NPROMPT ? P.in[I_PP] + (long)row * 256 : P.in[I_PS] + (long)(row - NPROMPT) * 256;
        const f32x4 v = *(const f32x4*)(src + c4);
        u32x2 o; o.x = pk2(v[0], v[1]); o.y = pk2(v[2], v[3]);
        *(u32x2*)(pb + (long)row * 256 + c4) = o;
    }
    __syncthreads();
}

DEV void conv_load7(const bf16_t* __restrict__ pcol, long row0, int t0, u32x4 (&raw)[7]) {
#pragma unroll
    for (int i = 0; i < 7; ++i) {
        const int t = t0 - 3 + i;
        raw[i] = (u32x4){0u, 0u, 0u, 0u};
        if (t >= 0) raw[i] = *(const u32x4*)(pcol + (row0 - 3 + i) * PLD);
    }
}
DEV void conv_compute(const u32x4 (&rawp)[7], const float* __restrict__ cw, const float* __restrict__ cb, float (&o)[4][8]) {
    float raw[7][8];
#pragma unroll
    for (int i = 0; i < 7; ++i) {
        const u32x4 u = rawp[i];
        raw[i][0] = bflo(u.x); raw[i][1] = bfhi(u.x); raw[i][2] = bflo(u.y); raw[i][3] = bfhi(u.y);
        raw[i][4] = bflo(u.z); raw[i][5] = bfhi(u.z); raw[i][6] = bflo(u.w); raw[i][7] = bfhi(u.w);
    }
    float w[4][8], bias[8];
#pragma unroll
    for (int k = 0; k < 4; ++k) {
        const f32x4 a = *(const f32x4*)(cw + k * 1536), b = *(const f32x4*)(cw + k * 1536 + 4);
        w[k][0] = a[0]; w[k][1] = a[1]; w[k][2] = a[2]; w[k][3] = a[3]; w[k][4] = b[0]; w[k][5] = b[1]; w[k][6] = b[2]; w[k][7] = b[3];
    }
    { const f32x4 a = *(const f32x4*)(cb), b = *(const f32x4*)(cb + 4);
      bias[0] = a[0]; bias[1] = a[1]; bias[2] = a[2]; bias[3] = a[3]; bias[4] = b[0]; bias[5] = b[1]; bias[6] = b[2]; bias[7] = b[3]; }
#pragma unroll
    for (int j = 0; j < 4; ++j)
#pragma unroll
        for (int c = 0; c < 8; ++c) {
            float a = bias[c];
#pragma unroll
            for (int k = 0; k < 4; ++k) a += w[k][c] * raw[j + k][c];
            o[j][c] = siluf(a);
        }
}
DEV void conv_compute_lds(const u32x4 (&rawp)[7], const float* cwl, float (&o)[4][8]) {
    float raw[7][8];
#pragma unroll
    for (int i = 0; i < 7; ++i) {
        const u32x4 u = rawp[i];
        raw[i][0] = bflo(u.x); raw[i][1] = bfhi(u.x); raw[i][2] = bflo(u.y); raw[i][3] = bfhi(u.y);
        raw[i][4] = bflo(u.z); raw[i][5] = bfhi(u.z); raw[i][6] = bflo(u.w); raw[i][7] = bfhi(u.w);
    }
    float w[5][8];
#pragma unroll
    for (int k = 0; k < 5; ++k) {
        const f32x4 a = *(const f32x4*)(cwl + k * 512), b = *(const f32x4*)(cwl + k * 512 + 4);
        w[k][0] = a[0]; w[k][1] = a[1]; w[k][2] = a[2]; w[k][3] = a[3]; w[k][4] = b[0]; w[k][5] = b[1]; w[k][6] = b[2]; w[k][7] = b[3];
    }
#pragma unroll
    for (int j = 0; j < 4; ++j)
#pragma unroll
        for (int c = 0; c < 8; ++c) {
            float a = w[4][c];
#pragma unroll
            for (int k = 0; k < 4; ++k) a += w[k][c] * raw[j + k][c];
            o[j][c] = siluf(a);
        }
}
DEV void conv4x8(const bf16_t* __restrict__ pcol, long row0, int t0, const float* __restrict__ hist, const float* __restrict__ cw, const float* __restrict__ cb, float (&o)[4][8]) {
    float raw[7][8];
#pragma unroll
    for (int i = 0; i < 7; ++i) {
        const int t = t0 - 3 + i;
        if (t >= 0) {
            const u32x4 u = *(const u32x4*)(pcol + (row0 - 3 + i) * PLD);
            raw[i][0] = bflo(u.x); raw[i][1] = bfhi(u.x); raw[i][2] = bflo(u.y); raw[i][3] = bfhi(u.y);
            raw[i][4] = bflo(u.z); raw[i][5] = bfhi(u.z); raw[i][6] = bflo(u.w); raw[i][7] = bfhi(u.w);
        } else if (hist) {
            const f32x4 a = *(const f32x4*)(hist + (long)(t + 3) * 1536), b = *(const f32x4*)(hist + (long)(t + 3) * 1536 + 4);
            raw[i][0] = a[0]; raw[i][1] = a[1]; raw[i][2] = a[2]; raw[i][3] = a[3]; raw[i][4] = b[0]; raw[i][5] = b[1]; raw[i][6] = b[2]; raw[i][7] = b[3];
        } else {
#pragma unroll
            for (int c = 0; c < 8; ++c) raw[i][c] = 0.f;
        }
    }
    float w[4][8], bias[8];
#pragma unroll
    for (int k = 0; k < 4; ++k) {
        const f32x4 a = *(const f32x4*)(cw + k * 1536), b = *(const f32x4*)(cw + k * 1536 + 4);
        w[k][0] = a[0]; w[k][1] = a[1]; w[k][2] = a[2]; w[k][3] = a[3]; w[k][4] = b[0]; w[k][5] = b[1]; w[k][6] = b[2]; w[k][7] = b[3];
    }
    { const f32x4 a = *(const f32x4*)(cb), b = *(const f32x4*)(cb + 4);
      bias[0] = a[0]; bias[1] = a[1]; bias[2] = a[2]; bias[3] = a[3]; bias[4] = b[0]; bias[5] = b[1]; bias[6] = b[2]; bias[7] = b[3]; }
#pragma unroll
    for (int j = 0; j < 4; ++j)
#pragma unroll
        for (int c = 0; c < 8; ++c) {
            float a = bias[c];
#pragma unroll
            for (int k = 0; k < 4; ++k) a += w[k][c] * raw[j + k][c];
            o[j][c] = siluf(a);
        }
}

constexpr int PIT = 136;
constexpr int R1_OFF = 0, R2_OFF = 128 * PIT * 2, R3_OFF = 2 * 128 * PIT * 2, R4_OFF = 3 * 128 * PIT * 2;

DEV void ssd_s1_item(const Params& P, int item) {
    const int tid = tid_fresh(), lane = tid & 63, w = tid >> 6, fr = lane & 15, fq = lane >> 4;
    const int b = item >> 5, c = (item >> 1) & 15, g = item & 1;
    char* ws = P.ws;
    const bf16_t* proj = (const bf16_t*)(ws + W_PROJ);
    const long rowc = (long)b * 2048 + c * 128;
    bf16_t* R1 = (bf16_t*)(smem + R1_OFF); bf16_t* R2 = (bf16_t*)(smem + R2_OFF); bf16_t* R3 = (bf16_t*)(smem + R3_OFF);
    float* acs = (float*)(smem + R4_OFF);
    float* dtv = acs + 1024;
    {
        const int h = g * 8 + w;
        const float bias = P.in[I_DTB][h], A = -__expf(P.in[I_ALOG][h]);
        const float* dtr = (const float*)(ws + W_DTR);
        float x0 = dtr[(rowc + 2 * lane) * 16 + h] + bias, x1 = dtr[(rowc + 2 * lane + 1) * 16 + h] + bias;
        float d0 = x0 > 20.f ? x0 : log1pf(__expf(x0)), d1 = x1 > 20.f ? x1 : log1pf(__expf(x1));
        float a0 = d0 * A, a1 = a0 + d1 * A;
        float run = a1;
#pragma unroll
        for (int o = 1; o < 64; o <<= 1) { float t = __shfl_up(run, o); if (lane >= o) run += t; }
        const float excl = run - a1;
        a0 += excl; a1 += excl;
        acs[w * 128 + 2 * lane] = a0; acs[w * 128 + 2 * lane + 1] = a1;
        dtv[w * 128 + 2 * lane] = d0; dtv[w * 128 + 2 * lane + 1] = d1;
        float* acsg = (float*)(ws + W_ACS) + (((long)b * 16 + c) * 16 + h) * 128;
        acsg[2 * lane] = a0; acsg[2 * lane + 1] = a1;
        if (lane == 63) ((float*)(ws + W_CDEC))[(b * 16 + c) * 16 + h] = __expf(a1);
    }
    float* cwl = (float*)(smem + R4_OFF + 8192);
    for (int u = tid; u < 5 * 512; u += 512) { const int k = u >> 9, ch = u & 511; cwl[u] = k < 4 ? P.in[I_CONVW][k * 1536 + g * 512 + ch] : P.in[I_CONVB][g * 512 + ch]; }
    {
        const int nblk = tid & 15, lq = tid >> 4, l0 = lq * 4;
#pragma unroll
        for (int j = 0; j < 2; ++j) {
            const int ch0 = 1024 + j * 256 + g * 128 + nblk * 8;
            float o[4][8];
            conv4x8(proj + C_XBC + ch0, rowc + l0, c * 128 + l0, nullptr, P.in[I_CONVW] + ch0, P.in[I_CONVB] + ch0, o);
            bf16_t* dst = j == 0 ? R2 : R1;
#pragma unroll
            for (int r = 0; r < 4; ++r) {
                u32x4 q; q.x = pk2(o[r][0], o[r][1]); q.y = pk2(o[r][2], o[r][3]); q.z = pk2(o[r][4], o[r][5]); q.w = pk2(o[r][6], o[r][7]);
                *(u32x4*)(dst + (l0 + r) * PIT + nblk * 8) = q;
            }
            if (j == 0) {
#pragma unroll
                for (int i = 0; i < 8; ++i) {
                    u32x2 q; q.x = pk2(o[0][i], o[1][i]); q.y = pk2(o[2][i], o[3][i]);
                    *(u32x2*)(R3 + (nblk * 8 + i) * PIT + l0) = q;
                }
            }
        }
    }
    __syncthreads();
    const int wr = w >> 1, wc = w & 1;
    f32x4 cbm[2][4];
#pragma unroll
    for (int m = 0; m < 2; ++m)
#pragma unroll
        for (int n = 0; n < 4; ++n) cbm[m][n] = (f32x4){0.f, 0.f, 0.f, 0.f};
#pragma unroll
    for (int ks = 0; ks < 4; ++ks) {
        bf16x8 af[2], bfm[4];
#pragma unroll
        for (int m = 0; m < 2; ++m) af[m] = *(const bf16x8*)(R1 + (wr * 32 + m * 16 + fr) * PIT + ks * 32 + fq * 8);
#pragma unroll
        for (int n = 0; n < 4; ++n) bfm[n] = *(const bf16x8*)(R2 + (wc * 64 + n * 16 + fr) * PIT + ks * 32 + fq * 8);
#pragma unroll
        for (int m = 0; m < 2; ++m)
#pragma unroll
            for (int n = 0; n < 4; ++n) cbm[m][n] = mfma16(bfm[n], af[m], cbm[m][n]);
    }
    __syncthreads();
    bf16_t* XT = R2; bf16_t* XW = R2 + 64 * PIT;
    bf16_t* ydg = (bf16_t*)(ws + W_NB);
    float* states = P.out;
    const int wp = w >> 2, wn = w & 3;
    u32x4 rawn[7];
    if (tid < 256) conv_load7(proj + C_XBC + (g * 8) * 64 + (tid & 7) * 8, rowc + (tid >> 3) * 4, c * 128 + (tid >> 3) * 4, rawn);
    for (int e = 0; e < 8; ++e) {
        const int h = g * 8 + e;
        const float dskip = P.in[I_SSDD][h];
        if (tid < 256) {
            const int pblk = tid & 7, lq = tid >> 3, l0 = lq * 4, ch0 = h * 64 + pblk * 8;
            float o[4][8];
            conv_compute_lds(rawn, cwl + e * 64 + pblk * 8, o);
            if (e < 7) conv_load7(proj + C_XBC + ch0 + 64, rowc + l0, c * 128 + l0, rawn);
            const float alast = acs[e * 128 + 127];
            float we[4];
#pragma unroll
            for (int r = 0; r < 4; ++r) we[r] = __expf(alast - acs[e * 128 + l0 + r]) * dtv[e * 128 + l0 + r];
#pragma unroll
            for (int i = 0; i < 8; ++i) {
                u32x2 q; q.x = pk2(o[0][i], o[1][i]); q.y = pk2(o[2][i], o[3][i]);
                *(u32x2*)(XT + (pblk * 8 + i) * PIT + l0) = q;
                u32x2 q2; q2.x = pk2(o[0][i] * we[0], o[1][i] * we[1]); q2.y = pk2(o[2][i] * we[2], o[3][i] * we[3]);
                *(u32x2*)(XW + (pblk * 8 + i) * PIT + l0) = q2;
            }
        }
#pragma unroll
        for (int m = 0; m < 2; ++m) {
            const int l = wr * 32 + m * 16 + fr; const float al = acs[e * 128 + l];
#pragma unroll
            for (int n = 0; n < 4; ++n) {
                const int s0 = wc * 64 + n * 16 + fq * 4;
                const f32x4 as = *(const f32x4*)(acs + e * 128 + s0), ds = *(const f32x4*)(dtv + e * 128 + s0);
                float v[4];
#pragma unroll
                for (int r = 0; r < 4; ++r) { const float t = cbm[m][n][r] * __expf(al - as[r]) * ds[r]; v[r] = (s0 + r <= l) ? t : 0.f; }
                u32x2 q; q.x = pk2(v[0], v[1]); q.y = pk2(v[2], v[3]);
                *(u32x2*)(R1 + l * PIT + s0) = q;
            }
        }
        __syncthreads();
        {
            f32x4 yd[2][2];
#pragma unroll
            for (int m = 0; m < 2; ++m)
#pragma unroll
                for (int n = 0; n < 2; ++n) yd[m][n] = (f32x4){0.f, 0.f, 0.f, 0.f};
            {
                bf16x8 af[4][2], bfm[4][2];
#pragma unroll
                for (int ks = 0; ks < 4; ++ks) {
#pragma unroll
                    for (int m = 0; m < 2; ++m) af[ks][m] = *(const bf16x8*)(R1 + (wr * 32 + m * 16 + fr) * PIT + ks * 32 + fq * 8);
#pragma unroll
                    for (int n = 0; n < 2; ++n) bfm[ks][n] = *(const bf16x8*)(XT + (wc * 32 + n * 16 + fr) * PIT + ks * 32 + fq * 8);
                }
                __builtin_amdgcn_sched_barrier(0);
#pragma unroll
                for (int ks = 0; ks < 4; ++ks)
                    if (ks <= wr) {
#pragma unroll
                        for (int m = 0; m < 2; ++m)
#pragma unroll
                            for (int n = 0; n < 2; ++n) yd[m][n] = mfma16(bfm[ks][n], af[ks][m], yd[m][n]);
                    }
            }
#pragma unroll
            for (int m = 0; m < 2; ++m)
#pragma unroll
                for (int n = 0; n < 2; ++n) {
                    const int l = wr * 32 + m * 16 + fr, p0 = wc * 32 + n * 16 + fq * 4;
                    const float x0 = __uint_as_float(((unsigned)XT[(p0 + 0) * PIT + l]) << 16), x1 = __uint_as_float(((unsigned)XT[(p0 + 1) * PIT + l]) << 16);
                    const float x2 = __uint_as_float(((unsigned)XT[(p0 + 2) * PIT + l]) << 16), x3 = __uint_as_float(((unsigned)XT[(p0 + 3) * PIT + l]) << 16);
                    u32x2 q; q.x = pk2(yd[m][n][0] + dskip * x0, yd[m][n][1] + dskip * x1); q.y = pk2(yd[m][n][2] + dskip * x2, yd[m][n][3] + dskip * x3);
                    *(u32x2*)(ydg + (rowc + l) * 1024 + h * 64 + p0) = q;
                }
        }
        {
            f32x4 st[2][2];
#pragma unroll
            for (int m = 0; m < 2; ++m)
#pragma unroll
                for (int n = 0; n < 2; ++n) st[m][n] = (f32x4){0.f, 0.f, 0.f, 0.f};
            {
                bf16x8 af[4][2], bfm[4][2];
#pragma unroll
                for (int ks = 0; ks < 4; ++ks) {
#pragma unroll
                    for (int m = 0; m < 2; ++m) af[ks][m] = *(const bf16x8*)(XW + (wp * 32 + m * 16 + fr) * PIT + ks * 32 + fq * 8);
#pragma unroll
                    for (int n = 0; n < 2; ++n) bfm[ks][n] = *(const bf16x8*)(R3 + (wn * 32 + n * 16 + fr) * PIT + ks * 32 + fq * 8);
                }
                __builtin_amdgcn_sched_barrier(0);
#pragma unroll
                for (int ks = 0; ks < 4; ++ks)
#pragma unroll
                    for (int m = 0; m < 2; ++m)
#pragma unroll
                        for (int n = 0; n < 2; ++n) st[m][n] = mfma16(bfm[ks][n], af[ks][m], st[m][n]);
            }
            float* sp = states + (((long)b * 16 + c) * 16 + h) * 8192;
#pragma unroll
            for (int m = 0; m < 2; ++m)
#pragma unroll
                for (int n = 0; n < 2; ++n) {
                    const int p = wp * 32 + m * 16 + fr, n0 = wn * 32 + n * 16 + fq * 4;
                    *(f32x4*)(sp + p * 128 + n0) = st[m][n];
                }
        }
        __syncthreads();
    }
}

DEV void ssd_s2(const Params& P) {
    float* states = P.out;
    const float* cdec = (const float*)(P.ws + W_CDEC);
    for (int idx = blockIdx.x * 512 + threadIdx.x; idx < 262144; idx += gridDim.x * 512) {
        const int bh = idx >> 11, q = idx & 2047, b = bh >> 4, h = bh & 15;
        f32x4 H = (f32x4){0.f, 0.f, 0.f, 0.f};
#pragma unroll
        for (int c = 0; c < 16; ++c) {
            f32x4* ptr = (f32x4*)(states + (((long)b * 16 + c) * 16 + h) * 8192) + q;
            const f32x4 s = *ptr; *ptr = H;
            const float d = cdec[(b * 16 + c) * 16 + h];
            H = H * d + s;
        }
        *((f32x4*)(P.out + O_SSDP + (long)bh * 8192) + q) = H;
    }
}

DEV void ssd_s3_item(const Params& P, int item) {
    const int tid = tid_fresh(), lane = tid & 63, w = tid >> 6, fr = lane & 15, fq = lane >> 4;
    const int b = item >> 5, c = (item >> 1) & 15, g = item & 1;
    char* ws = P.ws;
    bf16_t* proj = (bf16_t*)(ws + W_PROJ);
    const long rowc = (long)b * 2048 + c * 128;
    bf16_t* R1 = (bf16_t*)(smem + R1_OFF); bf16_t* HB = (bf16_t*)(smem + R2_OFF);
    float* ssq = (float*)(smem + R4_OFF);
    const bf16_t* ydg = (const bf16_t*)(ws + W_NB);
    const float* states = P.out;
    const float* acsg = (const float*)(ws + W_ACS);
    const int hp = tid >> 3, hn0 = (tid & 7) * 16;
    f32x4 hreg[4];
    {
        const float* sp = states + (((long)b * 16 + c) * 16 + g * 8) * 8192 + hp * 128 + hn0;
#pragma unroll
        for (int i = 0; i < 4; ++i) hreg[i] = *(const f32x4*)(sp + i * 4);
    }
    __syncthreads();
    {
        const int nblk = tid & 15, lq = tid >> 4, l0 = lq * 4;
        const int ch0 = 1280 + g * 128 + nblk * 8;
        float o[4][8];
        conv4x8(proj + C_XBC + ch0, rowc + l0, c * 128 + l0, nullptr, P.in[I_CONVW] + ch0, P.in[I_CONVB] + ch0, o);
#pragma unroll
        for (int r = 0; r < 4; ++r) {
            u32x4 q; q.x = pk2(o[r][0], o[r][1]); q.y = pk2(o[r][2], o[r][3]); q.z = pk2(o[r][4], o[r][5]); q.w = pk2(o[r][6], o[r][7]);
            *(u32x4*)(R1 + (l0 + r) * PIT + nblk * 8) = q;
        }
    }
    const int wr = w >> 1, wc = w & 1;
    unsigned ypk[8][2][2][2];
    float ssl[2] = {0.f, 0.f};
    bf16x8 afc[4][2];
#pragma unroll
    for (int e = 0; e < 8; ++e) {
        const int h = g * 8 + e;
        bf16_t* hb = HB + (e & 1) * 64 * PIT;
        {
            u32x4 q0, q1;
            q0.x = pk2(hreg[0][0], hreg[0][1]); q0.y = pk2(hreg[0][2], hreg[0][3]); q0.z = pk2(hreg[1][0], hreg[1][1]); q0.w = pk2(hreg[1][2], hreg[1][3]);
            q1.x = pk2(hreg[2][0], hreg[2][1]); q1.y = pk2(hreg[2][2], hreg[2][3]); q1.z = pk2(hreg[3][0], hreg[3][1]); q1.w = pk2(hreg[3][2], hreg[3][3]);
            *(u32x4*)(hb + hp * PIT + hn0) = q0; *(u32x4*)(hb + hp * PIT + hn0 + 8) = q1;
        }
        if (e < 7) {
            const float* sp = states + (((long)b * 16 + c) * 16 + h + 1) * 8192 + hp * 128 + hn0;
#pragma unroll
            for (int i = 0; i < 4; ++i) hreg[i] = *(const f32x4*)(sp + i * 4);
        }
        u32x2 yq[2][2], zz[2][2]; float ea[2];
#pragma unroll
        for (int m = 0; m < 2; ++m) {
            const int l = wr * 32 + m * 16 + fr;
            ea[m] = acsg[(((long)b * 16 + c) * 16 + h) * 128 + l];
#pragma unroll
            for (int n = 0; n < 2; ++n) {
                const int p0 = wc * 32 + n * 16 + fq * 4;
                yq[m][n] = *(const u32x2*)(ydg + (rowc + l) * 1024 + h * 64 + p0);
                zz[m][n] = *(const u32x2*)(proj + (rowc + l) * PLD + C_ZA + h * 64 + p0);
            }
        }
        __syncthreads();
        if (e == 0) {
#pragma unroll
            for (int ks = 0; ks < 4; ++ks)
#pragma unroll
                for (int m = 0; m < 2; ++m) afc[ks][m] = *(const bf16x8*)(R1 + (wr * 32 + m * 16 + fr) * PIT + ks * 32 + fq * 8);
        }
        f32x4 yo[2][2];
#pragma unroll
        for (int m = 0; m < 2; ++m)
#pragma unroll
            for (int n = 0; n < 2; ++n) yo[m][n] = (f32x4){0.f, 0.f, 0.f, 0.f};
        {
            bf16x8 bfm[4][2];
#pragma unroll
            for (int ks = 0; ks < 4; ++ks)
#pragma unroll
                for (int n = 0; n < 2; ++n) bfm[ks][n] = *(const bf16x8*)(hb + (wc * 32 + n * 16 + fr) * PIT + ks * 32 + fq * 8);
            __builtin_amdgcn_sched_barrier(0);
#pragma unroll
            for (int ks = 0; ks < 4; ++ks)
#pragma unroll
                for (int m = 0; m < 2; ++m)
#pragma unroll
                    for (int n = 0; n < 2; ++n) yo[m][n] = mfma16(bfm[ks][n], afc[ks][m], yo[m][n]);
        }
#pragma unroll
        for (int m = 0; m < 2; ++m) {
            const float eam = __expf(ea[m]);
#pragma unroll
            for (int n = 0; n < 2; ++n) {
                const float v0 = (bflo(yq[m][n].x) + eam * yo[m][n][0]) * siluf(bflo(zz[m][n].x)), v1 = (bfhi(yq[m][n].x) + eam * yo[m][n][1]) * siluf(bfhi(zz[m][n].x));
                const float v2 = (bflo(yq[m][n].y) + eam * yo[m][n][2]) * siluf(bflo(zz[m][n].y)), v3 = (bfhi(yq[m][n].y) + eam * yo[m][n][3]) * siluf(bfhi(zz[m][n].y));
                ssl[m] += v0 * v0 + v1 * v1 + v2 * v2 + v3 * v3;
                ypk[e][m][n][0] = pk2(v0, v1); ypk[e][m][n][1] = pk2(v2, v3);
            }
        }
    }
#pragma unroll
    for (int m = 0; m < 2; ++m) {
        float ss = ssl[m];
        ss += __shfl_xor(ss, 16); ss += __shfl_xor(ss, 32);
        if (fq == 0) ssq[wc * 128 + wr * 32 + m * 16 + fr] = ss;
    }
    f32x4 ggv[8][2];
#pragma unroll
    for (int e = 0; e < 8; ++e)
#pragma unroll
        for (int n = 0; n < 2; ++n) ggv[e][n] = *(const f32x4*)(P.in[I_SSDG] + (g * 8 + e) * 64 + wc * 32 + n * 16 + fq * 4);
    __syncthreads();
#pragma unroll
    for (int m = 0; m < 2; ++m) {
        const int l = wr * 32 + m * 16 + fr;
        const float rstd = rsqrtf((ssq[l] + ssq[128 + l]) * (1.f / 512.f) + EPS);
#pragma unroll
        for (int e = 0; e < 8; ++e)
#pragma unroll
            for (int n = 0; n < 2; ++n) {
                const int h = g * 8 + e, p0 = wc * 32 + n * 16 + fq * 4;
                const f32x4 gg = ggv[e][n];
                const unsigned a0 = ypk[e][m][n][0], a1 = ypk[e][m][n][1];
                u32x2 o; o.x = pk2(bflo(a0) * rstd * gg[0], bfhi(a0) * rstd * gg[1]); o.y = pk2(bflo(a1) * rstd * gg[2], bfhi(a1) * rstd * gg[3]);
                *(u32x2*)(proj + (rowc + l) * PLD + C_ZA + h * 64 + p0) = o;
            }
    }
}

DEV void ssd_sample_item(const Params& P, int item) {
    const int tid = tid_fresh();
    const int b = item >> 1, g = item & 1;
    char* ws = P.ws;
    bf16_t* proj = (bf16_t*)(ws + W_PROJ);
    const long row0 = NPROMPT + (long)b * 4;
    float* xs = (float*)smem;
    float* Bs = xs + 2048;
    float* Cs = Bs + 512;
    float* dts = Cs + 512;
    float* das = dts + 32;
    float* vs = das + 32;
    float* red = vs + 2048;
    float* zs = red + 32;
    for (int u = tid; u < 768; u += 512) {
        int ch; float* dst; int dcol;
        if (u < 512) { ch = g * 512 + u; dst = xs; dcol = u; }
        else if (u < 640) { ch = 1024 + g * 128 + (u - 512); dst = Bs; dcol = u - 512; }
        else { ch = 1280 + g * 128 + (u - 640); dst = Cs; dcol = u - 640; }
        const int pitch = u < 512 ? 512 : 128;
        float full[7];
#pragma unroll
        for (int i = 0; i < 3; ++i) full[i] = P.in[I_CONV][((long)b * 3 + i) * 1536 + ch];
#pragma unroll
        for (int i = 0; i < 4; ++i) full[3 + i] = __uint_as_float(((unsigned)proj[(row0 + i) * PLD + C_XBC + ch]) << 16);
        const float w0 = P.in[I_CONVW][ch], w1 = P.in[I_CONVW][1536 + ch], w2 = P.in[I_CONVW][3072 + ch], w3 = P.in[I_CONVW][4608 + ch], bias = P.in[I_CONVB][ch];
#pragma unroll
        for (int t = 0; t < 4; ++t) dst[t * pitch + dcol] = siluf(bias + w0 * full[t] + w1 * full[t + 1] + w2 * full[t + 2] + w3 * full[t + 3]);
    }
    for (int u = tid; u < 4 * 256; u += 512) {
        const int t = u >> 8, c2 = (u & 255) * 2;
        const unsigned zz = *(const unsigned*)(proj + (row0 + t) * PLD + C_ZA + g * 512 + c2);
        zs[t * 512 + c2] = bflo(zz); zs[t * 512 + c2 + 1] = bfhi(zz);
    }
    if (tid < 32) {
        const int t = tid >> 3, e = tid & 7, h = g * 8 + e;
        const float x = ((const float*)(ws + W_DTR))[(row0 + t) * 16 + h] + P.in[I_DTB][h];
        const float d = x > 20.f ? x : log1pf(__expf(x));
        dts[tid] = d; das[tid] = __expf(-d * __expf(P.in[I_ALOG][h]));
    }
    __syncthreads();
    const int p = tid >> 3, nb = tid & 7, n0 = nb * 16;
    f32x4 hn[4];
    {
        const float* sp0 = P.in[I_SSD] + (((long)b * 16 + g * 8) * 64 + p) * 128 + n0;
#pragma unroll
        for (int i = 0; i < 4; ++i) hn[i] = *(const f32x4*)(sp0 + i * 4);
    }
    for (int e = 0; e < 8; ++e) {
        const int h = g * 8 + e;
        float* op = P.out + O_SSDS + (((long)b * 16 + h) * 64 + p) * 128 + n0;
        f32x4 hv[4];
#pragma unroll
        for (int i = 0; i < 4; ++i) hv[i] = hn[i];
        if (e < 7) {
            const float* sp = P.in[I_SSD] + (((long)b * 16 + h + 1) * 64 + p) * 128 + n0;
#pragma unroll
            for (int i = 0; i < 4; ++i) hn[i] = *(const f32x4*)(sp + i * 4);
        }
        const float dsk = P.in[I_SSDD][h];
        float yv4[4], xv4[4];
#pragma unroll
        for (int t = 0; t < 4; ++t) {
            const float dec = das[t * 8 + e], xv = xs[t * 512 + e * 64 + p], coef = dts[t * 8 + e] * xv;
            float part = 0.f;
#pragma unroll
            for (int i = 0; i < 4; ++i) {
                const f32x4 bv = *(const f32x4*)(Bs + t * 128 + n0 + i * 4), cv = *(const f32x4*)(Cs + t * 128 + n0 + i * 4);
                hv[i] = hv[i] * dec + bv * coef;
                part += hv[i][0] * cv[0] + hv[i][1] * cv[1] + hv[i][2] * cv[2] + hv[i][3] * cv[3];
            }
            yv4[t] = part; xv4[t] = xv;
        }
#pragma unroll
        for (int t = 0; t < 4; ++t) yv4[t] += __shfl_xor(yv4[t], 1);
#pragma unroll
        for (int t = 0; t < 4; ++t) yv4[t] += __shfl_xor(yv4[t], 2);
#pragma unroll
        for (int t = 0; t < 4; ++t) yv4[t] += __shfl_xor(yv4[t], 4);
        if (nb == 0) {
#pragma unroll
            for (int t = 0; t < 4; ++t) vs[t * 512 + e * 64 + p] = (yv4[t] + dsk * xv4[t]) * siluf(zs[t * 512 + e * 64 + p]);
        }
#pragma unroll
        for (int i = 0; i < 4; ++i) *(f32x4*)(op + i * 4) = hv[i];
    }
    __syncthreads();
    {
        const int t = tid >> 7, cidx = tid & 127;
        float v[4]; float ss = 0.f;
#pragma unroll
        for (int i = 0; i < 4; ++i) { v[i] = vs[t * 512 + cidx * 4 + i]; ss += v[i] * v[i]; }
        ss = wave_sum(ss);
        if ((tid & 63) == 0) red[tid >> 6] = ss;
        __syncthreads();
        const float tot = red[t * 2] + red[t * 2 + 1];
        const float rstd = rsqrtf(tot * (1.f / 512.f) + EPS);
        const f32x4 gg = *(const f32x4*)(P.in[I_SSDG] + g * 512 + cidx * 4);
        u32x2 o; o.x = pk2(v[0] * rstd * gg[0], v[1] * rstd * gg[1]); o.y = pk2(v[2] * rstd * gg[2], v[3] * rstd * gg[3]);
        *(u32x2*)(proj + (row0 + t) * PLD + C_ZA + g * 512 + cidx * 4) = o;
    }
    __syncthreads();
}

constexpr int S5P = 20;
template <bool SAMPLE>
DEV void s5_item(const Params& P, int g, long rowbase, int bidx) {
    const int tid = tid_fresh(), lane = tid & 63, w = tid >> 6, fr = lane & 15, fq = lane >> 4;
    constexpr int TPW = SAMPLE ? 16 : 256;
    bf16_t* proj = (bf16_t*)(P.ws + W_PROJ);
    float* buf = (float*)smem + w * (128 * S5P);
    float* carry = (float*)smem + 8 * 128 * S5P;
    float* fs = carry + 1024 + w * 128;
    float ar, ai;
    {
        const float lr = P.in[I_LRE][g * 64 + lane], li = P.in[I_LIM][g * 64 + lane], delta = expf(P.in[I_LDT][g]);
        const float mag = expf(lr * delta), ang = li * delta;
        ar = mag * cosf(ang); ai = mag * sinf(ang);
        const float qre = ar - 1.f, den = lr * lr + li * li;
        fs[lane] = (qre * lr + ai * li) / den; fs[64 + lane] = (ai * lr - qre * li) / den;
    }
    lds_fence();
    bf16x8 bbf[8];
#pragma unroll
    for (int j = 0; j < 8; ++j) {
        bf16x8 z = {0, 0, 0, 0, 0, 0, 0, 0};
        if (fq < 2) {
            const int p = (j & 3) * 16 + fr;
            const float f_r = fs[p], f_i = fs[64 + p];
            const float* br = P.in[I_BRE] + ((long)(g * 64 + p)) * 16 + fq * 8;
            const float* bi = P.in[I_BIM] + ((long)(g * 64 + p)) * 16 + fq * 8;
            const f32x4 r0 = *(const f32x4*)br, r1 = *(const f32x4*)(br + 4), i0 = *(const f32x4*)bi, i1 = *(const f32x4*)(bi + 4);
            f32x4 o0, o1;
            if (j < 4) { o0 = r0 * f_r - i0 * f_i; o1 = r1 * f_r - i1 * f_i; }
            else { o0 = i0 * f_r + r0 * f_i; o1 = i1 * f_r + r1 * f_i; }
            u32x4 q; q.x = pk2(o0[0], o0[1]); q.y = pk2(o0[2], o0[3]); q.z = pk2(o1[0], o1[1]); q.w = pk2(o1[2], o1[3]);
            z = __builtin_bit_cast(bf16x8, q);
        }
        bbf[j] = z;
    }
    bf16x8 ccf[4];
#pragma unroll
    for (int ks = 0; ks < 4; ++ks) {
        const float* src = (ks < 2 ? P.in[I_CRE] : P.in[I_CIM]) + ((long)(g * 16 + fr)) * 64 + (ks & 1) * 32 + fq * 8;
        f32x4 c0 = *(const f32x4*)src, c1 = *(const f32x4*)(src + 4);
        if (ks >= 2) { c0 = -c0; c1 = -c1; }
        u32x4 q; q.x = pk2(c0[0], c0[1]); q.y = pk2(c0[2], c0[3]); q.z = pk2(c1[0], c1[1]); q.w = pk2(c1[2], c1[3]);
        ccf[ks] = __builtin_bit_cast(bf16x8, q);
    }
    const f32x4 dsk = *(const f32x4*)(P.in[I_S5D] + g * 16 + fq * 4);
    const long roww = rowbase + (long)w * TPW;
    float xr = 0.f, xi = 0.f;
    float sre[8], sim[8];
#pragma unroll
    for (int j = 0; j < 8; ++j) { sre[j] = 0.f; sim[j] = 0.f; }
    if (SAMPLE) {
#pragma unroll
        for (int j = 0; j < TPW / 4; ++j) {
            const long seq = (roww - NPROMPT) / 4 + j;
            sre[j] = P.in[I_S5R][(seq * 64 + g) * 64 + lane]; sim[j] = P.in[I_S5I][(seq * 64 + g) * 64 + lane];
        }
    }
    constexpr int NPASS = SAMPLE ? 1 : 2;
#pragma unroll 1
    for (int pass = 0; pass < NPASS; ++pass) {
        const bool last = (pass == NPASS - 1);
        if (!SAMPLE && pass == 1) {
            carry[w * 128 + lane] = xr; carry[w * 128 + 64 + lane] = xi;
            __syncthreads();
            float pr = ar, pi = ai;
#pragma unroll
            for (int q = 0; q < 8; ++q) { const float nr = pr * pr - pi * pi, ni = 2.f * pr * pi; pr = nr; pi = ni; }
            float sr = 0.f, si = 0.f;
            for (int ww = 0; ww < w; ++ww) {
                const float cr = carry[ww * 128 + lane], ci = carry[ww * 128 + 64 + lane];
                const float nr = pr * sr - pi * si + cr, ni = pr * si + pi * sr + ci; sr = nr; si = ni;
            }
            xr = sr; xi = si;
        }
        if (!SAMPLE && pass == 0 && w == 7) continue;
        bf16x8 ufn = {0, 0, 0, 0, 0, 0, 0, 0};
        if (fq < 2) ufn = *(const bf16x8*)(proj + (roww + fr) * PLD + C_UB + g * 16 + fq * 8);
#pragma unroll 1
        for (int sb = 0; sb < TPW / 16; ++sb) {
            const long r = roww + sb * 16;
            const bf16x8 uf = ufn;
            if (fq < 2 && sb + 1 < TPW / 16) ufn = *(const bf16x8*)(proj + (r + 16 + fr) * PLD + C_UB + g * 16 + fq * 8);
            u32x2* up = (u32x2*)(proj + (r + fr) * PLD + C_UB + g * 16 + fq * 4);
            u32x2 uu = {0u, 0u};
            if (last) uu = *up;
            const f32x4 zero = {0.f, 0.f, 0.f, 0.f};
#pragma unroll
            for (int j = 0; j < 8; ++j) {
                const f32x4 d = mfma16(uf, bbf[j], zero);
                *(f32x4*)(buf + (j * 16 + fr) * S5P + fq * 4) = d;
            }
            lds_fence();
            {
                f32x4 brv[4], biv[4];
#pragma unroll
                for (int q = 0; q < 4; ++q) { brv[q] = *(const f32x4*)(buf + lane * S5P + q * 4); biv[q] = *(const f32x4*)(buf + (64 + lane) * S5P + q * 4); }
                __builtin_amdgcn_sched_barrier(0);
#pragma unroll
                for (int q = 0; q < 4; ++q) {
                    if (SAMPLE) {
#pragma unroll
                        for (int j = 0; j < 8; ++j) if (j == sb * 4 + q) { xr = sre[j]; xi = sim[j]; }
                    }
#pragma unroll
                    for (int i = 0; i < 4; ++i) {
                        const float nr = ar * xr - ai * xi + brv[q][i], ni = ar * xi + ai * xr + biv[q][i];
                        xr = nr; xi = ni; brv[q][i] = nr; biv[q][i] = ni;
                    }
                    if (SAMPLE) {
                        const long seq = (r - NPROMPT) / 4 + q;
                        P.out[O_S5RS + (seq * 64 + g) * 64 + lane] = xr; P.out[O_S5IS + (seq * 64 + g) * 64 + lane] = xi;
                    }
                }
                if (last) {
#pragma unroll
                    for (int q = 0; q < 4; ++q) { *(f32x4*)(buf + lane * S5P + q * 4) = brv[q]; *(f32x4*)(buf + (64 + lane) * S5P + q * 4) = biv[q]; }
                }
            }
            if (last) {
                lds_fence();
                f32x4 y = {0.f, 0.f, 0.f, 0.f};
                float xv[4][8];
#pragma unroll
                for (int ks = 0; ks < 4; ++ks)
#pragma unroll
                    for (int i = 0; i < 8; ++i) xv[ks][i] = buf[(ks * 32 + fq * 8 + i) * S5P + fr];
                __builtin_amdgcn_sched_barrier(0);
#pragma unroll
                for (int ks = 0; ks < 4; ++ks) {
                    u32x4 q; q.x = pk2(xv[ks][0], xv[ks][1]); q.y = pk2(xv[ks][2], xv[ks][3]); q.z = pk2(xv[ks][4], xv[ks][5]); q.w = pk2(xv[ks][6], xv[ks][7]);
                    y = mfma16(ccf[ks], __builtin_bit_cast(bf16x8, q), y);
                }
                const float y0 = geluf(y[0] + dsk[0] * bflo(uu.x)), y1 = geluf(y[1] + dsk[1] * bfhi(uu.x));
                const float y2 = geluf(y[2] + dsk[2] * bflo(uu.y)), y3 = geluf(y[3] + dsk[3] * bfhi(uu.y));
                u32x2 o; o.x = pk2(y0, y1); o.y = pk2(y2, y3);
                *up = o;
            }
            lds_fence();
        }
    }
    if (!SAMPLE && w == 7) {
        P.out[O_S5RP + ((long)bidx * 64 + g) * 64 + lane] = xr; P.out[O_S5IP + ((long)bidx * 64 + g) * 64 + lane] = xi;
    }
    __syncthreads();
}

__global__ void __launch_bounds__(512) hymba_fwd(Params P) {
#ifdef PROBE_K
    unsigned long long tb_[9]; int nb_ = 0;
#define TB() do { tb_[nb_++] = wall_clock64(); } while (0)
    TB();
#else
#define TB() do {} while (0)
#endif
    const int G = gridDim.x, bid = blockIdx.x;
    char* ws = P.ws;
    bf16_t* proj = (bf16_t*)(ws + W_PROJ);
    unsigned* barw = (unsigned*)(ws + W_BAR);
    volatile LAS unsigned* stw = (volatile LAS unsigned*)(smem + 131072);
    if (threadIdx.x < 4) stw[threadIdx.x] = 0u;
    __syncthreads();
    const XcdBarrier xb = xcd_barrier_post(barw, stw);
#ifndef NO_P0
    phase0(P);
#endif
    xcd_barrier(xb); TB();
#ifndef NO_P1
    for (int L = bid; L < 1188; L += G) {
        int pm, pn; tile_of(L, 66, 18, pm, pn);
        gemm_tile((const bf16_t*)(ws + W_NB), 1024, (const bf16_t*)(ws + W_WTIN), 1024, 1024, pm * 256, pn * 256, EpiBf16{proj, PLD, (const float*)(ws + W_RSTD)});
    }
    for (int L = (bid + G - 1188 % G) % G; L < 264; L += G) {
        int pm, pn; tile_of(L, 66, 4, pm, pn);
        gemm_tile((const bf16_t*)(ws + W_PB), 256, (const bf16_t*)(ws + W_WTPP), 256, 256, pm * 256, pn * 256, EpiBf16{(bf16_t*)(ws + W_PP), 1024, nullptr});
    }
#endif
    xcd_barrier(xb); TB();
    for (int idx = bid * 512 + threadIdx.x; idx < (8 + 128) * 3 * 192; idx += G * 512) {
        const int c8 = (idx % 192) * 8, sj = idx / 192, j = sj % 3, sq = sj / 3;
        const long row = sq < 8 ? (long)sq * 2048 + 2045 + j : NPROMPT + (long)(sq - 8) * 4 + 1 + j;
        const u32x4 u = *(const u32x4*)(proj + row * PLD + C_XBC + c8);
        float* dst = sq < 8 ? P.out + O_CONVP + ((long)sq * 3 + j) * 1536 + c8 : P.out + O_CONVS + ((long)(sq - 8) * 3 + j) * 1536 + c8;
        *(f32x4*)dst = (f32x4){bflo(u.x), bfhi(u.x), bflo(u.y), bfhi(u.y)};
        *(f32x4*)(dst + 4) = (f32x4){bflo(u.z), bfhi(u.z), bflo(u.w), bfhi(u.w)};
    }
#ifdef PROBE2
    unsigned long long tq_[5]; tq_[0] = wall_clock64();
#endif
#ifndef NO_S1
    for (int it = bid; it < 256; it += G) ssd_s1_item(P, it);
#endif
#ifdef PROBE2
    tq_[1] = wall_clock64();
#endif
#ifndef NO_SS
    for (int it = bid; it < 256; it += G) ssd_sample_item(P, it);
#endif
#ifdef PROBE2
    tq_[2] = wall_clock64();
#endif
#ifndef NO_S5P
    for (int it = bid; it < 512; it += G) s5_item<false>(P, it & 63, (long)(it >> 6) * 2048, it >> 6);
#endif
#ifdef PROBE2
    tq_[3] = wall_clock64();
#endif
#ifndef NO_S5S
    for (int it = bid; it < 256; it += G) s5_item<true>(P, it & 63, NPROMPT + (long)(it >> 6) * 128, 0);
#endif
#ifdef PROBE2
    tq_[4] = wall_clock64();
    { const unsigned long long d = tq_[PROBE2 + 1] - tq_[PROBE2], t0 = wall_clock64(); while (wall_clock64() - t0 < d) __builtin_amdgcn_s_sleep(8); }
#endif
    xcd_barrier(xb); TB();
    if (bid & 1) ssd_s2(P);
    {
        const EpiGlu eg{proj, P.in[I_GLUB]};
        for (int L = bid; L < 256; L += G) {
            int pm, pn; tile_of(L, 64, 4, pm, pn);
            gemm_tile(proj + C_UB, PLD, (const bf16_t*)(ws + W_WTGLU), 1024, 1024, pm * 256, pn * 256, eg);
        }
        for (int L = bid; L < 256; L += G)
            gemm_small(proj + C_UB, PLD, (const bf16_t*)(ws + W_WTGLU), 1024, 1024, NPROMPT + (L >> 3) * 16, (L & 7) * 128, eg);
    }
    if (!(bid & 1)) ssd_s2(P);
    xcd_barrier(xb); TB();
#ifndef NO_S3
    for (int it = bid; it < 256; it += G) ssd_s3_item(P, it);
#endif
    xcd_barrier(xb); TB();
#ifndef NO_P5
    {
        const EpiOut eo{P.in[I_XP], P.in[I_XS], (bf16_t*)(ws + W_NB), (float*)(ws + W_RSS1)};
        if (bid & 1)
            for (int L = bid; L < 256; L += G)
                gemm_small(proj, PLD, (const bf16_t*)(ws + W_WTOUT), 2048, 2048, NPROMPT + (L >> 3) * 16, (L & 7) * 128, eo);
        for (int L = bid; L < 256; L += G) {
            int pm, pn; tile_of(L, 64, 4, pm, pn);
            gemm_tile(proj, PLD, (const bf16_t*)(ws + W_WTOUT), 2048, 2048, pm * 256, pn * 256, eo);
        }
        if (!(bid & 1))
            for (int L = bid; L < 256; L += G)
                gemm_small(proj, PLD, (const bf16_t*)(ws + W_WTOUT), 2048, 2048, NPROMPT + (L >> 3) * 16, (L & 7) * 128, eo);
    }
#endif
    xcd_barrier(xb); TB();
#ifndef NO_P6
    {
        const EpiPle ep{P.out, (const bf16_t*)(ws + W_NB), (const bf16_t*)(ws + W_PP), (const float*)(ws + W_RSS1), (float*)(ws + W_RSS2)};
        if (bid & 1)
            for (int L = bid; L < 256; L += G)
                gemm_small((const bf16_t*)(ws + W_NB), 1024, (const bf16_t*)(ws + W_WTGATE), 1024, 1024, NPROMPT + (L >> 3) * 16, (L & 7) * 128, ep);
        for (int L = bid; L < 256; L += G) {
            int pm, pn; tile_of(L, 64, 4, pm, pn);
            gemm_tile((const bf16_t*)(ws + W_NB), 1024, (const bf16_t*)(ws + W_WTGATE), 1024, 1024, pm * 256, pn * 256, ep);
        }
        if (!(bid & 1))
            for (int L = bid; L < 256; L += G)
                gemm_small((const bf16_t*)(ws + W_NB), 1024, (const bf16_t*)(ws + W_WTGATE), 1024, 1024, NPROMPT + (L >> 3) * 16, (L & 7) * 128, ep);
    }
#endif
    xcd_barrier(xb); TB();
    {
        const float* rss2 = (const float*)(ws + W_RSS2);
        for (int idx = bid * 512 + threadIdx.x; idx < NTOK * 256; idx += G * 512) {
            const int row = idx >> 8, c4 = (idx & 255) * 4;
            const f32x4 r0 = *(const f32x4*)(rss2 + (long)row * 16), r1 = *(const f32x4*)(rss2 + (long)row * 16 + 4), r2 = *(const f32x4*)(rss2 + (long)row * 16 + 8), r3 = *(const f32x4*)(rss2 + (long)row * 16 + 12);
            const float tot = (((r0[0] + r0[1]) + (r0[2] + r0[3])) + ((r1[0] + r1[1]) + (r1[2] + r1[3]))) + (((r2[0] + r2[1]) + (r2[2] + r2[3])) + ((r3[0] + r3[1]) + (r3[2] + r3[3])));
            const float rstd = rsqrtf(tot * (1.f / 1024.f) + EPS);
            f32x4* p = (f32x4*)(P.out + (long)row * 1024 + c4);
            const f32x4 gf = *(const f32x4*)(P.in[I_GFIN] + c4);
            *p = *p * rstd * gf;
        }
    }
#ifdef PROBE_K
    { TB(); const unsigned long long d = tb_[PROBE_K + 1] - tb_[PROBE_K], t0 = wall_clock64(); while (wall_clock64() - t0 < d) __builtin_amdgcn_s_sleep(8); }
#endif
}

extern "C" void kernel_launch(void* const* d_in, const int* in_sizes, int n_in, void* d_out, int out_size, void* d_ws, size_t ws_size, hipStream_t stream) {
    static int grid_blocks = 0;
    if (grid_blocks == 0) {
        if (n_in != 31 || out_size != (int)O_END || ws_size < W_END) {
            fprintf(stderr, "kernel_launch: unexpected shapes n_in %d out %d ws %zu (need %zu)\n", n_in, out_size, ws_size, (size_t)W_END);
            grid_blocks = -1; return;
        }
        int dev = 0, cus = 0, per_cu = 0;
        hipGetDevice(&dev);
        hipDeviceGetAttribute(&cus, hipDeviceAttributeMultiprocessorCount, dev);
        hipFuncSetAttribute((const void*)hymba_fwd, hipFuncAttributeMaxDynamicSharedMemorySize, LDS_BYTES);
        hipOccupancyMaxActiveBlocksPerMultiprocessor(&per_cu, (const void*)hymba_fwd, 512, LDS_BYTES);
        if (per_cu < 1) { fprintf(stderr, "kernel_launch: occupancy query says %d blocks/CU\n", per_cu); per_cu = 1; }
        grid_blocks = cus;
        (void)hipGetLastError();
    }
    if (grid_blocks < 0) return;
    if (hipMemsetAsync((char*)d_ws + W_BAR, 0, XCD_BAR_WORDS * sizeof(unsigned), stream) != hipSuccess) { fprintf(stderr, "kernel_launch: memset of the barrier words failed\n"); return; }
    Params p{};
    for (int i = 0; i < 31; ++i) p.in[i] = (const float*)d_in[i];
    p.out = (float*)d_out; p.ws = (char*)d_ws;
    void* args[] = {&p};
    hipError_t e = hipLaunchCooperativeKernel((const void*)hymba_fwd, dim3(grid_blocks), dim3(512), args, LDS_BYTES, stream);
    if (e != hipSuccess) fprintf(stderr, "cooperative launch failed: %s (grid %d)\n", hipGetErrorString(e), grid_blocks);
}
```

```cpp
#include <hip/hip_runtime.h>
#include <hip/hip_cooperative_groups.h>
#include <cstdio>
namespace cg = cooperative_groups;

typedef unsigned short bf16_t;
typedef short bf16x8 __attribute__((ext_vector_type(8)));
typedef float f32x4 __attribute__((ext_vector_type(4)));
typedef unsigned u32x2 __attribute__((ext_vector_type(2)));
typedef unsigned u32x4 __attribute__((ext_vector_type(4)));
#define DEV __device__ __forceinline__

constexpr int NPROMPT = 16384, NSAMPLE = 512, NTOK = 16896;
constexpr int PLD = 4608;
constexpr int C_ZA = 0, C_ZB = 1024, C_XBC = 2048, C_UB = 3584;
constexpr float EPS = 1e-6f;
constexpr long O_YP = 0, O_YS = 16777216, O_SSDP = 17301504, O_CONVP = 18350080, O_S5RP = 18386944, O_S5IP = 18419712,
               O_SSDS = 18452480, O_CONVS = 35229696, O_S5RS = 35819520, O_S5IS = 36343808, O_END = 36868096;
constexpr size_t W_WTIN = 0;
constexpr size_t W_WTOUT = W_WTIN + 4608ull * 1024 * 2;
constexpr size_t W_WTGLU = W_WTOUT + 1024ull * 2048 * 2;
constexpr size_t W_WTGATE = W_WTGLU + 1024ull * 1024 * 2;
constexpr size_t W_WTPP = W_WTGATE + 1024ull * 1024 * 2;
constexpr size_t W_NB = W_WTPP + 1024ull * 256 * 2;
constexpr size_t W_PB = W_NB + 16896ull * 1024 * 2;
constexpr size_t W_DTR = W_PB + 16896ull * 256 * 2;
constexpr size_t W_ACS = W_DTR + 16896ull * 16 * 4;
constexpr size_t W_CDEC = W_ACS + 16384ull * 16 * 4;
constexpr size_t W_RSS1 = W_CDEC + 8192;
constexpr size_t W_RSS2 = W_RSS1 + 16896ull * 16 * 4;
constexpr size_t W_PROJ = W_RSS2 + 16896ull * 16 * 4;
constexpr size_t W_PP = W_PROJ + 16896ull * 4608 * 2;
constexpr size_t W_RSTD = W_PP + 16896ull * 1024 * 2;
constexpr size_t W_BAR = W_RSTD + 16896ull * 4;
constexpr size_t W_END = W_BAR + 16384;

constexpr int LDS_BYTES = 131072 + 64;

struct Params {
    const float* in[31];
    float* out;
    char* ws;
};
enum { I_XP = 0, I_XS, I_PP, I_PS, I_SSD, I_CONV, I_S5R, I_S5I, I_WIN, I_GIN, I_CONVW, I_CONVB, I_DTB, I_ALOG, I_SSDD, I_SSDG,
       I_LRE, I_LIM, I_LDT, I_BRE, I_BIM, I_CRE, I_CIM, I_S5D, I_GLUW, I_GLUB, I_WOUT, I_GPLE, I_WGATE, I_WPP, I_GFIN };

extern __shared__ __attribute__((aligned(16))) char smem[];

DEV unsigned pk2(float lo, float hi) { unsigned r; asm("v_cvt_pk_bf16_f32 %0, %1, %2" : "=v"(r) : "v"(lo), "v"(hi)); return r; }
DEV float bflo(unsigned u) { return __uint_as_float(u << 16); }
DEV float bfhi(unsigned u) { return __uint_as_float(u & 0xffff0000u); }
DEV float wave_sum(float v) {
#pragma unroll
    for (int o = 1; o < 64; o <<= 1) v += __shfl_xor(v, o);
    return v;
}
DEV float siluf(float v) { return v * __builtin_amdgcn_rcpf(1.f + __expf(-v)); }
DEV float sigmf(float v) { return __builtin_amdgcn_rcpf(1.f + __expf(-v)); }
DEV float sigsilu(float v, float z) { return z * __builtin_amdgcn_rcpf((1.f + __expf(-v)) * (1.f + __expf(-z))); }
DEV float geluf(float y) { float z = 0.7978845608f * (y + 0.044715f * y * y * y); return y * __builtin_amdgcn_rcpf(1.f + __expf(-2.f * z)); }
DEV f32x4 mfma16(bf16x8 a, bf16x8 b, f32x4 c) { return __builtin_amdgcn_mfma_f32_16x16x32_bf16(a, b, c, 0, 0, 0); }
DEV int tid_fresh() { int t = threadIdx.x; asm volatile("" : "+v"(t)); return t; }
DEV void lds_fence() { asm volatile("s_waitcnt lgkmcnt(0)" ::: "memory"); }


#define XB_TMO      128
#define XB_XCNT(j)  (256  + 64 * (j))
#define XB_XSUB(j)  (1280 + 64 * (j))
#define XB_XGEN(j)  (2304 + 64 * (j))
#define XB_TOP      3328
#define XB_TOPGEN   3392
#define XCD_BAR_WORDS 3456
#define XB_SPIN_CAP (1u << 22)
#define LAS __attribute__((address_space(3)))
DEV unsigned xb_ld(unsigned* p) { return __hip_atomic_load(p, __ATOMIC_RELAXED, __HIP_MEMORY_SCOPE_AGENT); }
DEV unsigned xb_add(unsigned* p, unsigned v) { return __hip_atomic_fetch_add(p, v, __ATOMIC_RELAXED, __HIP_MEMORY_SCOPE_AGENT); }
DEV unsigned xb_xcc_id() { return (unsigned)__builtin_amdgcn_s_getreg((3 << 11) | 20) & 0xFu; }
#define XB_SPIN(cond, bar) do { unsigned _sp = 0; while (cond) { __builtin_amdgcn_s_sleep(1); \
    if ((++_sp & 255u) == 0u) { if (xb_ld(&(bar)[XB_TMO])) break; if (_sp > XB_SPIN_CAP) { atomicAdd(&(bar)[XB_TMO], 1u); break; } } } } while (0)
struct XcdBarrier { unsigned* bar; unsigned x; volatile LAS unsigned* st; };
DEV XcdBarrier xcd_barrier_post(unsigned* bar, volatile LAS unsigned* st) {
    XcdBarrier b; b.bar = bar; b.x = xb_xcc_id(); b.st = st;
    if (threadIdx.x == 0) (void)xb_add(&bar[XB_XCNT(b.x)], 1u);
    return b;
}
DEV void xcd_barrier_complete(unsigned* bar, unsigned x, unsigned& nloc, unsigned& nx) {
    const unsigned G = gridDim.x * gridDim.y * gridDim.z;
    unsigned sum, cnt, mine, sp = 0u;
    for (;;) {
        sum = 0u; cnt = 0u; mine = 0u;
#pragma unroll
        for (unsigned j = 0; j < 16; ++j) { const unsigned c = xb_ld(&bar[XB_XCNT(j)]); sum += c; cnt += (c > 0u) ? 1u : 0u; mine = (j == x) ? c : mine; }
        if (sum == G) break;
        __builtin_amdgcn_s_sleep(1);
        if ((++sp & 255u) == 0u) { if (xb_ld(&bar[XB_TMO])) break; if (sp > XB_SPIN_CAP) { atomicAdd(&bar[XB_TMO], 1u); break; } }
    }
    nloc = mine > 0u ? mine : 1u; nx = cnt > 0u ? cnt : 1u;
}
DEV void xcd_barrier(const XcdBarrier& b) {
    asm volatile("s_waitcnt vmcnt(0)" ::: "memory");
    __syncthreads();
    if (threadIdx.x == 0) {
        unsigned* bar = b.bar;
        __builtin_amdgcn_s_waitcnt(0);
        unsigned nloc = b.st[0], nx = b.st[1];
        if (nloc == 0u) { xcd_barrier_complete(bar, b.x, nloc, nx); b.st[0] = nloc; b.st[1] = nx; }
        const unsigned old = xb_add(&bar[XB_XSUB(b.x)], 1u);
        const unsigned gen = old / nloc;
        if (old + 1u == (gen + 1u) * nloc) {
            __builtin_amdgcn_fence(__ATOMIC_RELEASE, "agent");
            asm volatile("s_waitcnt vmcnt(0)" ::: "memory");
            const unsigned og = xb_add(&bar[XB_TOP], 1u);
            const unsigned tg = og / nx;
            if (og + 1u == (tg + 1u) * nx) xb_add(&bar[XB_TOPGEN], 1u);
            else XB_SPIN(xb_ld(&bar[XB_TOPGEN]) == tg, bar);
            __builtin_amdgcn_fence(__ATOMIC_ACQUIRE, "agent");
            xb_add(&bar[XB_XGEN(b.x)], 1u);
            asm volatile("s_waitcnt vmcnt(0)" ::: "memory");
        } else {
            XB_SPIN(xb_ld(&bar[XB_XGEN(b.x)]) == gen, bar);
            __builtin_amdgcn_fence(__ATOMIC_ACQUIRE, "agent");
            asm volatile("s_waitcnt vmcnt(0)" ::: "memory");
        }
    }
    __syncthreads();
}

constexpr int BM = 256, BK = 64, HALF = 128, HT = HALF * BK;
DEV int lds_byte(int r, int c) {
    int st = (r >> 4) * 2 + (c >> 5), rr = r & 15, cc = c & 31, ob = rr * 64 + cc * 2;
    return st * 1024 + (ob ^ (((ob >> 9) & 1) << 5));
}
DEV void stage_rc(int b, int& R, int& C) {
    int st = b / 1024, sb = b % 1024, swz = sb ^ (((sb >> 9) & 1) << 5);
    R = (st >> 1) * 16 + swz / 64; C = (st & 1) * 32 + (swz % 64) / 2;
}

template <class Epi>
DEV void gemm_tile(const bf16_t* __restrict__ A, int lda, const bf16_t* __restrict__ Bt, int ldb, int K, int brow, int bcol, const Epi& epi) {
    LAS unsigned char* lds = (LAS unsigned char*)smem;
    constexpr int HTB = HT * 2;
    const int tid = tid_fresh(), wid = __builtin_amdgcn_readfirstlane(tid >> 6), lane = tid & 63, wr = wid >> 2, wc = wid & 3, fr = lane & 15, fq = lane >> 4;
    unsigned voffA[2], voffB[2];
#pragma unroll
    for (int i = 0; i < 2; ++i) {
        int R, C; stage_rc(tid * 16 + i * 8192, R, C);
        const int rho = R & 31, Rb = Epi::PERM ? ((R & ~31) + 8 * ((rho & 15) >> 2) + 4 * (rho >> 4) + (rho & 3)) : R;
        voffA[i] = (unsigned)(R * lda + C) * 2u; voffB[i] = (unsigned)(Rb * ldb + C) * 2u;
    }
    const size_t kstep = (size_t)(BK * 2), hstepA = (size_t)HALF * lda * 2, hstepB = (size_t)HALF * ldb * 2;
    const unsigned ldsw = (unsigned)wid * 1024u;
    const int aoff = lds_byte(wr * 64 + fr, fq * 8), boff = lds_byte(wc * 32 + fr, fq * 8);
#define SA(b, h) (((b) * 2 + (h)) * HTB)
#define SB(b, h) ((4 + (b) * 2 + (h)) * HTB)
#define STAGE(bufoff, gbase, voff) do { _Pragma("unroll") for (int _i = 0; _i < 2; ++_i) \
        __builtin_amdgcn_global_load_lds((const unsigned*)((const char*)(gbase) + (voff)[_i]), (LAS unsigned*)(lds + (bufoff) + ldsw + _i * 8192), 16, 0, 0); } while (0)
#define LDA(dst, b, h) do { _Pragma("unroll") for (int m = 0; m < 4; ++m) _Pragma("unroll") for (int k = 0; k < 2; ++k) dst[m][k] = *(const LAS bf16x8*)(lds + SA(b, h) + aoff + m * 2048 + k * 1024); } while (0)
#define LDB(dst, b, h) do { _Pragma("unroll") for (int n = 0; n < 2; ++n) _Pragma("unroll") for (int k = 0; k < 2; ++k) dst[n][k] = *(const LAS bf16x8*)(lds + SB(b, h) + boff + n * 2048 + k * 1024); } while (0)
#define MMA(ai, bj, At, Bt_) do { __builtin_amdgcn_s_setprio(1); _Pragma("unroll") for (int m = 0; m < 4; ++m) _Pragma("unroll") for (int n = 0; n < 2; ++n) _Pragma("unroll") for (int k = 0; k < 2; ++k) \
        acc[ai][bj][m][n] = __builtin_amdgcn_mfma_f32_16x16x32_bf16(Bt_[n][k], At[m][k], acc[ai][bj][m][n], 0, 0, 0); __builtin_amdgcn_s_setprio(0); } while (0)
#define WAIT_V(n) asm volatile("s_waitcnt vmcnt(" #n ")" ::: "memory")
#define WAIT_L(n) asm volatile("s_waitcnt lgkmcnt(" #n ")" ::: "memory")
#define BAR __builtin_amdgcn_s_barrier()
#define SCHED __builtin_amdgcn_sched_barrier(0)
    f32x4 acc[2][2][4][2];
#pragma unroll
    for (int a = 0; a < 2; ++a)
#pragma unroll
        for (int b = 0; b < 2; ++b)
#pragma unroll
            for (int m = 0; m < 4; ++m)
#pragma unroll
                for (int n = 0; n < 2; ++n) acc[a][b][m][n] = (f32x4){0.f, 0.f, 0.f, 0.f};
    bf16x8 At[4][2], B0[2][2], B1[2][2];
    const int nt = K / BK;
    const char* cA = (const char*)A + (size_t)brow * lda * 2; const char* cB = (const char*)Bt + (size_t)bcol * ldb * 2;
    STAGE(SB(0, 0), cB, voffB); STAGE(SA(0, 0), cA, voffA); STAGE(SB(0, 1), cB + hstepB, voffB); STAGE(SA(0, 1), cA + hstepA, voffA);
    if (wr == 1) BAR;
    WAIT_V(4); BAR;
    STAGE(SB(1, 0), cB + kstep, voffB); STAGE(SA(1, 0), cA + kstep, voffA); STAGE(SB(1, 1), cB + hstepB + kstep, voffB);
    WAIT_V(6); BAR;
    for (int t = 0; t < nt - 2; t += 2) {
        const char* a1 = cA + (size_t)(t + 1) * kstep;
        const char* a2 = cA + (size_t)(t + 2) * kstep; const char* b2 = cB + (size_t)(t + 2) * kstep;
        const char* a3 = a2 + kstep; const char* b3 = b2 + kstep;
        LDB(B0, 0, 0); SCHED; LDA(At, 0, 0); STAGE(SA(1, 1), a1 + hstepA, voffA);
        WAIT_L(8); BAR; WAIT_L(0); MMA(0, 0, At, B0); BAR; SCHED;
        LDB(B1, 0, 1); STAGE(SB(0, 0), b2, voffB);
        BAR; WAIT_L(0); MMA(0, 1, At, B1); BAR;
        LDA(At, 0, 1); STAGE(SA(0, 0), a2, voffA);
        BAR; WAIT_L(0); MMA(1, 0, At, B0); BAR; SCHED;
        STAGE(SB(0, 1), b2 + hstepB, voffB);
        WAIT_V(6); BAR; MMA(1, 1, At, B1); BAR;
        LDB(B0, 1, 0); SCHED; LDA(At, 1, 0); STAGE(SA(0, 1), a2 + hstepA, voffA);
        WAIT_L(8); BAR; WAIT_L(0); MMA(0, 0, At, B0); BAR; SCHED;
        LDB(B1, 1, 1); STAGE(SB(1, 0), b3, voffB);
        BAR; WAIT_L(0); MMA(0, 1, At, B1); BAR;
        LDA(At, 1, 1); STAGE(SA(1, 0), a3, voffA);
        BAR; WAIT_L(0); MMA(1, 0, At, B0); BAR; SCHED;
        STAGE(SB(1, 1), b3 + hstepB, voffB);
        WAIT_V(6); BAR; MMA(1, 1, At, B1); BAR;
    }
    { const char* a1 = cA + (size_t)(nt - 1) * kstep;
      LDB(B0, 0, 0); LDA(At, 0, 0); STAGE(SA(1, 1), a1 + hstepA, voffA);
      BAR; WAIT_L(0); MMA(0, 0, At, B0); BAR;
      LDB(B1, 0, 1); BAR; WAIT_L(0); MMA(0, 1, At, B1); BAR;
      LDA(At, 0, 1); WAIT_V(4); BAR; WAIT_L(0); MMA(1, 0, At, B0); MMA(1, 1, At, B1); BAR; }
    { LDB(B0, 1, 0); LDA(At, 1, 0); WAIT_V(2); BAR; WAIT_L(0); MMA(0, 0, At, B0); BAR;
      LDB(B1, 1, 1); WAIT_V(0); BAR; WAIT_L(0); MMA(0, 1, At, B1); BAR;
      LDA(At, 1, 1); BAR; WAIT_L(0); MMA(1, 0, At, B0); MMA(1, 1, At, B1); BAR; }
    if (wr == 0) BAR;
    if constexpr (Epi::PERM) epi_big8(epi, acc, brow, bcol, wr, wc, fr, fq); else epi_big(epi, acc, brow, bcol, wr, wc, fr, fq);
    __syncthreads();
#undef SA
#undef SB
#undef STAGE
#undef LDA
#undef LDB
#undef MMA
}

DEV void tile_of(int L, int nM, int nN, int& pm, int& pn) {
    const int nwg = nM * nN; int wgid = L;
    { const int q = nwg / 8, r = nwg % 8, xcd = wgid % 8, off = wgid / 8; wgid = (xcd < r ? xcd * (q + 1) : r * (q + 1) + (xcd - r) * q) + off; }
    const int nig = 8 * nN, gid = wgid / nig, fm = gid * 8, gsz = (nM - fm) < 8 ? (nM - fm) : 8;
    pm = fm + ((wgid % nig) % gsz); pn = (wgid % nig) / gsz;
}

struct EpiBf16 {
    static constexpr bool PERM = true;
    bf16_t* dst; int ld; const float* rstd;
    struct Ld8 { int unused; };
    DEV void load8(int row, int col8, Ld8& d) const { d.unused = 0; }
    DEV float rowload(int row) const { return rstd ? rstd[row] : 1.f; }
    DEV void apply8(int row, int col8, const f32x4& v0, const f32x4& v1, const Ld8& d, float& ss, float rs) const {
        u32x4 o; o.x = pk2(v0[0] * rs, v0[1] * rs); o.y = pk2(v0[2] * rs, v0[3] * rs); o.z = pk2(v1[0] * rs, v1[1] * rs); o.w = pk2(v1[2] * rs, v1[3] * rs);
        *(u32x4*)(dst + (long)row * ld + col8) = o;
    }
    DEV void rowdone(int row, float ss, int fq, int slot) const {}
};
struct EpiGlu {
    static constexpr bool PERM = true;
    bf16_t* proj; const float* glu_b;
    struct Ld8 { u32x4 g, z; f32x4 b0, b1; };
    DEV void load8(int row, int col8, Ld8& d) const {
        d.g = *(const u32x4*)(proj + (long)row * PLD + C_UB + col8); d.z = *(const u32x4*)(proj + (long)row * PLD + C_ZB + col8);
        d.b0 = *(const f32x4*)(glu_b + col8); d.b1 = *(const f32x4*)(glu_b + col8 + 4);
    }
    DEV void apply8(int row, int col8, const f32x4& v0, const f32x4& v1, const Ld8& d, float& ss, float rowv) const {
        u32x4 o;
        o.x = pk2(bflo(d.g.x) * sigsilu(v0[0] + d.b0[0], bflo(d.z.x)), bfhi(d.g.x) * sigsilu(v0[1] + d.b0[1], bfhi(d.z.x)));
        o.y = pk2(bflo(d.g.y) * sigsilu(v0[2] + d.b0[2], bflo(d.z.y)), bfhi(d.g.y) * sigsilu(v0[3] + d.b0[3], bfhi(d.z.y)));
        o.z = pk2(bflo(d.g.z) * sigsilu(v1[0] + d.b1[0], bflo(d.z.z)), bfhi(d.g.z) * sigsilu(v1[1] + d.b1[1], bfhi(d.z.z)));
        o.w = pk2(bflo(d.g.w) * sigsilu(v1[2] + d.b1[2], bflo(d.z.w)), bfhi(d.g.w) * sigsilu(v1[3] + d.b1[3], bfhi(d.z.w)));
        *(u32x4*)(proj + (long)row * PLD + C_ZB + col8) = o;
    }
    struct Ld { u32x2 g, z; f32x4 b; };
    DEV void load(int row, int col, Ld& d) const {
        d.g = *(const u32x2*)(proj + (long)row * PLD + C_UB + col); d.z = *(const u32x2*)(proj + (long)row * PLD + C_ZB + col); d.b = *(const f32x4*)(glu_b + col);
    }
    DEV void apply(int row, int col, const f32x4& v, const Ld& d, float& ss, float rowv) const {
        const float y0 = bflo(d.g.x) * sigsilu(v[0] + d.b[0], bflo(d.z.x)), y1 = bfhi(d.g.x) * sigsilu(v[1] + d.b[1], bfhi(d.z.x));
        const float y2 = bflo(d.g.y) * sigsilu(v[2] + d.b[2], bflo(d.z.y)), y3 = bfhi(d.g.y) * sigsilu(v[3] + d.b[3], bfhi(d.z.y));
        u32x2 o; o.x = pk2(y0, y1); o.y = pk2(y2, y3);
        *(u32x2*)(proj + (long)row * PLD + C_ZB + col) = o;
    }
    DEV float rowload(int row) const { return 0.f; }
    DEV void rowdone(int row, float ss, int fq, int slot) const {}
    DEV void rowput(int row, float tot, int slot) const {}
};
struct EpiOut {
    static constexpr bool PERM = true;
    const float* xp; const float* xs; bf16_t* h1b; float* rss;
    struct Ld8 { f32x4 x0, x1; };
    DEV void load8(int row, int col8, Ld8& d) const {
        const float* xrow = row < NPROMPT ? xp + (long)row * 1024 : xs + (long)(row - NPROMPT) * 1024;
        d.x0 = *(const f32x4*)(xrow + col8); d.x1 = *(const f32x4*)(xrow + col8 + 4);
    }
    DEV void apply8(int row, int col8, const f32x4& a0, const f32x4& a1, const Ld8& d, float& ss, float rowv) const {
        const f32x4 v0 = a0 + d.x0, v1 = a1 + d.x1;
        u32x4 o; o.x = pk2(v0[0], v0[1]); o.y = pk2(v0[2], v0[3]); o.z = pk2(v1[0], v1[1]); o.w = pk2(v1[2], v1[3]);
        *(u32x4*)(h1b + (long)row * 1024 + col8) = o;
        const float r0 = bflo(o.x), r1 = bfhi(o.x), r2 = bflo(o.y), r3 = bfhi(o.y), r4 = bflo(o.z), r5 = bfhi(o.z), r6 = bflo(o.w), r7 = bfhi(o.w);
        ss += ((r0 * r0 + r1 * r1) + (r2 * r2 + r3 * r3)) + ((r4 * r4 + r5 * r5) + (r6 * r6 + r7 * r7));
    }
    struct Ld { f32x4 x; };
    DEV void load(int row, int col, Ld& d) const {
        const float* xrow = row < NPROMPT ? xp + (long)row * 1024 : xs + (long)(row - NPROMPT) * 1024;
        d.x = *(const f32x4*)(xrow + col);
    }
    DEV void apply(int row, int col, const f32x4& a, const Ld& d, float& ss, float rowv) const {
        const f32x4 v = a + d.x;
        u32x2 o; o.x = pk2(v[0], v[1]); o.y = pk2(v[2], v[3]);
        *(u32x2*)(h1b + (long)row * 1024 + col) = o;
        const float r0 = bflo(o.x), r1 = bfhi(o.x), r2 = bflo(o.y), r3 = bfhi(o.y);
        ss += r0 * r0 + r1 * r1 + r2 * r2 + r3 * r3;
    }
    DEV float rowload(int row) const { return 0.f; }
    DEV void rowdone(int row, float ss, int fq, int slot) const {
        ss += __shfl_xor(ss, 16); ss += __shfl_xor(ss, 32);
        if (fq == 0) rss[(long)row * 16 + slot] = ss;
    }
    DEV void rowput(int row, float tot, int slot) const { rss[(long)row * 16 + slot] = tot; rss[(long)row * 16 + slot + 1] = 0.f; }
};
struct EpiPle {
    static constexpr bool PERM = true;
    float* out; const bf16_t* h1b; const bf16_t* pp; const float* rss1; float* rss2;
    struct Ld8 { u32x4 h, pv; };
    DEV void load8(int row, int col8, Ld8& d) const {
        d.h = *(const u32x4*)(h1b + (long)row * 1024 + col8); d.pv = *(const u32x4*)(pp + (long)row * 1024 + col8);
    }
    DEV void apply8(int row, int col8, const f32x4& a0, const f32x4& a1, const Ld8& d, float& ss, float rowv) const {
        const float rstd = rsqrtf(rowv * (1.f / 1024.f) + EPS);
        f32x4 h0, h1;
        h0[0] = bflo(d.h.x) + bflo(d.pv.x) * sigmf(a0[0] * rstd); h0[1] = bfhi(d.h.x) + bfhi(d.pv.x) * sigmf(a0[1] * rstd);
        h0[2] = bflo(d.h.y) + bflo(d.pv.y) * sigmf(a0[2] * rstd); h0[3] = bfhi(d.h.y) + bfhi(d.pv.y) * sigmf(a0[3] * rstd);
        h1[0] = bflo(d.h.z) + bflo(d.pv.z) * sigmf(a1[0] * rstd); h1[1] = bfhi(d.h.z) + bfhi(d.pv.z) * sigmf(a1[1] * rstd);
        h1[2] = bflo(d.h.w) + bflo(d.pv.w) * sigmf(a1[2] * rstd); h1[3] = bfhi(d.h.w) + bfhi(d.pv.w) * sigmf(a1[3] * rstd);
        *(f32x4*)(out + (long)row * 1024 + col8) = h0; *(f32x4*)(out + (long)row * 1024 + col8 + 4) = h1;
        ss += ((h0[0] * h0[0] + h0[1] * h0[1]) + (h0[2] * h0[2] + h0[3] * h0[3])) + ((h1[0] * h1[0] + h1[1] * h1[1]) + (h1[2] * h1[2] + h1[3] * h1[3]));
    }
    struct Ld { u32x2 h; u32x2 pv; };
    DEV void load(int row, int col, Ld& d) const {
        d.h = *(const u32x2*)(h1b + (long)row * 1024 + col); d.pv = *(const u32x2*)(pp + (long)row * 1024 + col);
    }
    DEV void apply(int row, int col, const f32x4& a, const Ld& d, float& ss, float rowv) const {
        const float rstd = rsqrtf(rowv * (1.f / 1024.f) + EPS);
        f32x4 h;
        h[0] = bflo(d.h.x) + bflo(d.pv.x) * sigmf(a[0] * rstd); h[1] = bfhi(d.h.x) + bfhi(d.pv.x) * sigmf(a[1] * rstd);
        h[2] = bflo(d.h.y) + bflo(d.pv.y) * sigmf(a[2] * rstd); h[3] = bfhi(d.h.y) + bfhi(d.pv.y) * sigmf(a[3] * rstd);
        *(f32x4*)(out + (long)row * 1024 + col) = h;
        ss += h[0] * h[0] + h[1] * h[1] + h[2] * h[2] + h[3] * h[3];
    }
    DEV float rowload(int row) const {
        const f32x4 a = *(const f32x4*)(rss1 + (long)row * 16), b = *(const f32x4*)(rss1 + (long)row * 16 + 4), c = *(const f32x4*)(rss1 + (long)row * 16 + 8), d = *(const f32x4*)(rss1 + (long)row * 16 + 12);
        return (((a[0] + a[1]) + (a[2] + a[3])) + ((b[0] + b[1]) + (b[2] + b[3]))) + (((c[0] + c[1]) + (c[2] + c[3])) + ((d[0] + d[1]) + (d[2] + d[3])));
    }
    DEV void rowdone(int row, float ss, int fq, int slot) const {
        ss += __shfl_xor(ss, 16); ss += __shfl_xor(ss, 32);
        if (fq == 0) rss2[(long)row * 16 + slot] = ss;
    }
    DEV void rowput(int row, float tot, int slot) const { rss2[(long)row * 16 + slot] = tot; rss2[(long)row * 16 + slot + 1] = 0.f; }
};
template <class Epi>
DEV void epi_big8(const Epi& E, const f32x4 (&acc)[2][2][4][2], int brow, int bcol, int wr, int wc, int fr, int fq) {
#pragma unroll
    for (int ai = 0; ai < 2; ++ai)
#pragma unroll
        for (int mp = 0; mp < 2; ++mp) {
            typename Epi::Ld8 d[2][2]; float rv[2];
#pragma unroll
            for (int mm = 0; mm < 2; ++mm) {
                const int row = brow + ai * 128 + wr * 64 + (mp * 2 + mm) * 16 + fr;
                rv[mm] = E.rowload(row);
#pragma unroll
                for (int bj = 0; bj < 2; ++bj) E.load8(row, bcol + bj * 128 + wc * 32 + 8 * fq, d[mm][bj]);
            }
#pragma unroll
            for (int mm = 0; mm < 2; ++mm) {
                const int row = brow + ai * 128 + wr * 64 + (mp * 2 + mm) * 16 + fr; float ss = 0.f;
#pragma unroll
                for (int bj = 0; bj < 2; ++bj)
                    E.apply8(row, bcol + bj * 128 + wc * 32 + 8 * fq, acc[ai][bj][mp * 2 + mm][0], acc[ai][bj][mp * 2 + mm][1], d[mm][bj], ss, rv[mm]);
                E.rowdone(row, ss, fq, ((bcol >> 8) & 3) * 4 + wc);
            }
        }
}
template <class Epi>
DEV void epi_big(const Epi& E, const f32x4 (&acc)[2][2][4][2], int brow, int bcol, int wr, int wc, int fr, int fq) {
#pragma unroll
    for (int ai = 0; ai < 2; ++ai)
#pragma unroll
        for (int mp = 0; mp < 2; ++mp) {
            typename Epi::Ld d[2][4]; float rv[2];
#pragma unroll
            for (int mm = 0; mm < 2; ++mm) {
                rv[mm] = E.rowload(brow + ai * 128 + wr * 64 + (mp * 2 + mm) * 16 + fr);
#pragma unroll
                for (int j = 0; j < 4; ++j)
                    E.load(brow + ai * 128 + wr * 64 + (mp * 2 + mm) * 16 + fr, bcol + (j >> 1) * 128 + wc * 32 + (j & 1) * 16 + fq * 4, d[mm][j]);
            }
#pragma unroll
            for (int mm = 0; mm < 2; ++mm) {
                const int row = brow + ai * 128 + wr * 64 + (mp * 2 + mm) * 16 + fr; float ss = 0.f;
#pragma unroll
                for (int j = 0; j < 4; ++j)
                    E.apply(row, bcol + (j >> 1) * 128 + wc * 32 + (j & 1) * 16 + fq * 4, acc[ai][j >> 1][mp * 2 + mm][j & 1], d[mm][j], ss, rv[mm]);
                E.rowdone(row, ss, fq, ((bcol >> 8) & 3) * 4 + wc);
            }
        }
}
template <class Epi>
DEV void gemm_small(const bf16_t* __restrict__ A, int lda, const bf16_t* __restrict__ Bt, int ldb, int K, int row0, int col0, const Epi& E) {
    const int tid = tid_fresh(), w = tid >> 6, lane = tid & 63, fr = lane & 15, fq = lane >> 4;
    const int kw = K >> 3;
    const bf16_t* ap = A + (long)(row0 + fr) * lda + w * kw + fq * 8;
    const bf16_t* bp = Bt + (long)(col0 + fr) * ldb + w * kw + fq * 8;
    const int row = row0 + fr, col = col0 + w * 16 + fq * 4;
    typename Epi::Ld d;
    E.load(row, col, d);
    const float rv = E.rowload(row);
    f32x4 pacc[8];
#pragma unroll
    for (int n = 0; n < 8; ++n) pacc[n] = (f32x4){0.f, 0.f, 0.f, 0.f};
    for (int k0 = 0; k0 < kw; k0 += 128) {
        bf16x8 af[4], bf[4][8];
#pragma unroll
        for (int ks = 0; ks < 4; ++ks) {
            af[ks] = *(const bf16x8*)(ap + k0 + ks * 32);
#pragma unroll
            for (int n = 0; n < 8; ++n) bf[ks][n] = *(const bf16x8*)(bp + (long)n * 16 * ldb + k0 + ks * 32);
        }
#pragma unroll
        for (int ks = 0; ks < 4; ++ks)
#pragma unroll
            for (int n = 0; n < 8; ++n) pacc[n] = mfma16(bf[ks][n], af[ks], pacc[n]);
    }
    float* redk = (float*)smem;
    __syncthreads();
#pragma unroll
    for (int n = 0; n < 8; ++n) *(f32x4*)(redk + ((w * 8 + n) * 64 + lane) * 4) = pacc[n];
    __syncthreads();
    f32x4 acc = (f32x4){0.f, 0.f, 0.f, 0.f};
#pragma unroll
    for (int i = 0; i < 8; ++i) acc += *(const f32x4*)(redk + ((i * 8 + w) * 64 + lane) * 4);
    float ss = 0.f;
    E.apply(row, col, acc, d, ss, rv);
    ss += __shfl_xor(ss, 16); ss += __shfl_xor(ss, 32);
    float* red = (float*)smem;
    __syncthreads();
    if (fq == 0) red[w * 16 + fr] = ss;
    __syncthreads();
    if (tid < 16) {
        float t = 0.f;
#pragma unroll
        for (int i = 0; i < 8; ++i) t += red[i * 16 + tid];
        E.rowput(row0 + tid, t, (col0 >> 7) * 2);
    }
    __syncthreads();
}

DEV void transpose_item(const float* __restrict__ src, int ldsrc, int k0, int c0, bf16_t* __restrict__ dst, int lddst, int n0,
                        const float* __restrict__ kscale, float* scr, int lane) {
    const int cl = lane & 31, kh = lane >> 5;
    float v[32];
#pragma unroll
    for (int i = 0; i < 32; ++i) v[i] = src[(long)(k0 + 2 * i + kh) * ldsrc + c0 + cl];
    if (kscale) {
#pragma unroll
        for (int i = 0; i < 32; ++i) v[i] *= kscale[k0 + 2 * i + kh];
    }
#pragma unroll
    for (int i = 0; i < 32; ++i) scr[(2 * i + kh) * 33 + cl] = v[i];
    lds_fence();
    const int c = lane & 7;
#pragma unroll
    for (int j = 0; j < 4; ++j) {
        const int n = (lane >> 3) + 8 * j; const float* sp = scr + (8 * c) * 33 + n;
        u32x4 o; o.x = pk2(sp[0 * 33], sp[1 * 33]); o.y = pk2(sp[2 * 33], sp[3 * 33]); o.z = pk2(sp[4 * 33], sp[5 * 33]); o.w = pk2(sp[6 * 33], sp[7 * 33]);
        *(u32x4*)(dst + (long)(n0 + n) * lddst + k0 + 8 * c) = o;
    }
    lds_fence();
}

DEV void phase0(const Params& P) {
    const int tid = tid_fresh(), lane = tid & 63, wave = tid >> 6, G = gridDim.x, bid = blockIdx.x;
    char* ws = P.ws;
    float* tile = (float*)smem;
    {
        float* scr = (float*)smem + wave * (64 * 33);
        constexpr int I_IN = 144 * 16, I_OUT = 32 * 32, I_GLU = 32 * 16, I_GATE = 32 * 16, I_PPW = 32 * 4;
        constexpr int I_ALL = I_IN + I_OUT + I_GLU + I_GATE + I_PPW;
        for (int it = bid * 8 + wave; it < I_ALL; it += G * 8) {
            int r = it;
            if (r < I_IN) {
                const int nb = r >> 4, kb = r & 15, n0 = nb * 32;
                int c0;
                if (n0 < 1024) c0 = n0; else if (n0 < 2048) c0 = 2576 + (n0 - 1024); else if (n0 < 3584) c0 = 1024 + (n0 - 2048); else c0 = 3600 + (n0 - 3584);
                transpose_item(P.in[I_WIN], 4624, kb * 64, c0, (bf16_t*)(ws + W_WTIN), 1024, n0, P.in[I_GIN], scr, lane); continue;
            }
            r -= I_IN;
            if (r < I_OUT) { const int nb = r >> 5, kb = r & 31; transpose_item(P.in[I_WOUT], 1024, kb * 64, nb * 32, (bf16_t*)(ws + W_WTOUT), 2048, nb * 32, nullptr, scr, lane); continue; }
            r -= I_OUT;
            if (r < I_GLU) { const int nb = r >> 4, kb = r & 15; transpose_item(P.in[I_GLUW], 1024, kb * 64, nb * 32, (bf16_t*)(ws + W_WTGLU), 1024, nb * 32, nullptr, scr, lane); continue; }
            r -= I_GLU;
            if (r < I_GATE) { const int nb = r >> 4, kb = r & 15; transpose_item(P.in[I_WGATE], 1024, kb * 64, nb * 32, (bf16_t*)(ws + W_WTGATE), 1024, nb * 32, P.in[I_GPLE], scr, lane); continue; }
            r -= I_GATE;
            { const int nb = r >> 2, kb = r & 3; transpose_item(P.in[I_WPP], 1024, kb * 64, nb * 32, (bf16_t*)(ws + W_WTPP), 256, nb * 32, nullptr, scr, lane); }
        }
        __syncthreads();
    }
    bf16_t* wdt = (bf16_t*)smem;
    float* psum = (float*)(smem + 16 * 1032 * 2);
    float* pdt = psum + 128;
    {
        float wv[32];
#pragma unroll
        for (int i = 0; i < 32; ++i) { const int idx = tid + i * 512, k = idx >> 4, e = idx & 15; wv[i] = P.in[I_WIN][(long)k * 4624 + 2560 + e] * P.in[I_GIN][k]; }
#pragma unroll
        for (int i = 0; i < 32; ++i) { const int idx = tid + i * 512, k = idx >> 4, e = idx & 15; wdt[e * 1032 + k] = (bf16_t)(pk2(wv[i], 0.f) & 0xffffu); }
    }
    __syncthreads();
    {
        const int fr = lane & 15, fq = lane >> 4;
        bf16x8 wf[4];
#pragma unroll
        for (int j = 0; j < 4; ++j) wf[j] = *(const bf16x8*)(wdt + fr * 1032 + (wave * 4 + j) * 32 + fq * 8);
        bf16_t* xb = (bf16_t*)(ws + W_NB);
        float* dtr = (float*)(ws + W_DTR);
        float* rstdp = (float*)(ws + W_RSTD);
        f32x4 xan[4], xcn[4];
        if (bid < NTOK / 16) {
            const int row = bid * 16 + fr;
            const float* xr = (row < NPROMPT ? P.in[I_XP] + (long)row * 1024 : P.in[I_XS] + (long)(row - NPROMPT) * 1024) + wave * 128 + fq * 8;
#pragma unroll
            for (int j = 0; j < 4; ++j) { xan[j] = *(const f32x4*)(xr + j * 32); xcn[j] = *(const f32x4*)(xr + j * 32 + 4); }
        }
        for (int task = bid; task < NTOK / 16; task += G) {
            const int row = task * 16 + fr;
            f32x4 xa[4], xc[4];
#pragma unroll
            for (int j = 0; j < 4; ++j) { xa[j] = xan[j]; xc[j] = xcn[j]; }
            if (task + G < NTOK / 16) {
                const int rown = (task + G) * 16 + fr;
                const float* xr = (rown < NPROMPT ? P.in[I_XP] + (long)rown * 1024 : P.in[I_XS] + (long)(rown - NPROMPT) * 1024) + wave * 128 + fq * 8;
#pragma unroll
                for (int j = 0; j < 4; ++j) { xan[j] = *(const f32x4*)(xr + j * 32); xcn[j] = *(const f32x4*)(xr + j * 32 + 4); }
            }
            f32x4 acc = {0.f, 0.f, 0.f, 0.f}; float ss = 0.f;
#pragma unroll
            for (int j = 0; j < 4; ++j) {
                ss += xa[j][0] * xa[j][0] + xa[j][1] * xa[j][1] + xa[j][2] * xa[j][2] + xa[j][3] * xa[j][3] + xc[j][0] * xc[j][0] + xc[j][1] * xc[j][1] + xc[j][2] * xc[j][2] + xc[j][3] * xc[j][3];
                u32x4 q; q.x = pk2(xa[j][0], xa[j][1]); q.y = pk2(xa[j][2], xa[j][3]); q.z = pk2(xc[j][0], xc[j][1]); q.w = pk2(xc[j][2], xc[j][3]);
                *(u32x4*)(xb + (long)row * 1024 + wave * 128 + j * 32 + fq * 8) = q;
                acc = mfma16(wf[j], __builtin_bit_cast(bf16x8, q), acc);
            }
            ss += __shfl_xor(ss, 16); ss += __shfl_xor(ss, 32);
            if (fq == 0) psum[wave * 16 + fr] = ss;
            *(f32x4*)(pdt + wave * 256 + fr * 16 + fq * 4) = acc;
            __syncthreads();
            if (tid < 256) {
                const int t = tid >> 4, e = tid & 15;
                float tot = 0.f, d = 0.f;
#pragma unroll
                for (int w8 = 0; w8 < 8; ++w8) { tot += psum[w8 * 16 + t]; d += pdt[w8 * 256 + t * 16 + e]; }
                const float rstd = rsqrtf(tot * (1.f / 1024.f) + EPS);
                dtr[(long)(task * 16 + t) * 16 + e] = d * rstd;
                if (e == 0) rstdp[task * 16 + t] = rstd;
            }
            __syncthreads();
        }
    }
    bf16_t* pb = (bf16_t*)(ws + W_PB);
    for (int idx = bid * 512 + tid; idx < NTOK * 64; idx += G * 512) {
        const int row = idx >> 6, c4 = (idx & 63) * 4;
        const float* src = row < NPROMPT ? P.in[I_PP] + (long)row * 256 : P.in[I_PS] + (long)(row - NPROMPT) * 256;
        const f32x4 v = *(const f32x4*)(src + c4);
        u32x2 o; o.x = pk2(v[0], v[1]); o.y = pk2(v[2], v[3]);
        *(u32x2*)(pb + (long)row * 256 + c4) = o;
    }
    __syncthreads();
}

DEV void conv_load7(const bf16_t* __restrict__ pcol, long row0, int t0, u32x4 (&raw)[7]) {
#pragma unroll
    for (int i = 0; i < 7; ++i) {
        const int t = t0 - 3 + i;
        raw[i] = (u32x4){0u, 0u, 0u, 0u};
        if (t >= 0) raw[i] = *(const u32x4*)(pcol + (row0 - 3 + i) * PLD);
    }
}
DEV void conv_compute(const u32x4 (&rawp)[7], const float* __restrict__ cw, const float* __restrict__ cb, float (&o)[4][8]) {
    float raw[7][8];
#pragma unroll
    for (int i = 0; i < 7; ++i) {
        const u32x4 u = rawp[i];
        raw[i][0] = bflo(u.x); raw[i][1] = bfhi(u.x); raw[i][2] = bflo(u.y); raw[i][3] = bfhi(u.y);
        raw[i][4] = bflo(u.z); raw[i][5] = bfhi(u.z); raw[i][6] = bflo(u.w); raw[i][7] = bfhi(u.w);
    }
    float w[4][8], bias[8];
#pragma unroll
    for (int k = 0; k < 4; ++k) {
        const f32x4 a = *(const f32x4*)(cw + k * 1536), b = *(const f32x4*)(cw + k * 1536 + 4);
        w[k][0] = a[0]; w[k][1] = a[1]; w[k][2] = a[2]; w[k][3] = a[3]; w[k][4] = b[0]; w[k][5] = b[1]; w[k][6] = b[2]; w[k][7] = b[3];
    }
    { const f32x4 a = *(const f32x4*)(cb), b = *(const f32x4*)(cb + 4);
      bias[0] = a[0]; bias[1] = a[1]; bias[2] = a[2]; bias[3] = a[3]; bias[4] = b[0]; bias[5] = b[1]; bias[6] = b[2]; bias[7] = b[3]; }
#pragma unroll
    for (int j = 0; j < 4; ++j)
#pragma unroll
        for (int c = 0; c < 8; ++c) {
            float a = bias[c];
#pragma unroll
            for (int k = 0; k < 4; ++k) a += w[k][c] * raw[j + k][c];
            o[j][c] = siluf(a);
        }
}
DEV void conv_compute_lds(const u32x4 (&rawp)[7], const float* cwl, float (&o)[4][8]) {
    float raw[7][8];
#pragma unroll
    for (int i = 0; i < 7; ++i) {
        const u32x4 u = rawp[i];
        raw[i][0] = bflo(u.x); raw[i][1] = bfhi(u.x); raw[i][2] = bflo(u.y); raw[i][3] = bfhi(u.y);
        raw[i][4] = bflo(u.z); raw[i][5] = bfhi(u.z); raw[i][6] = bflo(u.w); raw[i][7] = bfhi(u.w);
    }
    float w[5][8];
#pragma unroll
    for (int k = 0; k < 5; ++k) {
        const f32x4 a = *(const f32x4*)(cwl + k * 512), b = *(const f32x4*)(cwl + k * 512 + 4);
        w[k][0] = a[0]; w[k][1] = a[1]; w[k][2] = a[2]; w[k][3] = a[3]; w[k][4] = b[0]; w[k][5] = b[1]; w[k][6] = b[2]; w[k][7] = b[3];
    }
#pragma unroll
    for (int j = 0; j < 4; ++j)
#pragma unroll
        for (int c = 0; c < 8; ++c) {
            float a = w[4][c];
#pragma unroll
            for (int k = 0; k < 4; ++k) a += w[k][c] * raw[j + k][c];
            o[j][c] = siluf(a);
        }
}
DEV void conv4x8(const bf16_t* __restrict__ pcol, long row0, int t0, const float* __restrict__ hist, const float* __restrict__ cw, const float* __restrict__ cb, float (&o)[4][8]) {
    float raw[7][8];
#pragma unroll
    for (int i = 0; i < 7; ++i) {
        const int t = t0 - 3 + i;
        if (t >= 0) {
            const u32x4 u = *(const u32x4*)(pcol + (row0 - 3 + i) * PLD);
            raw[i][0] = bflo(u.x); raw[i][1] = bfhi(u.x); raw[i][2] = bflo(u.y); raw[i][3] = bfhi(u.y);
            raw[i][4] = bflo(u.z); raw[i][5] = bfhi(u.z); raw[i][6] = bflo(u.w); raw[i][7] = bfhi(u.w);
        } else if (hist) {
            const f32x4 a = *(const f32x4*)(hist + (long)(t + 3) * 1536), b = *(const f32x4*)(hist + (long)(t + 3) * 1536 + 4);
            raw[i][0] = a[0]; raw[i][1] = a[1]; raw[i][2] = a[2]; raw[i][3] = a[3]; raw[i][4] = b[0]; raw[i][5] = b[1]; raw[i][6] = b[2]; raw[i][7] = b[3];
        } else {
#pragma unroll
            for (int c = 0; c < 8; ++c) raw[i][c] = 0.f;
        }
    }
    float w[4][8], bias[8];
#pragma unroll
    for (int k = 0; k < 4; ++k) {
        const f32x4 a = *(const f32x4*)(cw + k * 1536), b = *(const f32x4*)(cw + k * 1536 + 4);
        w[k][0] = a[0]; w[k][1] = a[1]; w[k][2] = a[2]; w[k][3] = a[3]; w[k][4] = b[0]; w[k][5] = b[1]; w[k][6] = b[2]; w[k][7] = b[3];
    }
    { const f32x4 a = *(const f32x4*)(cb), b = *(const f32x4*)(cb + 4);
      bias[0] = a[0]; bias[1] = a[1]; bias[2] = a[2]; bias[3] = a[3]; bias[4] = b[0]; bias[5] = b[1]; bias[6] = b[2]; bias[7] = b[3]; }
#pragma unroll
    for (int j = 0; j < 4; ++j)
#pragma unroll
        for (int c = 0; c < 8; ++c) {
            float a = bias[c];
#pragma unroll
            for (int k = 0; k < 4; ++k) a += w[k][c] * raw[j + k][c];
            o[j][c] = siluf(a);
        }
}

constexpr int PIT = 136;
constexpr int R1_OFF = 0, R2_OFF = 128 * PIT * 2, R3_OFF = 2 * 128 * PIT * 2, R4_OFF = 3 * 128 * PIT * 2;

DEV void ssd_s1_item(const Params& P, int item) {
    const int tid = tid_fresh(), lane = tid & 63, w = tid >> 6, fr = lane & 15, fq = lane >> 4;
    const int b = item >> 5, c = (item >> 1) & 15, g = item & 1;
    char* ws = P.ws;
    const bf16_t* proj = (const bf16_t*)(ws + W_PROJ);
    const long rowc = (long)b * 2048 + c * 128;
    bf16_t* R1 = (bf16_t*)(smem + R1_OFF); bf16_t* R2 = (bf16_t*)(smem + R2_OFF); bf16_t* R3 = (bf16_t*)(smem + R3_OFF);
    float* acs = (float*)(smem + R4_OFF);
    float* dtv = acs + 1024;
    {
        const int h = g * 8 + w;
        const float bias = P.in[I_DTB][h], A = -__expf(P.in[I_ALOG][h]);
        const float* dtr = (const float*)(ws + W_DTR);
        float x0 = dtr[(rowc + 2 * lane) * 16 + h] + bias, x1 = dtr[(rowc + 2 * lane + 1) * 16 + h] + bias;
        float d0 = x0 > 20.f ? x0 : log1pf(__expf(x0)), d1 = x1 > 20.f ? x1 : log1pf(__expf(x1));
        float a0 = d0 * A, a1 = a0 + d1 * A;
        float run = a1;
#pragma unroll
        for (int o = 1; o < 64; o <<= 1) { float t = __shfl_up(run, o); if (lane >= o) run += t; }
        const float excl = run - a1;
        a0 += excl; a1 += excl;
        acs[w * 128 + 2 * lane] = a0; acs[w * 128 + 2 * lane + 1] = a1;
        dtv[w * 128 + 2 * lane] = d0; dtv[w * 128 + 2 * lane + 1] = d1;
        float* acsg = (float*)(ws + W_ACS) + (((long)b * 16 + c) * 16 + h) * 128;
        acsg[2 * lane] = a0; acsg[2 * lane + 1] = a1;
        if (lane == 63) ((float*)(ws + W_CDEC))[(b * 16 + c) * 16 + h] = __expf(a1);
    }
    float* cwl = (float*)(smem + R4_OFF + 8192);
    for (int u = tid; u < 5 * 512; u += 512) { const int k = u >> 9, ch = u & 511; cwl[u] = k < 4 ? P.in[I_CONVW][k * 1536 + g * 512 + ch] : P.in[I_CONVB][g * 512 + ch]; }
    {
        const int nblk = tid & 15, lq = tid >> 4, l0 = lq * 4;
#pragma unroll
        for (int j = 0; j < 2; ++j) {
            const int ch0 = 1024 + j * 256 + g * 128 + nblk * 8;
            float o[4][8];
            conv4x8(proj + C_XBC + ch0, rowc + l0, c * 128 + l0, nullptr, P.in[I_CONVW] + ch0, P.in[I_CONVB] + ch0, o);
            bf16_t* dst = j == 0 ? R2 : R1;
#pragma unroll
            for (int r = 0; r < 4; ++r) {
                u32x4 q; q.x = pk2(o[r][0], o[r][1]); q.y = pk2(o[r][2], o[r][3]); q.z = pk2(o[r][4], o[r][5]); q.w = pk2(o[r][6], o[r][7]);
                *(u32x4*)(dst + (l0 + r) * PIT + nblk * 8) = q;
            }
            if (j == 0) {
#pragma unroll
                for (int i = 0; i < 8; ++i) {
                    u32x2 q; q.x = pk2(o[0][i], o[1][i]); q.y = pk2(o[2][i], o[3][i]);
                    *(u32x2*)(R3 + (nblk * 8 + i) * PIT + l0) = q;
                }
            }
        }
    }
    __syncthreads();
    const int wr = w >> 1, wc = w & 1;
    f32x4 cbm[2][4];
#pragma unroll
    for (int m = 0; m < 2; ++m)
#pragma unroll
        for (int n = 0; n < 4; ++n) cbm[m][n] = (f32x4){0.f, 0.f, 0.f, 0.f};
#pragma unroll
    for (int ks = 0; ks < 4; ++ks) {
        bf16x8 af[2], bfm[4];
#pragma unroll
        for (int m = 0; m < 2; ++m) af[m] = *(const bf16x8*)(R1 + (wr * 32 + m * 16 + fr) * PIT + ks * 32 + fq * 8);
#pragma unroll
        for (int n = 0; n < 4; ++n) bfm[n] = *(const bf16x8*)(R2 + (wc * 64 + n * 16 + fr) * PIT + ks * 32 + fq * 8);
#pragma unroll
        for (int m = 0; m < 2; ++m)
#pragma unroll
            for (int n = 0; n < 4; ++n) cbm[m][n] = mfma16(bfm[n], af[m], cbm[m][n]);
    }
    __syncthreads();
    bf16_t* XT = R2; bf16_t* XW = R2 + 64 * PIT;
    bf16_t* ydg = (bf16_t*)(ws + W_NB);
    float* states = P.out;
    const int wp = w >> 2, wn = w & 3;
    u32x4 rawn[7];
    if (tid < 256) conv_load7(proj + C_XBC + (g * 8) * 64 + (tid & 7) * 8, rowc + (tid >> 3) * 4, c * 128 + (tid >> 3) * 4, rawn);
    for (int e = 0; e < 8; ++e) {
        const int h = g * 8 + e;
        const float dskip = P.in[I_SSDD][h];
        if (tid < 256) {
            const int pblk = tid & 7, lq = tid >> 3, l0 = lq * 4, ch0 = h * 64 + pblk * 8;
            float o[4][8];
            conv_compute_lds(rawn, cwl + e * 64 + pblk * 8, o);
            if (e < 7) conv_load7(proj + C_XBC + ch0 + 64, rowc + l0, c * 128 + l0, rawn);
            const float alast = acs[e * 128 + 127];
            float we[4];
#pragma unroll
            for (int r = 0; r < 4; ++r) we[r] = __expf(alast - acs[e * 128 + l0 + r]) * dtv[e * 128 + l0 + r];
#pragma unroll
            for (int i = 0; i < 8; ++i) {
                u32x2 q; q.x = pk2(o[0][i], o[1][i]); q.y = pk2(o[2][i], o[3][i]);
                *(u32x2*)(XT + (pblk * 8 + i) * PIT + l0) = q;
                u32x2 q2; q2.x = pk2(o[0][i] * we[0], o[1][i] * we[1]); q2.y = pk2(o[2][i] * we[2], o[3][i] * we[3]);
                *(u32x2*)(XW + (pblk * 8 + i) * PIT + l0) = q2;
            }
        }
#pragma unroll
        for (int m = 0; m < 2; ++m) {
            const int l = wr * 32 + m * 16 + fr; const float al = acs[e * 128 + l];
#pragma unroll
            for (int n = 0; n < 4; ++n) {
                const int s0 = wc * 64 + n * 16 + fq * 4;
                const f32x4 as = *(const f32x4*)(acs + e * 128 + s0), ds = *(const f32x4*)(dtv + e * 128 + s0);
                float v[4];
#pragma unroll
                for (int r = 0; r < 4; ++r) { const float t = cbm[m][n][r] * __expf(al - as[r]) * ds[r]; v[r] = (s0 + r <= l) ? t : 0.f; }
                u32x2 q; q.x = pk2(v[0], v[1]); q.y = pk2(v[2], v[3]);
                *(u32x2*)(R1 + l * PIT + s0) = q;
            }
        }
        __syncthreads();
        {
            f32x4 yd[2][2];
#pragma unroll
            for (int m = 0; m < 2; ++m)
#pragma unroll
                for (int n = 0; n < 2; ++n) yd[m][n] = (f32x4){0.f, 0.f, 0.f, 0.f};
            {
                bf16x8 af[4][2], bfm[4][2];
#pragma unroll
                for (int ks = 0; ks < 4; ++ks) {
#pragma unroll
                    for (int m = 0; m < 2; ++m) af[ks][m] = *(const bf16x8*)(R1 + (wr * 32 + m * 16 + fr) * PIT + ks * 32 + fq * 8);
#pragma unroll
                    for (int n = 0; n < 2; ++n) bfm[ks][n] = *(const bf16x8*)(XT + (wc * 32 + n * 16 + fr) * PIT + ks * 32 + fq * 8);
                }
                __builtin_amdgcn_sched_barrier(0);
#pragma unroll
                for (int ks = 0; ks < 4; ++ks)
                    if (ks <= wr) {
#pragma unroll
                        for (int m = 0; m < 2; ++m)
#pragma unroll
                            for (int n = 0; n < 2; ++n) yd[m][n] = mfma16(bfm[ks][n], af[ks][m], yd[m][n]);
                    }
            }
#pragma unroll
            for (int m = 0; m < 2; ++m)
#pragma unroll
                for (int n = 0; n < 2; ++n) {
                    const int l = wr * 32 + m * 16 + fr, p0 = wc * 32 + n * 16 + fq * 4;
                    const float x0 = __uint_as_float(((unsigned)XT[(p0 + 0) * PIT + l]) << 16), x1 = __uint_as_float(((unsigned)XT[(p0 + 1) * PIT + l]) << 16);
                    const float x2 = __uint_as_float(((unsigned)XT[(p0 + 2) * PIT + l]) << 16), x3 = __uint_as_float(((unsigned)XT[(p0 + 3) * PIT + l]) << 16);
                    u32x2 q; q.x = pk2(yd[m][n][0] + dskip * x0, yd[m][n][1] + dskip * x1); q.y = pk2(yd[m][n][2] + dskip * x2, yd[m][n][3] + dskip * x3);
                    *(u32x2*)(ydg + (rowc + l) * 1024 + h * 64 + p0) = q;
                }
        }
        {
            f32x4 st[2][2];
#pragma unroll
            for (int m = 0; m < 2; ++m)
#pragma unroll
                for (int n = 0; n < 2; ++n) st[m][n] = (f32x4){0.f, 0.f, 0.f, 0.f};
            {
                bf16x8 af[4][2], bfm[4][2];
#pragma unroll
                for (int ks = 0; ks < 4; ++ks) {
#pragma unroll
                    for (int m = 0; m < 2; ++m) af[ks][m] = *(const bf16x8*)(XW + (wp * 32 + m * 16 + fr) * PIT + ks * 32 + fq * 8);
#pragma unroll
                    for (int n = 0; n < 2; ++n) bfm[ks][n] = *(const bf16x8*)(R3 + (wn * 32 + n * 16 + fr) * PIT + ks * 32 + fq * 8);
                }
                __builtin_amdgcn_sched_barrier(0);
#pragma unroll
                for (int ks = 0; ks < 4; ++ks)
#pragma unroll
                    for (int m = 0; m < 2; ++m)
#pragma unroll
                        for (int n = 0; n < 2; ++n) st[m][n] = mfma16(bfm[ks][n], af[ks][m], st[m][n]);
            }
            float* sp = states + (((long)b * 16 + c) * 16 + h) * 8192;
#pragma unroll
            for (int m = 0; m < 2; ++m)
#pragma unroll
                for (int n = 0; n < 2; ++n) {
                    const int p = wp * 32 + m * 16 + fr, n0 = wn * 32 + n * 16 + fq * 4;
                    *(f32x4*)(sp + p * 128 + n0) = st[m][n];
                }
        }
        __syncthreads();
    }
}

DEV void ssd_s2(const Params& P) {
    float* states = P.out;
    const float* cdec = (const float*)(P.ws + W_CDEC);
    for (int idx = blockIdx.x * 512 + threadIdx.x; idx < 262144; idx += gridDim.x * 512) {
        const int bh = idx >> 11, q = idx & 2047, b = bh >> 4, h = bh & 15;
        f32x4 H = (f32x4){0.f, 0.f, 0.f, 0.f};
#pragma unroll
        for (int c = 0; c < 16; ++c) {
            f32x4* ptr = (f32x4*)(states + (((long)b * 16 + c) * 16 + h) * 8192) + q;
            const f32x4 s = *ptr; *ptr = H;
            const float d = cdec[(b * 16 + c) * 16 + h];
            H = H * d + s;
        }
        *((f32x4*)(P.out + O_SSDP + (long)bh * 8192) + q) = H;
    }
}

DEV void ssd_s3_item(const Params& P, int item) {
    const int tid = tid_fresh(), lane = tid & 63, w = tid >> 6, fr = lane & 15, fq = lane >> 4;
    const int b = item >> 5, c = (item >> 1) & 15, g = item & 1;
    char* ws = P.ws;
    bf16_t* proj = (bf16_t*)(ws + W_PROJ);
    const long rowc = (long)b * 2048 + c * 128;
    bf16_t* R1 = (bf16_t*)(smem + R1_OFF); bf16_t* HB = (bf16_t*)(smem + R2_OFF);
    float* ssq = (float*)(smem + R4_OFF);
    const bf16_t* ydg = (const bf16_t*)(ws + W_NB);
    const float* states = P.out;
    const float* acsg = (const float*)(ws + W_ACS);
    const int hp = tid >> 3, hn0 = (tid & 7) * 16;
    f32x4 hreg[4];
    {
        const float* sp = states + (((long)b * 16 + c) * 16 + g * 8) * 8192 + hp * 128 + hn0;
#pragma unroll
        for (int i = 0; i < 4; ++i) hreg[i] = *(const f32x4*)(sp + i * 4);
    }
    __syncthreads();
    {
        const int nblk = tid & 15, lq = tid >> 4, l0 = lq * 4;
        const int ch0 = 1280 + g * 128 + nblk * 8;
        float o[4][8];
        conv4x8(proj + C_XBC + ch0, rowc + l0, c * 128 + l0, nullptr, P.in[I_CONVW] + ch0, P.in[I_CONVB] + ch0, o);
#pragma unroll
        for (int r = 0; r < 4; ++r) {
            u32x4 q; q.x = pk2(o[r][0], o[r][1]); q.y = pk2(o[r][2], o[r][3]); q.z = pk2(o[r][4], o[r][5]); q.w = pk2(o[r][6], o[r][7]);
            *(u32x4*)(R1 + (l0 + r) * PIT + nblk * 8) = q;
        }
    }
    const int wr = w >> 1, wc = w & 1;
    unsigned ypk[8][2][2][2];
    float ssl[2] = {0.f, 0.f};
    bf16x8 afc[4][2];
#pragma unroll
    for (int e = 0; e < 8; ++e) {
        const int h = g * 8 + e;
        bf16_t* hb = HB + (e & 1) * 64 * PIT;
        {
            u32x4 q0, q1;
            q0.x = pk2(hreg[0][0], hreg[0][1]); q0.y = pk2(hreg[0][2], hreg[0][3]); q0.z = pk2(hreg[1][0], hreg[1][1]); q0.w = pk2(hreg[1][2], hreg[1][3]);
            q1.x = pk2(hreg[2][0], hreg[2][1]); q1.y = pk2(hreg[2][2], hreg[2][3]); q1.z = pk2(hreg[3][0], hreg[3][1]); q1.w = pk2(hreg[3][2], hreg[3][3]);
            *(u32x4*)(hb + hp * PIT + hn0) = q0; *(u32x4*)(hb + hp * PIT + hn0 + 8) = q1;
        }
        if (e < 7) {
            const float* sp = states + (((long)b * 16 + c) * 16 + h + 1) * 8192 + hp * 128 + hn0;
#pragma unroll
            for (int i = 0; i < 4; ++i) hreg[i] = *(const f32x4*)(sp + i * 4);
        }
        u32x2 yq[2][2], zz[2][2]; float ea[2];
#pragma unroll
        for (int m = 0; m < 2; ++m) {
            const int l = wr * 32 + m * 16 + fr;
            ea[m] = acsg[(((long)b * 16 + c) * 16 + h) * 128 + l];
#pragma unroll
            for (int n = 0; n < 2; ++n) {
                const int p0 = wc * 32 + n * 16 + fq * 4;
                yq[m][n] = *(const u32x2*)(ydg + (rowc + l) * 1024 + h * 64 + p0);
                zz[m][n] = *(const u32x2*)(proj + (rowc + l) * PLD + C_ZA + h * 64 + p0);
            }
        }
        __syncthreads();
        if (e == 0) {
#pragma unroll
            for (int ks = 0; ks < 4; ++ks)
#pragma unroll
                for (int m = 0; m < 2; ++m) afc[ks][m] = *(const bf16x8*)(R1 + (wr * 32 + m * 16 + fr) * PIT + ks * 32 + fq * 8);
        }
        f32x4 yo[2][2];
#pragma unroll
        for (int m = 0; m < 2; ++m)
#pragma unroll
            for (int n = 0; n < 2; ++n) yo[m][n] = (f32x4){0.f, 0.f, 0.f, 0.f};
        {
            bf16x8 bfm[4][2];
#pragma unroll
            for (int ks = 0; ks < 4; ++ks)
#pragma unroll
                for (int n = 0; n < 2; ++n) bfm[ks][n] = *(const bf16x8*)(hb + (wc * 32 + n * 16 + fr) * PIT + ks * 32 + fq * 8);
            __builtin_amdgcn_sched_barrier(0);
#pragma unroll
            for (int ks = 0; ks < 4; ++ks)
#pragma unroll
                for (int m = 0; m < 2; ++m)
#pragma unroll
                    for (int n = 0; n < 2; ++n) yo[m][n] = mfma16(bfm[ks][n], afc[ks][m], yo[m][n]);
        }
#pragma unroll
        for (int m = 0; m < 2; ++m) {
            const float eam = __expf(ea[m]);
#pragma unroll
            for (int n = 0; n < 2; ++n) {
                const float v0 = (bflo(yq[m][n].x) + eam * yo[m][n][0]) * siluf(bflo(zz[m][n].x)), v1 = (bfhi(yq[m][n].x) + eam * yo[m][n][1]) * siluf(bfhi(zz[m][n].x));
                const float v2 = (bflo(yq[m][n].y) + eam * yo[m][n][2]) * siluf(bflo(zz[m][n].y)), v3 = (bfhi(yq[m][n].y) + eam * yo[m][n][3]) * siluf(bfhi(zz[m][n].y));
                ssl[m] += v0 * v0 + v1 * v1 + v2 * v2 + v3 * v3;
                ypk[e][m][n][0] = pk2(v0, v1); ypk[e][m][n][1] = pk2(v2, v3);
            }
        }
    }
#pragma unroll
    for (int m = 0; m < 2; ++m) {
        float ss = ssl[m];
        ss += __shfl_xor(ss, 16); ss += __shfl_xor(ss, 32);
        if (fq == 0) ssq[wc * 128 + wr * 32 + m * 16 + fr] = ss;
    }
    f32x4 ggv[8][2];
#pragma unroll
    for (int e = 0; e < 8; ++e)
#pragma unroll
        for (int n = 0; n < 2; ++n) ggv[e][n] = *(const f32x4*)(P.in[I_SSDG] + (g * 8 + e) * 64 + wc * 32 + n * 16 + fq * 4);
    __syncthreads();
#pragma unroll
    for (int m = 0; m < 2; ++m) {
        const int l = wr * 32 + m * 16 + fr;
        const float rstd = rsqrtf((ssq[l] + ssq[128 + l]) * (1.f / 512.f) + EPS);
#pragma unroll
        for (int e = 0; e < 8; ++e)
#pragma unroll
            for (int n = 0; n < 2; ++n) {
                const int h = g * 8 + e, p0 = wc * 32 + n * 16 + fq * 4;
                const f32x4 gg = ggv[e][n];
                const unsigned a0 = ypk[e][m][n][0], a1 = ypk[e][m][n][1];
                u32x2 o; o.x = pk2(bflo(a0) * rstd * gg[0], bfhi(a0) * rstd * gg[1]); o.y = pk2(bflo(a1) * rstd * gg[2], bfhi(a1) * rstd * gg[3]);
                *(u32x2*)(proj + (rowc + l) * PLD + C_ZA + h * 64 + p0) = o;
            }
    }
}

DEV void ssd_sample_item(const Params& P, int item) {
    const int tid = tid_fresh();
    const int b = item >> 1, g = item & 1;
    char* ws = P.ws;
    bf16_t* proj = (bf16_t*)(ws + W_PROJ);
    const long row0 = NPROMPT + (long)b * 4;
    float* xs = (float*)smem;
    float* Bs = xs + 2048;
    float* Cs = Bs + 512;
    float* dts = Cs + 512;
    float* das = dts + 32;
    float* vs = das + 32;
    float* red = vs + 2048;
    float* zs = red + 32;
    for (int u = tid; u < 768; u += 512) {
        int ch; float* dst; int dcol;
        if (u < 512) { ch = g * 512 + u; dst = xs; dcol = u; }
        else if (u < 640) { ch = 1024 + g * 128 + (u - 512); dst = Bs; dcol = u - 512; }
        else { ch = 1280 + g * 128 + (u - 640); dst = Cs; dcol = u - 640; }
        const int pitch = u < 512 ? 512 : 128;
        float full[7];
#pragma unroll
        for (int i = 0; i < 3; ++i) full[i] = P.in[I_CONV][((long)b * 3 + i) * 1536 + ch];
#pragma unroll
        for (int i = 0; i < 4; ++i) full[3 + i] = __uint_as_float(((unsigned)proj[(row0 + i) * PLD + C_XBC + ch]) << 16);
        const float w0 = P.in[I_CONVW][ch], w1 = P.in[I_CONVW][1536 + ch], w2 = P.in[I_CONVW][3072 + ch], w3 = P.in[I_CONVW][4608 + ch], bias = P.in[I_CONVB][ch];
#pragma unroll
        for (int t = 0; t < 4; ++t) dst[t * pitch + dcol] = siluf(bias + w0 * full[t] + w1 * full[t + 1] + w2 * full[t + 2] + w3 * full[t + 3]);
    }
    for (int u = tid; u < 4 * 256; u += 512) {
        const int t = u >> 8, c2 = (u & 255) * 2;
        const unsigned zz = *(const unsigned*)(proj + (row0 + t) * PLD + C_ZA + g * 512 + c2);
        zs[t * 512 + c2] = bflo(zz); zs[t * 512 + c2 + 1] = bfhi(zz);
    }
    if (tid < 32) {
        const int t = tid >> 3, e = tid & 7, h = g * 8 + e;
        const float x = ((const float*)(ws + W_DTR))[(row0 + t) * 16 + h] + P.in[I_DTB][h];
        const float d = x > 20.f ? x : log1pf(__expf(x));
        dts[tid] = d; das[tid] = __expf(-d * __expf(P.in[I_ALOG][h]));
    }
    __syncthreads();
    const int p = tid >> 3, nb = tid & 7, n0 = nb * 16;
    f32x4 hn[4], hn2[4];
    {
        const float* sp0 = P.in[I_SSD] + (((long)b * 16 + g * 8) * 64 + p) * 128 + n0;
#pragma unroll
        for (int i = 0; i < 4; ++i) { hn[i] = *(const f32x4*)(sp0 + i * 4); hn2[i] = *(const f32x4*)(sp0 + 8192 + i * 4); }
    }
    for (int e = 0; e < 8; ++e) {
        const int h = g * 8 + e;
        float* op = P.out + O_SSDS + (((long)b * 16 + h) * 64 + p) * 128 + n0;
        f32x4 hv[4];
#pragma unroll
        for (int i = 0; i < 4; ++i) { hv[i] = hn[i]; hn[i] = hn2[i]; }
        if (e < 6) {
            const float* sp = P.in[I_SSD] + (((long)b * 16 + h + 2) * 64 + p) * 128 + n0;
#pragma unroll
            for (int i = 0; i < 4; ++i) hn2[i] = *(const f32x4*)(sp + i * 4);
        }
        const float dsk = P.in[I_SSDD][h];
        float yv4[4], xv4[4];
#pragma unroll
        for (int t = 0; t < 4; ++t) {
            const float dec = das[t * 8 + e], xv = xs[t * 512 + e * 64 + p], coef = dts[t * 8 + e] * xv;
            float part = 0.f;
#pragma unroll
            for (int i = 0; i < 4; ++i) {
                const f32x4 bv = *(const f32x4*)(Bs + t * 128 + n0 + i * 4), cv = *(const f32x4*)(Cs + t * 128 + n0 + i * 4);
                hv[i] = hv[i] * dec + bv * coef;
                part += hv[i][0] * cv[0] + hv[i][1] * cv[1] + hv[i][2] * cv[2] + hv[i][3] * cv[3];
            }
            yv4[t] = part; xv4[t] = xv;
        }
#pragma unroll
        for (int t = 0; t < 4; ++t) yv4[t] += __shfl_xor(yv4[t], 1);
#pragma unroll
        for (int t = 0; t < 4; ++t) yv4[t] += __shfl_xor(yv4[t], 2);
#pragma unroll
        for (int t = 0; t < 4; ++t) yv4[t] += __shfl_xor(yv4[t], 4);
        if (nb == 0) {
#pragma unroll
            for (int t = 0; t < 4; ++t) vs[t * 512 + e * 64 + p] = (yv4[t] + dsk * xv4[t]) * siluf(zs[t * 512 + e * 64 + p]);
        }
#pragma unroll
        for (int i = 0; i < 4; ++i) *(f32x4*)(op + i * 4) = hv[i];
    }
    __syncthreads();
    {
        const int t = tid >> 7, cidx = tid & 127;
        float v[4]; float ss = 0.f;
#pragma unroll
        for (int i = 0; i < 4; ++i) { v[i] = vs[t * 512 + cidx * 4 + i]; ss += v[i] * v[i]; }
        ss = wave_sum(ss);
        if ((tid & 63) == 0) red[tid >> 6] = ss;
        __syncthreads();
        const float tot = red[t * 2] + red[t * 2 + 1];
        const float rstd = rsqrtf(tot * (1.f / 512.f) + EPS);
        const f32x4 gg = *(const f32x4*)(P.in[I_SSDG] + g * 512 + cidx * 4);
        u32x2 o; o.x = pk2(v[0] * rstd * gg[0], v[1] * rstd * gg[1]); o.y = pk2(v[2] * rstd * gg[2], v[3] * rstd * gg[3]);
        *(u32x2*)(proj + (row0 + t) * PLD + C_ZA + g * 512 + cidx * 4) = o;
    }
    __syncthreads();
}

constexpr int S5P = 20;
template <bool SAMPLE>
DEV void s5_item(const Params& P, int g, long rowbase, int bidx) {
    const int tid = tid_fresh(), lane = tid & 63, w = tid >> 6, fr = lane & 15, fq = lane >> 4;
    constexpr int TPW = SAMPLE ? 16 : 256;
    bf16_t* proj = (bf16_t*)(P.ws + W_PROJ);
    float* buf = (float*)smem + w * (128 * S5P);
    float* carry = (float*)smem + 8 * 128 * S5P;
    float* fs = carry + 1024 + w * 128;
    float ar, ai;
    {
        const float lr = P.in[I_LRE][g * 64 + lane], li = P.in[I_LIM][g * 64 + lane], delta = expf(P.in[I_LDT][g]);
        const float mag = expf(lr * delta), ang = li * delta;
        ar = mag * cosf(ang); ai = mag * sinf(ang);
        const float qre = ar - 1.f, den = lr * lr + li * li;
        fs[lane] = (qre * lr + ai * li) / den; fs[64 + lane] = (ai * lr - qre * li) / den;
    }
    lds_fence();
    bf16x8 bbf[8];
#pragma unroll
    for (int j = 0; j < 8; ++j) {
        bf16x8 z = {0, 0, 0, 0, 0, 0, 0, 0};
        if (fq < 2) {
            const int p = (j & 3) * 16 + fr;
            const float f_r = fs[p], f_i = fs[64 + p];
            const float* br = P.in[I_BRE] + ((long)(g * 64 + p)) * 16 + fq * 8;
            const float* bi = P.in[I_BIM] + ((long)(g * 64 + p)) * 16 + fq * 8;
            const f32x4 r0 = *(const f32x4*)br, r1 = *(const f32x4*)(br + 4), i0 = *(const f32x4*)bi, i1 = *(const f32x4*)(bi + 4);
            f32x4 o0, o1;
            if (j < 4) { o0 = r0 * f_r - i0 * f_i; o1 = r1 * f_r - i1 * f_i; }
            else { o0 = i0 * f_r + r0 * f_i; o1 = i1 * f_r + r1 * f_i; }
            u32x4 q; q.x = pk2(o0[0], o0[1]); q.y = pk2(o0[2], o0[3]); q.z = pk2(o1[0], o1[1]); q.w = pk2(o1[2], o1[3]);
            z = __builtin_bit_cast(bf16x8, q);
        }
        bbf[j] = z;
    }
    bf16x8 ccf[4];
#pragma unroll
    for (int ks = 0; ks < 4; ++ks) {
        const float* src = (ks < 2 ? P.in[I_CRE] : P.in[I_CIM]) + ((long)(g * 16 + fr)) * 64 + (ks & 1) * 32 + fq * 8;
        f32x4 c0 = *(const f32x4*)src, c1 = *(const f32x4*)(src + 4);
        if (ks >= 2) { c0 = -c0; c1 = -c1; }
        u32x4 q; q.x = pk2(c0[0], c0[1]); q.y = pk2(c0[2], c0[3]); q.z = pk2(c1[0], c1[1]); q.w = pk2(c1[2], c1[3]);
        ccf[ks] = __builtin_bit_cast(bf16x8, q);
    }
    const f32x4 dsk = *(const f32x4*)(P.in[I_S5D] + g * 16 + fq * 4);
    const long roww = rowbase + (long)w * TPW;
    float xr = 0.f, xi = 0.f;
    float sre[8], sim[8];
#pragma unroll
    for (int j = 0; j < 8; ++j) { sre[j] = 0.f; sim[j] = 0.f; }
    if (SAMPLE) {
#pragma unroll
        for (int j = 0; j < TPW / 4; ++j) {
            const long seq = (roww - NPROMPT) / 4 + j;
            sre[j] = P.in[I_S5R][(seq * 64 + g) * 64 + lane]; sim[j] = P.in[I_S5I][(seq * 64 + g) * 64 + lane];
        }
    }
    constexpr int NPASS = SAMPLE ? 1 : 2;
#pragma unroll 1
    for (int pass = 0; pass < NPASS; ++pass) {
        const bool last = (pass == NPASS - 1);
        if (!SAMPLE && pass == 1) {
            carry[w * 128 + lane] = xr; carry[w * 128 + 64 + lane] = xi;
            __syncthreads();
            float pr = ar, pi = ai;
#pragma unroll
            for (int q = 0; q < 8; ++q) { const float nr = pr * pr - pi * pi, ni = 2.f * pr * pi; pr = nr; pi = ni; }
            float sr = 0.f, si = 0.f;
            for (int ww = 0; ww < w; ++ww) {
                const float cr = carry[ww * 128 + lane], ci = carry[ww * 128 + 64 + lane];
                const float nr = pr * sr - pi * si + cr, ni = pr * si + pi * sr + ci; sr = nr; si = ni;
            }
            xr = sr; xi = si;
        }
        if (!SAMPLE && pass == 0 && w == 7) continue;
        bf16x8 ufn = {0, 0, 0, 0, 0, 0, 0, 0};
        if (fq < 2) ufn = *(const bf16x8*)(proj + (roww + fr) * PLD + C_UB + g * 16 + fq * 8);
#pragma unroll 1
        for (int sb = 0; sb < TPW / 16; ++sb) {
            const long r = roww + sb * 16;
            const bf16x8 uf = ufn;
            if (fq < 2 && sb + 1 < TPW / 16) ufn = *(const bf16x8*)(proj + (r + 16 + fr) * PLD + C_UB + g * 16 + fq * 8);
            u32x2* up = (u32x2*)(proj + (r + fr) * PLD + C_UB + g * 16 + fq * 4);
            u32x2 uu = {0u, 0u};
            if (last) uu = *up;
            const f32x4 zero = {0.f, 0.f, 0.f, 0.f};
#pragma unroll
            for (int j = 0; j < 8; ++j) {
                const f32x4 d = mfma16(uf, bbf[j], zero);
                *(f32x4*)(buf + (j * 16 + fr) * S5P + fq * 4) = d;
            }
            lds_fence();
            {
                f32x4 brv[4], biv[4];
#pragma unroll
                for (int q = 0; q < 4; ++q) { brv[q] = *(const f32x4*)(buf + lane * S5P + q * 4); biv[q] = *(const f32x4*)(buf + (64 + lane) * S5P + q * 4); }
                __builtin_amdgcn_sched_barrier(0);
#pragma unroll
                for (int q = 0; q < 4; ++q) {
                    if (SAMPLE) {
#pragma unroll
                        for (int j = 0; j < 8; ++j) if (j == sb * 4 + q) { xr = sre[j]; xi = sim[j]; }
                    }
#pragma unroll
                    for (int i = 0; i < 4; ++i) {
                        const float nr = ar * xr - ai * xi + brv[q][i], ni = ar * xi + ai * xr + biv[q][i];
                        xr = nr; xi = ni; brv[q][i] = nr; biv[q][i] = ni;
                    }
                    if (SAMPLE) {
                        const long seq = (r - NPROMPT) / 4 + q;
                        P.out[O_S5RS + (seq * 64 + g) * 64 + lane] = xr; P.out[O_S5IS + (seq * 64 + g) * 64 + lane] = xi;
                    }
                }
                if (last) {
#pragma unroll
                    for (int q = 0; q < 4; ++q) { *(f32x4*)(buf + lane * S5P + q * 4) = brv[q]; *(f32x4*)(buf + (64 + lane) * S5P + q * 4) = biv[q]; }
                }
            }
            if (last) {
                lds_fence();
                f32x4 y = {0.f, 0.f, 0.f, 0.f};
                float xv[4][8];
#pragma unroll
                for (int ks = 0; ks < 4; ++ks)
#pragma unroll
                    for (int i = 0; i < 8; ++i) xv[ks][i] = buf[(ks * 32 + fq * 8 + i) * S5P + fr];
                __builtin_amdgcn_sched_barrier(0);
#pragma unroll
                for (int ks = 0; ks < 4; ++ks) {
                    u32x4 q; q.x = pk2(xv[ks][0], xv[ks][1]); q.y = pk2(xv[ks][2], xv[ks][3]); q.z = pk2(xv[ks][4], xv[ks][5]); q.w = pk2(xv[ks][6], xv[ks][7]);
                    y = mfma16(ccf[ks], __builtin_bit_cast(bf16x8, q), y);
                }
                const float y0 = geluf(y[0] + dsk[0] * bflo(uu.x)), y1 = geluf(y[1] + dsk[1] * bfhi(uu.x));
                const float y2 = geluf(y[2] + dsk[2] * bflo(uu.y)), y3 = geluf(y[3] + dsk[3] * bfhi(uu.y));
                u32x2 o; o.x = pk2(y0, y1); o.y = pk2(y2, y3);
                *up = o;
            }
            lds_fence();
        }
    }
    if (!SAMPLE && w == 7) {
        P.out[O_S5RP + ((long)bidx * 64 + g) * 64 + lane] = xr; P.out[O_S5IP + ((long)bidx * 64 + g) * 64 + lane] = xi;
    }
    __syncthreads();
}

__global__ void __launch_bounds__(512) hymba_fwd(Params P) {
#ifdef PROBE_K
    unsigned long long tb_[9]; int nb_ = 0;
#define TB() do { tb_[nb_++] = wall_clock64(); } while (0)
    TB();
#else
#define TB() do {} while (0)
#endif
    const int G = gridDim.x, bid = blockIdx.x;
    char* ws = P.ws;
    bf16_t* proj = (bf16_t*)(ws + W_PROJ);
    unsigned* barw = (unsigned*)(ws + W_BAR);
    volatile LAS unsigned* stw = (volatile LAS unsigned*)(smem + 131072);
    if (threadIdx.x < 4) stw[threadIdx.x] = 0u;
    __syncthreads();
    const XcdBarrier xb = xcd_barrier_post(barw, stw);
#ifndef NO_P0
    phase0(P);
#endif
    xcd_barrier(xb); TB();
#ifndef NO_P1
    for (int L = bid; L < 1188; L += G) {
        int pm, pn; tile_of(L, 66, 18, pm, pn);
        gemm_tile((const bf16_t*)(ws + W_NB), 1024, (const bf16_t*)(ws + W_WTIN), 1024, 1024, pm * 256, pn * 256, EpiBf16{proj, PLD, (const float*)(ws + W_RSTD)});
    }
    for (int L = (bid + G - 1188 % G) % G; L < 264; L += G) {
        int pm, pn; tile_of(L, 66, 4, pm, pn);
        gemm_tile((const bf16_t*)(ws + W_PB), 256, (const bf16_t*)(ws + W_WTPP), 256, 256, pm * 256, pn * 256, EpiBf16{(bf16_t*)(ws + W_PP), 1024, nullptr});
    }
#endif
    xcd_barrier(xb); TB();
    for (int idx = bid * 512 + threadIdx.x; idx < (8 + 128) * 3 * 192; idx += G * 512) {
        const int c8 = (idx % 192) * 8, sj = idx / 192, j = sj % 3, sq = sj / 3;
        const long row = sq < 8 ? (long)sq * 2048 + 2045 + j : NPROMPT + (long)(sq - 8) * 4 + 1 + j;
        const u32x4 u = *(const u32x4*)(proj + row * PLD + C_XBC + c8);
        float* dst = sq < 8 ? P.out + O_CONVP + ((long)sq * 3 + j) * 1536 + c8 : P.out + O_CONVS + ((long)(sq - 8) * 3 + j) * 1536 + c8;
        *(f32x4*)dst = (f32x4){bflo(u.x), bfhi(u.x), bflo(u.y), bfhi(u.y)};
        *(f32x4*)(dst + 4) = (f32x4){bflo(u.z), bfhi(u.z), bflo(u.w), bfhi(u.w)};
    }
#ifdef PROBE2
    unsigned long long tq_[5]; tq_[0] = wall_clock64();
#endif
#ifndef NO_S1
    for (int it = bid; it < 256; it += G) ssd_s1_item(P, it);
#endif
#ifdef PROBE2
    tq_[1] = wall_clock64();
#endif
#ifndef NO_SS
    for (int it = bid; it < 256; it += G) ssd_sample_item(P, it);
#endif
#ifdef PROBE2
    tq_[2] = wall_clock64();
#endif
#ifndef NO_S5P
    for (int it = bid; it < 512; it += G) s5_item<false>(P, it & 63, (long)(it >> 6) * 2048, it >> 6);
#endif
#ifdef PROBE2
    tq_[3] = wall_clock64();
#endif
#ifndef NO_S5S
    for (int it = bid; it < 256; it += G) s5_item<true>(P, it & 63, NPROMPT + (long)(it >> 6) * 128, 0);
#endif
#ifdef PROBE2
    tq_[4] = wall_clock64();
    { const unsigned long long d = tq_[PROBE2 + 1] - tq_[PROBE2], t0 = wall_clock64(); while (wall_clock64() - t0 < d) __builtin_amdgcn_s_sleep(8); }
#endif
    xcd_barrier(xb); TB();
    if (bid & 1) ssd_s2(P);
    {
        const EpiGlu eg{proj, P.in[I_GLUB]};
        for (int L = bid; L < 256; L += G) {
            int pm, pn; tile_of(L, 64, 4, pm, pn);
            gemm_tile(proj + C_UB, PLD, (const bf16_t*)(ws + W_WTGLU), 1024, 1024, pm * 256, pn * 256, eg);
        }
        for (int L = bid; L < 256; L += G)
            gemm_small(proj + C_UB, PLD, (const bf16_t*)(ws + W_WTGLU), 1024, 1024, NPROMPT + (L >> 3) * 16, (L & 7) * 128, eg);
    }
    if (!(bid & 1)) ssd_s2(P);
    xcd_barrier(xb); TB();
#ifndef NO_S3
    for (int it = bid; it < 256; it += G) ssd_s3_item(P, it);
#endif
    xcd_barrier(xb); TB();
#ifndef NO_P5
    {
        const EpiOut eo{P.in[I_XP], P.in[I_XS], (bf16_t*)(ws + W_NB), (float*)(ws + W_RSS1)};
        if (bid & 1)
            for (int L = bid; L < 256; L += G)
                gemm_small(proj, PLD, (const bf16_t*)(ws + W_WTOUT), 2048, 2048, NPROMPT + (L >> 3) * 16, (L & 7) * 128, eo);
        for (int L = bid; L < 256; L += G) {
            int pm, pn; tile_of(L, 64, 4, pm, pn);
            gemm_tile(proj, PLD, (const bf16_t*)(ws + W_WTOUT), 2048, 2048, pm * 256, pn * 256, eo);
        }
        if (!(bid & 1))
            for (int L = bid; L < 256; L += G)
                gemm_small(proj, PLD, (const bf16_t*)(ws + W_WTOUT), 2048, 2048, NPROMPT + (L >> 3) * 16, (L & 7) * 128, eo);
    }
#endif
    xcd_barrier(xb); TB();
#ifndef NO_P6
    {
        const EpiPle ep{P.out, (const bf16_t*)(ws + W_NB), (const bf16_t*)(ws + W_PP), (const float*)(ws + W_RSS1), (float*)(ws + W_RSS2)};
        if (bid & 1)
            for (int L = bid; L < 256; L += G)
                gemm_small((const bf16_t*)(ws + W_NB), 1024, (const bf16_t*)(ws + W_WTGATE), 1024, 1024, NPROMPT + (L >> 3) * 16, (L & 7) * 128, ep);
        for (int L = bid; L < 256; L += G) {
            int pm, pn; tile_of(L, 64, 4, pm, pn);
            gemm_tile((const bf16_t*)(ws + W_NB), 1024, (const bf16_t*)(ws + W_WTGATE), 1024, 1024, pm * 256, pn * 256, ep);
        }
        if (!(bid & 1))
            for (int L = bid; L < 256; L += G)
                gemm_small((const bf16_t*)(ws + W_NB), 1024, (const bf16_t*)(ws + W_WTGATE), 1024, 1024, NPROMPT + (L >> 3) * 16, (L & 7) * 128, ep);
    }
#endif
    xcd_barrier(xb); TB();
    {
        const float* rss2 = (const float*)(ws + W_RSS2);
        for (int idx = bid * 512 + threadIdx.x; idx < NTOK * 256; idx += G * 512) {
            const int row = idx >> 8, c4 = (idx & 255) * 4;
            const f32x4 r0 = *(const f32x4*)(rss2 + (long)row * 16), r1 = *(const f32x4*)(rss2 + (long)row * 16 + 4), r2 = *(const f32x4*)(rss2 + (long)row * 16 + 8), r3 = *(const f32x4*)(rss2 + (long)row * 16 + 12);
            const float tot = (((r0[0] + r0[1]) + (r0[2] + r0[3])) + ((r1[0] + r1[1]) + (r1[2] + r1[3]))) + (((r2[0] + r2[1]) + (r2[2] + r2[3])) + ((r3[0] + r3[1]) + (r3[2] + r3[3])));
            const float rstd = rsqrtf(tot * (1.f / 1024.f) + EPS);
            f32x4* p = (f32x4*)(P.out + (long)row * 1024 + c4);
            const f32x4 gf = *(const f32x4*)(P.in[I_GFIN] + c4);
            *p = *p * rstd * gf;
        }
    }
#ifdef PROBE_K
    { TB(); const unsigned long long d = tb_[PROBE_K + 1] - tb_[PROBE_K], t0 = wall_clock64(); while (wall_clock64() - t0 < d) __builtin_amdgcn_s_sleep(8); }
#endif
}

extern "C" void kernel_launch(void* const* d_in, const int* in_sizes, int n_in, void* d_out, int out_size, void* d_ws, size_t ws_size, hipStream_t stream) {
    static int grid_blocks = 0;
    if (grid_blocks == 0) {
        if (n_in != 31 || out_size != (int)O_END || ws_size < W_END) {
            fprintf(stderr, "kernel_launch: unexpected shapes n_in %d out %d ws %zu (need %zu)\n", n_in, out_size, ws_size, (size_t)W_END);
            grid_blocks = -1; return;
        }
        int dev = 0, cus = 0, per_cu = 0;
        hipGetDevice(&dev);
        hipDeviceGetAttribute(&cus, hipDeviceAttributeMultiprocessorCount, dev);
        hipFuncSetAttribute((const void*)hymba_fwd, hipFuncAttributeMaxDynamicSharedMemorySize, LDS_BYTES);
        hipOccupancyMaxActiveBlocksPerMultiprocessor(&per_cu, (const void*)hymba_fwd, 512, LDS_BYTES);
        if (per_cu < 1) { fprintf(stderr, "kernel_launch: occupancy query says %d blocks/CU\n", per_cu); per_cu = 1; }
        grid_blocks = cus;
        (void)hipGetLastError();
    }
    if (grid_blocks < 0) return;
    if (hipMemsetAsync((char*)d_ws + W_BAR, 0, XCD_BAR_WORDS * sizeof(unsigned), stream) != hipSuccess) { fprintf(stderr, "kernel_launch: memset of the barrier words failed\n"); return; }
    Params p{};
    for (int i = 0; i < 31; ++i) p.in[i] = (const float*)d_in[i];
    p.out = (float*)d_out; p.ws = (char*)d_ws;
    void* args[] = {&p};
    hipError_t e = hipLaunchCooperativeKernel((const void*)hymba_fwd, dim3(grid_blocks), dim3(512), args, LDS_BYTES, stream);
    if (e != hipSuccess) fprintf(stderr, "cooperative launch failed: %s (grid %d)\n", hipGetErrorString(e), grid_blocks);
}
```
